# Optimizing an MI355X kernel written in HIP

```python
import math, functools
import jax, jax.numpy as jnp
from jax import lax
import numpy as np

D_MODEL = 1024
BATCH = 2
SEQ = 8192
DEPTH = 2
DEC_BATCH = 128
DEC_SEQ = 4
PAST_LEN = 2048
PAGE_SIZE = 128

N_BRANCH = 4
W_MIX = D_MODEL // 4
W_SSM = W_MIX
SSM_GROUP = 16
SSM_GROUPS = W_SSM // SSM_GROUP
SSM_P = 64
W_CONV = W_MIX
CONV_B_W = 3
GDN_H = 4
GDN_DK = W_MIX // GDN_H
GDN_DV = W_MIX // GDN_H
GDN_CONV = 4
GDN_CHUNK = 64
W_GDN_QKV = 2 * GDN_H * GDN_DK + GDN_H * GDN_DV
SB_H = 4
SB_DH = W_MIX // SB_H
SB_BLOCK = 128
D_FF = ((8 * D_MODEL + 3 * 256 - 1) // (3 * 256)) * 256
N_IN = W_SSM + 3 * W_CONV + W_GDN_QKV + GDN_H * GDN_DV + 2 * GDN_H + 3 * SB_H * SB_DH
ALPHA_DN = (2 * DEPTH) ** 0.25
BETA_DN = (8 * DEPTH) ** -0.25
LN_EPS = 1e-5
RMS_EPS = 1e-6

kernel_name = 'hybrid_gated_branch_decoder_step'


def layer_norm(x, g=None, b=None):
    xf = x.astype(jnp.float32)
    mu = jnp.mean(xf, axis=-1, keepdims=True)
    var = jnp.mean(jnp.square(xf - mu), axis=-1, keepdims=True)
    y = (xf - mu) * lax.rsqrt(var + LN_EPS)
    if g is not None:
        y = y * g.astype(jnp.float32) + b.astype(jnp.float32)
    return y.astype(x.dtype)


def l2norm(x):
    return x * lax.rsqrt(jnp.sum(jnp.square(x), axis=-1, keepdims=True) + RMS_EPS)


def causal_conv(u, w, buf):
    k_w = w.shape[0]
    L = u.shape[1]
    xc = jnp.concatenate([buf.astype(u.dtype), u], axis=1)
    out = xc[:, 0:L] * w[0]
    for i in range(1, k_w):
        out = out + xc[:, i:i + L] * w[i]
    return out, xc[:, L:]


def cmul(ar, ai, br, bi):
    return ar * br - ai * bi, ar * bi + ai * br


def s5_ssm(u, a_re, a_im, log_dt, b_re, b_im, c_re, c_im, d, h0_re, h0_im):
    f32 = jnp.float32
    bsz, L, _ = u.shape
    uf = u.astype(f32).reshape(bsz, L, SSM_GROUPS, SSM_GROUP)
    a_re = a_re.astype(f32)
    a_im = a_im.astype(f32)
    dt = jnp.exp(log_dt.astype(f32))[:, None]
    mag = jnp.exp(dt * a_re)
    ab_re = mag * jnp.cos(dt * a_im)
    ab_im = mag * jnp.sin(dt * a_im)
    den = a_re * a_re + a_im * a_im
    f_re = ((ab_re - 1.0) * a_re + ab_im * a_im) / den
    f_im = (ab_im * a_re - (ab_re - 1.0) * a_im) / den
    bb_re, bb_im = cmul(f_re[..., None], f_im[..., None], b_re.astype(f32), b_im.astype(f32))
    bu_re = jnp.einsum('blgh,gph->blgp', uf, bb_re)
    bu_im = jnp.einsum('blgh,gph->blgp', uf, bb_im)
    a_b_re = jnp.broadcast_to(ab_re, bu_re.shape)
    a_b_im = jnp.broadcast_to(ab_im, bu_re.shape)

    def combine(e1, e2):
        a1r, a1i, b1r, b1i = e1
        a2r, a2i, b2r, b2i = e2
        ar, ai = cmul(a2r, a2i, a1r, a1i)
        br, bi = cmul(a2r, a2i, b1r, b1i)
        return ar, ai, br + b2r, bi + b2i

    p_re, p_im, s_re, s_im = lax.associative_scan(combine, (a_b_re, a_b_im, bu_re, bu_im), axis=1)
    i_re, i_im = cmul(p_re, p_im, h0_re.astype(f32)[:, None], h0_im.astype(f32)[:, None])
    h_re = i_re + s_re
    h_im = i_im + s_im
    y = (jnp.einsum('blgp,ghp->blgh', h_re, c_re.astype(f32))
         - jnp.einsum('blgp,ghp->blgh', h_im, c_im.astype(f32))
         + d.astype(f32).reshape(SSM_GROUPS, SSM_GROUP) * uf)
    return y.reshape(bsz, L, W_SSM).astype(u.dtype), h_re[:, -1], h_im[:, -1]


def gated_delta_chunked(q, k, v, g, beta, s0):
    f32 = jnp.float32
    bsz, L, nh, dk = q.shape
    dv = v.shape[-1]
    cs = min(GDN_CHUNK, L)
    n_c = -(-L // cs)
    pad = n_c * cs - L

    def blocks(t):
        t = jnp.pad(t.astype(f32), [(0, 0), (0, pad)] + [(0, 0)] * (t.ndim - 2))
        t = t.reshape((bsz, n_c, cs) + t.shape[2:])
        return jnp.moveaxis(jnp.moveaxis(t, 1, 0), 2, 3)

    qb, kb, vb, gb, bb = blocks(q), blocks(k), blocks(v), blocks(g), blocks(beta)
    gc = jnp.cumsum(gb, axis=-1)
    idx = jnp.arange(cs)
    strict = idx[:, None] > idx[None, :]
    incl = idx[:, None] >= idx[None, :]
    diff = gc[..., :, None] - gc[..., None, :]
    dec_strict = jnp.where(strict, jnp.exp(jnp.where(strict, diff, 0.0)), 0.0)
    dec_incl = jnp.where(incl, jnp.exp(jnp.where(incl, diff, 0.0)), 0.0)
    m = bb[..., :, None] * jnp.einsum('nbhid,nbhjd->nbhij', kb, kb) * dec_strict
    egc = jnp.exp(gc)
    rhs = jnp.concatenate([bb[..., None] * vb, (bb * egc)[..., None] * kb], axis=-1)
    sol = lax.linalg.triangular_solve(m + jnp.eye(cs, dtype=f32), rhs, left_side=True, lower=True, unit_diagonal=True)
    u_v, w = sol[..., :dv], sol[..., dv:]
    qk = jnp.einsum('nbhid,nbhjd->nbhij', qb, kb) * dec_incl
    q_dec = qb * egc[..., None]
    g_last = gc[..., -1]
    k_dec = kb * jnp.exp(g_last[..., None] - gc)[..., None]

    def step(S, xs):
        u_v_c, w_c, q_c, qk_c, k_c, gl_c = xs
        u = u_v_c - jnp.einsum('bhik,bhkv->bhiv', w_c, S)
        o = jnp.einsum('bhik,bhkv->bhiv', q_c, S) + jnp.einsum('bhij,bhjv->bhiv', qk_c, u)
        S = jnp.exp(gl_c)[..., None, None] * S + jnp.einsum('bhik,bhiv->bhkv', k_c, u)
        return S, o

    s_fin, o = lax.scan(step, s0.astype(f32), (u_v, w, q_dec, qk, k_dec, g_last))
    o = jnp.moveaxis(jnp.moveaxis(o, 3, 2), 0, 1).reshape(bsz, n_c * cs, nh, dv)[:, :L]
    return o, s_fin


def stick_breaking(q, k, v, q_pos, k_pos):
    f32 = jnp.float32
    z = jnp.einsum('bqhd,bkhd->bhqk', q.astype(f32), k.astype(f32)) * (q.shape[-1] ** -0.5)
    causal = k_pos[None, :] < q_pos[:, None]
    log_neg = jnp.where(causal, jax.nn.log_sigmoid(-z), 0.0)
    csum = jnp.cumsum(log_neg, axis=-1)
    log_w = jax.nn.log_sigmoid(z) + csum[..., -1:] - csum
    wts = jnp.where(causal, jnp.exp(log_w), 0.0)
    return jnp.einsum('bhqk,bkhd->bqhd', wts, v.astype(f32)).astype(v.dtype)


def sb_prompt(q, k, v):
    bsz, L, nh, dh = q.shape
    nb = L // SB_BLOCK
    qb = jnp.moveaxis(q.reshape(bsz, nb, SB_BLOCK, nh, dh), 1, 0)
    k_pos = jnp.arange(L)

    def blk(args):
        qi, i = args
        q_pos = i * SB_BLOCK + jnp.arange(SB_BLOCK)
        return stick_breaking(qi, k, v, q_pos, k_pos)

    o = lax.map(blk, (qb, jnp.arange(nb)))
    return jnp.moveaxis(o, 0, 1).reshape(bsz, L, nh, dh)


def sb_sample(q, k, v, k_past, v_past):
    past = k_past.shape[1]
    t_new = q.shape[1]
    kk = jnp.concatenate([k_past.astype(k.dtype), k], axis=1)
    vv = jnp.concatenate([v_past.astype(v.dtype), v], axis=1)
    q_pos = past + jnp.arange(t_new)
    k_pos = jnp.arange(past + t_new)
    return stick_breaking(q, kk, vv, q_pos, k_pos)


def decoder_layer(x, c, p, st, attend):
    f32 = jnp.float32
    h0_re, h0_im, convb_buf, s0, convd_buf = st
    bsz, L, _ = x.shape
    mod = (jax.nn.silu(c) @ p['w_ada'] + p['b_ada'])[:, None, :]
    sh1, sc1, g1, sh2, sc2, g2 = jnp.split(mod, 6, axis=-1)
    h = layer_norm(x) * (1.0 + sc1) + sh1

    proj = h @ p['w_in']
    o = 0
    u_ssm = proj[..., o:o + W_SSM]; o += W_SSM
    b_g = proj[..., o:o + W_CONV]; o += W_CONV
    c_g = proj[..., o:o + W_CONV]; o += W_CONV
    x_c = proj[..., o:o + W_CONV]; o += W_CONV
    qkv_g = proj[..., o:o + W_GDN_QKV]; o += W_GDN_QKV
    z_g = proj[..., o:o + GDN_H * GDN_DV]; o += GDN_H * GDN_DV
    beta_logit = proj[..., o:o + GDN_H]; o += GDN_H
    a_logit = proj[..., o:o + GDN_H]; o += GDN_H
    q_sb = proj[..., o:o + SB_H * SB_DH].reshape(bsz, L, SB_H, SB_DH); o += SB_H * SB_DH
    k_sb = proj[..., o:o + SB_H * SB_DH].reshape(bsz, L, SB_H, SB_DH); o += SB_H * SB_DH
    v_sb = proj[..., o:o + SB_H * SB_DH].reshape(bsz, L, SB_H, SB_DH)

    y_s, h_re, h_im = s5_ssm(u_ssm, p['ssm_a_re'], p['ssm_a_im'], p['ssm_log_dt'], p['ssm_b_re'], p['ssm_b_im'],
                             p['ssm_c_re'], p['ssm_c_im'], p['ssm_d'], h0_re, h0_im)
    y_s = jax.nn.gelu(y_s)
    y_a = y_s * jax.nn.sigmoid(y_s @ p['w_glu'])

    conv_out, convb_new = causal_conv(c_g * x_c, p['conv_b_w'], convb_buf)
    y_b = b_g * conv_out

    qkv_c, convd_new = causal_conv(qkv_g, p['delta_conv_w'], convd_buf)
    qkv_c = jax.nn.silu(qkv_c.astype(f32))
    qd = l2norm(qkv_c[..., :GDN_H * GDN_DK].reshape(bsz, L, GDN_H, GDN_DK)) * (GDN_DK ** -0.5)
    kd = l2norm(qkv_c[..., GDN_H * GDN_DK:2 * GDN_H * GDN_DK].reshape(bsz, L, GDN_H, GDN_DK))
    vd = qkv_c[..., 2 * GDN_H * GDN_DK:].reshape(bsz, L, GDN_H, GDN_DV)
    beta_d = jax.nn.sigmoid(beta_logit.astype(f32))
    g_d = -jnp.exp(p['delta_a_log'].astype(f32)) * jax.nn.softplus(a_logit.astype(f32) + p['delta_dt_bias'].astype(f32))
    o_d, s_new = gated_delta_chunked(qd, kd, vd, g_d, beta_d, s0)
    o_d = (o_d * lax.rsqrt(jnp.mean(jnp.square(o_d), axis=-1, keepdims=True) + RMS_EPS)
           * p['delta_norm_w'].astype(f32) * jax.nn.silu(z_g.astype(f32).reshape(bsz, L, GDN_H, GDN_DV)))
    y_c = o_d.reshape(bsz, L, W_MIX).astype(x.dtype)

    y_d = attend(q_sb, k_sb, v_sb).reshape(bsz, L, W_MIX)

    branches = jnp.stack([y_a, y_b, y_c, y_d], axis=2)
    br = jnp.einsum('blnw,nwd->blnd', branches, p['w_branch'])
    gates = jax.nn.sigmoid(h @ p['w_gate']).reshape(bsz, L, N_BRANCH, D_MODEL)
    mixed = jnp.sum(gates * br, axis=2) @ p['w_o']
    x = layer_norm(ALPHA_DN * x + (1.0 + g1) * mixed, p['ln1_g'], p['ln1_b'])

    h2 = layer_norm(x) * (1.0 + sc2) + sh2
    up_a, up_b = jnp.split(h2 @ p['w_ffn_up'], 2, axis=-1)
    ffn = (jax.nn.silu(up_a) * up_b) @ p['w_ffn_down']
    x = layer_norm(ALPHA_DN * x + (1.0 + g2) * ffn, p['ln2_g'], p['ln2_b'])
    return x, (k_sb, v_sb, h_re, h_im, convb_new, s_new, convd_new)


def setup_inputs(seed: int = 0) -> dict:
    key = jax.random.key(seed)
    ks = iter(jax.random.split(key, 48))
    nxt = lambda: next(ks)
    f32 = jnp.float32
    n_pages = PAST_LEN // PAGE_SIZE
    n_used = DEC_BATCH * n_pages
    n_pool = n_used + max(1, n_used // 4)
    nrm = lambda shape, s: jax.random.normal(nxt(), shape, f32) * s

    x_prompt = nrm((BATCH, SEQ, D_MODEL), 1.0)
    x_sample = nrm((DEC_BATCH, DEC_SEQ, D_MODEL), 1.0)
    cache_k = nrm((DEPTH, n_pool, PAGE_SIZE, SB_H, SB_DH), 1.0)
    cache_v = nrm((DEPTH, n_pool, PAGE_SIZE, SB_H, SB_DH), 1.0)
    state_ssm_re = nrm((DEPTH, DEC_BATCH, SSM_GROUPS, SSM_P), 0.5)
    state_ssm_im = nrm((DEPTH, DEC_BATCH, SSM_GROUPS, SSM_P), 0.5)
    state_conv_b = nrm((DEPTH, DEC_BATCH, CONV_B_W - 1, W_CONV), 1.0)
    state_delta = nrm((DEPTH, DEC_BATCH, GDN_H, GDN_DK, GDN_DV), 0.1)
    state_conv_delta = nrm((DEPTH, DEC_BATCH, GDN_CONV - 1, W_GDN_QKV), 1.0)
    page_table = jax.random.permutation(nxt(), n_pool)[:n_used].reshape(DEC_BATCH, n_pages).astype(jnp.int32)
    c_prompt = nrm((BATCH, D_MODEL), 1.0)
    c_sample = nrm((DEC_BATCH, D_MODEL), 1.0)

    w_ada = nrm((DEPTH, D_MODEL, 6 * D_MODEL), 0.2 * D_MODEL ** -0.5)
    b_ada = nrm((DEPTH, 6 * D_MODEL), 0.01)
    w_in = nrm((DEPTH, D_MODEL, N_IN), D_MODEL ** -0.5)
    ssm_a_re = -0.5 + nrm((DEPTH, SSM_GROUPS, SSM_P), 0.01)
    ssm_a_im = jnp.pi * jnp.arange(SSM_P, dtype=f32) + nrm((DEPTH, SSM_GROUPS, SSM_P), 0.01)
    ssm_log_dt = jax.random.uniform(nxt(), (DEPTH, SSM_GROUPS), f32, math.log(1e-3), math.log(1e-1))
    ssm_b_re = nrm((DEPTH, SSM_GROUPS, SSM_P, SSM_GROUP), (2 * SSM_GROUP) ** -0.5)
    ssm_b_im = nrm((DEPTH, SSM_GROUPS, SSM_P, SSM_GROUP), (2 * SSM_GROUP) ** -0.5)
    ssm_c_re = nrm((DEPTH, SSM_GROUPS, SSM_GROUP, SSM_P), (2 * SSM_P) ** -0.5)
    ssm_c_im = nrm((DEPTH, SSM_GROUPS, SSM_GROUP, SSM_P), (2 * SSM_P) ** -0.5)
    ssm_d = nrm((DEPTH, W_SSM), 1.0)
    w_glu = nrm((DEPTH, W_SSM, W_SSM), W_SSM ** -0.5)
    conv_b_w = nrm((DEPTH, CONV_B_W, W_CONV), CONV_B_W ** -0.5)
    delta_conv_w = nrm((DEPTH, GDN_CONV, W_GDN_QKV), GDN_CONV ** -0.5)
    delta_a_log = jnp.log(jax.random.uniform(nxt(), (DEPTH, GDN_H), f32, 1.0, 16.0))
    dt0 = jnp.exp(jax.random.uniform(nxt(), (DEPTH, GDN_H), f32, math.log(1e-3), math.log(1e-1)))
    delta_dt_bias = jnp.log(jnp.expm1(dt0))
    delta_norm_w = 1.0 + nrm((DEPTH, GDN_DV), 0.01)
    w_branch = nrm((DEPTH, N_BRANCH, W_MIX, D_MODEL), W_MIX ** -0.5)
    w_gate = nrm((DEPTH, D_MODEL, N_BRANCH * D_MODEL), D_MODEL ** -0.5)
    w_o = nrm((DEPTH, D_MODEL, D_MODEL), BETA_DN * D_MODEL ** -0.5)
    ln1_g = 1.0 + nrm((DEPTH, D_MODEL), 0.01)
    ln1_b = nrm((DEPTH, D_MODEL), 0.01)
    w_ffn_up = nrm((DEPTH, D_MODEL, 2 * D_FF), D_MODEL ** -0.5)
    w_ffn_down = nrm((DEPTH, D_FF, D_MODEL), BETA_DN * D_FF ** -0.5)
    ln2_g = 1.0 + nrm((DEPTH, D_MODEL), 0.01)
    ln2_b = nrm((DEPTH, D_MODEL), 0.01)
    return {'x_prompt': x_prompt, 'x_sample': x_sample, 'cache_k': cache_k, 'cache_v': cache_v,
            'state_ssm_re': state_ssm_re, 'state_ssm_im': state_ssm_im, 'state_conv_b': state_conv_b,
            'state_delta': state_delta, 'state_conv_delta': state_conv_delta, 'page_table': page_table,
            'c_prompt': c_prompt, 'c_sample': c_sample, 'w_ada': w_ada, 'b_ada': b_ada, 'w_in': w_in,
            'ssm_a_re': ssm_a_re, 'ssm_a_im': ssm_a_im, 'ssm_log_dt': ssm_log_dt, 'ssm_b_re': ssm_b_re,
            'ssm_b_im': ssm_b_im, 'ssm_c_re': ssm_c_re, 'ssm_c_im': ssm_c_im, 'ssm_d': ssm_d, 'w_glu': w_glu,
            'conv_b_w': conv_b_w, 'delta_conv_w': delta_conv_w, 'delta_a_log': delta_a_log,
            'delta_dt_bias': delta_dt_bias, 'delta_norm_w': delta_norm_w, 'w_branch': w_branch, 'w_gate': w_gate,
            'w_o': w_o, 'ln1_g': ln1_g, 'ln1_b': ln1_b, 'w_ffn_up': w_ffn_up, 'w_ffn_down': w_ffn_down,
            'ln2_g': ln2_g, 'ln2_b': ln2_b}


def reference(x_prompt, x_sample, cache_k, cache_v, state_ssm_re, state_ssm_im, state_conv_b, state_delta,
              state_conv_delta, page_table, c_prompt, c_sample, w_ada, b_ada, w_in, ssm_a_re, ssm_a_im, ssm_log_dt,
              ssm_b_re, ssm_b_im, ssm_c_re, ssm_c_im, ssm_d, w_glu, conv_b_w, delta_conv_w, delta_a_log,
              delta_dt_bias, delta_norm_w, w_branch, w_gate, w_o, ln1_g, ln1_b, w_ffn_up, w_ffn_down, ln2_g, ln2_b):
    bp = x_prompt.shape[0]
    bs = x_sample.shape[0]
    dt_p = x_prompt.dtype
    x_p, x_s = x_prompt, x_sample
    prompt_new, sample_new = [], []
    for l in range(DEPTH):
        p = {'w_ada': w_ada[l], 'b_ada': b_ada[l], 'w_in': w_in[l], 'ssm_a_re': ssm_a_re[l], 'ssm_a_im': ssm_a_im[l],
             'ssm_log_dt': ssm_log_dt[l], 'ssm_b_re': ssm_b_re[l], 'ssm_b_im': ssm_b_im[l], 'ssm_c_re': ssm_c_re[l],
             'ssm_c_im': ssm_c_im[l], 'ssm_d': ssm_d[l], 'w_glu': w_glu[l], 'conv_b_w': conv_b_w[l],
             'delta_conv_w': delta_conv_w[l], 'delta_a_log': delta_a_log[l], 'delta_dt_bias': delta_dt_bias[l],
             'delta_norm_w': delta_norm_w[l], 'w_branch': w_branch[l], 'w_gate': w_gate[l], 'w_o': w_o[l],
             'ln1_g': ln1_g[l], 'ln1_b': ln1_b[l], 'w_ffn_up': w_ffn_up[l], 'w_ffn_down': w_ffn_down[l],
             'ln2_g': ln2_g[l], 'ln2_b': ln2_b[l]}
        st_p = (jnp.zeros((bp, SSM_GROUPS, SSM_P), dt_p), jnp.zeros((bp, SSM_GROUPS, SSM_P), dt_p),
                jnp.zeros((bp, CONV_B_W - 1, W_CONV), dt_p), jnp.zeros((bp, GDN_H, GDN_DK, GDN_DV), dt_p),
                jnp.zeros((bp, GDN_CONV - 1, W_GDN_QKV), dt_p))
        x_p, new_p = decoder_layer(x_p, c_prompt, p, st_p, sb_prompt)
        prompt_new.append(new_p)
        k_past = cache_k[l][page_table].reshape(bs, -1, SB_H, SB_DH)
        v_past = cache_v[l][page_table].reshape(bs, -1, SB_H, SB_DH)
        attend_s = functools.partial(sb_sample, k_past=k_past, v_past=v_past)
        st_s = (state_ssm_re[l], state_ssm_im[l], state_conv_b[l], state_delta[l], state_conv_delta[l])
        x_s, new_s = decoder_layer(x_s, c_sample, p, st_s, attend_s)
        sample_new.append(new_s)
    k_p, v_p, re_p, im_p, cb_p, d_p, cd_p = [jnp.stack(t, axis=0) for t in zip(*prompt_new)]
    k_s, v_s, re_s, im_s, cb_s, d_s, cd_s = [jnp.stack(t, axis=0) for t in zip(*sample_new)]
    return (x_p, x_s, k_p, v_p, k_s, v_s, re_p, im_p, re_s, im_s, cb_p, cb_s, d_p, d_s, cd_p, cd_s)
```

```cpp
#ifndef CPU_EMU
#include <hip/hip_runtime.h>
#endif
#include <cstdio>
#include <cstdint>
#include <cmath>

constexpr int D = 1024, NB = 2, DEPTH = 2, DEC_SEQ = 4, PAGE = 128;
#ifdef CPU_EMU
#ifndef EMU_SEQ
#define EMU_SEQ 512
#endif
#ifndef EMU_DB
#define EMU_DB 64
#endif
#ifndef EMU_PAST
#define EMU_PAST 512
#endif
constexpr int SEQ = EMU_SEQ, DB = EMU_DB, PAST = EMU_PAST;
#else
constexpr int SEQ = 8192, DB = 128, PAST = 2048;
#endif
constexpr int NPAGES = PAST / PAGE, NUSED = DB * NPAGES, NPOOL = NUSED + (NUSED / 4 > 1 ? NUSED / 4 : 1);
constexpr int MP = NB * SEQ, MS = DB * DEC_SEQ, M = MP + MS, NSEQ = NB + DB;
constexpr int WMIX = 256, NPROJ = 2816, NIN = 2824, NGATE = 4096, N1 = NPROJ + NGATE, DFF = 2816, NUP = 2 * DFF, NMOD = 6 * D;
constexpr int SSM_G = 16, SSM_P = 64, SSM_CH = 128, SSM_NCH = SEQ / SSM_CH;
constexpr int GH = 4, GDK = 64, GCH = 64, GNCH = SEQ / GCH, GQKV = 768;
constexpr int SBH = 4;
constexpr int PC_U = 0, PC_BG = 256, PC_CG = 512, PC_XC = 768, PC_QKV = 1024, PC_Z = 1792, PC_Q = 2048, PC_K = 2304, PC_V = 2560;
constexpr float LN_EPS = 1e-5f, RMS_EPS = 1e-6f, ALPHA = 1.41421356237309515f  ;
static_assert(M % 256 == 0 && MP % 256 == 0 && SEQ % 256 == 0 && NSEQ <= 256, "tile shapes");
constexpr size_t O_Y = 0, O_KP = (size_t)M * D, O_VP = O_KP + (size_t)DEPTH * MP * 256, O_KS = O_VP + (size_t)DEPTH * MP * 256, O_VS = O_KS + (size_t)DEPTH * MS * 256,
    O_REP = O_VS + (size_t)DEPTH * MS * 256, O_IMP = O_REP + DEPTH * NB * 1024, O_RES = O_IMP + DEPTH * NB * 1024, O_IMS = O_RES + (size_t)DEPTH * DB * 1024,
    O_CBP = O_IMS + (size_t)DEPTH * DB * 1024, O_CBS = O_CBP + DEPTH * NB * 512, O_DP = O_CBS + (size_t)DEPTH * DB * 512, O_DS = O_DP + (size_t)DEPTH * NB * 16384,
    O_CDP = O_DS + (size_t)DEPTH * DB * 16384, O_CDS = O_CDP + DEPTH * NB * 2304, O_END = O_CDS + (size_t)DEPTH * DB * 2304;

constexpr size_t MiB = 1u << 20;
constexpr size_t al(size_t x) { return (x + 4095) & ~(size_t)4095; }
constexpr size_t WS_CTL = 0, CTL_ZERO_BYTES = 1 * MiB;
constexpr size_t WL_ADA = 0, WL_W1 = WL_ADA + (size_t)NMOD * D * 2, WL_GLU = WL_W1 + (size_t)N1 * D * 2, WL_BR = WL_GLU + 256 * 256 * 2, WL_WO = WL_BR + (size_t)4 * D * 256 * 2,
    WL_UP = WL_WO + (size_t)D * D * 2, WL_DN = WL_UP + (size_t)NUP * D * 2, WL_LOG = WL_DN + (size_t)D * DFF * 2, WL_SIZE = (WL_LOG + 8 * D * 4 + 524287) & ~(size_t)524287;
constexpr size_t WS_W = 1 * MiB, WS_CSILU = WS_W + DEPTH * WL_SIZE, WS_MOD = WS_CSILU + 256 * D * 2, WS_H = WS_MOD + (size_t)DEPTH * 256 * NMOD * 4,
    WS_PROJ = WS_H + (size_t)M * D * 2, WS_GATE = al(WS_PROJ + (size_t)M * NPROJ * 2), WS_LOG8 = WS_GATE + (size_t)M * NGATE * 2, WS_Y = WS_LOG8 + (size_t)M * 8 * 4,
    WS_YS = WS_Y + (size_t)M * D * 2, WS_MERGE = WS_YS + (size_t)M * 256 * 2, WS_MERGEB = WS_MERGE + (size_t)M * D * 4, WS_X1 = WS_MERGEB + (size_t)M * D * 2,
    WS_ACT = WS_X1 + (size_t)M * D * 4, WS_X2 = al(WS_ACT + (size_t)M * DFF * 2), WS_SEND = WS_X2 + (size_t)M * D * 4, WS_HIN = WS_SEND + (size_t)NB * 16 * SSM_NCH * 128 * 4,
    WS_GD = WS_HIN + (size_t)NB * 16 * SSM_NCH * 128 * 4, WS_EGL = WS_GD + (size_t)NB * GH * GNCH * 5 * 4096 * 4, WS_ODRAW = al(WS_EGL + (size_t)NB * GH * GNCH * 4),
    WS_END = WS_ODRAW + (size_t)M * 256 * 4;
constexpr int CW_TMO = 0, CW_BAR = 4096;

#define LAS_HW __attribute__((address_space(3)))
#ifdef CPU_EMU
#define LAS
#else
#define LAS LAS_HW
#endif
typedef unsigned short bf16;
typedef unsigned v4u __attribute__((ext_vector_type(4)));
typedef unsigned v2u __attribute__((ext_vector_type(2)));
typedef float f32x4 __attribute__((ext_vector_type(4)));
typedef float f32x2 __attribute__((ext_vector_type(2)));
typedef short bf16x8 __attribute__((ext_vector_type(8)));
#ifdef CPU_EMU
#define LDS_WAIT() do {} while (0)
#define VM_WAIT() do {} while (0)
#define WAVE_SYNC() emu::wave_sync()
#define CFENCE() do {} while (0)
#else
#define LDS_WAIT() asm volatile("s_waitcnt lgkmcnt(0)" ::: "memory")
#define VM_WAIT() asm volatile("s_waitcnt vmcnt(0)" ::: "memory")
#define WAVE_SYNC() do { asm volatile("s_waitcnt lgkmcnt(0)" ::: "memory"); __builtin_amdgcn_wave_barrier(); } while (0)
#define CFENCE() asm volatile("" ::: "memory")
#endif
#ifdef CPU_EMU
#define OPAQUE_V(x) do {} while (0)
#else
#define OPAQUE_V(x) asm volatile("" : "+v"(x))
#endif
__device__ __forceinline__ unsigned f2bf(float f) { unsigned u = __builtin_bit_cast(unsigned, f); return (u + 0x7fffu + ((u >> 16) & 1u)) >> 16; }
__device__ __forceinline__ unsigned pk2(float lo, float hi) { return f2bf(lo) | (f2bf(hi) << 16); }
__device__ __forceinline__ float bf2f(unsigned b) { return __builtin_bit_cast(float, b << 16); }
__device__ __forceinline__ float bflo(unsigned w) { return __builtin_bit_cast(float, w << 16); }
__device__ __forceinline__ float bfhi(unsigned w) { return __builtin_bit_cast(float, w & 0xffff0000u); }
__device__ __forceinline__ float sigmoidf_(float x) { return 1.0f / (1.0f + __expf(-x)); }
__device__ __forceinline__ float siluf_(float x) { return x / (1.0f + __expf(-x)); }
__device__ __forceinline__ float wave_sum(float v) {
#pragma unroll
    for (int o = 1; o < 64; o <<= 1) v += __shfl_xor(v, o);
    return v;
}
__device__ __forceinline__ int seq_of(int m) { return m < MP ? m / SEQ : NB + (m - MP) / DEC_SEQ; }
namespace pg8 {
typedef unsigned short bf16_t;
constexpr int BM = 256, BK = 64, HALF = 128, HTB = HALF * BK * 2, STAGE_BYTES = 8 * HTB, NXCD = 8, WGM = 8;
__host__ __device__ __forceinline__ int lds_byte(int r, int c) { const int st = (r >> 4) * 2 + (c >> 5), rr = r & 15, cc = c & 31, ob = rr * 64 + cc * 2; return st * 1024 + (ob ^ (((ob >> 9) & 1) << 5)); }
__host__ __device__ __forceinline__ void stage_rc(int b, int& R, int& C) { const int st = b / 1024, sb = b % 1024, swz = sb ^ (((sb >> 9) & 1) << 5); R = (st >> 1) * 16 + swz / 64; C = (st & 1) * 32 + (swz % 64) / 2; }
__host__ __device__ __forceinline__ int perm32(int rho) { const int n = rho >> 4, i = rho & 15; return 8 * (i >> 2) + 4 * n + (i & 3); }
struct Unit { int pm, pn, ka, aux; };
struct Gemm { const bf16_t* A; const bf16_t* Bt; int lda, K; };
struct GridOrder {
    int nM, nN, nwg, G, c, pn0;
    __host__ __device__ void init(int nM_, int nN_, int G_, int c_, int pn0_ = 0) { nM = nM_; nN = nN_; nwg = nM * nN; G = G_; c = c_; pn0 = pn0_; }
    __host__ __device__ bool tile(long L, int& pm, int& pn) const {
        if (L >= nwg) return false;
        int wgid = (int)L; { const int q = nwg / NXCD, r = nwg % NXCD, xcd = wgid % NXCD, off = wgid / NXCD; wgid = (xcd < r ? xcd * (q + 1) : r * (q + 1) + (xcd - r) * q) + off; }
        const int nig = WGM * nN, gid = wgid / nig, fm = gid * WGM, gsz = (nM - fm) < WGM ? (nM - fm) : WGM;
        pm = fm + ((wgid % nig) % gsz); pn = (wgid % nig) / gsz; return true;
    }
    __host__ __device__ bool next(int i, Unit& u) const { int pm, pn; if (!tile((long)i * G + c, pm, pn)) return false; u.pm = pm; u.pn = pn0 + pn; u.ka = 0; u.aux = pn; return true; }
    __device__ __forceinline__ void a_ready(const Unit&) const {}
    __device__ __forceinline__ void done(const Unit&) const {}
};
struct MergeOrder : GridOrder {
    __host__ __device__ bool next(int i, Unit& u) const { int pm, pc; if (!tile((long)(i >> 2) * G + c, pm, pc)) return false; const int n = i & 3; u.pm = pm; u.pn = 4 * n + pc; u.ka = 256 * n; u.aux = (n << 8) | pc; return true; }
};
#ifndef CPU_EMU
#define PG8_LAS __attribute__((address_space(3)))
template <class Epi, class Sched, bool ALIGN_EPI = false, bool SP2 = false>
__device__ __forceinline__ void gemm_phase(PG8_LAS unsigned char* lds, const Gemm g, const Sched& S, const Epi& E) {
    int tid = threadIdx.x; asm volatile("" : "+v"(tid));
    const int wid = __builtin_amdgcn_readfirstlane(tid >> 6), lane = tid & 63, wr = wid >> 2, wc = wid & 3, fr = lane & 15, fq = lane >> 4;
    int K = g.K; asm volatile("" : "+s"(K));
    const int nt = K / BK, lda = g.lda;
    unsigned voffA[2], voffB[2];
#pragma unroll
    for (int i = 0; i < 2; ++i) { int R, C; stage_rc(tid * 16 + i * 8192, R, C); const int Rb = Epi::PERM ? ((R & ~31) + perm32(R & 31)) : R;
        voffA[i] = (unsigned)(R * lda + C) * 2u; voffB[i] = (unsigned)(Rb * K + C) * 2u; }
    const size_t kstep = (size_t)(BK * 2);
    const size_t hstepA = (size_t)HALF * lda * 2, hstepB = (size_t)HALF * K * 2;
    const size_t tstepA = 2 * hstepA, tstepB = 2 * hstepB;
    const unsigned ldsw = (unsigned)wid * 1024u;
    const int aoff = lds_byte(wr * 64 + fr, fq * 8), boff = lds_byte(wc * 32 + fr, fq * 8);
#define PG8_SA(b, h) (((b) * 2 + (h)) * HTB)
#define PG8_SB(b, h) ((4 + (b) * 2 + (h)) * HTB)
#define PG8_STAGE(bufoff, gbase, voff) do { _Pragma("unroll") for (int _i = 0; _i < 2; ++_i) \
        __builtin_amdgcn_global_load_lds((const unsigned*)((const char*)(gbase) + (voff)[_i]), (PG8_LAS unsigned*)(lds + (bufoff) + ldsw + _i * 8192), 16, 0, 0); } while (0)
#define PG8_LDA(dst, b, h) do { _Pragma("unroll") for (int m = 0; m < 4; ++m) _Pragma("unroll") for (int k = 0; k < 2; ++k) dst[m][k] = *(const PG8_LAS bf16x8*)(lds + PG8_SA(b, h) + aoff + m * 2048 + k * 1024); } while (0)
#define PG8_LDB(dst, b, h) do { _Pragma("unroll") for (int n = 0; n < 2; ++n) _Pragma("unroll") for (int k = 0; k < 2; ++k) dst[n][k] = *(const PG8_LAS bf16x8*)(lds + PG8_SB(b, h) + boff + n * 2048 + k * 1024); } while (0)
#define PG8_MMA(ai, bj, At, Bt) do { __builtin_amdgcn_s_setprio(1); _Pragma("unroll") for (int m = 0; m < 4; ++m) _Pragma("unroll") for (int n = 0; n < 2; ++n) _Pragma("unroll") for (int k = 0; k < 2; ++k) \
        acc[ai][bj][m][n] = __builtin_amdgcn_mfma_f32_16x16x32_bf16(Bt[n][k], At[m][k], acc[ai][bj][m][n], 0, 0, 0); __builtin_amdgcn_s_setprio(0); } while (0)
#define PG8_WAIT_V(n) asm volatile("s_waitcnt vmcnt(" #n ")" ::: "memory")
#define PG8_WAIT_L(n) asm volatile("s_waitcnt lgkmcnt(" #n ")" ::: "memory")
#define PG8_BAR __builtin_amdgcn_s_barrier()
#define PG8_SCHED __builtin_amdgcn_sched_barrier(0)
    Unit cur, nxt; int ui = 0;
    if (!S.next(0, cur)) return;
    f32x4 acc[2][2][4][2];
#pragma unroll
    for (int a = 0; a < 2; ++a)
#pragma unroll
        for (int b = 0; b < 2; ++b)
#pragma unroll
            for (int m = 0; m < 4; ++m)
#pragma unroll
                for (int n = 0; n < 2; ++n) acc[a][b][m][n] = (f32x4){0.f, 0.f, 0.f, 0.f};
    bf16x8 At[4][2], B0[2][2], B1[2][2];
    const char* cA = (const char*)g.A + (size_t)cur.pm * tstepA + (size_t)cur.ka * 2; const char* cB = (const char*)g.Bt + (size_t)cur.pn * tstepB;
    S.a_ready(cur);
    if constexpr (SP2) {
        PG8_STAGE(PG8_SB(0, 0), cB, voffB); PG8_STAGE(PG8_SB(0, 1), cB + hstepB, voffB); PG8_STAGE(PG8_SA(0, 0), cA, voffA); PG8_STAGE(PG8_SA(0, 1), cA + hstepA, voffA);
        if (wr == 1) PG8_BAR;
        PG8_WAIT_V(2); PG8_BAR;
        PG8_STAGE(PG8_SB(1, 0), cB + kstep, voffB); PG8_STAGE(PG8_SA(1, 0), cA + kstep, voffA); PG8_STAGE(PG8_SB(1, 1), cB + hstepB + kstep, voffB);
        PG8_WAIT_V(6); PG8_BAR;
    } else {
        PG8_STAGE(PG8_SB(0, 0), cB, voffB); PG8_STAGE(PG8_SA(0, 0), cA, voffA); PG8_STAGE(PG8_SB(0, 1), cB + hstepB, voffB); PG8_STAGE(PG8_SA(0, 1), cA + hstepA, voffA);
        if (wr == 1) PG8_BAR;
        PG8_WAIT_V(4); PG8_BAR;
        PG8_STAGE(PG8_SB(1, 0), cB + kstep, voffB); PG8_STAGE(PG8_SA(1, 0), cA + kstep, voffA); PG8_STAGE(PG8_SB(1, 1), cB + hstepB + kstep, voffB);
        PG8_WAIT_V(6); PG8_BAR;
    }
    for (;;) {
        const bool has_next = S.next(ui + 1, nxt);
        const char* nA = has_next ? (const char*)g.A + (size_t)nxt.pm * tstepA + (size_t)nxt.ka * 2 : cA; const char* nB = has_next ? (const char*)g.Bt + (size_t)nxt.pn * tstepB : cB;
        for (int t = 0; t < nt; t += 2) {
            const bool last = (t == nt - 2);
            const char* a1 = cA + (size_t)(t + 1) * kstep;
            const char* a2 = last ? nA : cA + (size_t)(t + 2) * kstep; const char* b2 = last ? nB : cB + (size_t)(t + 2) * kstep;
            const char* a3 = a2 + kstep; const char* b3 = b2 + kstep;
            if (last && has_next) S.a_ready(nxt);
            if constexpr (SP2) {
            PG8_LDB(B0, 0, 0); PG8_LDB(B1, 0, 1); PG8_SCHED; PG8_LDA(At, 0, 0); PG8_STAGE(PG8_SA(1, 1), a1 + hstepA, voffA);
            PG8_WAIT_V(8); PG8_WAIT_L(0); PG8_BAR; PG8_MMA(0, 0, At, B0); PG8_MMA(0, 1, At, B1); PG8_BAR; PG8_SCHED;
            PG8_LDA(At, 0, 1); PG8_STAGE(PG8_SB(0, 0), b2, voffB); PG8_STAGE(PG8_SB(0, 1), b2 + hstepB, voffB); PG8_STAGE(PG8_SA(0, 0), a2, voffA);
            PG8_WAIT_V(8); PG8_WAIT_L(0); PG8_BAR; PG8_MMA(1, 0, At, B0); PG8_MMA(1, 1, At, B1); PG8_BAR; PG8_SCHED;
            PG8_LDB(B0, 1, 0); PG8_LDB(B1, 1, 1); PG8_SCHED; PG8_LDA(At, 1, 0); PG8_STAGE(PG8_SA(0, 1), a2 + hstepA, voffA);
            PG8_WAIT_V(8); PG8_WAIT_L(0); PG8_BAR; PG8_MMA(0, 0, At, B0); PG8_MMA(0, 1, At, B1); PG8_BAR; PG8_SCHED;
            PG8_LDA(At, 1, 1); PG8_STAGE(PG8_SB(1, 0), b3, voffB); PG8_STAGE(PG8_SB(1, 1), b3 + hstepB, voffB); PG8_STAGE(PG8_SA(1, 0), a3, voffA);
            PG8_WAIT_V(8); PG8_WAIT_L(0); PG8_BAR; PG8_MMA(1, 0, At, B0); PG8_MMA(1, 1, At, B1); PG8_BAR; PG8_SCHED;
            } else {
            PG8_LDB(B0, 0, 0); PG8_SCHED; PG8_LDA(At, 0, 0); PG8_STAGE(PG8_SA(1, 1), a1 + hstepA, voffA);
            PG8_WAIT_L(8); PG8_BAR; PG8_WAIT_L(0); PG8_MMA(0, 0, At, B0); PG8_BAR; PG8_SCHED;
            PG8_LDB(B1, 0, 1); PG8_STAGE(PG8_SB(0, 0), b2, voffB);
            PG8_BAR; PG8_WAIT_L(0); PG8_MMA(0, 1, At, B1); PG8_BAR;
            PG8_LDA(At, 0, 1); PG8_STAGE(PG8_SA(0, 0), a2, voffA);
            PG8_BAR; PG8_WAIT_L(0); PG8_MMA(1, 0, At, B0); PG8_BAR; PG8_SCHED;
            PG8_STAGE(PG8_SB(0, 1), b2 + hstepB, voffB);
            PG8_WAIT_V(6); PG8_BAR; PG8_MMA(1, 1, At, B1); PG8_BAR;
            PG8_LDB(B0, 1, 0); PG8_SCHED; PG8_LDA(At, 1, 0); PG8_STAGE(PG8_SA(0, 1), a2 + hstepA, voffA);
            PG8_WAIT_L(8); PG8_BAR; PG8_WAIT_L(0); PG8_MMA(0, 0, At, B0); PG8_BAR; PG8_SCHED;
            PG8_LDB(B1, 1, 1); PG8_STAGE(PG8_SB(1, 0), b3, voffB);
            PG8_BAR; PG8_WAIT_L(0); PG8_MMA(0, 1, At, B1); PG8_BAR;
            PG8_LDA(At, 1, 1); PG8_STAGE(PG8_SA(1, 0), a3, voffA);
            PG8_BAR; PG8_WAIT_L(0); PG8_MMA(1, 0, At, B0); PG8_BAR; PG8_SCHED;
            PG8_STAGE(PG8_SB(1, 1), b3 + hstepB, voffB);
            PG8_WAIT_V(6); PG8_BAR; PG8_MMA(1, 1, At, B1); PG8_BAR;
            }
        }
        if constexpr (ALIGN_EPI) { if (wr == 0) PG8_BAR; }
        E(acc, cur, wr, wc, fr, fq); S.done(cur);
        if (!has_next) break;
#pragma unroll
        for (int a = 0; a < 2; ++a)
#pragma unroll
            for (int b = 0; b < 2; ++b)
#pragma unroll
                for (int m = 0; m < 4; ++m)
#pragma unroll
                    for (int n = 0; n < 2; ++n) acc[a][b][m][n] = (f32x4){0.f, 0.f, 0.f, 0.f};
        cur = nxt; cA = nA; cB = nB; ++ui;
        if constexpr (ALIGN_EPI) { if (wr == 1) PG8_BAR; }
    }
    PG8_WAIT_V(0);
    if constexpr (!ALIGN_EPI) { if (wr == 0) PG8_BAR; }
    PG8_BAR;
#undef PG8_SA
#undef PG8_SB
#undef PG8_STAGE
#undef PG8_LDA
#undef PG8_LDB
#undef PG8_MMA
#undef PG8_WAIT_V
#undef PG8_WAIT_L
#undef PG8_BAR
#undef PG8_SCHED
}
#else
template <class Epi, class Sched, bool ALIGN_EPI = false, bool SP2 = false>
void gemm_phase(unsigned char* lds, const Gemm g, const Sched& S, const Epi& E) {
    const int tid = threadIdx.x, wid = tid >> 6, lane = tid & 63, wr = wid >> 2, wc = wid & 3, fr = lane & 15, fq = lane >> 4;
    static thread_local float* Ct = nullptr; static thread_local float* Af = nullptr; static thread_local float* Bf = nullptr;
    Unit u;
    for (int i = 0; S.next(i, u); ++i) {
        S.a_ready(u);
        __syncthreads();
        if (tid == 0) {
            if (!Ct) { Ct = new float[256 * 256]; Af = new float[256 * 4096]; Bf = new float[256 * 4096]; }
            const int K = g.K;
            for (int r = 0; r < 256; ++r) for (int k = 0; k < K; ++k) { Af[r * K + k] = bf2f(g.A[(size_t)(u.pm * 256 + r) * g.lda + u.ka + k]); Bf[r * K + k] = bf2f(g.Bt[(size_t)(u.pn * 256 + r) * K + k]); }
            for (int r = 0; r < 256; ++r) for (int c = 0; c < 256; ++c) { float s = 0.f; const float* a = Af + r * K; const float* b = Bf + c * K; for (int k = 0; k < K; ++k) s += a[k] * b[k]; Ct[r * 256 + c] = s; }
        }
        __syncthreads();
        f32x4 acc[2][2][4][2];
        for (int ai = 0; ai < 2; ++ai) for (int bj = 0; bj < 2; ++bj) for (int m = 0; m < 4; ++m) for (int n = 0; n < 2; ++n) for (int e = 0; e < 4; ++e) {
            const int r = 128 * ai + 64 * wr + 16 * m + fr; const int c = Epi::PERM ? (128 * bj + 32 * wc + 8 * fq + 4 * n + e) : (128 * bj + 32 * wc + 16 * n + 4 * fq + e);
            acc[ai][bj][m][n][e] = Ct[r * 256 + c]; }
        E(acc, u, wr, wc, fr, fq); S.done(u);
    }
    __syncthreads();
}
#endif
}
namespace pg8 {
struct EpiMod {
    static constexpr bool PERM = false;
    float* C; const float* bias;
    __device__ __forceinline__ void operator()(const f32x4 (&acc)[2][2][4][2], const Unit& u, int wr, int wc, int fr_in, int fq_in) const {
        int fr = fr_in, fq = fq_in; OPAQUE_V(fr); OPAQUE_V(fq);
        const int row0 = wr * 64 + fr, col0 = u.aux * BM + wc * 32 + 4 * fq;
#pragma unroll
        for (int ai = 0; ai < 2; ++ai)
#pragma unroll
            for (int m = 0; m < 4; ++m) { float* rowp = C + (size_t)(row0 + ai * HALF + m * 16) * NMOD + col0;
#pragma unroll
                for (int bj = 0; bj < 2; ++bj)
#pragma unroll
                    for (int n = 0; n < 2; ++n) *(f32x4*)(rowp + bj * HALF + n * 16) = acc[ai][bj][m][n] + *(const f32x4*)(bias + col0 + bj * HALF + n * 16); }
    }
};
struct EpiProj {
    static constexpr bool PERM = true;
    bf16* proj; bf16* gate; float* outk_p; float* outv_p; float* outk_s; float* outv_s;
    __device__ __forceinline__ void operator()(const f32x4 (&acc)[2][2][4][2], const Unit& u, int wr, int wc, int fr_in, int fq_in) const {
        int fr = fr_in, fq = fq_in; OPAQUE_V(fr); OPAQUE_V(fq);
        const int t = u.aux; const bool isg = t >= 11;
        const int row0 = u.pm * BM + wr * 64 + fr, colt = wc * 32 + 8 * fq;
        bf16* base = isg ? gate + (size_t)(t - 11) * 256 : proj + (size_t)t * 256; const int ldc = isg ? NGATE : NPROJ;
#pragma unroll
        for (int ai = 0; ai < 2; ++ai)
#pragma unroll
            for (int m = 0; m < 4; ++m) { const int row = row0 + ai * HALF + m * 16; bf16* rowp = base + (size_t)row * ldc + colt;
#pragma unroll
                for (int bj = 0; bj < 2; ++bj) { f32x4 v0 = acc[ai][bj][m][0], v1 = acc[ai][bj][m][1];
                    if (isg) {
#pragma unroll
                        for (int e = 0; e < 4; ++e) { v0[e] = sigmoidf_(v0[e]); v1[e] = sigmoidf_(v1[e]); } }
                    else if (t >= 9) { float* o = (row < MP) ? ((t == 9 ? outk_p : outv_p) + (size_t)row * 256) : ((t == 9 ? outk_s : outv_s) + (size_t)(row - MP) * 256);
                        *(f32x4*)(o + colt + bj * HALF) = v0; *(f32x4*)(o + colt + bj * HALF + 4) = v1; }
                    v4u w; w.x = pk2(v0[0], v0[1]); w.y = pk2(v0[2], v0[3]); w.z = pk2(v1[0], v1[1]); w.w = pk2(v1[2], v1[3]);
                    *(v4u*)(rowp + bj * HALF) = w; } }
    }
};
struct EpiGlu {
    static constexpr bool PERM = true;
    const bf16* ys; bf16* y;
    __device__ __forceinline__ void operator()(const f32x4 (&acc)[2][2][4][2], const Unit& u, int wr, int wc, int fr_in, int fq_in) const {
        int fr = fr_in, fq = fq_in; OPAQUE_V(fr); OPAQUE_V(fq);
        const int row0 = u.pm * BM + wr * 64 + fr, colt = wc * 32 + 8 * fq;
#pragma unroll
        for (int ai = 0; ai < 2; ++ai)
#pragma unroll
            for (int m = 0; m < 4; ++m) { const int row = row0 + ai * HALF + m * 16;
#pragma unroll
                for (int bj = 0; bj < 2; ++bj) { const f32x4 v0 = acc[ai][bj][m][0], v1 = acc[ai][bj][m][1];
                    const v4u s = *(const v4u*)(ys + (size_t)row * 256 + colt + bj * HALF);
                    v4u w; w.x = pk2(bflo(s.x) * sigmoidf_(v0[0]), bfhi(s.x) * sigmoidf_(v0[1])); w.y = pk2(bflo(s.y) * sigmoidf_(v0[2]), bfhi(s.y) * sigmoidf_(v0[3]));
                    w.z = pk2(bflo(s.z) * sigmoidf_(v1[0]), bfhi(s.z) * sigmoidf_(v1[1])); w.w = pk2(bflo(s.w) * sigmoidf_(v1[2]), bfhi(s.w) * sigmoidf_(v1[3]));
                    *(v4u*)(y + (size_t)row * D + colt + bj * HALF) = w; } CFENCE(); }
    }
};
struct EpiMerge {
    static constexpr bool PERM = false;
    const bf16* gate; float* mg; bf16* mgb;
    __device__ __forceinline__ void operator()(const f32x4 (&acc)[2][2][4][2], const Unit& u, int wr, int wc, int fr_in, int fq_in) const {
        int fr = fr_in, fq = fq_in; OPAQUE_V(fr); OPAQUE_V(fq);
        const int n_ = u.aux >> 8, pc = u.aux & 255;
        const int row0 = u.pm * BM + wr * 64 + fr, col0 = pc * BM + wc * 32 + 4 * fq;
#pragma unroll
        for (int ai = 0; ai < 2; ++ai)
#pragma unroll
            for (int m = 0; m < 4; ++m) { const int row = row0 + ai * HALF + m * 16;
#pragma unroll
                for (int bj = 0; bj < 2; ++bj)
#pragma unroll
                    for (int n = 0; n < 2; ++n) { const int col = col0 + bj * HALF + n * 16;
                        const v2u gw = *(const v2u*)(gate + (size_t)row * NGATE + n_ * D + col);
                        f32x4 v = acc[ai][bj][m][n]; v[0] *= bflo(gw.x); v[1] *= bfhi(gw.x); v[2] *= bflo(gw.y); v[3] *= bfhi(gw.y);
                        float* p = mg + (size_t)row * D + col;
                        if (n_ > 0) v += *(const f32x4*)p;
                        if (n_ < 3) *(f32x4*)p = v;
                        else { v2u o; o.x = pk2(v[0], v[1]); o.y = pk2(v[2], v[3]); *(v2u*)(mgb + (size_t)row * D + col) = o; } } CFENCE(); }
    }
};
struct EpiRes {
    static constexpr bool PERM = false;
    const float* xP; const float* xS; const float* gmod; float* out;
    __device__ __forceinline__ void operator()(const f32x4 (&acc)[2][2][4][2], const Unit& u, int wr, int wc, int fr_in, int fq_in) const {
        int fr = fr_in, fq = fq_in; OPAQUE_V(fr); OPAQUE_V(fq);
        const int row0 = u.pm * BM + wr * 64 + fr, col0 = u.aux * BM + wc * 32 + 4 * fq;
#pragma unroll
        for (int ai = 0; ai < 2; ++ai)
#pragma unroll
            for (int m = 0; m < 4; ++m) { const int row = row0 + ai * HALF + m * 16; const float* xr = row < MP ? xP + (size_t)row * D : xS + (size_t)(row - MP) * D;
                const float* gr = gmod + (size_t)seq_of(row) * NMOD;
#pragma unroll
                for (int bj = 0; bj < 2; ++bj)
#pragma unroll
                    for (int n = 0; n < 2; ++n) { const int col = col0 + bj * HALF + n * 16;
                        const f32x4 xv = *(const f32x4*)(xr + col), gv = *(const f32x4*)(gr + col);
                        *(f32x4*)(out + (size_t)row * D + col) = xv * ALPHA + (gv + 1.0f) * acc[ai][bj][m][n]; } CFENCE(); }
    }
};
struct EpiUp {
    static constexpr bool PERM = true;
    bf16* act;
    __device__ __forceinline__ void operator()(const f32x4 (&acc)[2][2][4][2], const Unit& u, int wr, int wc, int fr_in, int fq_in) const {
        int fr = fr_in, fq = fq_in; OPAQUE_V(fr); OPAQUE_V(fq);
        const int row0 = u.pm * BM + wr * 64 + fr, col0 = u.aux * HALF + wc * 32 + 8 * fq;
#pragma unroll
        for (int ai = 0; ai < 2; ++ai)
#pragma unroll
            for (int m = 0; m < 4; ++m) { const int row = row0 + ai * HALF + m * 16;
                const f32x4 a0 = acc[ai][0][m][0], a1 = acc[ai][0][m][1], b0 = acc[ai][1][m][0], b1 = acc[ai][1][m][1];
                v4u w; w.x = pk2(siluf_(a0[0]) * b0[0], siluf_(a0[1]) * b0[1]); w.y = pk2(siluf_(a0[2]) * b0[2], siluf_(a0[3]) * b0[3]);
                w.z = pk2(siluf_(a1[0]) * b1[0], siluf_(a1[1]) * b1[1]); w.w = pk2(siluf_(a1[2]) * b1[2], siluf_(a1[3]) * b1[3]);
                *(v4u*)(act + (size_t)row * DFF + col0) = w; }
    }
};
}
struct Args { const float* in[38]; float* out; unsigned char* ws; int ph_lo, ph_hi, li, pad; };
enum { I_XP = 0, I_XS, I_CK, I_CV, I_SRE, I_SIM, I_SCB, I_SD, I_SCD, I_PT, I_CP, I_CS, I_WADA, I_BADA, I_WIN, I_ARE, I_AIM, I_LDT, I_BRE, I_BIM, I_CRE, I_CIM, I_SSD, I_WGLU,
       I_CBW, I_DCW, I_DAL, I_DDT, I_DNW, I_WBR, I_WGATE, I_WO, I_L1G, I_L1B, I_WUP, I_WDN, I_L2G, I_L2B };
constexpr int NWAVES = 8, RING_BYTES = 131072, MISC_OFF = RING_BYTES, LDS_BYTES = 147456;
#ifndef CPU_EMU
#define XB_TMO      128
#define XB_XCNT(j)  (256  + 64 * (j))
#define XB_XSUB(j)  (1280 + 64 * (j))
#define XB_XGEN(j)  (2304 + 64 * (j))
#define XB_TOP      3328
#define XB_TOPGEN   3392
#define XCD_BAR_WORDS 3456
#define XB_SPIN_CAP (1u << 18)
__device__ __forceinline__ unsigned xb_ld(unsigned* p)              { return __hip_atomic_load(p, __ATOMIC_RELAXED, __HIP_MEMORY_SCOPE_AGENT); }
__device__ __forceinline__ unsigned xb_add(unsigned* p, unsigned v) { return __hip_atomic_fetch_add(p, v, __ATOMIC_RELAXED, __HIP_MEMORY_SCOPE_AGENT); }
__device__ __forceinline__ unsigned xb_xcc_id() { return (unsigned)__builtin_amdgcn_s_getreg((3 << 11) | 20) & 0xFu; }
#define XB_SPIN(cond, bar) do { unsigned _sp = 0; while (cond) { __builtin_amdgcn_s_sleep(1); \
    if ((++_sp & 255u) == 0u) { if (xb_ld(&(bar)[XB_TMO])) break; if (_sp > XB_SPIN_CAP) { atomicAdd(&(bar)[XB_TMO], 1u); break; } } } } while (0)
struct XcdBarrier { unsigned* bar; unsigned x; volatile LAS_HW unsigned* st; };
__device__ __forceinline__ XcdBarrier xcd_barrier_post(unsigned* bar, volatile LAS_HW unsigned* st) {
    XcdBarrier b; b.bar = bar; b.x = xb_xcc_id(); b.st = st;
    if (threadIdx.x == 0) (void)xb_add(&bar[XB_XCNT(b.x)], 1u);
    return b;
}
__device__ __forceinline__ void xcd_barrier_complete(unsigned* bar, unsigned x, unsigned& nloc, unsigned& nx) {
    const unsigned G = gridDim.x * gridDim.y * gridDim.z;
    unsigned sum, cnt, mine, sp = 0u;
    for (;;) {
        sum = 0u; cnt = 0u; mine = 0u;
#pragma unroll
        for (unsigned j = 0; j < 16; ++j) { const unsigned c = xb_ld(&bar[XB_XCNT(j)]); sum += c; cnt += (c > 0u) ? 1u : 0u; mine = (j == x) ? c : mine; }
        if (sum == G) break;
        __builtin_amdgcn_s_sleep(1);
        if ((++sp & 255u) == 0u) { if (xb_ld(&bar[XB_TMO])) break; if (sp > XB_SPIN_CAP) { atomicAdd(&bar[XB_TMO], 1u); break; } }
    }
    nloc = mine > 0u ? mine : 1u; nx = cnt > 0u ? cnt : 1u;
}
__device__ __forceinline__ void xcd_barrier(const XcdBarrier& b) {
    asm volatile("s_waitcnt vmcnt(0)" ::: "memory");
    __syncthreads();
    if (threadIdx.x == 0) {
        unsigned* bar = b.bar;
        __builtin_amdgcn_s_waitcnt(0);
        unsigned nloc = b.st[0], nx = b.st[1];
        if (nloc == 0u) { xcd_barrier_complete(bar, b.x, nloc, nx); b.st[0] = nloc; b.st[1] = nx; }
        const unsigned old = xb_add(&bar[XB_XSUB(b.x)], 1u);
        const unsigned gen = old / nloc;
        if (old + 1u == (gen + 1u) * nloc) {
            __builtin_amdgcn_fence(__ATOMIC_RELEASE, "agent");
            asm volatile("s_waitcnt vmcnt(0)" ::: "memory");
            const unsigned og = xb_add(&bar[XB_TOP], 1u);
            const unsigned tg = og / nx;
            if (og + 1u == (tg + 1u) * nx) xb_add(&bar[XB_TOPGEN], 1u);
            else XB_SPIN(xb_ld(&bar[XB_TOPGEN]) == tg, bar);
            __builtin_amdgcn_fence(__ATOMIC_ACQUIRE, "agent");
            xb_add(&bar[XB_XGEN(b.x)], 1u);
            asm volatile("s_waitcnt vmcnt(0)" ::: "memory");
        } else {
            XB_SPIN(xb_ld(&bar[XB_XGEN(b.x)]) == gen, bar);
            __builtin_amdgcn_fence(__ATOMIC_ACQUIRE, "agent");
            asm volatile("s_waitcnt vmcnt(0)" ::: "memory");
        }
    }
    __syncthreads();
}
#else
#define XCD_BAR_WORDS 3456
struct XcdBarrier { int dummy; };
inline void xcd_barrier(const XcdBarrier&) { emu::grid_sync(); }
#endif

#define TIDS int tid_ = threadIdx.x; OPAQUE_V(tid_); const int tid = tid_, lane = tid & 63, wave = __builtin_amdgcn_readfirstlane(tid >> 6), G = gridDim.x, bid = blockIdx.x, gw = bid * NWAVES + wave, NGW = G * NWAVES; (void)lane; (void)wave; (void)gw; (void)NGW; (void)G; (void)bid
__device__ __forceinline__ bf16* wsb(const Args& A, size_t off) { return (bf16*)(A.ws + off); }
__device__ __forceinline__ float* wsf(const Args& A, size_t off) { return (float*)(A.ws + off); }
__device__ __forceinline__ float softplusf_(float x) { return fmaxf(x, 0.f) + log1pf(__expf(-fabsf(x))); }
__device__ __forceinline__ void tr_item(const float* W, int N, int K, int k0, int c0, bf16* WT, int drow0, LAS float* scr, int lane) {
#pragma unroll 8
    for (int i = 0; i < 32; ++i) { const int kk = 2 * i + (lane >> 5); scr[kk * 33 + (lane & 31)] = W[(size_t)(k0 + kk) * N + c0 + (lane & 31)]; }
    WAVE_SYNC();
    const int c = lane & 7;
#pragma unroll
    for (int j = 0; j < 4; ++j) { const int n = (lane >> 3) + 8 * j; const LAS float* s = scr + (8 * c) * 33 + n;
        v4u o; o.x = pk2(s[0 * 33], s[1 * 33]); o.y = pk2(s[2 * 33], s[3 * 33]); o.z = pk2(s[4 * 33], s[5 * 33]); o.w = pk2(s[6 * 33], s[7 * 33]);
        *(v4u*)(WT + (size_t)(drow0 + n) * K + k0 + 8 * c) = o; }
    WAVE_SYNC();
}
__device__ __forceinline__ void ph_prologue(const Args& A, LAS unsigned char* lds) {
    TIDS;
    LAS float* scr = (LAS float*)(lds + wave * 16384);
    constexpr int I_ADA = 16 * 192, I_IN1 = 16 * 64, I_IN2 = 16 * 24, I_GT = 16 * 128, I_GLU = 4 * 8, I_BR = 4 * 4 * 32, I_WO_ = 16 * 32, I_UP = 16 * 176, I_DN = 44 * 32;
    constexpr int PER_L = I_ADA + I_IN1 + I_IN2 + I_GT + I_GLU + I_BR + I_WO_ + I_UP + I_DN;
    for (int it = gw; it < DEPTH * PER_L; it += NGW) {
        const int l = it / PER_L; int r = it % PER_L; unsigned char* wl = A.ws + WS_W + (size_t)l * WL_SIZE;
        if (r < I_ADA) { const int kb = r / 192, nb = r % 192; tr_item(A.in[I_WADA] + (size_t)l * D * NMOD, NMOD, D, kb * 64, nb * 32, (bf16*)(wl + WL_ADA), nb * 32, scr, lane); continue; } r -= I_ADA;
        if (r < I_IN1) { const int kb = r / 64, nb = r % 64; tr_item(A.in[I_WIN] + (size_t)l * D * NIN, NIN, D, kb * 64, nb * 32, (bf16*)(wl + WL_W1), nb * 32, scr, lane); continue; } r -= I_IN1;
        if (r < I_IN2) { const int kb = r / 24, nb = r % 24; tr_item(A.in[I_WIN] + (size_t)l * D * NIN, NIN, D, kb * 64, 2056 + nb * 32, (bf16*)(wl + WL_W1), 2048 + nb * 32, scr, lane); continue; } r -= I_IN2;
        if (r < I_GT) { const int kb = r / 128, nb = r % 128; tr_item(A.in[I_WGATE] + (size_t)l * D * NGATE, NGATE, D, kb * 64, nb * 32, (bf16*)(wl + WL_W1), NPROJ + nb * 32, scr, lane); continue; } r -= I_GT;
        if (r < I_GLU) { const int kb = r / 8, nb = r % 8; tr_item(A.in[I_WGLU] + (size_t)l * 256 * 256, 256, 256, kb * 64, nb * 32, (bf16*)(wl + WL_GLU), nb * 32, scr, lane); continue; } r -= I_GLU;
        if (r < I_BR) { const int n = r / 128, r2 = r % 128, kb = r2 / 32, nb = r2 % 32; tr_item(A.in[I_WBR] + (size_t)(l * 4 + n) * 256 * D, D, 256, kb * 64, nb * 32, (bf16*)(wl + WL_BR), n * D + nb * 32, scr, lane); continue; } r -= I_BR;
        if (r < I_WO_) { const int kb = r / 32, nb = r % 32; tr_item(A.in[I_WO] + (size_t)l * D * D, D, D, kb * 64, nb * 32, (bf16*)(wl + WL_WO), nb * 32, scr, lane); continue; } r -= I_WO_;
        if (r < I_UP) { const int kb = r / 176, nb = r % 176; const int c0 = nb * 32, j = c0 < DFF ? c0 : c0 - DFF; const int drow = (j / 128) * 256 + (c0 < DFF ? 0 : 128) + (j % 128);
            tr_item(A.in[I_WUP] + (size_t)l * D * NUP, NUP, D, kb * 64, c0, (bf16*)(wl + WL_UP), drow, scr, lane); continue; } r -= I_UP;
        { const int kb = r / 32, nb = r % 32; tr_item(A.in[I_WDN] + (size_t)l * DFF * D, D, DFF, kb * 64, nb * 32, (bf16*)(wl + WL_DN), nb * 32, scr, lane); }
    }
    const int gt = bid * (NWAVES * 64) + tid, NGT = G * NWAVES * 64;
    for (int i = gt; i < DEPTH * 8 * D; i += NGT) { const int l = i / (8 * D), j = (i / D) % 8, k = i % D; ((float*)(A.ws + WS_W + (size_t)l * WL_SIZE + WL_LOG))[j * D + k] = A.in[I_WIN][((size_t)l * D + k) * NIN + 2048 + j]; }
    for (int i = gt; i < 256 * D; i += NGT) { const int r = i / D, k = i % D; float v = 0.f;
        if (r < NB) v = siluf_(A.in[I_CP][r * D + k]); else if (r < NSEQ) v = siluf_(A.in[I_CS][(r - NB) * D + k]);
        wsb(A, WS_CSILU)[i] = (bf16)f2bf(v); }
}
struct ModOrder {
    int G, c;
    __host__ __device__ bool next(int i, pg8::Unit& u) const { const int L = i * G + c; if (L >= 24 * DEPTH) return false; const int l = L / 24, pn = L % 24;
        u.pm = 0; u.pn = l * (int)(WL_SIZE / (512 * 1024)) + pn; u.ka = 0; u.aux = pn | (l << 8); return true; }
    __device__ __forceinline__ void a_ready(const pg8::Unit&) const {}
    __device__ __forceinline__ void done(const pg8::Unit&) const {}
};
struct EpiMod2 { static constexpr bool PERM = false; float* C; const float* bias;
    __device__ __forceinline__ void operator()(const f32x4 (&acc)[2][2][4][2], const pg8::Unit& u, int wr, int wc, int fr, int fq) const {
        const int l = u.aux >> 8; pg8::Unit u2 = u; u2.aux = u.aux & 255; pg8::EpiMod e{C + (size_t)l * 256 * NMOD, bias + (size_t)l * NMOD}; e(acc, u2, wr, wc, fr, fq); } };
template <int MODE> __device__ __forceinline__ void ph_rows(const Args& A, int l) {
    TIDS;
    const float* MOD = wsf(A, WS_MOD);
    for (int m = gw; m < M; m += NGW) {
        const float* src; float* dstx = nullptr;
        if (MODE == 0) src = m < MP ? A.in[I_XP] + (size_t)m * D : A.in[I_XS] + (size_t)(m - MP) * D;
        else if (MODE == 1) { src = wsf(A, WS_X1) + (size_t)m * D; dstx = wsf(A, WS_X1) + (size_t)m * D; }
        else { src = wsf(A, WS_X2) + (size_t)m * D; dstx = (l == DEPTH - 1) ? A.out + O_Y + (size_t)m * D : wsf(A, WS_X2) + (size_t)m * D; }
        f32x4 v[4];
#pragma unroll
        for (int j = 0; j < 4; ++j) v[j] = ((const f32x4*)src)[lane + 64 * j];
        if (MODE != 0) {
            float s = 0.f;
#pragma unroll
            for (int j = 0; j < 4; ++j) s += (v[j][0] + v[j][1]) + (v[j][2] + v[j][3]);
            const float mean = wave_sum(s) * (1.f / D); float s2 = 0.f;
#pragma unroll
            for (int j = 0; j < 4; ++j) { v[j] = v[j] - mean; s2 += (v[j][0] * v[j][0] + v[j][1] * v[j][1]) + (v[j][2] * v[j][2] + v[j][3] * v[j][3]); }
            const float rstd = 1.f / sqrtf(wave_sum(s2) * (1.f / D) + LN_EPS);
            const float* gp = A.in[MODE == 1 ? I_L1G : I_L2G] + (size_t)l * D; const float* bp = A.in[MODE == 1 ? I_L1B : I_L2B] + (size_t)l * D;
#pragma unroll
            for (int j = 0; j < 4; ++j) { const f32x4 g = ((const f32x4*)gp)[lane + 64 * j], b = ((const f32x4*)bp)[lane + 64 * j]; v[j] = v[j] * rstd * g + b; ((f32x4*)dstx)[lane + 64 * j] = v[j]; }
            if (MODE == 2 && l == DEPTH - 1) continue;
        }
        const int ln = (MODE == 2) ? l + 1 : l;
        const float* mr = MOD + ((size_t)ln * 256 + seq_of(m)) * NMOD + (MODE == 1 ? 3 * D : 0);
        float s = 0.f;
#pragma unroll
        for (int j = 0; j < 4; ++j) s += (v[j][0] + v[j][1]) + (v[j][2] + v[j][3]);
        const float mean = wave_sum(s) * (1.f / D); float s2 = 0.f;
#pragma unroll
        for (int j = 0; j < 4; ++j) { v[j] = v[j] - mean; s2 += (v[j][0] * v[j][0] + v[j][1] * v[j][1]) + (v[j][2] * v[j][2] + v[j][3] * v[j][3]); }
        const float rstd = 1.f / sqrtf(wave_sum(s2) * (1.f / D) + LN_EPS);
        v2u* hrow = (v2u*)(wsb(A, WS_H) + (size_t)m * D);
#pragma unroll
        for (int j = 0; j < 4; ++j) { const f32x4 sh = ((const f32x4*)mr)[lane + 64 * j], sc = ((const f32x4*)(mr + D))[lane + 64 * j]; v[j] = v[j] * rstd * (sc + 1.0f) + sh;
            v2u o; o.x = pk2(v[j][0], v[j][1]); o.y = pk2(v[j][2], v[j][3]); hrow[lane + 64 * j] = o; }
        if (MODE != 1) {
            const float* wl = (const float*)(A.ws + WS_W + (size_t)ln * WL_SIZE + WL_LOG);
            float lg[8];
#pragma unroll
            for (int jj = 0; jj < 8; ++jj) { float t = 0.f;
#pragma unroll
                for (int j = 0; j < 4; ++j) { const f32x4 w = ((const f32x4*)(wl + jj * D))[lane + 64 * j]; t += (v[j][0] * w[0] + v[j][1] * w[1]) + (v[j][2] * w[2] + v[j][3] * w[3]); }
                lg[jj] = wave_sum(t); }
            if (lane == 0) { float* o = wsf(A, WS_LOG8) + (size_t)m * 8; *(f32x4*)o = (f32x4){lg[0], lg[1], lg[2], lg[3]}; *(f32x4*)(o + 4) = (f32x4){lg[4], lg[5], lg[6], lg[7]}; }
        }
    }
}
struct SsmC { float abr, abi, bbr[16], bbi[16]; };
__device__ __forceinline__ void ssm_consts(const Args& A, int l, int g, int p, SsmC& c) {
    const int gi = l * 16 + g;
    const float dt = expf(A.in[I_LDT][gi]), ar = A.in[I_ARE][gi * 64 + p], ai = A.in[I_AIM][gi * 64 + p];
    const float mag = expf(dt * ar); c.abr = mag * cosf(dt * ai); c.abi = mag * sinf(dt * ai);
    const float den = ar * ar + ai * ai, fre = ((c.abr - 1.0f) * ar + c.abi * ai) / den, fim = (c.abi * ar - (c.abr - 1.0f) * ai) / den;
    const f32x4* br = (const f32x4*)(A.in[I_BRE] + (size_t)(gi * 64 + p) * 16); const f32x4* bi = (const f32x4*)(A.in[I_BIM] + (size_t)(gi * 64 + p) * 16);
#pragma unroll
    for (int q = 0; q < 4; ++q) { const f32x4 r = br[q], i = bi[q];
#pragma unroll
        for (int e = 0; e < 4; ++e) { c.bbr[4 * q + e] = fre * r[e] - fim * i[e]; c.bbi[4 * q + e] = fre * i[e] + fim * r[e]; } }
}
__device__ __forceinline__ void ssm_step(const SsmC& c, const bf16* urow, float& hr, float& hi) {
    const v4u u0 = *(const v4u*)urow, u1 = *(const v4u*)(urow + 8);
    float u[16] = {bflo(u0.x), bfhi(u0.x), bflo(u0.y), bfhi(u0.y), bflo(u0.z), bfhi(u0.z), bflo(u0.w), bfhi(u0.w), bflo(u1.x), bfhi(u1.x), bflo(u1.y), bfhi(u1.y), bflo(u1.z), bfhi(u1.z), bflo(u1.w), bfhi(u1.w)};
    float br = 0.f, bi = 0.f;
#pragma unroll
    for (int h = 0; h < 16; ++h) { br += c.bbr[h] * u[h]; bi += c.bbi[h] * u[h]; }
    const float nr = c.abr * hr - c.abi * hi + br, ni = c.abr * hi + c.abi * hr + bi; hr = nr; hi = ni;
}
__device__ __forceinline__ void ph_ssm1(const Args& A, int l) {
    TIDS;
    const bf16* proj = wsb(A, WS_PROJ);
    for (int un = gw; un < NB * 16 * SSM_NCH; un += NGW) {
        const int c = un % SSM_NCH, g = (un / SSM_NCH) % 16, b = un / (SSM_NCH * 16);
        SsmC k; ssm_consts(A, l, g, lane, k);
        float hr = 0.f, hi = 0.f;
        const bf16* up = proj + (size_t)(b * SEQ + c * SSM_CH) * NPROJ + PC_U + g * 16;
        for (int t = 0; t < SSM_CH; ++t) ssm_step(k, up + (size_t)t * NPROJ, hr, hi);
        float* o = wsf(A, WS_SEND) + (size_t)un * 128; o[lane] = hr; o[64 + lane] = hi;
    }
}
__device__ __forceinline__ void ph_ssm_carry(const Args& A, int l) {
    TIDS;
    const int gt = bid * (NWAVES * 64) + tid;
    if (gt < NB * 16 * 64) {
        const int p = gt & 63, g = (gt >> 6) & 15, b = gt >> 10; const int gi = l * 16 + g;
        const float dt = expf(A.in[I_LDT][gi]), ar = A.in[I_ARE][gi * 64 + p], ai = A.in[I_AIM][gi * 64 + p];
        const float mag = expf(dt * ar); float pr = mag * cosf(dt * ai), pi = mag * sinf(dt * ai);
        for (int s = 1; s < SSM_CH; s <<= 1) { const float nr = pr * pr - pi * pi, ni = 2.f * pr * pi; pr = nr; pi = ni; }
        float cr = 0.f, ci = 0.f;
        for (int c = 0; c < SSM_NCH; ++c) { const size_t un = ((size_t)(b * 16 + g) * SSM_NCH + c) * 128;
            wsf(A, WS_HIN)[un + p] = cr; wsf(A, WS_HIN)[un + 64 + p] = ci;
            const float sr = wsf(A, WS_SEND)[un + p], si = wsf(A, WS_SEND)[un + 64 + p];
            const float nr = pr * cr - pi * ci + sr, ni = pr * ci + pi * cr + si; cr = nr; ci = ni; }
    }
}
__device__ __forceinline__ float gelu_tanh(float x) { const float t = tanhf(0.7978845608028654f * (x + 0.044715f * x * x * x)); return 0.5f * x * (1.0f + t); }
__device__ __forceinline__ void ph_ssm2(const Args& A, LAS unsigned char* lds, int l) {
    TIDS;
    LAS float* ct = (LAS float*)(lds + wave * 16384);
    LAS float* ht = ct + 2048;
    const bf16* proj = wsb(A, WS_PROJ);
    constexpr int NPU = NB * 16 * SSM_NCH, NSU = DB * 16;
    for (int un = gw; un < NPU + NSU; un += NGW) {
        int g, m0, ntok; float hr, hi; float* fre = nullptr; float* fim = nullptr;
        if (un < NPU) { const int c = un % SSM_NCH; g = (un / SSM_NCH) % 16; const int b = un / (SSM_NCH * 16); m0 = b * SEQ + c * SSM_CH; ntok = SSM_CH;
            hr = wsf(A, WS_HIN)[(size_t)un * 128 + lane]; hi = wsf(A, WS_HIN)[(size_t)un * 128 + 64 + lane];
            if (c == SSM_NCH - 1) { fre = A.out + O_REP + ((size_t)(l * NB + b) * 16 + g) * 64; fim = A.out + O_IMP + ((size_t)(l * NB + b) * 16 + g) * 64; } }
        else { const int su = un - NPU; g = su & 15; const int s = su >> 4; m0 = MP + s * DEC_SEQ; ntok = DEC_SEQ;
            hr = A.in[I_SRE][((size_t)(l * DB + s) * 16 + g) * 64 + lane]; hi = A.in[I_SIM][((size_t)(l * DB + s) * 16 + g) * 64 + lane];
            fre = A.out + O_RES + ((size_t)(l * DB + s) * 16 + g) * 64; fim = A.out + O_IMS + ((size_t)(l * DB + s) * 16 + g) * 64; }
        SsmC k; ssm_consts(A, l, g, lane, k);
        const int gi = l * 16 + g;
        for (int ch = 0; ch < 16; ++ch) { ct[lane * 16 + ch] = A.in[I_CRE][((size_t)gi * 16 + ch) * 64 + lane]; ct[1024 + lane * 16 + ch] = A.in[I_CIM][((size_t)gi * 16 + ch) * 64 + lane]; }
        const float dd = A.in[I_SSD][l * 256 + g * 16 + (lane & 15)];
        for (int t0 = 0; t0 < ntok; t0 += 16) {
            const int nt = (ntok - t0) < 16 ? (ntok - t0) : 16;
            for (int t = 0; t < nt; ++t) { ssm_step(k, proj + (size_t)(m0 + t0 + t) * NPROJ + PC_U + g * 16, hr, hi); ht[t * 64 + lane] = hr; ht[1024 + t * 64 + lane] = hi; }
            WAVE_SYNC();
            const int ch = lane & 15, tq = lane >> 4;
#pragma unroll
            for (int i = 0; i < 4; ++i) { const int tt = tq + 4 * i;
                if (tt < nt) { float y = 0.f;
                    for (int p = 0; p < 64; ++p) y += ct[p * 16 + ch] * ht[tt * 64 + p] - ct[1024 + p * 16 + ch] * ht[1024 + tt * 64 + p];
                    const size_t m = (size_t)(m0 + t0 + tt);
                    y += dd * bf2f(proj[m * NPROJ + PC_U + g * 16 + ch]);
                    wsb(A, WS_YS)[m * 256 + g * 16 + ch] = (bf16)f2bf(gelu_tanh(y)); } }
            WAVE_SYNC();
        }
        if (fre) { fre[lane] = hr; fim[lane] = hi; }
    }
}
__device__ __forceinline__ void ph_conv(const Args& A, int l) {
    TIDS;
    const int gt = bid * (NWAVES * 64) + tid, NGT = G * NWAVES * 64;
    const bf16* proj = wsb(A, WS_PROJ);
    for (int i = gt; i < M * 128; i += NGT) {
        const int m = i >> 7, c = (i & 127) * 2;
        int t, L; const float* hist = nullptr; float* so;
        if (m < MP) { t = m % SEQ; L = SEQ; so = A.out + O_CBP + (size_t)(l * NB + m / SEQ) * 512; }
        else { const int s = (m - MP) / DEC_SEQ; t = (m - MP) % DEC_SEQ; L = DEC_SEQ; hist = A.in[I_SCB] + (size_t)(l * DB + s) * 512; so = A.out + O_CBS + (size_t)(l * DB + s) * 512; }
        float cx0[3], cx1[3];
#pragma unroll
        for (int j = 0; j < 3; ++j) { const int tt = t - 2 + j;
            if (tt >= 0) { const bf16* r = proj + (size_t)(m - 2 + j) * NPROJ; const unsigned cg = *(const unsigned*)(r + PC_CG + c), xc = *(const unsigned*)(r + PC_XC + c); cx0[j] = bflo(cg) * bflo(xc); cx1[j] = bfhi(cg) * bfhi(xc); }
            else if (hist) { cx0[j] = hist[(2 + tt) * 256 + c]; cx1[j] = hist[(2 + tt) * 256 + c + 1]; }
            else { cx0[j] = 0.f; cx1[j] = 0.f; } }
        const float* w = A.in[I_CBW] + (size_t)l * 3 * 256;
        const float o0 = w[c] * cx0[0] + w[256 + c] * cx0[1] + w[512 + c] * cx0[2], o1 = w[c + 1] * cx1[0] + w[256 + c + 1] * cx1[1] + w[512 + c + 1] * cx1[2];
        const unsigned bg = *(const unsigned*)(proj + (size_t)m * NPROJ + PC_BG + c);
        *(unsigned*)(wsb(A, WS_Y) + (size_t)m * D + 256 + c) = pk2(bflo(bg) * o0, bfhi(bg) * o1);
        if (t >= L - 2) { so[(t - (L - 2)) * 256 + c] = cx0[2]; so[(t - (L - 2)) * 256 + c + 1] = cx1[2]; }
    }
}
__device__ __forceinline__ void ph_gdn_c1(const Args& A, LAS unsigned char* lds, int l) {
    TIDS;
    LAS float* q = (LAS float*)lds; LAS float* k = q + 4096; LAS float* v = q + 8192; LAS float* MM = q + 12288; LAS float* QK = q + 16384; LAS float* sol = q + 20480;
    LAS float* gcs = q + 28672; LAS float* bet = q + 28736; LAS float* egc = q + 28800;
    const bf16* proj = wsb(A, WS_PROJ); const float* cw = A.in[I_DCW] + (size_t)l * 4 * GQKV; const float* lg8 = wsf(A, WS_LOG8);
    for (int un = bid; un < NB * GH * GNCH; un += G) {
        const int c = un % GNCH, h = (un / GNCH) % GH, b = un / (GNCH * GH); const int m0 = b * SEQ + c * GCH;
        for (int idx = tid; idx < 64 * 192; idx += 512) {
            const int i = idx / 192, cc = idx % 192, sec = cc >> 6, d = cc & 63, src = sec * 256 + h * 64 + d, t = c * GCH + i;
            float acc = 0.f, cur = 0.f;
#pragma unroll
            for (int j = 0; j < 4; ++j) { const int tt = t - 3 + j; const float x = tt >= 0 ? bf2f(proj[(size_t)(b * SEQ + tt) * NPROJ + PC_QKV + src]) : 0.f; acc += cw[j * GQKV + src] * x; cur = x; }
            (sec == 0 ? q : sec == 1 ? k : v)[i * 64 + d] = siluf_(acc);
            if (t >= SEQ - 3) A.out[O_CDP + ((size_t)(l * NB + b) * 3 + (t - (SEQ - 3))) * GQKV + src] = cur;
        }
        __syncthreads();
        for (int r = 0; r < 8; ++r) { const int i = wave * 8 + r;
            const float qv = q[i * 64 + lane], kv = k[i * 64 + lane];
            const float sq = wave_sum(qv * qv), sk = wave_sum(kv * kv);
            q[i * 64 + lane] = qv * (1.0f / sqrtf(sq + RMS_EPS)) * 0.125f; k[i * 64 + lane] = kv * (1.0f / sqrtf(sk + RMS_EPS)); }
        if (tid < 64) { const float* lr = lg8 + (size_t)(m0 + tid) * 8; bet[tid] = sigmoidf_(lr[h]); gcs[tid] = -expf(A.in[I_DAL][l * 4 + h]) * softplusf_(lr[4 + h] + A.in[I_DDT][l * 4 + h]); }
        __syncthreads();
        if (tid == 0) { float s = 0.f; for (int i = 0; i < 64; ++i) { s += gcs[i]; gcs[i] = s; } }
        __syncthreads();
        if (tid < 64) egc[tid] = expf(gcs[tid]);
        __syncthreads();
        for (int idx = tid; idx < 4096; idx += 512) { const int i = idx >> 6, j = idx & 63; float kk = 0.f, qk = 0.f;
            for (int d = 0; d < 64; ++d) { const float kj = k[j * 64 + d]; kk += k[i * 64 + d] * kj; qk += q[i * 64 + d] * kj; }
            const float dec = i >= j ? expf(gcs[i] - gcs[j]) : 0.f;
            MM[idx] = i > j ? bet[i] * kk * dec : 0.f; QK[idx] = qk * dec; }
        for (int idx = tid; idx < 64 * 128; idx += 512) { const int i = idx >> 7, cc = idx & 127; sol[idx] = cc < 64 ? bet[i] * v[i * 64 + cc] : bet[i] * egc[i] * k[i * 64 + cc - 64]; }
        __syncthreads();
        for (int i = 0; i < 63; ++i) {
            for (int idx = tid; idx < (63 - i) * 128; idx += 512) { const int r = i + 1 + (idx >> 7), cc = idx & 127; sol[r * 128 + cc] -= MM[r * 64 + i] * sol[i * 128 + cc]; }
            __syncthreads();
        }
        float* gd = wsf(A, WS_GD) + (size_t)un * 5 * 4096; const float gl = gcs[63];
        for (int idx = tid; idx < 4096; idx += 512) { const int i = idx >> 6, d = idx & 63;
            gd[idx] = sol[i * 128 + d]; gd[4096 + idx] = sol[i * 128 + 64 + d]; gd[8192 + idx] = QK[idx]; gd[12288 + idx] = q[idx] * egc[i]; gd[16384 + idx] = k[idx] * expf(gl - gcs[i]); }
        if (tid == 0) wsf(A, WS_EGL)[un] = expf(gl);
        __syncthreads();
    }
}
__device__ __forceinline__ void ph_gdn_scan(const Args& A, LAS unsigned char* lds, int l) {
    TIDS;
    LAS float* S = (LAS float*)lds; LAS float* U = S + 1024;
    const int r = tid >> 3, c0 = (tid & 7) * 2;
    for (int un = bid; un < NB * GH * 4; un += G) {
        const int vs = un & 3, h = (un >> 2) % GH, b = un / (4 * GH);
        S[r * 16 + c0] = 0.f; S[r * 16 + c0 + 1] = 0.f;
        __syncthreads();
        for (int c = 0; c < GNCH; ++c) {
            const size_t cu = (size_t)(b * GH + h) * GNCH + c; const float* gd = wsf(A, WS_GD) + cu * 5 * 4096; const float egl = wsf(A, WS_EGL)[cu];
            float u0 = gd[r * 64 + vs * 16 + c0], u1 = gd[r * 64 + vs * 16 + c0 + 1];
            for (int kk = 0; kk < 64; ++kk) { const float w = gd[4096 + r * 64 + kk]; u0 -= w * S[kk * 16 + c0]; u1 -= w * S[kk * 16 + c0 + 1]; }
            U[r * 16 + c0] = u0; U[r * 16 + c0 + 1] = u1;
            __syncthreads();
            float o0 = 0.f, o1 = 0.f;
            for (int kk = 0; kk < 64; ++kk) { const float qd = gd[12288 + r * 64 + kk], qk = gd[8192 + r * 64 + kk]; o0 += qd * S[kk * 16 + c0] + qk * U[kk * 16 + c0]; o1 += qd * S[kk * 16 + c0 + 1] + qk * U[kk * 16 + c0 + 1]; }
            float* od = wsf(A, WS_ODRAW) + (size_t)(b * SEQ + c * GCH + r) * 256 + h * 64 + vs * 16 + c0; od[0] = o0; od[1] = o1;
            float s0 = egl * S[r * 16 + c0], s1 = egl * S[r * 16 + c0 + 1];
            for (int i = 0; i < 64; ++i) { const float kd = gd[16384 + i * 64 + r]; s0 += kd * U[i * 16 + c0]; s1 += kd * U[i * 16 + c0 + 1]; }
            __syncthreads();
            S[r * 16 + c0] = s0; S[r * 16 + c0 + 1] = s1;
            __syncthreads();
        }
        float* so = A.out + O_DP + (((size_t)(l * NB + b) * GH + h) * 64 + r) * 64 + vs * 16 + c0; so[0] = S[r * 16 + c0]; so[1] = S[r * 16 + c0 + 1];
        __syncthreads();
    }
}
__device__ __forceinline__ void ph_gdn_sample(const Args& A, LAS unsigned char* lds, int l) {
    TIDS;
    LAS float* S = (LAS float*)(lds + wave * 16384);
    LAS float* kq = (LAS float*)(lds + MISC_OFF + 1024 + wave * 512);
    const bf16* proj = wsb(A, WS_PROJ); const float* cw = A.in[I_DCW] + (size_t)l * 4 * GQKV; const float* lg8 = wsf(A, WS_LOG8);
    for (int un = gw; un < DB * GH; un += NGW) {
        const int h = un % GH, s = un / GH;
        const float* s0 = A.in[I_SD] + ((size_t)(l * DB + s) * GH + h) * 4096;
#pragma unroll 8
        for (int kk = 0; kk < 64; ++kk) S[kk * 64 + lane] = s0[kk * 64 + lane];
        const float* hist = A.in[I_SCD] + (size_t)(l * DB + s) * 3 * GQKV;
        for (int t = 0; t < DEC_SEQ; ++t) {
            const size_t m = (size_t)MP + s * DEC_SEQ + t;
            float val[3];
#pragma unroll
            for (int sec = 0; sec < 3; ++sec) { const int src = sec * 256 + h * 64 + lane; float acc = 0.f, cur = 0.f;
#pragma unroll
                for (int j = 0; j < 4; ++j) { const int tt = t - 3 + j; const float x = tt >= 0 ? bf2f(proj[(size_t)(MP + s * DEC_SEQ + tt) * NPROJ + PC_QKV + src]) : hist[(3 + tt) * GQKV + src]; acc += cw[j * GQKV + src] * x; cur = x; }
                val[sec] = siluf_(acc);
                if (t >= 1) A.out[O_CDS + ((size_t)(l * DB + s) * 3 + (t - 1)) * GQKV + src] = cur; }
            const float sq = wave_sum(val[0] * val[0]), sk = wave_sum(val[1] * val[1]);
            const float qv = val[0] * (1.0f / sqrtf(sq + RMS_EPS)) * 0.125f, kv = val[1] * (1.0f / sqrtf(sk + RMS_EPS)), vv = val[2];
            const float* lr = lg8 + m * 8; const float beta = sigmoidf_(lr[h]); const float a = expf(-expf(A.in[I_DAL][l * 4 + h]) * softplusf_(lr[4 + h] + A.in[I_DDT][l * 4 + h]));
            kq[lane] = kv; kq[64 + lane] = qv;
            WAVE_SYNC();
            float kS = 0.f;
#pragma unroll 8
            for (int kk = 0; kk < 64; ++kk) kS += kq[kk] * S[kk * 64 + lane];
            float o = 0.f;
#pragma unroll 8
            for (int kk = 0; kk < 64; ++kk) { const float bk = beta * kq[kk]; const float sn = a * (S[kk * 64 + lane] - bk * kS) + bk * vv; S[kk * 64 + lane] = sn; o += kq[64 + kk] * sn; }
            wsf(A, WS_ODRAW)[m * 256 + h * 64 + lane] = o;
            WAVE_SYNC();
        }
        float* so = A.out + O_DS + ((size_t)(l * DB + s) * GH + h) * 4096;
#pragma unroll 8
        for (int kk = 0; kk < 64; ++kk) so[kk * 64 + lane] = S[kk * 64 + lane];
    }
}
__device__ __forceinline__ void ph_gdn_out(const Args& A, int l) {
    TIDS;
    for (int idx = gw; idx < M * GH; idx += NGW) { const size_t m = idx >> 2; const int h = idx & 3;
        const float o = wsf(A, WS_ODRAW)[m * 256 + h * 64 + lane];
        const float ms = wave_sum(o * o) * (1.0f / 64.0f);
        const float z = bf2f(wsb(A, WS_PROJ)[m * NPROJ + PC_Z + h * 64 + lane]);
        wsb(A, WS_Y)[m * D + 512 + h * 64 + lane] = (bf16)f2bf(o * (1.0f / sqrtf(ms + RMS_EPS)) * A.in[I_DNW][l * 64 + lane] * siluf_(z)); }
}
__device__ __forceinline__ void sb_terms(float z, float& ls, float& ln) { const float L = log1pf(__expf(-fabsf(z))); ls = fminf(z, 0.f) - L; ln = -fmaxf(z, 0.f) - L; }
constexpr float SB_CUT = -105.0f;
__device__ __forceinline__ void ph_sb_prompt(const Args& A, LAS unsigned char* lds, int l) {
    TIDS; (void)l;
    LAS float* kt = (LAS float*)(lds + wave * 16384); LAS float* vt = kt + 2048;
    const bf16* proj = wsb(A, WS_PROJ);
    constexpr int NQB = SEQ / 32;
    for (int un0 = gw; un0 < NB * SBH * NQB; un0 += NGW) {
        const int un = NB * SBH * NQB - 1 - un0;
        const int qb = un / (NB * SBH), h = un % SBH, b = (un / SBH) % NB;
        const int i = lane & 31, half = lane >> 5, qi = qb * 32 + i; const size_t m = (size_t)b * SEQ + qi;
        float q[32], acc[32];
        { const v4u* qp = (const v4u*)(proj + m * NPROJ + PC_Q + h * 64 + half * 32);
#pragma unroll
          for (int x = 0; x < 4; ++x) { const v4u w = qp[x]; q[8 * x] = bflo(w.x) * 0.125f; q[8 * x + 1] = bfhi(w.x) * 0.125f; q[8 * x + 2] = bflo(w.y) * 0.125f; q[8 * x + 3] = bfhi(w.y) * 0.125f;
              q[8 * x + 4] = bflo(w.z) * 0.125f; q[8 * x + 5] = bfhi(w.z) * 0.125f; q[8 * x + 6] = bflo(w.w) * 0.125f; q[8 * x + 7] = bfhi(w.w) * 0.125f; } }
#pragma unroll
        for (int d = 0; d < 32; ++d) acc[d] = 0.f;
        float R = 0.f;
        for (int kb = qb; kb >= 0; --kb) {
            { const int row = lane >> 1, hr = lane & 1; const bf16* rp = proj + ((size_t)b * SEQ + kb * 32 + row) * NPROJ + h * 64 + hr * 32;
              const v4u* kp = (const v4u*)(rp + PC_K); const v4u* vp = (const v4u*)(rp + PC_V);
#pragma unroll
              for (int x = 0; x < 4; ++x) { const v4u w = kp[x], u = vp[x]; LAS float* kd = kt + row * 64 + hr * 32 + 8 * x; LAS float* vd = vt + row * 64 + hr * 32 + 8 * x;
                  kd[0] = bflo(w.x); kd[1] = bfhi(w.x); kd[2] = bflo(w.y); kd[3] = bfhi(w.y); kd[4] = bflo(w.z); kd[5] = bfhi(w.z); kd[6] = bflo(w.w); kd[7] = bfhi(w.w);
                  vd[0] = bflo(u.x); vd[1] = bfhi(u.x); vd[2] = bflo(u.y); vd[3] = bfhi(u.y); vd[4] = bflo(u.z); vd[5] = bfhi(u.z); vd[6] = bflo(u.w); vd[7] = bfhi(u.w); } }
            WAVE_SYNC();
            for (int jj = 31; jj >= 0; --jj) {
                const LAS float* kr = kt + jj * 64 + half * 32; float zp = 0.f;
#pragma unroll
                for (int d = 0; d < 32; ++d) zp += q[d] * kr[d];
                const float z = zp + __shfl_xor(zp, 32);
                float ls, ln; sb_terms(z, ls, ln);
                const bool valid = (kb * 32 + jj) < qi;
                const float w = valid ? __expf(ls + R) : 0.f;
                const LAS float* vr = vt + jj * 64 + half * 32;
#pragma unroll
                for (int d = 0; d < 32; ++d) acc[d] += w * vr[d];
                R += valid ? ln : 0.f;
            }
            WAVE_SYNC();
            if (kb < qb && __all(R < SB_CUT)) break;
        }
        v4u* yp = (v4u*)(wsb(A, WS_Y) + m * D + 768 + h * 64 + half * 32);
#pragma unroll
        for (int x = 0; x < 4; ++x) { v4u o; o.x = pk2(acc[8 * x], acc[8 * x + 1]); o.y = pk2(acc[8 * x + 2], acc[8 * x + 3]); o.z = pk2(acc[8 * x + 4], acc[8 * x + 5]); o.w = pk2(acc[8 * x + 6], acc[8 * x + 7]); yp[x] = o; }
    }
}
__device__ __forceinline__ void ph_sb_sample(const Args& A, int l) {
    TIDS;
    const bf16* proj = wsb(A, WS_PROJ); const int* pt = (const int*)A.in[I_PT];
    for (int un = gw; un < DB * SBH; un += NGW) {
        const int h = un % SBH, s = un / SBH; const int qi = lane & 3, ds = lane >> 2;
        const size_t mq = (size_t)MP + s * DEC_SEQ + qi;
        f32x4 q; { const v2u w = *(const v2u*)(proj + mq * NPROJ + PC_Q + h * 64 + ds * 4); q = (f32x4){bflo(w.x), bfhi(w.x), bflo(w.y), bfhi(w.y)} * 0.125f; }
        f32x4 acc = {0.f, 0.f, 0.f, 0.f}; float R = 0.f;
        for (int j = DEC_SEQ - 1; j >= 0; --j) {
            const bf16* rp = proj + ((size_t)MP + s * DEC_SEQ + j) * NPROJ + h * 64 + ds * 4;
            const v2u kw = *(const v2u*)(rp + PC_K), vw = *(const v2u*)(rp + PC_V);
            float zp = q[0] * bflo(kw.x) + q[1] * bfhi(kw.x) + q[2] * bflo(kw.y) + q[3] * bfhi(kw.y);
            zp += __shfl_xor(zp, 4); zp += __shfl_xor(zp, 8); zp += __shfl_xor(zp, 16); zp += __shfl_xor(zp, 32);
            float ls, ln; sb_terms(zp, ls, ln);
            const bool valid = j < qi; const float w = valid ? __expf(ls + R) : 0.f;
            acc += (f32x4){bflo(vw.x), bfhi(vw.x), bflo(vw.y), bfhi(vw.y)} * w; R += valid ? ln : 0.f;
        }
        for (int jp = PAST - 1; jp >= 0; --jp) {
            const int page = pt[s * NPAGES + jp / PAGE];
            const size_t off = ((((size_t)l * NPOOL + page) * PAGE + jp % PAGE) * SBH + h) * 64 + ds * 4;
            const f32x4 k4 = *(const f32x4*)(A.in[I_CK] + off), v4 = *(const f32x4*)(A.in[I_CV] + off);
            float zp = q[0] * k4[0] + q[1] * k4[1] + q[2] * k4[2] + q[3] * k4[3];
            zp += __shfl_xor(zp, 4); zp += __shfl_xor(zp, 8); zp += __shfl_xor(zp, 16); zp += __shfl_xor(zp, 32);
            float ls, ln; sb_terms(zp, ls, ln);
            acc += v4 * __expf(ls + R); R += ln;
            if ((jp & 15) == 0 && __all(R < SB_CUT)) break;
        }
        v2u o; o.x = pk2(acc[0], acc[1]); o.y = pk2(acc[2], acc[3]);
        *(v2u*)(wsb(A, WS_Y) + mq * D + 768 + h * 64 + ds * 4) = o;
    }
}
constexpr int PH_PER_LAYER = 12, NPHASE = 2 + PH_PER_LAYER * DEPTH;
#ifndef MK_N_LAUNCHES
#define MK_N_LAUNCHES 1
#endif
__global__ void __launch_bounds__(NWAVES * 64, 2) fwd_kernel(Args A) {
#ifndef CPU_EMU
    extern __shared__ __attribute__((aligned(16))) unsigned char lds_raw[];
    LAS unsigned char* lds = (LAS unsigned char*)lds_raw;
    volatile LAS unsigned* MISC = (volatile LAS unsigned*)(lds + MISC_OFF);
    for (int u = threadIdx.x; u < (LDS_BYTES - MISC_OFF) / 4; u += NWAVES * 64) ((LAS unsigned*)(lds + MISC_OFF))[u] = 0u;
    __syncthreads();
    XcdBarrier bar; bar.bar = (unsigned*)(A.ws + WS_CTL) + CW_BAR + A.li * XCD_BAR_WORDS; bar.x = 0; bar.st = nullptr;
    if (A.ph_hi - A.ph_lo > 1) bar = xcd_barrier_post((unsigned*)(A.ws + WS_CTL) + CW_BAR + A.li * XCD_BAR_WORDS, MISC + 8);
#else
    unsigned char* lds = emu::B->lds; XcdBarrier bar{0};
#endif
    const int lo = A.ph_lo, hi = A.ph_hi, G = gridDim.x, bid = blockIdx.x;
#define IN(k) (lo <= (k) && (k) < hi)
#define SEAM(k) do { if (IN((k) + 1)) xcd_barrier(bar); } while (0)
    if (IN(0)) { ph_prologue(A, lds); SEAM(0); }
    if (IN(1)) {
        pg8::Gemm g{wsb(A, WS_CSILU), (const bf16*)(A.ws + WS_W + WL_ADA), D, D}; ModOrder S{G, bid}; EpiMod2 E{wsf(A, WS_MOD), A.in[I_BADA]};
        pg8::gemm_phase<EpiMod2, ModOrder, true, true>(lds, g, S, E); SEAM(1);
    }
    for (int l = 0; l < DEPTH; ++l) {
        const int pb = 2 + PH_PER_LAYER * l;
        unsigned char* wl = A.ws + WS_W + (size_t)l * WL_SIZE;
        if (IN(pb + 0)) { if (l == 0) ph_rows<0>(A, 0); SEAM(pb + 0); }
        if (IN(pb + 1)) {
            pg8::Gemm g{wsb(A, WS_H), (const bf16*)(wl + WL_W1), D, D}; pg8::GridOrder S; S.init(M / 256, N1 / 256, G, bid);
            pg8::EpiProj E{wsb(A, WS_PROJ), wsb(A, WS_GATE), A.out + O_KP + (size_t)l * MP * 256, A.out + O_VP + (size_t)l * MP * 256, A.out + O_KS + (size_t)l * MS * 256, A.out + O_VS + (size_t)l * MS * 256};
            pg8::gemm_phase<pg8::EpiProj, pg8::GridOrder, true, true>(lds, g, S, E); SEAM(pb + 1);
        }
        if (IN(pb + 2)) { ph_gdn_c1(A, lds, l); ph_sb_prompt(A, lds, l); __syncthreads(); ph_gdn_sample(A, lds, l); ph_sb_sample(A, l); ph_ssm1(A, l); ph_conv(A, l); SEAM(pb + 2); }
        if (IN(pb + 3)) { ph_gdn_scan(A, lds, l); ph_ssm_carry(A, l); SEAM(pb + 3); }
        if (IN(pb + 4)) { ph_ssm2(A, lds, l); ph_gdn_out(A, l); SEAM(pb + 4); }
        if (IN(pb + 5)) {
            pg8::Gemm g{wsb(A, WS_YS), (const bf16*)(wl + WL_GLU), 256, 256}; pg8::GridOrder S; S.init(M / 256, 1, G, bid);
            pg8::EpiGlu E{wsb(A, WS_YS), wsb(A, WS_Y)};
            pg8::gemm_phase<pg8::EpiGlu, pg8::GridOrder, true, true>(lds, g, S, E); SEAM(pb + 5);
        }
        if (IN(pb + 6)) {
            pg8::Gemm g{wsb(A, WS_Y), (const bf16*)(wl + WL_BR), D, 256}; pg8::MergeOrder S; S.init(M / 256, 4, G, bid);
            pg8::EpiMerge E{wsb(A, WS_GATE), wsf(A, WS_MERGE), wsb(A, WS_MERGEB)};
            pg8::gemm_phase<pg8::EpiMerge, pg8::MergeOrder, true, true>(lds, g, S, E); SEAM(pb + 6);
        }
        if (IN(pb + 7)) {
            pg8::Gemm g{wsb(A, WS_MERGEB), (const bf16*)(wl + WL_WO), D, D}; pg8::GridOrder S; S.init(M / 256, 4, G, bid);
            pg8::EpiRes E{l == 0 ? A.in[I_XP] : wsf(A, WS_X2), l == 0 ? A.in[I_XS] : wsf(A, WS_X2) + (size_t)MP * D, wsf(A, WS_MOD) + (size_t)l * 256 * NMOD + 2 * D, wsf(A, WS_X1)};
            pg8::gemm_phase<pg8::EpiRes, pg8::GridOrder, true, true>(lds, g, S, E); SEAM(pb + 7);
        }
        if (IN(pb + 8)) { ph_rows<1>(A, l); SEAM(pb + 8); }
        if (IN(pb + 9)) {
            pg8::Gemm g{wsb(A, WS_H), (const bf16*)(wl + WL_UP), D, D}; pg8::GridOrder S; S.init(M / 256, NUP / 256, G, bid);
            pg8::EpiUp E{wsb(A, WS_ACT)};
            pg8::gemm_phase<pg8::EpiUp, pg8::GridOrder, true, true>(lds, g, S, E); SEAM(pb + 9);
        }
        if (IN(pb + 10)) {
            pg8::Gemm g{wsb(A, WS_ACT), (const bf16*)(wl + WL_DN), DFF, DFF}; pg8::GridOrder S; S.init(M / 256, 4, G, bid);
            pg8::EpiRes E{wsf(A, WS_X1), wsf(A, WS_X1) + (size_t)MP * D, wsf(A, WS_MOD) + (size_t)l * 256 * NMOD + 5 * D, wsf(A, WS_X2)};
            pg8::gemm_phase<pg8::EpiRes, pg8::GridOrder, true, true>(lds, g, S, E); SEAM(pb + 10);
        }
        if (IN(pb + 11)) { ph_rows<2>(A, l); SEAM(pb + 11); }
    }
#undef IN
#undef SEAM
}
#ifndef CPU_EMU
extern "C" void kernel_launch(void* const* d_in, const int* in_sizes, int n_in, void* d_out, int out_size, void* d_ws, size_t ws_size, hipStream_t stream) {
    static int grid = 0;
    if (grid == 0) {
        if (n_in != 38 || (size_t)out_size != O_END || ws_size < WS_END) { fprintf(stderr, "kernel_launch: unexpected shapes (n_in %d out %d ws %zu; want 38, %zu, >= %zu)\n", n_in, out_size, ws_size, (size_t)O_END, (size_t)WS_END); grid = -1; return; }
        int dev = 0, cus = 0, per_cu = 0;
        if (hipGetDevice(&dev) != hipSuccess || hipDeviceGetAttribute(&cus, hipDeviceAttributeMultiprocessorCount, dev) != hipSuccess) { grid = -1; return; }
        if (hipFuncSetAttribute((const void*)fwd_kernel, hipFuncAttributeMaxDynamicSharedMemorySize, LDS_BYTES) != hipSuccess) { fprintf(stderr, "kernel_launch: hipFuncSetAttribute failed\n"); grid = -1; return; }
        if (hipOccupancyMaxActiveBlocksPerMultiprocessor(&per_cu, (const void*)fwd_kernel, NWAVES * 64, LDS_BYTES) != hipSuccess || per_cu < 1) { fprintf(stderr, "kernel_launch: occupancy query says %d\n", per_cu); }
        (void)hipGetLastError();
        grid = cus;
    }
    if (grid < 0) return;
    if (hipMemsetAsync((char*)d_ws + WS_CTL, 0, CTL_ZERO_BYTES, stream) != hipSuccess) return;
    Args a{};
    for (int i = 0; i < 38; ++i) a.in[i] = (const float*)d_in[i];
    a.out = (float*)d_out; a.ws = (unsigned char*)d_ws;
    if (MK_N_LAUNCHES == 1) { a.ph_lo = 0; a.ph_hi = NPHASE; a.li = 0; hipLaunchKernelGGL(fwd_kernel, dim3(grid), dim3(NWAVES * 64), LDS_BYTES, stream, a); }
    else for (int p = 0; p < NPHASE; ++p) { if (p == 2 + PH_PER_LAYER) continue; a.ph_lo = p; a.ph_hi = p + 1; a.li = 0; hipLaunchKernelGGL(fwd_kernel, dim3(grid), dim3(NWAVES * 64), LDS_BYTES, stream, a); }
}
#endif
```

```cpp
#ifndef CPU_EMU
#include <hip/hip_runtime.h>
#endif
#include <cstdio>
#include <cstdint>
#include <cmath>

constexpr int D = 1024, NB = 2, DEPTH = 2, DEC_SEQ = 4, PAGE = 128;
#ifdef CPU_EMU
#ifndef EMU_SEQ
#define EMU_SEQ 512
#endif
#ifndef EMU_DB
#define EMU_DB 64
#endif
#ifndef EMU_PAST
#define EMU_PAST 512
#endif
constexpr int SEQ = EMU_SEQ, DB = EMU_DB, PAST = EMU_PAST;
#else
constexpr int SEQ = 8192, DB = 128, PAST = 2048;
#endif
constexpr int NPAGES = PAST / PAGE, NUSED = DB * NPAGES, NPOOL = NUSED + (NUSED / 4 > 1 ? NUSED / 4 : 1);
constexpr int MP = NB * SEQ, MS = DB * DEC_SEQ, M = MP + MS, NSEQ = NB + DB;
constexpr int WMIX = 256, NPROJ = 2816, NIN = 2824, NGATE = 4096, N1 = NPROJ + NGATE, DFF = 2816, NUP = 2 * DFF, NMOD = 6 * D;
constexpr int SSM_G = 16, SSM_P = 64, SSM_CH = 128, SSM_NCH = SEQ / SSM_CH;
constexpr int GH = 4, GDK = 64, GCH = 64, GNCH = SEQ / GCH, GQKV = 768;
constexpr int SBH = 4;
constexpr int PC_U = 0, PC_BG = 256, PC_CG = 512, PC_XC = 768, PC_QKV = 1024, PC_Z = 1792, PC_Q = 2048, PC_K = 2304, PC_V = 2560;
constexpr float LN_EPS = 1e-5f, RMS_EPS = 1e-6f, ALPHA = 1.41421356237309515f  ;
static_assert(M % 256 == 0 && MP % 256 == 0 && SEQ % 256 == 0 && NSEQ <= 256, "tile shapes");
constexpr size_t O_Y = 0, O_KP = (size_t)M * D, O_VP = O_KP + (size_t)DEPTH * MP * 256, O_KS = O_VP + (size_t)DEPTH * MP * 256, O_VS = O_KS + (size_t)DEPTH * MS * 256,
    O_REP = O_VS + (size_t)DEPTH * MS * 256, O_IMP = O_REP + DEPTH * NB * 1024, O_RES = O_IMP + DEPTH * NB * 1024, O_IMS = O_RES + (size_t)DEPTH * DB * 1024,
    O_CBP = O_IMS + (size_t)DEPTH * DB * 1024, O_CBS = O_CBP + DEPTH * NB * 512, O_DP = O_CBS + (size_t)DEPTH * DB * 512, O_DS = O_DP + (size_t)DEPTH * NB * 16384,
    O_CDP = O_DS + (size_t)DEPTH * DB * 16384, O_CDS = O_CDP + DEPTH * NB * 2304, O_END = O_CDS + (size_t)DEPTH * DB * 2304;

constexpr size_t MiB = 1u << 20;
constexpr size_t al(size_t x) { return (x + 4095) & ~(size_t)4095; }
constexpr size_t WS_CTL = 0, CTL_ZERO_BYTES = 1 * MiB;
constexpr size_t WL_ADA = 0, WL_W1 = WL_ADA + (size_t)NMOD * D * 2, WL_GLU = WL_W1 + (size_t)N1 * D * 2, WL_BR = WL_GLU + 256 * 256 * 2, WL_WO = WL_BR + (size_t)4 * D * 256 * 2,
    WL_UP = WL_WO + (size_t)D * D * 2, WL_DN = WL_UP + (size_t)NUP * D * 2, WL_LOG = WL_DN + (size_t)D * DFF * 2, WL_SIZE = (WL_LOG + 8 * D * 4 + 524287) & ~(size_t)524287;
constexpr size_t WS_W = 1 * MiB, WS_CSILU = WS_W + DEPTH * WL_SIZE, WS_MOD = WS_CSILU + 256 * D * 2, WS_H = WS_MOD + (size_t)DEPTH * 256 * NMOD * 4,
    WS_PROJ = WS_H + (size_t)M * D * 2, WS_GATE = al(WS_PROJ + (size_t)M * NPROJ * 2), WS_LOG8 = WS_GATE + (size_t)M * NGATE * 2, WS_Y = WS_LOG8 + (size_t)M * 8 * 4,
    WS_YS = WS_Y + (size_t)M * D * 2, WS_MERGE = WS_YS + (size_t)M * 256 * 2, WS_MERGEB = WS_MERGE + (size_t)M * D * 4, WS_X1 = WS_MERGEB + (size_t)M * D * 2,
    WS_ACT = WS_X1 + (size_t)M * D * 4, WS_X2 = al(WS_ACT + (size_t)M * DFF * 2), WS_SEND = WS_X2 + (size_t)M * D * 4, WS_HIN = WS_SEND + (size_t)NB * 16 * SSM_NCH * 128 * 4,
    WS_GD = WS_HIN + (size_t)NB * 16 * SSM_NCH * 128 * 4, WS_EGL = WS_GD + (size_t)NB * GH * GNCH * 49152, WS_ODRAW = al(WS_EGL + (size_t)NB * GH * GNCH * 4),
    WS_END = WS_ODRAW + (size_t)M * 256 * 4;
constexpr int CW_TMO = 0, CW_BAR = 4096;
constexpr size_t GD_UNIT = 49152;

#define LAS_HW __attribute__((address_space(3)))
#ifdef CPU_EMU
#define LAS
#else
#define LAS LAS_HW
#endif
typedef unsigned short bf16;
typedef unsigned v4u __attribute__((ext_vector_type(4)));
typedef unsigned v2u __attribute__((ext_vector_type(2)));
typedef float f32x4 __attribute__((ext_vector_type(4)));
typedef float f32x2 __attribute__((ext_vector_type(2)));
typedef short bf16x8 __attribute__((ext_vector_type(8)));
#ifdef CPU_EMU
#define LDS_WAIT() do {} while (0)
#define VM_WAIT() do {} while (0)
#define WAVE_SYNC() emu::wave_sync()
#define CFENCE() do {} while (0)
#else
#define LDS_WAIT() asm volatile("s_waitcnt lgkmcnt(0)" ::: "memory")
#define VM_WAIT() asm volatile("s_waitcnt vmcnt(0)" ::: "memory")
#define WAVE_SYNC() do { asm volatile("s_waitcnt lgkmcnt(0)" ::: "memory"); __builtin_amdgcn_wave_barrier(); } while (0)
#define CFENCE() asm volatile("" ::: "memory")
#endif
#ifdef CPU_EMU
#define OPAQUE_V(x) do {} while (0)
#else
#define OPAQUE_V(x) asm volatile("" : "+v"(x))
#endif
__device__ __forceinline__ unsigned f2bf(float f) { unsigned u = __builtin_bit_cast(unsigned, f); return (u + 0x7fffu + ((u >> 16) & 1u)) >> 16; }
__device__ __forceinline__ unsigned pk2(float lo, float hi) { return f2bf(lo) | (f2bf(hi) << 16); }
__device__ __forceinline__ float bf2f(unsigned b) { return __builtin_bit_cast(float, b << 16); }
__device__ __forceinline__ float bflo(unsigned w) { return __builtin_bit_cast(float, w << 16); }
__device__ __forceinline__ float bfhi(unsigned w) { return __builtin_bit_cast(float, w & 0xffff0000u); }
__device__ __forceinline__ float sigmoidf_(float x) { return 1.0f / (1.0f + __expf(-x)); }
__device__ __forceinline__ float siluf_(float x) { return x / (1.0f + __expf(-x)); }
__device__ __forceinline__ float wave_sum(float v) {
#pragma unroll
    for (int o = 1; o < 64; o <<= 1) v += __shfl_xor(v, o);
    return v;
}
__device__ __forceinline__ int seq_of(int m) { return m < MP ? m / SEQ : NB + (m - MP) / DEC_SEQ; }
namespace pg8 {
typedef unsigned short bf16_t;
constexpr int BM = 256, BK = 64, HALF = 128, HTB = HALF * BK * 2, STAGE_BYTES = 8 * HTB, NXCD = 8, WGM = 8;
__host__ __device__ __forceinline__ int lds_byte(int r, int c) { const int st = (r >> 4) * 2 + (c >> 5), rr = r & 15, cc = c & 31, ob = rr * 64 + cc * 2; return st * 1024 + (ob ^ (((ob >> 9) & 1) << 5)); }
__host__ __device__ __forceinline__ void stage_rc(int b, int& R, int& C) { const int st = b / 1024, sb = b % 1024, swz = sb ^ (((sb >> 9) & 1) << 5); R = (st >> 1) * 16 + swz / 64; C = (st & 1) * 32 + (swz % 64) / 2; }
__host__ __device__ __forceinline__ int perm32(int rho) { const int n = rho >> 4, i = rho & 15; return 8 * (i >> 2) + 4 * n + (i & 3); }
struct Unit { int pm, pn, ka, aux; };
struct Gemm { const bf16_t* A; const bf16_t* Bt; int lda, K; };
struct GridOrder {
    int nM, nN, nwg, G, c, pn0;
    __host__ __device__ void init(int nM_, int nN_, int G_, int c_, int pn0_ = 0) { nM = nM_; nN = nN_; nwg = nM * nN; G = G_; c = c_; pn0 = pn0_; }
    __host__ __device__ bool tile(long L, int& pm, int& pn) const {
        if (L >= nwg) return false;
        int wgid = (int)L; { const int q = nwg / NXCD, r = nwg % NXCD, xcd = wgid % NXCD, off = wgid / NXCD; wgid = (xcd < r ? xcd * (q + 1) : r * (q + 1) + (xcd - r) * q) + off; }
        const int nig = WGM * nN, gid = wgid / nig, fm = gid * WGM, gsz = (nM - fm) < WGM ? (nM - fm) : WGM;
        pm = fm + ((wgid % nig) % gsz); pn = (wgid % nig) / gsz; return true;
    }
    __host__ __device__ bool next(int i, Unit& u) const { int pm, pn; if (!tile((long)i * G + c, pm, pn)) return false; u.pm = pm; u.pn = pn0 + pn; u.ka = 0; u.aux = pn; return true; }
    __device__ __forceinline__ void a_ready(const Unit&) const {}
    __device__ __forceinline__ void done(const Unit&) const {}
};
struct MergeOrder : GridOrder {
    __host__ __device__ bool next(int i, Unit& u) const { int pm, pc; if (!tile((long)(i >> 2) * G + c, pm, pc)) return false; const int n = i & 3; u.pm = pm; u.pn = 4 * n + pc; u.ka = 256 * n; u.aux = (n << 8) | pc; return true; }
};
#ifndef CPU_EMU
#define PG8_LAS __attribute__((address_space(3)))
template <class Epi, class Sched, bool ALIGN_EPI = false, bool SP2 = false>
__device__ __forceinline__ void gemm_phase(PG8_LAS unsigned char* lds, const Gemm g, const Sched& S, const Epi& E) {
    int tid = threadIdx.x; asm volatile("" : "+v"(tid));
    const int wid = __builtin_amdgcn_readfirstlane(tid >> 6), lane = tid & 63, wr = wid >> 2, wc = wid & 3, fr = lane & 15, fq = lane >> 4;
    int K = g.K; asm volatile("" : "+s"(K));
    const int nt = K / BK, lda = g.lda;
    unsigned voffA[2], voffB[2];
#pragma unroll
    for (int i = 0; i < 2; ++i) { int R, C; stage_rc(tid * 16 + i * 8192, R, C); const int Rb = Epi::PERM ? ((R & ~31) + perm32(R & 31)) : R;
        voffA[i] = (unsigned)(R * lda + C) * 2u; voffB[i] = (unsigned)(Rb * K + C) * 2u; }
    const size_t kstep = (size_t)(BK * 2);
    const size_t hstepA = (size_t)HALF * lda * 2, hstepB = (size_t)HALF * K * 2;
    const size_t tstepA = 2 * hstepA, tstepB = 2 * hstepB;
    const unsigned ldsw = (unsigned)wid * 1024u;
    const int aoff = lds_byte(wr * 64 + fr, fq * 8), boff = lds_byte(wc * 32 + fr, fq * 8);
#define PG8_SA(b, h) (((b) * 2 + (h)) * HTB)
#define PG8_SB(b, h) ((4 + (b) * 2 + (h)) * HTB)
#define PG8_STAGE(bufoff, gbase, voff) do { _Pragma("unroll") for (int _i = 0; _i < 2; ++_i) \
        __builtin_amdgcn_global_load_lds((const unsigned*)((const char*)(gbase) + (voff)[_i]), (PG8_LAS unsigned*)(lds + (bufoff) + ldsw + _i * 8192), 16, 0, 0); } while (0)
#define PG8_LDA(dst, b, h) do { _Pragma("unroll") for (int m = 0; m < 4; ++m) _Pragma("unroll") for (int k = 0; k < 2; ++k) dst[m][k] = *(const PG8_LAS bf16x8*)(lds + PG8_SA(b, h) + aoff + m * 2048 + k * 1024); } while (0)
#define PG8_LDB(dst, b, h) do { _Pragma("unroll") for (int n = 0; n < 2; ++n) _Pragma("unroll") for (int k = 0; k < 2; ++k) dst[n][k] = *(const PG8_LAS bf16x8*)(lds + PG8_SB(b, h) + boff + n * 2048 + k * 1024); } while (0)
#define PG8_MMA(ai, bj, At, Bt) do { __builtin_amdgcn_s_setprio(1); _Pragma("unroll") for (int m = 0; m < 4; ++m) _Pragma("unroll") for (int n = 0; n < 2; ++n) _Pragma("unroll") for (int k = 0; k < 2; ++k) \
        acc[ai][bj][m][n] = __builtin_amdgcn_mfma_f32_16x16x32_bf16(Bt[n][k], At[m][k], acc[ai][bj][m][n], 0, 0, 0); __builtin_amdgcn_s_setprio(0); } while (0)
#define PG8_WAIT_V(n) asm volatile("s_waitcnt vmcnt(" #n ")" ::: "memory")
#define PG8_WAIT_L(n) asm volatile("s_waitcnt lgkmcnt(" #n ")" ::: "memory")
#define PG8_BAR __builtin_amdgcn_s_barrier()
#define PG8_SCHED __builtin_amdgcn_sched_barrier(0)
    Unit cur, nxt; int ui = 0;
    if (!S.next(0, cur)) return;
    f32x4 acc[2][2][4][2];
#pragma unroll
    for (int a = 0; a < 2; ++a)
#pragma unroll
        for (int b = 0; b < 2; ++b)
#pragma unroll
            for (int m = 0; m < 4; ++m)
#pragma unroll
                for (int n = 0; n < 2; ++n) acc[a][b][m][n] = (f32x4){0.f, 0.f, 0.f, 0.f};
    bf16x8 At[4][2], B0[2][2], B1[2][2];
    const char* cA = (const char*)g.A + (size_t)cur.pm * tstepA + (size_t)cur.ka * 2; const char* cB = (const char*)g.Bt + (size_t)cur.pn * tstepB;
    S.a_ready(cur);
    if constexpr (SP2) {
        PG8_STAGE(PG8_SB(0, 0), cB, voffB); PG8_STAGE(PG8_SB(0, 1), cB + hstepB, voffB); PG8_STAGE(PG8_SA(0, 0), cA, voffA); PG8_STAGE(PG8_SA(0, 1), cA + hstepA, voffA);
        if (wr == 1) PG8_BAR;
        PG8_WAIT_V(2); PG8_BAR;
        PG8_STAGE(PG8_SB(1, 0), cB + kstep, voffB); PG8_STAGE(PG8_SA(1, 0), cA + kstep, voffA); PG8_STAGE(PG8_SB(1, 1), cB + hstepB + kstep, voffB);
        PG8_WAIT_V(6); PG8_BAR;
    } else {
        PG8_STAGE(PG8_SB(0, 0), cB, voffB); PG8_STAGE(PG8_SA(0, 0), cA, voffA); PG8_STAGE(PG8_SB(0, 1), cB + hstepB, voffB); PG8_STAGE(PG8_SA(0, 1), cA + hstepA, voffA);
        if (wr == 1) PG8_BAR;
        PG8_WAIT_V(4); PG8_BAR;
        PG8_STAGE(PG8_SB(1, 0), cB + kstep, voffB); PG8_STAGE(PG8_SA(1, 0), cA + kstep, voffA); PG8_STAGE(PG8_SB(1, 1), cB + hstepB + kstep, voffB);
        PG8_WAIT_V(6); PG8_BAR;
    }
    for (;;) {
        const bool has_next = S.next(ui + 1, nxt);
        const char* nA = has_next ? (const char*)g.A + (size_t)nxt.pm * tstepA + (size_t)nxt.ka * 2 : cA; const char* nB = has_next ? (const char*)g.Bt + (size_t)nxt.pn * tstepB : cB;
        for (int t = 0; t < nt; t += 2) {
            const bool last = (t == nt - 2);
            const char* a1 = cA + (size_t)(t + 1) * kstep;
            const char* a2 = last ? nA : cA + (size_t)(t + 2) * kstep; const char* b2 = last ? nB : cB + (size_t)(t + 2) * kstep;
            const char* a3 = a2 + kstep; const char* b3 = b2 + kstep;
            if (last && has_next) S.a_ready(nxt);
            if constexpr (SP2) {
            PG8_LDB(B0, 0, 0); PG8_LDB(B1, 0, 1); PG8_SCHED; PG8_LDA(At, 0, 0); PG8_STAGE(PG8_SA(1, 1), a1 + hstepA, voffA);
            PG8_WAIT_V(8); PG8_WAIT_L(0); PG8_BAR; PG8_MMA(0, 0, At, B0); PG8_MMA(0, 1, At, B1); PG8_BAR; PG8_SCHED;
            PG8_LDA(At, 0, 1); PG8_STAGE(PG8_SB(0, 0), b2, voffB); PG8_STAGE(PG8_SB(0, 1), b2 + hstepB, voffB); PG8_STAGE(PG8_SA(0, 0), a2, voffA);
            PG8_WAIT_V(8); PG8_WAIT_L(0); PG8_BAR; PG8_MMA(1, 0, At, B0); PG8_MMA(1, 1, At, B1); PG8_BAR; PG8_SCHED;
            PG8_LDB(B0, 1, 0); PG8_LDB(B1, 1, 1); PG8_SCHED; PG8_LDA(At, 1, 0); PG8_STAGE(PG8_SA(0, 1), a2 + hstepA, voffA);
            PG8_WAIT_V(8); PG8_WAIT_L(0); PG8_BAR; PG8_MMA(0, 0, At, B0); PG8_MMA(0, 1, At, B1); PG8_BAR; PG8_SCHED;
            PG8_LDA(At, 1, 1); PG8_STAGE(PG8_SB(1, 0), b3, voffB); PG8_STAGE(PG8_SB(1, 1), b3 + hstepB, voffB); PG8_STAGE(PG8_SA(1, 0), a3, voffA);
            PG8_WAIT_V(8); PG8_WAIT_L(0); PG8_BAR; PG8_MMA(1, 0, At, B0); PG8_MMA(1, 1, At, B1); PG8_BAR; PG8_SCHED;
            } else {
            PG8_LDB(B0, 0, 0); PG8_SCHED; PG8_LDA(At, 0, 0); PG8_STAGE(PG8_SA(1, 1), a1 + hstepA, voffA);
            PG8_WAIT_L(8); PG8_BAR; PG8_WAIT_L(0); PG8_MMA(0, 0, At, B0); PG8_BAR; PG8_SCHED;
            PG8_LDB(B1, 0, 1); PG8_STAGE(PG8_SB(0, 0), b2, voffB);
            PG8_BAR; PG8_WAIT_L(0); PG8_MMA(0, 1, At, B1); PG8_BAR;
            PG8_LDA(At, 0, 1); PG8_STAGE(PG8_SA(0, 0), a2, voffA);
            PG8_BAR; PG8_WAIT_L(0); PG8_MMA(1, 0, At, B0); PG8_BAR; PG8_SCHED;
            PG8_STAGE(PG8_SB(0, 1), b2 + hstepB, voffB);
            PG8_WAIT_V(6); PG8_BAR; PG8_MMA(1, 1, At, B1); PG8_BAR;
            PG8_LDB(B0, 1, 0); PG8_SCHED; PG8_LDA(At, 1, 0); PG8_STAGE(PG8_SA(0, 1), a2 + hstepA, voffA);
            PG8_WAIT_L(8); PG8_BAR; PG8_WAIT_L(0); PG8_MMA(0, 0, At, B0); PG8_BAR; PG8_SCHED;
            PG8_LDB(B1, 1, 1); PG8_STAGE(PG8_SB(1, 0), b3, voffB);
            PG8_BAR; PG8_WAIT_L(0); PG8_MMA(0, 1, At, B1); PG8_BAR;
            PG8_LDA(At, 1, 1); PG8_STAGE(PG8_SA(1, 0), a3, voffA);
            PG8_BAR; PG8_WAIT_L(0); PG8_MMA(1, 0, At, B0); PG8_BAR; PG8_SCHED;
            PG8_STAGE(PG8_SB(1, 1), b3 + hstepB, voffB);
            PG8_WAIT_V(6); PG8_BAR; PG8_MMA(1, 1, At, B1); PG8_BAR;
            }
        }
        if constexpr (ALIGN_EPI) { if (wr == 0) PG8_BAR; }
        E(acc, cur, wr, wc, fr, fq); S.done(cur);
        if (!has_next) break;
#pragma unroll
        for (int a = 0; a < 2; ++a)
#pragma unroll
            for (int b = 0; b < 2; ++b)
#pragma unroll
                for (int m = 0; m < 4; ++m)
#pragma unroll
                    for (int n = 0; n < 2; ++n) acc[a][b][m][n] = (f32x4){0.f, 0.f, 0.f, 0.f};
        cur = nxt; cA = nA; cB = nB; ++ui;
        if constexpr (ALIGN_EPI) { if (wr == 1) PG8_BAR; }
    }
    PG8_WAIT_V(0);
    if constexpr (!ALIGN_EPI) { if (wr == 0) PG8_BAR; }
    PG8_BAR;
#undef PG8_SA
#undef PG8_SB
#undef PG8_STAGE
#undef PG8_LDA
#undef PG8_LDB
#undef PG8_MMA
#undef PG8_WAIT_V
#undef PG8_WAIT_L
#undef PG8_BAR
#undef PG8_SCHED
}
#else
template <class Epi, class Sched, bool ALIGN_EPI = false, bool SP2 = false>
void gemm_phase(unsigned char* lds, const Gemm g, const Sched& S, const Epi& E) {
    const int tid = threadIdx.x, wid = tid >> 6, lane = tid & 63, wr = wid >> 2, wc = wid & 3, fr = lane & 15, fq = lane >> 4;
    static thread_local float* Ct = nullptr; static thread_local float* Af = nullptr; static thread_local float* Bf = nullptr;
    Unit u;
    for (int i = 0; S.next(i, u); ++i) {
        S.a_ready(u);
        __syncthreads();
        if (tid == 0) {
            if (!Ct) { Ct = new float[256 * 256]; Af = new float[256 * 4096]; Bf = new float[256 * 4096]; }
            const int K = g.K;
            for (int r = 0; r < 256; ++r) for (int k = 0; k < K; ++k) { Af[r * K + k] = bf2f(g.A[(size_t)(u.pm * 256 + r) * g.lda + u.ka + k]); Bf[r * K + k] = bf2f(g.Bt[(size_t)(u.pn * 256 + r) * K + k]); }
            for (int r = 0; r < 256; ++r) for (int c = 0; c < 256; ++c) { float s = 0.f; const float* a = Af + r * K; const float* b = Bf + c * K; for (int k = 0; k < K; ++k) s += a[k] * b[k]; Ct[r * 256 + c] = s; }
        }
        __syncthreads();
        f32x4 acc[2][2][4][2];
        for (int ai = 0; ai < 2; ++ai) for (int bj = 0; bj < 2; ++bj) for (int m = 0; m < 4; ++m) for (int n = 0; n < 2; ++n) for (int e = 0; e < 4; ++e) {
            const int r = 128 * ai + 64 * wr + 16 * m + fr; const int c = Epi::PERM ? (128 * bj + 32 * wc + 8 * fq + 4 * n + e) : (128 * bj + 32 * wc + 16 * n + 4 * fq + e);
            acc[ai][bj][m][n][e] = Ct[r * 256 + c]; }
        E(acc, u, wr, wc, fr, fq); S.done(u);
    }
    __syncthreads();
}
#endif
}
namespace pg8 {
struct EpiMod {
    static constexpr bool PERM = false;
    float* C; const float* bias;
    __device__ __forceinline__ void operator()(const f32x4 (&acc)[2][2][4][2], const Unit& u, int wr, int wc, int fr_in, int fq_in) const {
        int fr = fr_in, fq = fq_in; OPAQUE_V(fr); OPAQUE_V(fq);
        const int row0 = wr * 64 + fr, col0 = u.aux * BM + wc * 32 + 4 * fq;
#pragma unroll
        for (int ai = 0; ai < 2; ++ai)
#pragma unroll
            for (int m = 0; m < 4; ++m) { float* rowp = C + (size_t)(row0 + ai * HALF + m * 16) * NMOD + col0;
#pragma unroll
                for (int bj = 0; bj < 2; ++bj)
#pragma unroll
                    for (int n = 0; n < 2; ++n) *(f32x4*)(rowp + bj * HALF + n * 16) = acc[ai][bj][m][n] + *(const f32x4*)(bias + col0 + bj * HALF + n * 16); }
    }
};
struct EpiProj {
    static constexpr bool PERM = true;
    bf16* proj; bf16* gate; float* outk_p; float* outv_p; float* outk_s; float* outv_s;
    __device__ __forceinline__ void operator()(const f32x4 (&acc)[2][2][4][2], const Unit& u, int wr, int wc, int fr_in, int fq_in) const {
        int fr = fr_in, fq = fq_in; OPAQUE_V(fr); OPAQUE_V(fq);
        const int t = u.aux; const bool isg = t >= 11;
        const int row0 = u.pm * BM + wr * 64 + fr, colt = wc * 32 + 8 * fq;
        bf16* base = isg ? gate + (size_t)(t - 11) * 256 : proj + (size_t)t * 256; const int ldc = isg ? NGATE : NPROJ;
#pragma unroll
        for (int ai = 0; ai < 2; ++ai)
#pragma unroll
            for (int m = 0; m < 4; ++m) { const int row = row0 + ai * HALF + m * 16; bf16* rowp = base + (size_t)row * ldc + colt;
#pragma unroll
                for (int bj = 0; bj < 2; ++bj) { f32x4 v0 = acc[ai][bj][m][0], v1 = acc[ai][bj][m][1];
                    if (isg) {
#pragma unroll
                        for (int e = 0; e < 4; ++e) { v0[e] = sigmoidf_(v0[e]); v1[e] = sigmoidf_(v1[e]); } }
                    else if (t >= 9) { float* o = (row < MP) ? ((t == 9 ? outk_p : outv_p) + (size_t)row * 256) : ((t == 9 ? outk_s : outv_s) + (size_t)(row - MP) * 256);
                        *(f32x4*)(o + colt + bj * HALF) = v0; *(f32x4*)(o + colt + bj * HALF + 4) = v1; }
                    v4u w; w.x = pk2(v0[0], v0[1]); w.y = pk2(v0[2], v0[3]); w.z = pk2(v1[0], v1[1]); w.w = pk2(v1[2], v1[3]);
                    *(v4u*)(rowp + bj * HALF) = w; } }
    }
};
struct EpiGlu {
    static constexpr bool PERM = true;
    const bf16* ys; bf16* y;
    __device__ __forceinline__ void operator()(const f32x4 (&acc)[2][2][4][2], const Unit& u, int wr, int wc, int fr_in, int fq_in) const {
        int fr = fr_in, fq = fq_in; OPAQUE_V(fr); OPAQUE_V(fq);
        const int row0 = u.pm * BM + wr * 64 + fr, colt = wc * 32 + 8 * fq;
#pragma unroll
        for (int ai = 0; ai < 2; ++ai)
#pragma unroll
            for (int m = 0; m < 4; ++m) { const int row = row0 + ai * HALF + m * 16;
#pragma unroll
                for (int bj = 0; bj < 2; ++bj) { const f32x4 v0 = acc[ai][bj][m][0], v1 = acc[ai][bj][m][1];
                    const v4u s = *(const v4u*)(ys + (size_t)row * 256 + colt + bj * HALF);
                    v4u w; w.x = pk2(bflo(s.x) * sigmoidf_(v0[0]), bfhi(s.x) * sigmoidf_(v0[1])); w.y = pk2(bflo(s.y) * sigmoidf_(v0[2]), bfhi(s.y) * sigmoidf_(v0[3]));
                    w.z = pk2(bflo(s.z) * sigmoidf_(v1[0]), bfhi(s.z) * sigmoidf_(v1[1])); w.w = pk2(bflo(s.w) * sigmoidf_(v1[2]), bfhi(s.w) * sigmoidf_(v1[3]));
                    *(v4u*)(y + (size_t)row * D + colt + bj * HALF) = w; } CFENCE(); }
    }
};
struct EpiMerge {
    static constexpr bool PERM = false;
    const bf16* gate; float* mg; bf16* mgb;
    __device__ __forceinline__ void operator()(const f32x4 (&acc)[2][2][4][2], const Unit& u, int wr, int wc, int fr_in, int fq_in) const {
        int fr = fr_in, fq = fq_in; OPAQUE_V(fr); OPAQUE_V(fq);
        const int n_ = u.aux >> 8, pc = u.aux & 255;
        const int row0 = u.pm * BM + wr * 64 + fr, col0 = pc * BM + wc * 32 + 4 * fq;
#pragma unroll
        for (int ai = 0; ai < 2; ++ai)
#pragma unroll
            for (int m = 0; m < 4; ++m) { const int row = row0 + ai * HALF + m * 16;
#pragma unroll
                for (int bj = 0; bj < 2; ++bj)
#pragma unroll
                    for (int n = 0; n < 2; ++n) { const int col = col0 + bj * HALF + n * 16;
                        const v2u gw = *(const v2u*)(gate + (size_t)row * NGATE + n_ * D + col);
                        f32x4 v = acc[ai][bj][m][n]; v[0] *= bflo(gw.x); v[1] *= bfhi(gw.x); v[2] *= bflo(gw.y); v[3] *= bfhi(gw.y);
                        float* p = mg + (size_t)row * D + col;
                        if (n_ > 0) v += *(const f32x4*)p;
                        if (n_ < 3) *(f32x4*)p = v;
                        else { v2u o; o.x = pk2(v[0], v[1]); o.y = pk2(v[2], v[3]); *(v2u*)(mgb + (size_t)row * D + col) = o; } } CFENCE(); }
    }
};
struct EpiRes {
    static constexpr bool PERM = false;
    const float* xP; const float* xS; const float* gmod; float* out;
    __device__ __forceinline__ void operator()(const f32x4 (&acc)[2][2][4][2], const Unit& u, int wr, int wc, int fr_in, int fq_in) const {
        int fr = fr_in, fq = fq_in; OPAQUE_V(fr); OPAQUE_V(fq);
        const int row0 = u.pm * BM + wr * 64 + fr, col0 = u.aux * BM + wc * 32 + 4 * fq;
#pragma unroll
        for (int ai = 0; ai < 2; ++ai)
#pragma unroll
            for (int m = 0; m < 4; ++m) { const int row = row0 + ai * HALF + m * 16; const float* xr = row < MP ? xP + (size_t)row * D : xS + (size_t)(row - MP) * D;
                const float* gr = gmod + (size_t)seq_of(row) * NMOD;
#pragma unroll
                for (int bj = 0; bj < 2; ++bj)
#pragma unroll
                    for (int n = 0; n < 2; ++n) { const int col = col0 + bj * HALF + n * 16;
                        const f32x4 xv = *(const f32x4*)(xr + col), gv = *(const f32x4*)(gr + col);
                        *(f32x4*)(out + (size_t)row * D + col) = xv * ALPHA + (gv + 1.0f) * acc[ai][bj][m][n]; } CFENCE(); }
    }
};
struct EpiUp {
    static constexpr bool PERM = true;
    bf16* act;
    __device__ __forceinline__ void operator()(const f32x4 (&acc)[2][2][4][2], const Unit& u, int wr, int wc, int fr_in, int fq_in) const {
        int fr = fr_in, fq = fq_in; OPAQUE_V(fr); OPAQUE_V(fq);
        const int row0 = u.pm * BM + wr * 64 + fr, col0 = u.aux * HALF + wc * 32 + 8 * fq;
#pragma unroll
        for (int ai = 0; ai < 2; ++ai)
#pragma unroll
            for (int m = 0; m < 4; ++m) { const int row = row0 + ai * HALF + m * 16;
                const f32x4 a0 = acc[ai][0][m][0], a1 = acc[ai][0][m][1], b0 = acc[ai][1][m][0], b1 = acc[ai][1][m][1];
                v4u w; w.x = pk2(siluf_(a0[0]) * b0[0], siluf_(a0[1]) * b0[1]); w.y = pk2(siluf_(a0[2]) * b0[2], siluf_(a0[3]) * b0[3]);
                w.z = pk2(siluf_(a1[0]) * b1[0], siluf_(a1[1]) * b1[1]); w.w = pk2(siluf_(a1[2]) * b1[2], siluf_(a1[3]) * b1[3]);
                *(v4u*)(act + (size_t)row * DFF + col0) = w; }
    }
};
}
struct Args { const float* in[38]; float* out; unsigned char* ws; int ph_lo, ph_hi, li, pad; };
enum { I_XP = 0, I_XS, I_CK, I_CV, I_SRE, I_SIM, I_SCB, I_SD, I_SCD, I_PT, I_CP, I_CS, I_WADA, I_BADA, I_WIN, I_ARE, I_AIM, I_LDT, I_BRE, I_BIM, I_CRE, I_CIM, I_SSD, I_WGLU,
       I_CBW, I_DCW, I_DAL, I_DDT, I_DNW, I_WBR, I_WGATE, I_WO, I_L1G, I_L1B, I_WUP, I_WDN, I_L2G, I_L2B };
constexpr int NWAVES = 8, RING_BYTES = 131072, MISC_OFF = RING_BYTES, LDS_BYTES = 147456;
#ifndef CPU_EMU
#define XB_TMO      128
#define XB_XCNT(j)  (256  + 64 * (j))
#define XB_XSUB(j)  (1280 + 64 * (j))
#define XB_XGEN(j)  (2304 + 64 * (j))
#define XB_TOP      3328
#define XB_TOPGEN   3392
#define XCD_BAR_WORDS 3456
#define XB_SPIN_CAP (1u << 18)
__device__ __forceinline__ unsigned xb_ld(unsigned* p)              { return __hip_atomic_load(p, __ATOMIC_RELAXED, __HIP_MEMORY_SCOPE_AGENT); }
__device__ __forceinline__ unsigned xb_add(unsigned* p, unsigned v) { return __hip_atomic_fetch_add(p, v, __ATOMIC_RELAXED, __HIP_MEMORY_SCOPE_AGENT); }
__device__ __forceinline__ unsigned xb_xcc_id() { return (unsigned)__builtin_amdgcn_s_getreg((3 << 11) | 20) & 0xFu; }
#define XB_SPIN(cond, bar) do { unsigned _sp = 0; while (cond) { __builtin_amdgcn_s_sleep(1); \
    if ((++_sp & 255u) == 0u) { if (xb_ld(&(bar)[XB_TMO])) break; if (_sp > XB_SPIN_CAP) { atomicAdd(&(bar)[XB_TMO], 1u); break; } } } } while (0)
struct XcdBarrier { unsigned* bar; unsigned x; volatile LAS_HW unsigned* st; };
__device__ __forceinline__ XcdBarrier xcd_barrier_post(unsigned* bar, volatile LAS_HW unsigned* st) {
    XcdBarrier b; b.bar = bar; b.x = xb_xcc_id(); b.st = st;
    if (threadIdx.x == 0) (void)xb_add(&bar[XB_XCNT(b.x)], 1u);
    return b;
}
__device__ __forceinline__ void xcd_barrier_complete(unsigned* bar, unsigned x, unsigned& nloc, unsigned& nx) {
    const unsigned G = gridDim.x * gridDim.y * gridDim.z;
    unsigned sum, cnt, mine, sp = 0u;
    for (;;) {
        sum = 0u; cnt = 0u; mine = 0u;
#pragma unroll
        for (unsigned j = 0; j < 16; ++j) { const unsigned c = xb_ld(&bar[XB_XCNT(j)]); sum += c; cnt += (c > 0u) ? 1u : 0u; mine = (j == x) ? c : mine; }
        if (sum == G) break;
        __builtin_amdgcn_s_sleep(1);
        if ((++sp & 255u) == 0u) { if (xb_ld(&bar[XB_TMO])) break; if (sp > XB_SPIN_CAP) { atomicAdd(&bar[XB_TMO], 1u); break; } }
    }
    nloc = mine > 0u ? mine : 1u; nx = cnt > 0u ? cnt : 1u;
}
__device__ __forceinline__ void xcd_barrier(const XcdBarrier& b) {
    asm volatile("s_waitcnt vmcnt(0)" ::: "memory");
    __syncthreads();
    if (threadIdx.x == 0) {
        unsigned* bar = b.bar;
        __builtin_amdgcn_s_waitcnt(0);
        unsigned nloc = b.st[0], nx = b.st[1];
        if (nloc == 0u) { xcd_barrier_complete(bar, b.x, nloc, nx); b.st[0] = nloc; b.st[1] = nx; }
        const unsigned old = xb_add(&bar[XB_XSUB(b.x)], 1u);
        const unsigned gen = old / nloc;
        if (old + 1u == (gen + 1u) * nloc) {
            __builtin_amdgcn_fence(__ATOMIC_RELEASE, "agent");
            asm volatile("s_waitcnt vmcnt(0)" ::: "memory");
            const unsigned og = xb_add(&bar[XB_TOP], 1u);
            const unsigned tg = og / nx;
            if (og + 1u == (tg + 1u) * nx) xb_add(&bar[XB_TOPGEN], 1u);
            else XB_SPIN(xb_ld(&bar[XB_TOPGEN]) == tg, bar);
            __builtin_amdgcn_fence(__ATOMIC_ACQUIRE, "agent");
            xb_add(&bar[XB_XGEN(b.x)], 1u);
            asm volatile("s_waitcnt vmcnt(0)" ::: "memory");
        } else {
            XB_SPIN(xb_ld(&bar[XB_XGEN(b.x)]) == gen, bar);
            __builtin_amdgcn_fence(__ATOMIC_ACQUIRE, "agent");
            asm volatile("s_waitcnt vmcnt(0)" ::: "memory");
        }
    }
    __syncthreads();
}
#else
#define XCD_BAR_WORDS 3456
struct XcdBarrier { int dummy; };
inline void xcd_barrier(const XcdBarrier&) { emu::grid_sync(); }
#endif

#define TIDS int tid_ = threadIdx.x; OPAQUE_V(tid_); const int tid = tid_, lane = tid & 63, wave = __builtin_amdgcn_readfirstlane(tid >> 6), G = gridDim.x, bid = blockIdx.x, gw = bid * NWAVES + wave, NGW = G * NWAVES; (void)lane; (void)wave; (void)gw; (void)NGW; (void)G; (void)bid
__device__ __forceinline__ bf16* wsb(const Args& A, size_t off) { return (bf16*)(A.ws + off); }
__device__ __forceinline__ float* wsf(const Args& A, size_t off) { return (float*)(A.ws + off); }
__device__ __forceinline__ float softplusf_(float x) { return fmaxf(x, 0.f) + log1pf(__expf(-fabsf(x))); }
__device__ __forceinline__ void tr_item(const float* W, int N, int K, int k0, int c0, bf16* WT, int drow0, LAS float* scr, int lane) {
#pragma unroll 8
    for (int i = 0; i < 32; ++i) { const int kk = 2 * i + (lane >> 5); scr[kk * 33 + (lane & 31)] = W[(size_t)(k0 + kk) * N + c0 + (lane & 31)]; }
    WAVE_SYNC();
    const int c = lane & 7;
#pragma unroll
    for (int j = 0; j < 4; ++j) { const int n = (lane >> 3) + 8 * j; const LAS float* s = scr + (8 * c) * 33 + n;
        v4u o; o.x = pk2(s[0 * 33], s[1 * 33]); o.y = pk2(s[2 * 33], s[3 * 33]); o.z = pk2(s[4 * 33], s[5 * 33]); o.w = pk2(s[6 * 33], s[7 * 33]);
        *(v4u*)(WT + (size_t)(drow0 + n) * K + k0 + 8 * c) = o; }
    WAVE_SYNC();
}
__device__ __forceinline__ void ph_prologue(const Args& A, LAS unsigned char* lds) {
    TIDS;
    LAS float* scr = (LAS float*)(lds + wave * 16384);
    constexpr int I_ADA = 16 * 192, I_IN1 = 16 * 64, I_IN2 = 16 * 24, I_GT = 16 * 128, I_GLU = 4 * 8, I_BR = 4 * 4 * 32, I_WO_ = 16 * 32, I_UP = 16 * 176, I_DN = 44 * 32;
    constexpr int PER_L = I_ADA + I_IN1 + I_IN2 + I_GT + I_GLU + I_BR + I_WO_ + I_UP + I_DN;
    for (int it = gw; it < DEPTH * PER_L; it += NGW) {
        const int l = it / PER_L; int r = it % PER_L; unsigned char* wl = A.ws + WS_W + (size_t)l * WL_SIZE;
        if (r < I_ADA) { const int kb = r / 192, nb = r % 192; tr_item(A.in[I_WADA] + (size_t)l * D * NMOD, NMOD, D, kb * 64, nb * 32, (bf16*)(wl + WL_ADA), nb * 32, scr, lane); continue; } r -= I_ADA;
        if (r < I_IN1) { const int kb = r / 64, nb = r % 64; tr_item(A.in[I_WIN] + (size_t)l * D * NIN, NIN, D, kb * 64, nb * 32, (bf16*)(wl + WL_W1), nb * 32, scr, lane); continue; } r -= I_IN1;
        if (r < I_IN2) { const int kb = r / 24, nb = r % 24; tr_item(A.in[I_WIN] + (size_t)l * D * NIN, NIN, D, kb * 64, 2056 + nb * 32, (bf16*)(wl + WL_W1), 2048 + nb * 32, scr, lane); continue; } r -= I_IN2;
        if (r < I_GT) { const int kb = r / 128, nb = r % 128; tr_item(A.in[I_WGATE] + (size_t)l * D * NGATE, NGATE, D, kb * 64, nb * 32, (bf16*)(wl + WL_W1), NPROJ + nb * 32, scr, lane); continue; } r -= I_GT;
        if (r < I_GLU) { const int kb = r / 8, nb = r % 8; tr_item(A.in[I_WGLU] + (size_t)l * 256 * 256, 256, 256, kb * 64, nb * 32, (bf16*)(wl + WL_GLU), nb * 32, scr, lane); continue; } r -= I_GLU;
        if (r < I_BR) { const int n = r / 128, r2 = r % 128, kb = r2 / 32, nb = r2 % 32; tr_item(A.in[I_WBR] + (size_t)(l * 4 + n) * 256 * D, D, 256, kb * 64, nb * 32, (bf16*)(wl + WL_BR), n * D + nb * 32, scr, lane); continue; } r -= I_BR;
        if (r < I_WO_) { const int kb = r / 32, nb = r % 32; tr_item(A.in[I_WO] + (size_t)l * D * D, D, D, kb * 64, nb * 32, (bf16*)(wl + WL_WO), nb * 32, scr, lane); continue; } r -= I_WO_;
        if (r < I_UP) { const int kb = r / 176, nb = r % 176; const int c0 = nb * 32, j = c0 < DFF ? c0 : c0 - DFF; const int drow = (j / 128) * 256 + (c0 < DFF ? 0 : 128) + (j % 128);
            tr_item(A.in[I_WUP] + (size_t)l * D * NUP, NUP, D, kb * 64, c0, (bf16*)(wl + WL_UP), drow, scr, lane); continue; } r -= I_UP;
        { const int kb = r / 32, nb = r % 32; tr_item(A.in[I_WDN] + (size_t)l * DFF * D, D, DFF, kb * 64, nb * 32, (bf16*)(wl + WL_DN), nb * 32, scr, lane); }
    }
    const int gt = bid * (NWAVES * 64) + tid, NGT = G * NWAVES * 64;
    for (int i = gt; i < DEPTH * 8 * D; i += NGT) { const int l = i / (8 * D), j = (i / D) % 8, k = i % D; ((float*)(A.ws + WS_W + (size_t)l * WL_SIZE + WL_LOG))[j * D + k] = A.in[I_WIN][((size_t)l * D + k) * NIN + 2048 + j]; }
    for (int i = gt; i < 256 * D; i += NGT) { const int r = i / D, k = i % D; float v = 0.f;
        if (r < NB) v = siluf_(A.in[I_CP][r * D + k]); else if (r < NSEQ) v = siluf_(A.in[I_CS][(r - NB) * D + k]);
        wsb(A, WS_CSILU)[i] = (bf16)f2bf(v); }
}
struct ModOrder {
    int G, c;
    __host__ __device__ bool next(int i, pg8::Unit& u) const { const int L = i * G + c; if (L >= 24 * DEPTH) return false; const int l = L / 24, pn = L % 24;
        u.pm = 0; u.pn = l * (int)(WL_SIZE / (512 * 1024)) + pn; u.ka = 0; u.aux = pn | (l << 8); return true; }
    __device__ __forceinline__ void a_ready(const pg8::Unit&) const {}
    __device__ __forceinline__ void done(const pg8::Unit&) const {}
};
struct EpiMod2 { static constexpr bool PERM = false; float* C; const float* bias;
    __device__ __forceinline__ void operator()(const f32x4 (&acc)[2][2][4][2], const pg8::Unit& u, int wr, int wc, int fr, int fq) const {
        const int l = u.aux >> 8; pg8::Unit u2 = u; u2.aux = u.aux & 255; pg8::EpiMod e{C + (size_t)l * 256 * NMOD, bias + (size_t)l * NMOD}; e(acc, u2, wr, wc, fr, fq); } };
template <int MODE> __device__ __forceinline__ void ph_rows(const Args& A, int l) {
    TIDS;
    const float* MOD = wsf(A, WS_MOD);
    for (int m = gw; m < M; m += NGW) {
        const float* src; float* dstx = nullptr;
        if (MODE == 0) src = m < MP ? A.in[I_XP] + (size_t)m * D : A.in[I_XS] + (size_t)(m - MP) * D;
        else if (MODE == 1) { src = wsf(A, WS_X1) + (size_t)m * D; dstx = wsf(A, WS_X1) + (size_t)m * D; }
        else { src = wsf(A, WS_X2) + (size_t)m * D; dstx = (l == DEPTH - 1) ? A.out + O_Y + (size_t)m * D : wsf(A, WS_X2) + (size_t)m * D; }
        f32x4 v[4];
#pragma unroll
        for (int j = 0; j < 4; ++j) v[j] = ((const f32x4*)src)[lane + 64 * j];
        if (MODE != 0) {
            float s = 0.f;
#pragma unroll
            for (int j = 0; j < 4; ++j) s += (v[j][0] + v[j][1]) + (v[j][2] + v[j][3]);
            const float mean = wave_sum(s) * (1.f / D); float s2 = 0.f;
#pragma unroll
            for (int j = 0; j < 4; ++j) { v[j] = v[j] - mean; s2 += (v[j][0] * v[j][0] + v[j][1] * v[j][1]) + (v[j][2] * v[j][2] + v[j][3] * v[j][3]); }
            const float rstd = 1.f / sqrtf(wave_sum(s2) * (1.f / D) + LN_EPS);
            const float* gp = A.in[MODE == 1 ? I_L1G : I_L2G] + (size_t)l * D; const float* bp = A.in[MODE == 1 ? I_L1B : I_L2B] + (size_t)l * D;
#pragma unroll
            for (int j = 0; j < 4; ++j) { const f32x4 g = ((const f32x4*)gp)[lane + 64 * j], b = ((const f32x4*)bp)[lane + 64 * j]; v[j] = v[j] * rstd * g + b; ((f32x4*)dstx)[lane + 64 * j] = v[j]; }
            if (MODE == 2 && l == DEPTH - 1) continue;
        }
        const int ln = (MODE == 2) ? l + 1 : l;
        const float* mr = MOD + ((size_t)ln * 256 + seq_of(m)) * NMOD + (MODE == 1 ? 3 * D : 0);
        float s = 0.f;
#pragma unroll
        for (int j = 0; j < 4; ++j) s += (v[j][0] + v[j][1]) + (v[j][2] + v[j][3]);
        const float mean = wave_sum(s) * (1.f / D); float s2 = 0.f;
#pragma unroll
        for (int j = 0; j < 4; ++j) { v[j] = v[j] - mean; s2 += (v[j][0] * v[j][0] + v[j][1] * v[j][1]) + (v[j][2] * v[j][2] + v[j][3] * v[j][3]); }
        const float rstd = 1.f / sqrtf(wave_sum(s2) * (1.f / D) + LN_EPS);
        v2u* hrow = (v2u*)(wsb(A, WS_H) + (size_t)m * D);
#pragma unroll
        for (int j = 0; j < 4; ++j) { const f32x4 sh = ((const f32x4*)mr)[lane + 64 * j], sc = ((const f32x4*)(mr + D))[lane + 64 * j]; v[j] = v[j] * rstd * (sc + 1.0f) + sh;
            v2u o; o.x = pk2(v[j][0], v[j][1]); o.y = pk2(v[j][2], v[j][3]); hrow[lane + 64 * j] = o; }
        if (MODE != 1) {
            const float* wl = (const float*)(A.ws + WS_W + (size_t)ln * WL_SIZE + WL_LOG);
            float lg[8];
#pragma unroll
            for (int jj = 0; jj < 8; ++jj) { float t = 0.f;
#pragma unroll
                for (int j = 0; j < 4; ++j) { const f32x4 w = ((const f32x4*)(wl + jj * D))[lane + 64 * j]; t += (v[j][0] * w[0] + v[j][1] * w[1]) + (v[j][2] * w[2] + v[j][3] * w[3]); }
                lg[jj] = wave_sum(t); }
            if (lane == 0) { float* o = wsf(A, WS_LOG8) + (size_t)m * 8; *(f32x4*)o = (f32x4){lg[0], lg[1], lg[2], lg[3]}; *(f32x4*)(o + 4) = (f32x4){lg[4], lg[5], lg[6], lg[7]}; }
        }
    }
}
struct SsmC { float abr, abi, bbr[16], bbi[16]; };
__device__ __forceinline__ void ssm_consts(const Args& A, int l, int g, int p, SsmC& c) {
    const int gi = l * 16 + g;
    const float dt = expf(A.in[I_LDT][gi]), ar = A.in[I_ARE][gi * 64 + p], ai = A.in[I_AIM][gi * 64 + p];
    const float mag = expf(dt * ar); c.abr = mag * cosf(dt * ai); c.abi = mag * sinf(dt * ai);
    const float den = ar * ar + ai * ai, fre = ((c.abr - 1.0f) * ar + c.abi * ai) / den, fim = (c.abi * ar - (c.abr - 1.0f) * ai) / den;
    const f32x4* br = (const f32x4*)(A.in[I_BRE] + (size_t)(gi * 64 + p) * 16); const f32x4* bi = (const f32x4*)(A.in[I_BIM] + (size_t)(gi * 64 + p) * 16);
#pragma unroll
    for (int q = 0; q < 4; ++q) { const f32x4 r = br[q], i = bi[q];
#pragma unroll
        for (int e = 0; e < 4; ++e) { c.bbr[4 * q + e] = fre * r[e] - fim * i[e]; c.bbi[4 * q + e] = fre * i[e] + fim * r[e]; } }
}
__device__ __forceinline__ void ssm_step(const SsmC& c, const bf16* urow, float& hr, float& hi) {
    const v4u u0 = *(const v4u*)urow, u1 = *(const v4u*)(urow + 8);
    float u[16] = {bflo(u0.x), bfhi(u0.x), bflo(u0.y), bfhi(u0.y), bflo(u0.z), bfhi(u0.z), bflo(u0.w), bfhi(u0.w), bflo(u1.x), bfhi(u1.x), bflo(u1.y), bfhi(u1.y), bflo(u1.z), bfhi(u1.z), bflo(u1.w), bfhi(u1.w)};
    float br = 0.f, bi = 0.f;
#pragma unroll
    for (int h = 0; h < 16; ++h) { br += c.bbr[h] * u[h]; bi += c.bbi[h] * u[h]; }
    const float nr = c.abr * hr - c.abi * hi + br, ni = c.abr * hi + c.abi * hr + bi; hr = nr; hi = ni;
}
__device__ __forceinline__ void ph_ssm1(const Args& A, int l) {
    TIDS;
    const bf16* proj = wsb(A, WS_PROJ);
    for (int un = gw; un < NB * 16 * SSM_NCH; un += NGW) {
        const int c = un % SSM_NCH, g = (un / SSM_NCH) % 16, b = un / (SSM_NCH * 16);
        SsmC k; ssm_consts(A, l, g, lane, k);
        float hr = 0.f, hi = 0.f;
        const bf16* up = proj + (size_t)(b * SEQ + c * SSM_CH) * NPROJ + PC_U + g * 16;
        for (int t = 0; t < SSM_CH; ++t) ssm_step(k, up + (size_t)t * NPROJ, hr, hi);
        float* o = wsf(A, WS_SEND) + (size_t)un * 128; o[lane] = hr; o[64 + lane] = hi;
    }
}
__device__ __forceinline__ void ph_ssm_carry(const Args& A, int l) {
    TIDS;
    const int gt = (G - 1 - bid) * (NWAVES * 64) + tid;
    if (gt < NB * 16 * 64) {
        const int p = gt & 63, g = (gt >> 6) & 15, b = gt >> 10; const int gi = l * 16 + g;
        const float dt = expf(A.in[I_LDT][gi]), ar = A.in[I_ARE][gi * 64 + p], ai = A.in[I_AIM][gi * 64 + p];
        const float mag = expf(dt * ar); float pr = mag * cosf(dt * ai), pi = mag * sinf(dt * ai);
        for (int s = 1; s < SSM_CH; s <<= 1) { const float nr = pr * pr - pi * pi, ni = 2.f * pr * pi; pr = nr; pi = ni; }
        float cr = 0.f, ci = 0.f;
        for (int c = 0; c < SSM_NCH; ++c) { const size_t un = ((size_t)(b * 16 + g) * SSM_NCH + c) * 128;
            wsf(A, WS_HIN)[un + p] = cr; wsf(A, WS_HIN)[un + 64 + p] = ci;
            const float sr = wsf(A, WS_SEND)[un + p], si = wsf(A, WS_SEND)[un + 64 + p];
            const float nr = pr * cr - pi * ci + sr, ni = pr * ci + pi * cr + si; cr = nr; ci = ni; }
    }
}
__device__ __forceinline__ float gelu_tanh(float x) { const float t = tanhf(0.7978845608028654f * (x + 0.044715f * x * x * x)); return 0.5f * x * (1.0f + t); }
__device__ __forceinline__ void ph_ssm2(const Args& A, LAS unsigned char* lds, int l) {
    TIDS;
    LAS float* ct = (LAS float*)(lds + wave * 16384);
    LAS float* ht = ct + 2048;
    const bf16* proj = wsb(A, WS_PROJ);
    constexpr int NPU = NB * 16 * SSM_NCH, NSU = DB * 16;
    for (int un = gw; un < NPU + NSU; un += NGW) {
        int g, m0, ntok; float hr, hi; float* fre = nullptr; float* fim = nullptr;
        if (un < NPU) { const int c = un % SSM_NCH; g = (un / SSM_NCH) % 16; const int b = un / (SSM_NCH * 16); m0 = b * SEQ + c * SSM_CH; ntok = SSM_CH;
            hr = wsf(A, WS_HIN)[(size_t)un * 128 + lane]; hi = wsf(A, WS_HIN)[(size_t)un * 128 + 64 + lane];
            if (c == SSM_NCH - 1) { fre = A.out + O_REP + ((size_t)(l * NB + b) * 16 + g) * 64; fim = A.out + O_IMP + ((size_t)(l * NB + b) * 16 + g) * 64; } }
        else { const int su = un - NPU; g = su & 15; const int s = su >> 4; m0 = MP + s * DEC_SEQ; ntok = DEC_SEQ;
            hr = A.in[I_SRE][((size_t)(l * DB + s) * 16 + g) * 64 + lane]; hi = A.in[I_SIM][((size_t)(l * DB + s) * 16 + g) * 64 + lane];
            fre = A.out + O_RES + ((size_t)(l * DB + s) * 16 + g) * 64; fim = A.out + O_IMS + ((size_t)(l * DB + s) * 16 + g) * 64; }
        SsmC k; ssm_consts(A, l, g, lane, k);
        const int gi = l * 16 + g;
        for (int ch = 0; ch < 16; ++ch) { ct[lane * 16 + ch] = A.in[I_CRE][((size_t)gi * 16 + ch) * 64 + lane]; ct[1024 + lane * 16 + ch] = A.in[I_CIM][((size_t)gi * 16 + ch) * 64 + lane]; }
        const float dd = A.in[I_SSD][l * 256 + g * 16 + (lane & 15)];
        for (int t0 = 0; t0 < ntok; t0 += 16) {
            const int nt = (ntok - t0) < 16 ? (ntok - t0) : 16;
            for (int t = 0; t < nt; ++t) { ssm_step(k, proj + (size_t)(m0 + t0 + t) * NPROJ + PC_U + g * 16, hr, hi); ht[t * 64 + lane] = hr; ht[1024 + t * 64 + lane] = hi; }
            WAVE_SYNC();
            const int ch = lane & 15, tq = lane >> 4;
#pragma unroll
            for (int i = 0; i < 4; ++i) { const int tt = tq + 4 * i;
                if (tt < nt) { float y = 0.f;
                    for (int p = 0; p < 64; ++p) y += ct[p * 16 + ch] * ht[tt * 64 + p] - ct[1024 + p * 16 + ch] * ht[1024 + tt * 64 + p];
                    const size_t m = (size_t)(m0 + t0 + tt);
                    y += dd * bf2f(proj[m * NPROJ + PC_U + g * 16 + ch]);
                    wsb(A, WS_YS)[m * 256 + g * 16 + ch] = (bf16)f2bf(gelu_tanh(y)); } }
            WAVE_SYNC();
        }
        if (fre) { fre[lane] = hr; fim[lane] = hi; }
    }
}
__device__ __forceinline__ void ph_conv(const Args& A, int l) {
    TIDS;
    const int gt = bid * (NWAVES * 64) + tid, NGT = G * NWAVES * 64;
    const bf16* proj = wsb(A, WS_PROJ);
    for (int i = gt; i < M * 128; i += NGT) {
        const int m = i >> 7, c = (i & 127) * 2;
        int t, L; const float* hist = nullptr; float* so;
        if (m < MP) { t = m % SEQ; L = SEQ; so = A.out + O_CBP + (size_t)(l * NB + m / SEQ) * 512; }
        else { const int s = (m - MP) / DEC_SEQ; t = (m - MP) % DEC_SEQ; L = DEC_SEQ; hist = A.in[I_SCB] + (size_t)(l * DB + s) * 512; so = A.out + O_CBS + (size_t)(l * DB + s) * 512; }
        float cx0[3], cx1[3];
#pragma unroll
        for (int j = 0; j < 3; ++j) { const int tt = t - 2 + j;
            if (tt >= 0) { const bf16* r = proj + (size_t)(m - 2 + j) * NPROJ; const unsigned cg = *(const unsigned*)(r + PC_CG + c), xc = *(const unsigned*)(r + PC_XC + c); cx0[j] = bflo(cg) * bflo(xc); cx1[j] = bfhi(cg) * bfhi(xc); }
            else if (hist) { cx0[j] = hist[(2 + tt) * 256 + c]; cx1[j] = hist[(2 + tt) * 256 + c + 1]; }
            else { cx0[j] = 0.f; cx1[j] = 0.f; } }
        const float* w = A.in[I_CBW] + (size_t)l * 3 * 256;
        const float o0 = w[c] * cx0[0] + w[256 + c] * cx0[1] + w[512 + c] * cx0[2], o1 = w[c + 1] * cx1[0] + w[256 + c + 1] * cx1[1] + w[512 + c + 1] * cx1[2];
        const unsigned bg = *(const unsigned*)(proj + (size_t)m * NPROJ + PC_BG + c);
        *(unsigned*)(wsb(A, WS_Y) + (size_t)m * D + 256 + c) = pk2(bflo(bg) * o0, bfhi(bg) * o1);
        if (t >= L - 2) { so[(t - (L - 2)) * 256 + c] = cx0[2]; so[(t - (L - 2)) * 256 + c + 1] = cx1[2]; }
    }
}
__device__ __forceinline__ void ph_gdn_c1(const Args& A, LAS unsigned char* lds, int l) {
    TIDS;
    LAS float* q = (LAS float*)lds; LAS float* k = q + 4096; LAS float* v = q + 8192; LAS float* MM = q + 12288; LAS float* QK = q + 16384; LAS float* sol = q + 20480;
    LAS float* gcs = q + 28672; LAS float* bet = q + 28736; LAS float* egc = q + 28800;
    const bf16* proj = wsb(A, WS_PROJ); const float* cw = A.in[I_DCW] + (size_t)l * 4 * GQKV; const float* lg8 = wsf(A, WS_LOG8);
    for (int un = bid; un < NB * GH * GNCH; un += G) {
        const int c = un % GNCH, h = (un / GNCH) % GH, b = un / (GNCH * GH); const int m0 = b * SEQ + c * GCH;
        for (int idx = tid; idx < 64 * 192; idx += 512) {
            const int i = idx / 192, cc = idx % 192, sec = cc >> 6, d = cc & 63, src = sec * 256 + h * 64 + d, t = c * GCH + i;
            float acc = 0.f, cur = 0.f;
#pragma unroll
            for (int j = 0; j < 4; ++j) { const int tt = t - 3 + j; const float x = tt >= 0 ? bf2f(proj[(size_t)(b * SEQ + tt) * NPROJ + PC_QKV + src]) : 0.f; acc += cw[j * GQKV + src] * x; cur = x; }
            (sec == 0 ? q : sec == 1 ? k : v)[i * 64 + d] = siluf_(acc);
            if (t >= SEQ - 3) A.out[O_CDP + ((size_t)(l * NB + b) * 3 + (t - (SEQ - 3))) * GQKV + src] = cur;
        }
        __syncthreads();
        for (int r = 0; r < 8; ++r) { const int i = wave * 8 + r;
            const float qv = q[i * 64 + lane], kv = k[i * 64 + lane];
            const float sq = wave_sum(qv * qv), sk = wave_sum(kv * kv);
            q[i * 64 + lane] = qv * (1.0f / sqrtf(sq + RMS_EPS)) * 0.125f; k[i * 64 + lane] = kv * (1.0f / sqrtf(sk + RMS_EPS)); }
        if (tid < 64) { const float* lr = lg8 + (size_t)(m0 + tid) * 8; bet[tid] = sigmoidf_(lr[h]); gcs[tid] = -expf(A.in[I_DAL][l * 4 + h]) * softplusf_(lr[4 + h] + A.in[I_DDT][l * 4 + h]); }
        __syncthreads();
        if (tid == 0) { float s = 0.f; for (int i = 0; i < 64; ++i) { s += gcs[i]; gcs[i] = s; } }
        __syncthreads();
        if (tid < 64) egc[tid] = expf(gcs[tid]);
        __syncthreads();
        for (int idx = tid; idx < 4096; idx += 512) { const int i = idx >> 6, j = idx & 63; float kk = 0.f, qk = 0.f;
            for (int d = 0; d < 64; ++d) { const float kj = k[j * 64 + d]; kk += k[i * 64 + d] * kj; qk += q[i * 64 + d] * kj; }
            const float dec = i >= j ? expf(gcs[i] - gcs[j]) : 0.f;
            MM[idx] = i > j ? bet[i] * kk * dec : 0.f; QK[idx] = qk * dec; }
        for (int idx = tid; idx < 64 * 128; idx += 512) { const int i = idx >> 7, cc = idx & 127; sol[idx] = cc < 64 ? bet[i] * v[i * 64 + cc] : bet[i] * egc[i] * k[i * 64 + cc - 64]; }
        __syncthreads();
        for (int i = 0; i < 63; ++i) {
            for (int idx = tid; idx < (63 - i) * 128; idx += 512) { const int r = i + 1 + (idx >> 7), cc = idx & 127; sol[r * 128 + cc] -= MM[r * 64 + i] * sol[i * 128 + cc]; }
            __syncthreads();
        }
        unsigned char* gd = A.ws + WS_GD + (size_t)un * GD_UNIT; const float gl = gcs[63];
        for (int idx = tid; idx < 4096; idx += 512) { const int f = idx >> 9, ln = (idx >> 3) & 63, j = idx & 7, row = 16 * (f >> 1) + (ln & 15), kx = 32 * (f & 1) + 16 * (j >> 2) + 4 * (ln >> 4) + (j & 3);
            ((bf16*)gd)[idx] = (bf16)f2bf(-sol[row * 128 + 64 + kx]); ((bf16*)gd)[4096 + idx] = (bf16)f2bf(q[row * 64 + kx] * egc[row]); ((bf16*)gd)[8192 + idx] = (bf16)f2bf(QK[row * 64 + kx]);
            ((bf16*)gd)[12288 + idx] = (bf16)f2bf(k[kx * 64 + row] * expf(gl - gcs[kx])); }
        for (int idx = tid; idx < 4096; idx += 512) { const int r = idx & 3, ln = (idx >> 2) & 63, T = (idx >> 8) & 3, vs = idx >> 10; ((float*)(gd + 32768))[idx] = sol[(16 * T + 4 * (ln >> 4) + r) * 128 + 16 * vs + (ln & 15)]; }
        if (tid == 0) wsf(A, WS_EGL)[un] = expf(gl);
        __syncthreads();
    }
}
__device__ __forceinline__ bf16x8 acc2b(const f32x4& lo, const f32x4& hi) { v4u w; w.x = pk2(lo[0], lo[1]); w.y = pk2(lo[2], lo[3]); w.z = pk2(hi[0], hi[1]); w.w = pk2(hi[2], hi[3]); return __builtin_bit_cast(bf16x8, w); }
__device__ __forceinline__ void ph_gdn_scan(const Args& A, int l) {
    TIDS;
    if (wave >= 4) return;
    for (int grp = bid; grp < NB * GH; grp += G) {
        const int vs = wave, h = grp % GH, b = grp / GH; const int g = lane >> 4, cc = lane & 15;
        f32x4 S[4];
#pragma unroll
        for (int T = 0; T < 4; ++T) S[T] = (f32x4){0.f, 0.f, 0.f, 0.f};
        for (int c = 0; c < GNCH; ++c) {
            const size_t cu = (size_t)(b * GH + h) * GNCH + c; const unsigned char* gd = A.ws + WS_GD + cu * GD_UNIT; const float egl = wsf(A, WS_EGL)[cu];
            const bf16x8* fr = (const bf16x8*)gd + lane;
            const f32x4* uvp = (const f32x4*)(gd + 32768) + (vs * 4) * 64 + lane;
            bf16x8 Sb[2] = {acc2b(S[0], S[1]), acc2b(S[2], S[3])};
            f32x4 u[4], o[4];
#pragma unroll
            for (int T = 0; T < 4; ++T) { u[T] = uvp[T * 64]; o[T] = (f32x4){0.f, 0.f, 0.f, 0.f};
#pragma unroll
                for (int s = 0; s < 2; ++s) { u[T] = __builtin_amdgcn_mfma_f32_16x16x32_bf16(fr[(0 * 8 + 2 * T + s) * 64], Sb[s], u[T], 0, 0, 0); o[T] = __builtin_amdgcn_mfma_f32_16x16x32_bf16(fr[(1 * 8 + 2 * T + s) * 64], Sb[s], o[T], 0, 0, 0); } }
            bf16x8 ub[2] = {acc2b(u[0], u[1]), acc2b(u[2], u[3])};
#pragma unroll
            for (int T = 0; T < 4; ++T) { S[T] = S[T] * egl;
#pragma unroll
                for (int s = 0; s < 2; ++s) { o[T] = __builtin_amdgcn_mfma_f32_16x16x32_bf16(fr[(2 * 8 + 2 * T + s) * 64], ub[s], o[T], 0, 0, 0); S[T] = __builtin_amdgcn_mfma_f32_16x16x32_bf16(fr[(3 * 8 + 2 * T + s) * 64], ub[s], S[T], 0, 0, 0); } }
            float* od = wsf(A, WS_ODRAW) + (size_t)(b * SEQ + c * GCH + 4 * g) * 256 + h * 64 + vs * 16 + cc;
#pragma unroll
            for (int T = 0; T < 4; ++T)
#pragma unroll
                for (int r = 0; r < 4; ++r) od[(size_t)(16 * T + r) * 256] = o[T][r];
        }
        float* so = A.out + O_DP + (((size_t)(l * NB + b) * GH + h) * 64 + 4 * g) * 64 + vs * 16 + cc;
#pragma unroll
        for (int T = 0; T < 4; ++T)
#pragma unroll
            for (int r = 0; r < 4; ++r) so[(16 * T + r) * 64] = S[T][r];
    }
}
__device__ __forceinline__ void ph_gdn_sample(const Args& A, LAS unsigned char* lds, int l) {
    TIDS;
    LAS float* S = (LAS float*)(lds + wave * 16384);
    LAS float* kq = (LAS float*)(lds + MISC_OFF + 1024 + wave * 512);
    const bf16* proj = wsb(A, WS_PROJ); const float* cw = A.in[I_DCW] + (size_t)l * 4 * GQKV; const float* lg8 = wsf(A, WS_LOG8);
    for (int un = gw; un < DB * GH; un += NGW) {
        const int h = un % GH, s = un / GH;
        const float* s0 = A.in[I_SD] + ((size_t)(l * DB + s) * GH + h) * 4096;
#pragma unroll 8
        for (int kk = 0; kk < 64; ++kk) S[kk * 64 + lane] = s0[kk * 64 + lane];
        const float* hist = A.in[I_SCD] + (size_t)(l * DB + s) * 3 * GQKV;
        for (int t = 0; t < DEC_SEQ; ++t) {
            const size_t m = (size_t)MP + s * DEC_SEQ + t;
            float val[3];
#pragma unroll
            for (int sec = 0; sec < 3; ++sec) { const int src = sec * 256 + h * 64 + lane; float acc = 0.f, cur = 0.f;
#pragma unroll
                for (int j = 0; j < 4; ++j) { const int tt = t - 3 + j; const float x = tt >= 0 ? bf2f(proj[(size_t)(MP + s * DEC_SEQ + tt) * NPROJ + PC_QKV + src]) : hist[(3 + tt) * GQKV + src]; acc += cw[j * GQKV + src] * x; cur = x; }
                val[sec] = siluf_(acc);
                if (t >= 1) A.out[O_CDS + ((size_t)(l * DB + s) * 3 + (t - 1)) * GQKV + src] = cur; }
            const float sq = wave_sum(val[0] * val[0]), sk = wave_sum(val[1] * val[1]);
            const float qv = val[0] * (1.0f / sqrtf(sq + RMS_EPS)) * 0.125f, kv = val[1] * (1.0f / sqrtf(sk + RMS_EPS)), vv = val[2];
            const float* lr = lg8 + m * 8; const float beta = sigmoidf_(lr[h]); const float a = expf(-expf(A.in[I_DAL][l * 4 + h]) * softplusf_(lr[4 + h] + A.in[I_DDT][l * 4 + h]));
            kq[lane] = kv; kq[64 + lane] = qv;
            WAVE_SYNC();
            float kS = 0.f;
#pragma unroll 8
            for (int kk = 0; kk < 64; ++kk) kS += kq[kk] * S[kk * 64 + lane];
            float o = 0.f;
#pragma unroll 8
            for (int kk = 0; kk < 64; ++kk) { const float bk = beta * kq[kk]; const float sn = a * (S[kk * 64 + lane] - bk * kS) + bk * vv; S[kk * 64 + lane] = sn; o += kq[64 + kk] * sn; }
            wsf(A, WS_ODRAW)[m * 256 + h * 64 + lane] = o;
            WAVE_SYNC();
        }
        float* so = A.out + O_DS + ((size_t)(l * DB + s) * GH + h) * 4096;
#pragma unroll 8
        for (int kk = 0; kk < 64; ++kk) so[kk * 64 + lane] = S[kk * 64 + lane];
    }
}
__device__ __forceinline__ void ph_gdn_out(const Args& A, int l) {
    TIDS;
    for (int idx = gw; idx < M * GH; idx += NGW) { const size_t m = idx >> 2; const int h = idx & 3;
        const float o = wsf(A, WS_ODRAW)[m * 256 + h * 64 + lane];
        const float ms = wave_sum(o * o) * (1.0f / 64.0f);
        const float z = bf2f(wsb(A, WS_PROJ)[m * NPROJ + PC_Z + h * 64 + lane]);
        wsb(A, WS_Y)[m * D + 512 + h * 64 + lane] = (bf16)f2bf(o * (1.0f / sqrtf(ms + RMS_EPS)) * A.in[I_DNW][l * 64 + lane] * siluf_(z)); }
}
__device__ __forceinline__ void sb_terms(float z, float& ls, float& ln) { const float L = log1pf(__expf(-fabsf(z))); ls = fminf(z, 0.f) - L; ln = -fmaxf(z, 0.f) - L; }
constexpr float SB_CUT = -105.0f;
__device__ __forceinline__ void ph_sb_prompt(const Args& A, LAS unsigned char* lds, int l) {
    TIDS; (void)l;
    LAS float* kt = (LAS float*)(lds + wave * 16384); LAS float* vt = kt + 2048;
    const bf16* proj = wsb(A, WS_PROJ);
    constexpr int NQB = SEQ / 32;
    for (int un0 = gw; un0 < NB * SBH * NQB; un0 += NGW) {
        const int un = NB * SBH * NQB - 1 - un0;
        const int qb = un / (NB * SBH), h = un % SBH, b = (un / SBH) % NB;
        const int i = lane & 31, half = lane >> 5, qi = qb * 32 + i; const size_t m = (size_t)b * SEQ + qi;
        float q[32], acc[32];
        { const v4u* qp = (const v4u*)(proj + m * NPROJ + PC_Q + h * 64 + half * 32);
#pragma unroll
          for (int x = 0; x < 4; ++x) { const v4u w = qp[x]; q[8 * x] = bflo(w.x) * 0.125f; q[8 * x + 1] = bfhi(w.x) * 0.125f; q[8 * x + 2] = bflo(w.y) * 0.125f; q[8 * x + 3] = bfhi(w.y) * 0.125f;
              q[8 * x + 4] = bflo(w.z) * 0.125f; q[8 * x + 5] = bfhi(w.z) * 0.125f; q[8 * x + 6] = bflo(w.w) * 0.125f; q[8 * x + 7] = bfhi(w.w) * 0.125f; } }
#pragma unroll
        for (int d = 0; d < 32; ++d) acc[d] = 0.f;
        float R = 0.f;
        for (int kb = qb; kb >= 0; --kb) {
            { const int row = lane >> 1, hr = lane & 1; const bf16* rp = proj + ((size_t)b * SEQ + kb * 32 + row) * NPROJ + h * 64 + hr * 32;
              const v4u* kp = (const v4u*)(rp + PC_K); const v4u* vp = (const v4u*)(rp + PC_V);
#pragma unroll
              for (int x = 0; x < 4; ++x) { const v4u w = kp[x], u = vp[x]; LAS float* kd = kt + row * 64 + hr * 32 + 8 * x; LAS float* vd = vt + row * 64 + hr * 32 + 8 * x;
                  kd[0] = bflo(w.x); kd[1] = bfhi(w.x); kd[2] = bflo(w.y); kd[3] = bfhi(w.y); kd[4] = bflo(w.z); kd[5] = bfhi(w.z); kd[6] = bflo(w.w); kd[7] = bfhi(w.w);
                  vd[0] = bflo(u.x); vd[1] = bfhi(u.x); vd[2] = bflo(u.y); vd[3] = bfhi(u.y); vd[4] = bflo(u.z); vd[5] = bfhi(u.z); vd[6] = bflo(u.w); vd[7] = bfhi(u.w); } }
            WAVE_SYNC();
            for (int jj = 31; jj >= 0; --jj) {
                const LAS float* kr = kt + jj * 64 + half * 32; float zp = 0.f;
#pragma unroll
                for (int d = 0; d < 32; ++d) zp += q[d] * kr[d];
                const float z = zp + __shfl_xor(zp, 32);
                float ls, ln; sb_terms(z, ls, ln);
                const bool valid = (kb * 32 + jj) < qi;
                const float w = valid ? __expf(ls + R) : 0.f;
                const LAS float* vr = vt + jj * 64 + half * 32;
#pragma unroll
                for (int d = 0; d < 32; ++d) acc[d] += w * vr[d];
                R += valid ? ln : 0.f;
            }
            WAVE_SYNC();
            if (kb < qb && __all(R < SB_CUT)) break;
        }
        v4u* yp = (v4u*)(wsb(A, WS_Y) + m * D + 768 + h * 64 + half * 32);
#pragma unroll
        for (int x = 0; x < 4; ++x) { v4u o; o.x = pk2(acc[8 * x], acc[8 * x + 1]); o.y = pk2(acc[8 * x + 2], acc[8 * x + 3]); o.z = pk2(acc[8 * x + 4], acc[8 * x + 5]); o.w = pk2(acc[8 * x + 6], acc[8 * x + 7]); yp[x] = o; }
    }
}
__device__ __forceinline__ void ph_sb_sample(const Args& A, int l) {
    TIDS;
    const bf16* proj = wsb(A, WS_PROJ); const int* pt = (const int*)A.in[I_PT];
    for (int un = gw; un < DB * SBH; un += NGW) {
        const int h = un % SBH, s = un / SBH; const int qi = lane & 3, ds = lane >> 2;
        const size_t mq = (size_t)MP + s * DEC_SEQ + qi;
        f32x4 q; { const v2u w = *(const v2u*)(proj + mq * NPROJ + PC_Q + h * 64 + ds * 4); q = (f32x4){bflo(w.x), bfhi(w.x), bflo(w.y), bfhi(w.y)} * 0.125f; }
        f32x4 acc = {0.f, 0.f, 0.f, 0.f}; float R = 0.f;
        for (int j = DEC_SEQ - 1; j >= 0; --j) {
            const bf16* rp = proj + ((size_t)MP + s * DEC_SEQ + j) * NPROJ + h * 64 + ds * 4;
            const v2u kw = *(const v2u*)(rp + PC_K), vw = *(const v2u*)(rp + PC_V);
            float zp = q[0] * bflo(kw.x) + q[1] * bfhi(kw.x) + q[2] * bflo(kw.y) + q[3] * bfhi(kw.y);
            zp += __shfl_xor(zp, 4); zp += __shfl_xor(zp, 8); zp += __shfl_xor(zp, 16); zp += __shfl_xor(zp, 32);
            float ls, ln; sb_terms(zp, ls, ln);
            const bool valid = j < qi; const float w = valid ? __expf(ls + R) : 0.f;
            acc += (f32x4){bflo(vw.x), bfhi(vw.x), bflo(vw.y), bfhi(vw.y)} * w; R += valid ? ln : 0.f;
        }
        for (int jp = PAST - 1; jp >= 0; --jp) {
            const int page = pt[s * NPAGES + jp / PAGE];
            const size_t off = ((((size_t)l * NPOOL + page) * PAGE + jp % PAGE) * SBH + h) * 64 + ds * 4;
            const f32x4 k4 = *(const f32x4*)(A.in[I_CK] + off), v4 = *(const f32x4*)(A.in[I_CV] + off);
            float zp = q[0] * k4[0] + q[1] * k4[1] + q[2] * k4[2] + q[3] * k4[3];
            zp += __shfl_xor(zp, 4); zp += __shfl_xor(zp, 8); zp += __shfl_xor(zp, 16); zp += __shfl_xor(zp, 32);
            float ls, ln; sb_terms(zp, ls, ln);
            acc += v4 * __expf(ls + R); R += ln;
            if ((jp & 15) == 0 && __all(R < SB_CUT)) break;
        }
        v2u o; o.x = pk2(acc[0], acc[1]); o.y = pk2(acc[2], acc[3]);
        *(v2u*)(wsb(A, WS_Y) + mq * D + 768 + h * 64 + ds * 4) = o;
    }
}
constexpr int PH_PER_LAYER = 12, NPHASE = 2 + PH_PER_LAYER * DEPTH;
#ifndef DUP_MASK
#define DUP_MASK 0
#endif
#if DUP_MASK
__device__ __forceinline__ int rep_n(int k) { int n = ((DUP_MASK >> k) & 1) ? 2 : 1; asm volatile("" : "+s"(n)); return n; }
#define REP(k) _Pragma("nounroll") for (int rep_ = 0, repn_ = rep_n(k); rep_ < repn_; ++rep_)
#else
#define REP(k)
#endif
#ifndef TIME_MASK
#define TIME_MASK 0
#endif
#ifndef MK_N_LAUNCHES
#define MK_N_LAUNCHES 1
#endif
__global__ void __launch_bounds__(NWAVES * 64, 2) fwd_kernel(Args A) {
#ifndef CPU_EMU
    extern __shared__ __attribute__((aligned(16))) unsigned char lds_raw[];
    LAS unsigned char* lds = (LAS unsigned char*)lds_raw;
    volatile LAS unsigned* MISC = (volatile LAS unsigned*)(lds + MISC_OFF);
    for (int u = threadIdx.x; u < (LDS_BYTES - MISC_OFF) / 4; u += NWAVES * 64) ((LAS unsigned*)(lds + MISC_OFF))[u] = 0u;
    __syncthreads();
    XcdBarrier bar; bar.bar = (unsigned*)(A.ws + WS_CTL) + CW_BAR + A.li * XCD_BAR_WORDS; bar.x = 0; bar.st = nullptr;
    if (A.ph_hi - A.ph_lo > 1) bar = xcd_barrier_post((unsigned*)(A.ws + WS_CTL) + CW_BAR + A.li * XCD_BAR_WORDS, MISC + 8);
#else
    unsigned char* lds = emu::B->lds; XcdBarrier bar{0};
#endif
    const int lo = A.ph_lo, hi = A.ph_hi, G = gridDim.x, bid = blockIdx.x;
#define IN(k) (lo <= (k) && (k) < hi)
#if TIME_MASK
    unsigned long long tp_ = __builtin_amdgcn_s_memrealtime(), tacc_ = 0;
#define SEAM(k) do { if (IN((k) + 1)) xcd_barrier(bar); { const unsigned long long tn_ = __builtin_amdgcn_s_memrealtime(); if ((TIME_MASK >> (k)) & 1) tacc_ += tn_ - tp_; tp_ = tn_; } } while (0)
#else
#define SEAM(k) do { if (IN((k) + 1)) xcd_barrier(bar); } while (0)
#endif
    if (IN(0)) { REP(9) ph_prologue(A, lds); SEAM(0); }
    if (IN(1)) {
        pg8::Gemm g{wsb(A, WS_CSILU), (const bf16*)(A.ws + WS_W + WL_ADA), D, D}; ModOrder S{G, bid}; EpiMod2 E{wsf(A, WS_MOD), A.in[I_BADA]};
        pg8::gemm_phase<EpiMod2, ModOrder, true, true>(lds, g, S, E); SEAM(1);
    }
    for (int l = 0; l < DEPTH; ++l) {
        const int pb = 2 + PH_PER_LAYER * l;
        unsigned char* wl = A.ws + WS_W + (size_t)l * WL_SIZE;
        if (IN(pb + 0)) { if (l == 0) ph_rows<0>(A, 0); SEAM(pb + 0); }
        if (IN(pb + 1)) {
            pg8::Gemm g{wsb(A, WS_H), (const bf16*)(wl + WL_W1), D, D}; pg8::GridOrder S; S.init(M / 256, N1 / 256, G, bid);
            pg8::EpiProj E{wsb(A, WS_PROJ), wsb(A, WS_GATE), A.out + O_KP + (size_t)l * MP * 256, A.out + O_VP + (size_t)l * MP * 256, A.out + O_KS + (size_t)l * MS * 256, A.out + O_VS + (size_t)l * MS * 256};
            REP(5) pg8::gemm_phase<pg8::EpiProj, pg8::GridOrder, true, true>(lds, g, S, E); SEAM(pb + 1);
        }
        if (IN(pb + 2)) { REP(3) ph_gdn_c1(A, lds, l); REP(2) ph_sb_prompt(A, lds, l); __syncthreads(); REP(10) ph_gdn_sample(A, lds, l); REP(1) ph_sb_sample(A, l); REP(4) ph_ssm1(A, l); REP(10) ph_conv(A, l); SEAM(pb + 2); }
        if (IN(pb + 3)) { REP(0) ph_gdn_scan(A, l); REP(10) ph_ssm_carry(A, l); SEAM(pb + 3); }
        if (IN(pb + 4)) { REP(4) ph_ssm2(A, lds, l); REP(10) ph_gdn_out(A, l); SEAM(pb + 4); }
        if (IN(pb + 5)) {
            pg8::Gemm g{wsb(A, WS_YS), (const bf16*)(wl + WL_GLU), 256, 256}; pg8::GridOrder S; S.init(M / 256, 1, G, bid);
            pg8::EpiGlu E{wsb(A, WS_YS), wsb(A, WS_Y)};
            REP(8) pg8::gemm_phase<pg8::EpiGlu, pg8::GridOrder, true, true>(lds, g, S, E); SEAM(pb + 5);
        }
        if (IN(pb + 6)) {
            pg8::Gemm g{wsb(A, WS_Y), (const bf16*)(wl + WL_BR), D, 256}; pg8::MergeOrder S; S.init(M / 256, 4, G, bid);
            pg8::EpiMerge E{wsb(A, WS_GATE), wsf(A, WS_MERGE), wsb(A, WS_MERGEB)};
            REP(6) pg8::gemm_phase<pg8::EpiMerge, pg8::MergeOrder, true, true>(lds, g, S, E); SEAM(pb + 6);
        }
        if (IN(pb + 7)) {
            pg8::Gemm g{wsb(A, WS_MERGEB), (const bf16*)(wl + WL_WO), D, D}; pg8::GridOrder S; S.init(M / 256, 4, G, bid);
            pg8::EpiRes E{l == 0 ? A.in[I_XP] : wsf(A, WS_X2), l == 0 ? A.in[I_XS] : wsf(A, WS_X2) + (size_t)MP * D, wsf(A, WS_MOD) + (size_t)l * 256 * NMOD + 2 * D, wsf(A, WS_X1)};
            REP(8) pg8::gemm_phase<pg8::EpiRes, pg8::GridOrder, true, true>(lds, g, S, E); SEAM(pb + 7);
        }
        if (IN(pb + 8)) { ph_rows<1>(A, l); SEAM(pb + 8); }
        if (IN(pb + 9)) {
            pg8::Gemm g{wsb(A, WS_H), (const bf16*)(wl + WL_UP), D, D}; pg8::GridOrder S; S.init(M / 256, NUP / 256, G, bid);
            pg8::EpiUp E{wsb(A, WS_ACT)};
            REP(7) pg8::gemm_phase<pg8::EpiUp, pg8::GridOrder, true, true>(lds, g, S, E); SEAM(pb + 9);
        }
        if (IN(pb + 10)) {
            pg8::Gemm g{wsb(A, WS_ACT), (const bf16*)(wl + WL_DN), DFF, DFF}; pg8::GridOrder S; S.init(M / 256, 4, G, bid);
            pg8::EpiRes E{wsf(A, WS_X1), wsf(A, WS_X1) + (size_t)MP * D, wsf(A, WS_MOD) + (size_t)l * 256 * NMOD + 5 * D, wsf(A, WS_X2)};
            REP(7) pg8::gemm_phase<pg8::EpiRes, pg8::GridOrder, true, true>(lds, g, S, E); SEAM(pb + 10);
        }
        if (IN(pb + 11)) { ph_rows<2>(A, l); SEAM(pb + 11); }
    }
#if TIME_MASK
    if (blockIdx.x == 0 && threadIdx.x == 0) { const unsigned long long t0_ = __builtin_amdgcn_s_memrealtime(); while (__builtin_amdgcn_s_memrealtime() - t0_ < 4 * tacc_) __builtin_amdgcn_s_sleep(8); }
#endif
#undef IN
#undef SEAM
}
#ifndef CPU_EMU
extern "C" void kernel_launch(void* const* d_in, const int* in_sizes, int n_in, void* d_out, int out_size, void* d_ws, size_t ws_size, hipStream_t stream) {
    static int grid = 0;
    if (grid == 0) {
        if (n_in != 38 || (size_t)out_size != O_END || ws_size < WS_END) { fprintf(stderr, "kernel_launch: unexpected shapes (n_in %d out %d ws %zu; want 38, %zu, >= %zu)\n", n_in, out_size, ws_size, (size_t)O_END, (size_t)WS_END); grid = -1; return; }
        int dev = 0, cus = 0, per_cu = 0;
        if (hipGetDevice(&dev) != hipSuccess || hipDeviceGetAttribute(&cus, hipDeviceAttributeMultiprocessorCount, dev) != hipSuccess) { grid = -1; return; }
        if (hipFuncSetAttribute((const void*)fwd_kernel, hipFuncAttributeMaxDynamicSharedMemorySize, LDS_BYTES) != hipSuccess) { fprintf(stderr, "kernel_launch: hipFuncSetAttribute failed\n"); grid = -1; return; }
        if (hipOccupancyMaxActiveBlocksPerMultiprocessor(&per_cu, (const void*)fwd_kernel, NWAVES * 64, LDS_BYTES) != hipSuccess || per_cu < 1) { fprintf(stderr, "kernel_launch: occupancy query says %d\n", per_cu); }
        (void)hipGetLastError();
        grid = cus;
    }
    if (grid < 0) return;
    if (hipMemsetAsync((char*)d_ws + WS_CTL, 0, CTL_ZERO_BYTES, stream) != hipSuccess) return;
    Args a{};
    for (int i = 0; i < 38; ++i) a.in[i] = (const float*)d_in[i];
    a.out = (float*)d_out; a.ws = (unsigned char*)d_ws;
    if (MK_N_LAUNCHES == 1) { a.ph_lo = 0; a.ph_hi = NPHASE; a.li = 0; hipLaunchKernelGGL(fwd_kernel, dim3(grid), dim3(NWAVES * 64), LDS_BYTES, stream, a); }
    else for (int p = 0; p < NPHASE; ++p) { if (p == 2 + PH_PER_LAYER) continue; a.ph_lo = p; a.ph_hi = p + 1; a.li = 0; hipLaunchKernelGGL(fwd_kernel, dim3(grid), dim3(NWAVES * 64), LDS_BYTES, stream, a); }
}
#endif
```

```cpp
#ifndef CPU_EMU
#include <hip/hip_runtime.h>
#endif
#include <cstdio>
#include <cstdint>
#include <cmath>

constexpr int D = 1024, NB = 2, DEPTH = 2, DEC_SEQ = 4, PAGE = 128;
#ifdef CPU_EMU
#ifndef EMU_SEQ
#define EMU_SEQ 512
#endif
#ifndef EMU_DB
#define EMU_DB 64
#endif
#ifndef EMU_PAST
#define EMU_PAST 512
#endif
constexpr int SEQ = EMU_SEQ, DB = EMU_DB, PAST = EMU_PAST;
#else
constexpr int SEQ = 8192, DB = 128, PAST = 2048;
#endif
constexpr int NPAGES = PAST / PAGE, NUSED = DB * NPAGES, NPOOL = NUSED + (NUSED / 4 > 1 ? NUSED / 4 : 1);
constexpr int MP = NB * SEQ, MS = DB * DEC_SEQ, M = MP + MS, NSEQ = NB + DB;
constexpr int WMIX = 256, NPROJ = 2816, NIN = 2824, NGATE = 4096, N1 = NPROJ + NGATE, DFF = 2816, NUP = 2 * DFF, NMOD = 6 * D;
constexpr int SSM_G = 16, SSM_P = 64, SSM_CH = 128, SSM_NCH = SEQ / SSM_CH;
constexpr int GH = 4, GDK = 64, GCH = 64, GNCH = SEQ / GCH, GQKV = 768;
constexpr int SBH = 4;
constexpr int PC_U = 0, PC_BG = 256, PC_CG = 512, PC_XC = 768, PC_QKV = 1024, PC_Z = 1792, PC_Q = 2048, PC_K = 2304, PC_V = 2560;
constexpr float LN_EPS = 1e-5f, RMS_EPS = 1e-6f, ALPHA = 1.41421356237309515f  ;
static_assert(M % 256 == 0 && MP % 256 == 0 && SEQ % 256 == 0 && NSEQ <= 256, "tile shapes");
constexpr size_t O_Y = 0, O_KP = (size_t)M * D, O_VP = O_KP + (size_t)DEPTH * MP * 256, O_KS = O_VP + (size_t)DEPTH * MP * 256, O_VS = O_KS + (size_t)DEPTH * MS * 256,
    O_REP = O_VS + (size_t)DEPTH * MS * 256, O_IMP = O_REP + DEPTH * NB * 1024, O_RES = O_IMP + DEPTH * NB * 1024, O_IMS = O_RES + (size_t)DEPTH * DB * 1024,
    O_CBP = O_IMS + (size_t)DEPTH * DB * 1024, O_CBS = O_CBP + DEPTH * NB * 512, O_DP = O_CBS + (size_t)DEPTH * DB * 512, O_DS = O_DP + (size_t)DEPTH * NB * 16384,
    O_CDP = O_DS + (size_t)DEPTH * DB * 16384, O_CDS = O_CDP + DEPTH * NB * 2304, O_END = O_CDS + (size_t)DEPTH * DB * 2304;

constexpr size_t MiB = 1u << 20;
constexpr size_t al(size_t x) { return (x + 4095) & ~(size_t)4095; }
constexpr size_t WS_CTL = 0, CTL_ZERO_BYTES = 1 * MiB;
constexpr size_t WL_ADA = 0, WL_W1 = WL_ADA + (size_t)NMOD * D * 2, WL_GLU = WL_W1 + (size_t)N1 * D * 2, WL_BR = WL_GLU + 256 * 256 * 2, WL_WO = WL_BR + (size_t)4 * D * 256 * 2,
    WL_UP = WL_WO + (size_t)D * D * 2, WL_DN = WL_UP + (size_t)NUP * D * 2, WL_LOG = WL_DN + (size_t)D * DFF * 2, WL_SIZE = (WL_LOG + 8 * D * 4 + 524287) & ~(size_t)524287;
constexpr size_t WS_W = 1 * MiB, WS_CSILU = WS_W + DEPTH * WL_SIZE, WS_MOD = WS_CSILU + 256 * D * 2, WS_H = WS_MOD + (size_t)DEPTH * 256 * NMOD * 4,
    WS_PROJ = WS_H + (size_t)M * D * 2, WS_GATE = al(WS_PROJ + (size_t)M * NPROJ * 2), WS_LOG8 = WS_GATE + (size_t)M * NGATE * 2, WS_Y = WS_LOG8 + (size_t)M * 8 * 4,
    WS_YS = WS_Y + (size_t)M * D * 2, WS_MERGE = WS_YS + (size_t)M * 256 * 2, WS_MERGEB = WS_MERGE + (size_t)M * D * 4, WS_X1 = WS_MERGEB + (size_t)M * D * 2,
    WS_ACT = WS_X1 + (size_t)M * D * 4, WS_X2 = al(WS_ACT + (size_t)M * DFF * 2), WS_SEND = WS_X2 + (size_t)M * D * 4, WS_HIN = WS_SEND + (size_t)NB * 16 * SSM_NCH * 128 * 4,
    WS_GD = WS_HIN + (size_t)NB * 16 * SSM_NCH * 128 * 4, WS_EGL = WS_GD + (size_t)NB * GH * GNCH * 49152, WS_ODRAW = al(WS_EGL + (size_t)NB * GH * GNCH * 4),
    WS_END = WS_ODRAW + (size_t)M * 256 * 4;
constexpr int CW_TMO = 0, CW_BAR = 4096;
constexpr size_t GD_UNIT = 49152;

#define LAS_HW __attribute__((address_space(3)))
#ifdef CPU_EMU
#define LAS
#else
#define LAS LAS_HW
#endif
typedef unsigned short bf16;
typedef unsigned v4u __attribute__((ext_vector_type(4)));
typedef unsigned v2u __attribute__((ext_vector_type(2)));
typedef float f32x4 __attribute__((ext_vector_type(4)));
typedef float f32x2 __attribute__((ext_vector_type(2)));
typedef short bf16x8 __attribute__((ext_vector_type(8)));
#ifdef CPU_EMU
#define LDS_WAIT() do {} while (0)
#define VM_WAIT() do {} while (0)
#define WAVE_SYNC() emu::wave_sync()
#define CFENCE() do {} while (0)
#else
#define LDS_WAIT() asm volatile("s_waitcnt lgkmcnt(0)" ::: "memory")
#define VM_WAIT() asm volatile("s_waitcnt vmcnt(0)" ::: "memory")
#define WAVE_SYNC() do { asm volatile("s_waitcnt lgkmcnt(0)" ::: "memory"); __builtin_amdgcn_wave_barrier(); } while (0)
#define CFENCE() asm volatile("" ::: "memory")
#endif
#ifdef CPU_EMU
#define OPAQUE_V(x) do {} while (0)
#else
#define OPAQUE_V(x) asm volatile("" : "+v"(x))
#endif
__device__ __forceinline__ unsigned f2bf(float f) { unsigned u = __builtin_bit_cast(unsigned, f); return (u + 0x7fffu + ((u >> 16) & 1u)) >> 16; }
__device__ __forceinline__ unsigned pk2(float lo, float hi) { return f2bf(lo) | (f2bf(hi) << 16); }
__device__ __forceinline__ float bf2f(unsigned b) { return __builtin_bit_cast(float, b << 16); }
__device__ __forceinline__ float bflo(unsigned w) { return __builtin_bit_cast(float, w << 16); }
__device__ __forceinline__ float bfhi(unsigned w) { return __builtin_bit_cast(float, w & 0xffff0000u); }
__device__ __forceinline__ float sigmoidf_(float x) { return 1.0f / (1.0f + __expf(-x)); }
__device__ __forceinline__ float siluf_(float x) { return x / (1.0f + __expf(-x)); }
__device__ __forceinline__ float wave_sum(float v) {
#pragma unroll
    for (int o = 1; o < 64; o <<= 1) v += __shfl_xor(v, o);
    return v;
}
__device__ __forceinline__ int seq_of(int m) { return m < MP ? m / SEQ : NB + (m - MP) / DEC_SEQ; }
namespace pg8 {
typedef unsigned short bf16_t;
constexpr int BM = 256, BK = 64, HALF = 128, HTB = HALF * BK * 2, STAGE_BYTES = 8 * HTB, NXCD = 8, WGM = 8;
__host__ __device__ __forceinline__ int lds_byte(int r, int c) { const int st = (r >> 4) * 2 + (c >> 5), rr = r & 15, cc = c & 31, ob = rr * 64 + cc * 2; return st * 1024 + (ob ^ (((ob >> 9) & 1) << 5)); }
__host__ __device__ __forceinline__ void stage_rc(int b, int& R, int& C) { const int st = b / 1024, sb = b % 1024, swz = sb ^ (((sb >> 9) & 1) << 5); R = (st >> 1) * 16 + swz / 64; C = (st & 1) * 32 + (swz % 64) / 2; }
__host__ __device__ __forceinline__ int perm32(int rho) { const int n = rho >> 4, i = rho & 15; return 8 * (i >> 2) + 4 * n + (i & 3); }
struct Unit { int pm, pn, ka, aux; };
struct NoState {};
struct Gemm { const bf16_t* A; const bf16_t* Bt; int lda, K; };
struct GridOrder {
    int nM, nN, nwg, G, c, pn0;
    __host__ __device__ void init(int nM_, int nN_, int G_, int c_, int pn0_ = 0) { nM = nM_; nN = nN_; nwg = nM * nN; G = G_; c = c_; pn0 = pn0_; }
    __host__ __device__ bool tile(long L, int& pm, int& pn) const {
        if (L >= nwg) return false;
        int wgid = (int)L; { const int q = nwg / NXCD, r = nwg % NXCD, xcd = wgid % NXCD, off = wgid / NXCD; wgid = (xcd < r ? xcd * (q + 1) : r * (q + 1) + (xcd - r) * q) + off; }
        const int nig = WGM * nN, gid = wgid / nig, fm = gid * WGM, gsz = (nM - fm) < WGM ? (nM - fm) : WGM;
        pm = fm + ((wgid % nig) % gsz); pn = (wgid % nig) / gsz; return true;
    }
    __host__ __device__ bool next(int i, Unit& u) const { int pm, pn; if (!tile((long)i * G + c, pm, pn)) return false; u.pm = pm; u.pn = pn0 + pn; u.ka = 0; u.aux = pn; return true; }
    __device__ __forceinline__ void a_ready(const Unit&) const {}
    __device__ __forceinline__ void done(const Unit&) const {}
};
struct MergeOrder : GridOrder {
    __host__ __device__ bool next(int i, Unit& u) const { int pm, pc; if (!tile((long)(i >> 2) * G + c, pm, pc)) return false; const int n = i & 3; u.pm = pm; u.pn = 8 * n + pc; u.ka = 256 * n; u.aux = (n << 8) | pc; return true; }
};
#ifndef CPU_EMU
#define PG8_LAS __attribute__((address_space(3)))
template <class Epi, class Sched, bool ALIGN_EPI = false, bool SP2 = false, bool HALFN = false>
__device__ __forceinline__ void gemm_phase(PG8_LAS unsigned char* lds, const Gemm g, const Sched& S, const Epi& E) {
    int tid = threadIdx.x; asm volatile("" : "+v"(tid));
    const int wid = __builtin_amdgcn_readfirstlane(tid >> 6), lane = tid & 63, wr = wid >> 2, wc = wid & 3, fr = lane & 15, fq = lane >> 4;
    int K = g.K; asm volatile("" : "+s"(K));
    const int nt = K / BK, lda = g.lda;
    unsigned voffA[2], voffB[2];
#pragma unroll
    for (int i = 0; i < 2; ++i) { int R, C; stage_rc(tid * 16 + i * 8192, R, C); const int Rb = Epi::PERM ? ((R & ~31) + perm32(R & 31)) : R;
        voffA[i] = (unsigned)(R * lda + C) * 2u; voffB[i] = (unsigned)(Rb * K + C) * 2u; }
    const size_t kstep = (size_t)(BK * 2);
    const size_t hstepA = (size_t)HALF * lda * 2, hstepB = HALFN ? (size_t)0 : (size_t)HALF * K * 2;
    const size_t tstepA = 2 * hstepA, tstepB = HALFN ? (size_t)HALF * K * 2 : 2 * hstepB;
    const unsigned ldsw = (unsigned)wid * 1024u;
    const int aoff = lds_byte(wr * 64 + fr, fq * 8), boff = lds_byte(wc * 32 + fr, fq * 8);
#define PG8_SA(b, h) (((b) * 2 + (h)) * HTB)
#define PG8_SB(b, h) ((4 + (b) * 2 + (h)) * HTB)
#define PG8_STAGE(bufoff, gbase, voff) do { _Pragma("unroll") for (int _i = 0; _i < 2; ++_i) \
        __builtin_amdgcn_global_load_lds((const unsigned*)((const char*)(gbase) + (voff)[_i]), (PG8_LAS unsigned*)(lds + (bufoff) + ldsw + _i * 8192), 16, 0, 0); } while (0)
#define PG8_LDA(dst, b, h) do { _Pragma("unroll") for (int m = 0; m < 4; ++m) _Pragma("unroll") for (int k = 0; k < 2; ++k) dst[m][k] = *(const PG8_LAS bf16x8*)(lds + PG8_SA(b, h) + aoff + m * 2048 + k * 1024); } while (0)
#define PG8_LDB(dst, b, h) do { _Pragma("unroll") for (int n = 0; n < 2; ++n) _Pragma("unroll") for (int k = 0; k < 2; ++k) dst[n][k] = *(const PG8_LAS bf16x8*)(lds + PG8_SB(b, h) + boff + n * 2048 + k * 1024); } while (0)
#define PG8_MMA(ai, bj, At, Bt) do { __builtin_amdgcn_s_setprio(1); _Pragma("unroll") for (int m = 0; m < 4; ++m) _Pragma("unroll") for (int n = 0; n < 2; ++n) _Pragma("unroll") for (int k = 0; k < 2; ++k) \
        acc[ai][bj][m][n] = __builtin_amdgcn_mfma_f32_16x16x32_bf16(Bt[n][k], At[m][k], acc[ai][bj][m][n], 0, 0, 0); __builtin_amdgcn_s_setprio(0); } while (0)
#define PG8_WAIT_V(n) asm volatile("s_waitcnt vmcnt(" #n ")" ::: "memory")
#define PG8_WAIT_L(n) asm volatile("s_waitcnt lgkmcnt(" #n ")" ::: "memory")
#define PG8_BAR __builtin_amdgcn_s_barrier()
#define PG8_SCHED __builtin_amdgcn_sched_barrier(0)
    Unit cur, nxt; int ui = 0;
    if (!S.next(0, cur)) return;
    f32x4 acc[2][2][4][2];
    typename Epi::State est;
#pragma unroll
    for (int a = 0; a < 2; ++a)
#pragma unroll
        for (int b = 0; b < 2; ++b)
#pragma unroll
            for (int m = 0; m < 4; ++m)
#pragma unroll
                for (int n = 0; n < 2; ++n) acc[a][b][m][n] = (f32x4){0.f, 0.f, 0.f, 0.f};
    static_assert(!HALFN || SP2, "HALFN is written for the SP2 loop");
    bf16x8 At[4][2], B0[2][2], B1[2][2];
    const char* cA = (const char*)g.A + (size_t)cur.pm * tstepA + (size_t)cur.ka * 2; const char* cB = (const char*)g.Bt + (size_t)cur.pn * tstepB;
    S.a_ready(cur);
    if constexpr (SP2) {
        PG8_STAGE(PG8_SB(0, 0), cB, voffB); PG8_STAGE(PG8_SB(0, 1), cB + hstepB, voffB); PG8_STAGE(PG8_SA(0, 0), cA, voffA); PG8_STAGE(PG8_SA(0, 1), cA + hstepA, voffA);
        if (wr == 1) PG8_BAR;
        PG8_WAIT_V(2); PG8_BAR;
        PG8_STAGE(PG8_SB(1, 0), cB + kstep, voffB); PG8_STAGE(PG8_SA(1, 0), cA + kstep, voffA); PG8_STAGE(PG8_SB(1, 1), cB + hstepB + kstep, voffB);
        PG8_WAIT_V(6); PG8_BAR;
    } else {
        PG8_STAGE(PG8_SB(0, 0), cB, voffB); PG8_STAGE(PG8_SA(0, 0), cA, voffA); PG8_STAGE(PG8_SB(0, 1), cB + hstepB, voffB); PG8_STAGE(PG8_SA(0, 1), cA + hstepA, voffA);
        if (wr == 1) PG8_BAR;
        PG8_WAIT_V(4); PG8_BAR;
        PG8_STAGE(PG8_SB(1, 0), cB + kstep, voffB); PG8_STAGE(PG8_SA(1, 0), cA + kstep, voffA); PG8_STAGE(PG8_SB(1, 1), cB + hstepB + kstep, voffB);
        PG8_WAIT_V(6); PG8_BAR;
    }
    for (;;) {
        const bool has_next = S.next(ui + 1, nxt);
        const char* nA = has_next ? (const char*)g.A + (size_t)nxt.pm * tstepA + (size_t)nxt.ka * 2 : cA; const char* nB = has_next ? (const char*)g.Bt + (size_t)nxt.pn * tstepB : cB;
        for (int t = 0; t < nt; t += 2) {
            const bool last = (t == nt - 2);
            const char* a1 = cA + (size_t)(t + 1) * kstep;
            const char* a2 = last ? nA : cA + (size_t)(t + 2) * kstep; const char* b2 = last ? nB : cB + (size_t)(t + 2) * kstep;
            const char* a3 = a2 + kstep; const char* b3 = b2 + kstep;
            if (last && has_next) S.a_ready(nxt);
            if constexpr (SP2) {
            PG8_LDB(B0, 0, 0); if constexpr (!HALFN) PG8_LDB(B1, 0, 1); PG8_SCHED; PG8_LDA(At, 0, 0); PG8_STAGE(PG8_SA(1, 1), a1 + hstepA, voffA);
            PG8_WAIT_V(8); PG8_WAIT_L(0); PG8_BAR; PG8_MMA(0, 0, At, B0); if constexpr (!HALFN) PG8_MMA(0, 1, At, B1); PG8_BAR; PG8_SCHED;
            PG8_LDA(At, 0, 1); PG8_STAGE(PG8_SB(0, 0), b2, voffB); PG8_STAGE(PG8_SB(0, 1), b2 + hstepB, voffB); PG8_STAGE(PG8_SA(0, 0), a2, voffA);
            PG8_WAIT_V(8); PG8_WAIT_L(0); PG8_BAR; PG8_MMA(1, 0, At, B0); if constexpr (!HALFN) PG8_MMA(1, 1, At, B1); PG8_BAR; PG8_SCHED;
            PG8_LDB(B0, 1, 0); if constexpr (!HALFN) PG8_LDB(B1, 1, 1); PG8_SCHED; PG8_LDA(At, 1, 0); PG8_STAGE(PG8_SA(0, 1), a2 + hstepA, voffA);
            PG8_WAIT_V(8); PG8_WAIT_L(0); PG8_BAR; PG8_MMA(0, 0, At, B0); if constexpr (!HALFN) PG8_MMA(0, 1, At, B1); PG8_BAR; PG8_SCHED;
            PG8_LDA(At, 1, 1); PG8_STAGE(PG8_SB(1, 0), b3, voffB); PG8_STAGE(PG8_SB(1, 1), b3 + hstepB, voffB); PG8_STAGE(PG8_SA(1, 0), a3, voffA);
            PG8_WAIT_V(8); PG8_WAIT_L(0); PG8_BAR; PG8_MMA(1, 0, At, B0); if constexpr (!HALFN) PG8_MMA(1, 1, At, B1); PG8_BAR; PG8_SCHED;
            } else {
            PG8_LDB(B0, 0, 0); PG8_SCHED; PG8_LDA(At, 0, 0); PG8_STAGE(PG8_SA(1, 1), a1 + hstepA, voffA);
            PG8_WAIT_L(8); PG8_BAR; PG8_WAIT_L(0); PG8_MMA(0, 0, At, B0); PG8_BAR; PG8_SCHED;
            PG8_LDB(B1, 0, 1); PG8_STAGE(PG8_SB(0, 0), b2, voffB);
            PG8_BAR; PG8_WAIT_L(0); PG8_MMA(0, 1, At, B1); PG8_BAR;
            PG8_LDA(At, 0, 1); PG8_STAGE(PG8_SA(0, 0), a2, voffA);
            PG8_BAR; PG8_WAIT_L(0); PG8_MMA(1, 0, At, B0); PG8_BAR; PG8_SCHED;
            PG8_STAGE(PG8_SB(0, 1), b2 + hstepB, voffB);
            PG8_WAIT_V(6); PG8_BAR; PG8_MMA(1, 1, At, B1); PG8_BAR;
            PG8_LDB(B0, 1, 0); PG8_SCHED; PG8_LDA(At, 1, 0); PG8_STAGE(PG8_SA(0, 1), a2 + hstepA, voffA);
            PG8_WAIT_L(8); PG8_BAR; PG8_WAIT_L(0); PG8_MMA(0, 0, At, B0); PG8_BAR; PG8_SCHED;
            PG8_LDB(B1, 1, 1); PG8_STAGE(PG8_SB(1, 0), b3, voffB);
            PG8_BAR; PG8_WAIT_L(0); PG8_MMA(0, 1, At, B1); PG8_BAR;
            PG8_LDA(At, 1, 1); PG8_STAGE(PG8_SA(1, 0), a3, voffA);
            PG8_BAR; PG8_WAIT_L(0); PG8_MMA(1, 0, At, B0); PG8_BAR; PG8_SCHED;
            PG8_STAGE(PG8_SB(1, 1), b3 + hstepB, voffB);
            PG8_WAIT_V(6); PG8_BAR; PG8_MMA(1, 1, At, B1); PG8_BAR;
            }
        }
        if constexpr (ALIGN_EPI) { if (wr == 0) PG8_BAR; }
        E(acc, est, cur, wr, wc, fr, fq); S.done(cur);
        if (!has_next) break;
#pragma unroll
        for (int a = 0; a < 2; ++a)
#pragma unroll
            for (int b = 0; b < 2; ++b)
#pragma unroll
                for (int m = 0; m < 4; ++m)
#pragma unroll
                    for (int n = 0; n < 2; ++n) acc[a][b][m][n] = (f32x4){0.f, 0.f, 0.f, 0.f};
        cur = nxt; cA = nA; cB = nB; ++ui;
        if constexpr (ALIGN_EPI) { if (wr == 1) PG8_BAR; }
    }
    PG8_WAIT_V(0);
    if constexpr (!ALIGN_EPI) { if (wr == 0) PG8_BAR; }
    PG8_BAR;
#undef PG8_SA
#undef PG8_SB
#undef PG8_STAGE
#undef PG8_LDA
#undef PG8_LDB
#undef PG8_MMA
#undef PG8_WAIT_V
#undef PG8_WAIT_L
#undef PG8_BAR
#undef PG8_SCHED
}
#else
template <class Epi, class Sched, bool ALIGN_EPI = false, bool SP2 = false, bool HALFN = false>
void gemm_phase(unsigned char* lds, const Gemm g, const Sched& S, const Epi& E) {
    const int tid = threadIdx.x, wid = tid >> 6, lane = tid & 63, wr = wid >> 2, wc = wid & 3, fr = lane & 15, fq = lane >> 4;
    static thread_local float* Ct = nullptr; static thread_local float* Af = nullptr; static thread_local float* Bf = nullptr;
    Unit u; typename Epi::State est;
    for (int i = 0; S.next(i, u); ++i) {
        S.a_ready(u);
        __syncthreads();
        if (tid == 0) {
            if (!Ct) { Ct = new float[256 * 256]; Af = new float[256 * 4096]; Bf = new float[256 * 4096]; }
            const int K = g.K;
            for (int r = 0; r < 256; ++r) for (int k = 0; k < K; ++k) { Af[r * K + k] = bf2f(g.A[(size_t)(u.pm * 256 + r) * g.lda + u.ka + k]); Bf[r * K + k] = HALFN ? (r < 128 ? bf2f(g.Bt[(size_t)(u.pn * 128 + r) * K + k]) : 0.f) : bf2f(g.Bt[(size_t)(u.pn * 256 + r) * K + k]); }
            for (int r = 0; r < 256; ++r) for (int c = 0; c < 256; ++c) { float s = 0.f; const float* a = Af + r * K; const float* b = Bf + c * K; for (int k = 0; k < K; ++k) s += a[k] * b[k]; Ct[r * 256 + c] = s; }
        }
        __syncthreads();
        f32x4 acc[2][2][4][2];
        for (int ai = 0; ai < 2; ++ai) for (int bj = 0; bj < 2; ++bj) for (int m = 0; m < 4; ++m) for (int n = 0; n < 2; ++n) for (int e = 0; e < 4; ++e) {
            const int r = 128 * ai + 64 * wr + 16 * m + fr; const int c = Epi::PERM ? (128 * bj + 32 * wc + 8 * fq + 4 * n + e) : (128 * bj + 32 * wc + 16 * n + 4 * fq + e);
            acc[ai][bj][m][n][e] = Ct[r * 256 + c]; }
        E(acc, est, u, wr, wc, fr, fq); S.done(u);
    }
    __syncthreads();
}
#endif
}
namespace pg8 {
struct EpiMod {
    static constexpr bool PERM = false; typedef NoState State;
    float* C; const float* bias;
    __device__ __forceinline__ void operator()(const f32x4 (&acc)[2][2][4][2], State& st, const Unit& u, int wr, int wc, int fr_in, int fq_in) const {
        int fr = fr_in, fq = fq_in; OPAQUE_V(fr); OPAQUE_V(fq);
        const int row0 = wr * 64 + fr, col0 = u.aux * BM + wc * 32 + 4 * fq;
#pragma unroll
        for (int ai = 0; ai < 2; ++ai)
#pragma unroll
            for (int m = 0; m < 4; ++m) { float* rowp = C + (size_t)(row0 + ai * HALF + m * 16) * NMOD + col0;
#pragma unroll
                for (int bj = 0; bj < 2; ++bj)
#pragma unroll
                    for (int n = 0; n < 2; ++n) *(f32x4*)(rowp + bj * HALF + n * 16) = acc[ai][bj][m][n] + *(const f32x4*)(bias + col0 + bj * HALF + n * 16); }
    }
};
struct EpiProj {
    static constexpr bool PERM = true; typedef NoState State;
    bf16* proj; bf16* gate; float* outk_p; float* outv_p; float* outk_s; float* outv_s;
    __device__ __forceinline__ void operator()(const f32x4 (&acc)[2][2][4][2], State& st, const Unit& u, int wr, int wc, int fr_in, int fq_in) const {
        int fr = fr_in, fq = fq_in; OPAQUE_V(fr); OPAQUE_V(fq);
        const int t = u.aux; const bool isg = t >= 11;
        const int row0 = u.pm * BM + wr * 64 + fr, colt = wc * 32 + 8 * fq;
        bf16* base = isg ? gate + (size_t)(t - 11) * 256 : proj + (size_t)t * 256; const int ldc = isg ? NGATE : NPROJ;
#pragma unroll
        for (int ai = 0; ai < 2; ++ai)
#pragma unroll
            for (int m = 0; m < 4; ++m) { const int row = row0 + ai * HALF + m * 16; bf16* rowp = base + (size_t)row * ldc + colt;
#pragma unroll
                for (int bj = 0; bj < 2; ++bj) { f32x4 v0 = acc[ai][bj][m][0], v1 = acc[ai][bj][m][1];
                    if (isg) {
#pragma unroll
                        for (int e = 0; e < 4; ++e) { v0[e] = sigmoidf_(v0[e]); v1[e] = sigmoidf_(v1[e]); } }
                    else if (t >= 9) { float* o = (row < MP) ? ((t == 9 ? outk_p : outv_p) + (size_t)row * 256) : ((t == 9 ? outk_s : outv_s) + (size_t)(row - MP) * 256);
                        *(f32x4*)(o + colt + bj * HALF) = v0; *(f32x4*)(o + colt + bj * HALF + 4) = v1; }
                    v4u w; w.x = pk2(v0[0], v0[1]); w.y = pk2(v0[2], v0[3]); w.z = pk2(v1[0], v1[1]); w.w = pk2(v1[2], v1[3]);
                    *(v4u*)(rowp + bj * HALF) = w; } }
    }
};
struct EpiGlu {
    static constexpr bool PERM = true; typedef NoState State;
    const bf16* ys; bf16* y;
    __device__ __forceinline__ void operator()(const f32x4 (&acc)[2][2][4][2], State& st, const Unit& u, int wr, int wc, int fr_in, int fq_in) const {
        int fr = fr_in, fq = fq_in; OPAQUE_V(fr); OPAQUE_V(fq);
        const int row0 = u.pm * BM + wr * 64 + fr, colt = wc * 32 + 8 * fq;
#pragma unroll
        for (int ai = 0; ai < 2; ++ai)
#pragma unroll
            for (int m = 0; m < 4; ++m) { const int row = row0 + ai * HALF + m * 16;
#pragma unroll
                for (int bj = 0; bj < 2; ++bj) { const f32x4 v0 = acc[ai][bj][m][0], v1 = acc[ai][bj][m][1];
                    const v4u s = *(const v4u*)(ys + (size_t)row * 256 + colt + bj * HALF);
                    v4u w; w.x = pk2(bflo(s.x) * sigmoidf_(v0[0]), bfhi(s.x) * sigmoidf_(v0[1])); w.y = pk2(bflo(s.y) * sigmoidf_(v0[2]), bfhi(s.y) * sigmoidf_(v0[3]));
                    w.z = pk2(bflo(s.z) * sigmoidf_(v1[0]), bfhi(s.z) * sigmoidf_(v1[1])); w.w = pk2(bflo(s.w) * sigmoidf_(v1[2]), bfhi(s.w) * sigmoidf_(v1[3]));
                    *(v4u*)(y + (size_t)row * D + colt + bj * HALF) = w; } CFENCE(); }
    }
};
struct EpiMerge {
    static constexpr bool PERM = false; struct State { f32x4 macc[2][4][2]; };
    const bf16* gate; bf16* mgb;
    __device__ __forceinline__ void operator()(const f32x4 (&acc)[2][2][4][2], State& st, const Unit& u, int wr, int wc, int fr_in, int fq_in) const {
        int fr = fr_in, fq = fq_in; OPAQUE_V(fr); OPAQUE_V(fq);
        const int n_ = u.aux >> 8, pc = u.aux & 255;
        const int row0 = u.pm * BM + wr * 64 + fr, col0 = pc * HALF + wc * 32 + 4 * fq;
#pragma unroll
        for (int ai = 0; ai < 2; ++ai)
#pragma unroll
            for (int m = 0; m < 4; ++m) { const int row = row0 + ai * HALF + m * 16;
#pragma unroll
                for (int n = 0; n < 2; ++n) { const int col = col0 + n * 16;
                    const v2u gw = *(const v2u*)(gate + (size_t)row * NGATE + n_ * D + col);
                    f32x4 v = acc[ai][0][m][n]; v[0] *= bflo(gw.x); v[1] *= bfhi(gw.x); v[2] *= bflo(gw.y); v[3] *= bfhi(gw.y);
                    if (n_ > 0) v += st.macc[ai][m][n];
                    st.macc[ai][m][n] = v;
                    if (n_ == 3) { v2u o; o.x = pk2(v[0], v[1]); o.y = pk2(v[2], v[3]); *(v2u*)(mgb + (size_t)row * D + col) = o; } } CFENCE(); }
    }
};
struct EpiRes {
    static constexpr bool PERM = false; typedef NoState State;
    const float* xP; const float* xS; const float* gmod; float* out;
    __device__ __forceinline__ void operator()(const f32x4 (&acc)[2][2][4][2], State& st, const Unit& u, int wr, int wc, int fr_in, int fq_in) const {
        int fr = fr_in, fq = fq_in; OPAQUE_V(fr); OPAQUE_V(fq);
        const int row0 = u.pm * BM + wr * 64 + fr, col0 = u.aux * BM + wc * 32 + 4 * fq;
#pragma unroll
        for (int ai = 0; ai < 2; ++ai)
#pragma unroll
            for (int m = 0; m < 4; ++m) { const int row = row0 + ai * HALF + m * 16; const float* xr = row < MP ? xP + (size_t)row * D : xS + (size_t)(row - MP) * D;
                const float* gr = gmod + (size_t)seq_of(row) * NMOD;
#pragma unroll
                for (int bj = 0; bj < 2; ++bj)
#pragma unroll
                    for (int n = 0; n < 2; ++n) { const int col = col0 + bj * HALF + n * 16;
                        const f32x4 xv = *(const f32x4*)(xr + col), gv = *(const f32x4*)(gr + col);
                        *(f32x4*)(out + (size_t)row * D + col) = xv * ALPHA + (gv + 1.0f) * acc[ai][bj][m][n]; } CFENCE(); }
    }
};
struct EpiUp {
    static constexpr bool PERM = true; typedef NoState State;
    bf16* act;
    __device__ __forceinline__ void operator()(const f32x4 (&acc)[2][2][4][2], State& st, const Unit& u, int wr, int wc, int fr_in, int fq_in) const {
        int fr = fr_in, fq = fq_in; OPAQUE_V(fr); OPAQUE_V(fq);
        const int row0 = u.pm * BM + wr * 64 + fr, col0 = u.aux * HALF + wc * 32 + 8 * fq;
#pragma unroll
        for (int ai = 0; ai < 2; ++ai)
#pragma unroll
            for (int m = 0; m < 4; ++m) { const int row = row0 + ai * HALF + m * 16;
                const f32x4 a0 = acc[ai][0][m][0], a1 = acc[ai][0][m][1], b0 = acc[ai][1][m][0], b1 = acc[ai][1][m][1];
                v4u w; w.x = pk2(siluf_(a0[0]) * b0[0], siluf_(a0[1]) * b0[1]); w.y = pk2(siluf_(a0[2]) * b0[2], siluf_(a0[3]) * b0[3]);
                w.z = pk2(siluf_(a1[0]) * b1[0], siluf_(a1[1]) * b1[1]); w.w = pk2(siluf_(a1[2]) * b1[2], siluf_(a1[3]) * b1[3]);
                *(v4u*)(act + (size_t)row * DFF + col0) = w; }
    }
};
}
struct Args { const float* in[38]; float* out; unsigned char* ws; int ph_lo, ph_hi, li, pad; };
enum { I_XP = 0, I_XS, I_CK, I_CV, I_SRE, I_SIM, I_SCB, I_SD, I_SCD, I_PT, I_CP, I_CS, I_WADA, I_BADA, I_WIN, I_ARE, I_AIM, I_LDT, I_BRE, I_BIM, I_CRE, I_CIM, I_SSD, I_WGLU,
       I_CBW, I_DCW, I_DAL, I_DDT, I_DNW, I_WBR, I_WGATE, I_WO, I_L1G, I_L1B, I_WUP, I_WDN, I_L2G, I_L2B };
constexpr int NWAVES = 8, RING_BYTES = 131072, MISC_OFF = RING_BYTES, LDS_BYTES = 147456;
#ifndef CPU_EMU
#define XB_TMO      128
#define XB_XCNT(j)  (256  + 64 * (j))
#define XB_XSUB(j)  (1280 + 64 * (j))
#define XB_XGEN(j)  (2304 + 64 * (j))
#define XB_TOP      3328
#define XB_TOPGEN   3392
#define XCD_BAR_WORDS 3456
#define XB_SPIN_CAP (1u << 18)
__device__ __forceinline__ unsigned xb_ld(unsigned* p)              { return __hip_atomic_load(p, __ATOMIC_RELAXED, __HIP_MEMORY_SCOPE_AGENT); }
__device__ __forceinline__ unsigned xb_add(unsigned* p, unsigned v) { return __hip_atomic_fetch_add(p, v, __ATOMIC_RELAXED, __HIP_MEMORY_SCOPE_AGENT); }
__device__ __forceinline__ unsigned xb_xcc_id() { return (unsigned)__builtin_amdgcn_s_getreg((3 << 11) | 20) & 0xFu; }
#define XB_SPIN(cond, bar) do { unsigned _sp = 0; while (cond) { __builtin_amdgcn_s_sleep(1); \
    if ((++_sp & 255u) == 0u) { if (xb_ld(&(bar)[XB_TMO])) break; if (_sp > XB_SPIN_CAP) { atomicAdd(&(bar)[XB_TMO], 1u); break; } } } } while (0)
struct XcdBarrier { unsigned* bar; unsigned x; volatile LAS_HW unsigned* st; };
__device__ __forceinline__ XcdBarrier xcd_barrier_post(unsigned* bar, volatile LAS_HW unsigned* st) {
    XcdBarrier b; b.bar = bar; b.x = xb_xcc_id(); b.st = st;
    if (threadIdx.x == 0) (void)xb_add(&bar[XB_XCNT(b.x)], 1u);
    return b;
}
__device__ __forceinline__ void xcd_barrier_complete(unsigned* bar, unsigned x, unsigned& nloc, unsigned& nx) {
    const unsigned G = gridDim.x * gridDim.y * gridDim.z;
    unsigned sum, cnt, mine, sp = 0u;
    for (;;) {
        sum = 0u; cnt = 0u; mine = 0u;
#pragma unroll
        for (unsigned j = 0; j < 16; ++j) { const unsigned c = xb_ld(&bar[XB_XCNT(j)]); sum += c; cnt += (c > 0u) ? 1u : 0u; mine = (j == x) ? c : mine; }
        if (sum == G) break;
        __builtin_amdgcn_s_sleep(1);
        if ((++sp & 255u) == 0u) { if (xb_ld(&bar[XB_TMO])) break; if (sp > XB_SPIN_CAP) { atomicAdd(&bar[XB_TMO], 1u); break; } }
    }
    nloc = mine > 0u ? mine : 1u; nx = cnt > 0u ? cnt : 1u;
}
__device__ __forceinline__ void xcd_barrier(const XcdBarrier& b) {
    asm volatile("s_waitcnt vmcnt(0)" ::: "memory");
    __syncthreads();
    if (threadIdx.x == 0) {
        unsigned* bar = b.bar;
        __builtin_amdgcn_s_waitcnt(0);
        unsigned nloc = b.st[0], nx = b.st[1];
        if (nloc == 0u) { xcd_barrier_complete(bar, b.x, nloc, nx); b.st[0] = nloc; b.st[1] = nx; }
        const unsigned old = xb_add(&bar[XB_XSUB(b.x)], 1u);
        const unsigned gen = old / nloc;
        if (old + 1u == (gen + 1u) * nloc) {
            __builtin_amdgcn_fence(__ATOMIC_RELEASE, "agent");
            asm volatile("s_waitcnt vmcnt(0)" ::: "memory");
            const unsigned og = xb_add(&bar[XB_TOP], 1u);
            const unsigned tg = og / nx;
            if (og + 1u == (tg + 1u) * nx) xb_add(&bar[XB_TOPGEN], 1u);
            else XB_SPIN(xb_ld(&bar[XB_TOPGEN]) == tg, bar);
            __builtin_amdgcn_fence(__ATOMIC_ACQUIRE, "agent");
            xb_add(&bar[XB_XGEN(b.x)], 1u);
            asm volatile("s_waitcnt vmcnt(0)" ::: "memory");
        } else {
            XB_SPIN(xb_ld(&bar[XB_XGEN(b.x)]) == gen, bar);
            __builtin_amdgcn_fence(__ATOMIC_ACQUIRE, "agent");
            asm volatile("s_waitcnt vmcnt(0)" ::: "memory");
        }
    }
    __syncthreads();
}
#else
#define XCD_BAR_WORDS 3456
struct XcdBarrier { int dummy; };
inline void xcd_barrier(const XcdBarrier&) { emu::grid_sync(); }
#endif

#define TIDS int tid_ = threadIdx.x; OPAQUE_V(tid_); const int tid = tid_, lane = tid & 63, wave = __builtin_amdgcn_readfirstlane(tid >> 6), G = gridDim.x, bid = blockIdx.x, gw = bid * NWAVES + wave, NGW = G * NWAVES; (void)lane; (void)wave; (void)gw; (void)NGW; (void)G; (void)bid
__device__ __forceinline__ bf16* wsb(const Args& A, size_t off) { return (bf16*)(A.ws + off); }
__device__ __forceinline__ float* wsf(const Args& A, size_t off) { return (float*)(A.ws + off); }
__device__ __forceinline__ float softplusf_(float x) { return fmaxf(x, 0.f) + log1pf(__expf(-fabsf(x))); }
__device__ __forceinline__ void tr_item(const float* W, int N, int K, int k0, int c0, bf16* WT, int drow0, LAS float* scr, int lane) {
#pragma unroll 8
    for (int i = 0; i < 32; ++i) { const int kk = 2 * i + (lane >> 5); scr[kk * 33 + (lane & 31)] = W[(size_t)(k0 + kk) * N + c0 + (lane & 31)]; }
    WAVE_SYNC();
    const int c = lane & 7;
#pragma unroll
    for (int j = 0; j < 4; ++j) { const int n = (lane >> 3) + 8 * j; const LAS float* s = scr + (8 * c) * 33 + n;
        v4u o; o.x = pk2(s[0 * 33], s[1 * 33]); o.y = pk2(s[2 * 33], s[3 * 33]); o.z = pk2(s[4 * 33], s[5 * 33]); o.w = pk2(s[6 * 33], s[7 * 33]);
        *(v4u*)(WT + (size_t)(drow0 + n) * K + k0 + 8 * c) = o; }
    WAVE_SYNC();
}
__device__ __forceinline__ void ph_prologue(const Args& A, LAS unsigned char* lds) {
    TIDS;
    LAS float* scr = (LAS float*)(lds + wave * 16384);
    constexpr int I_ADA = 16 * 192, I_IN1 = 16 * 64, I_IN2 = 16 * 24, I_GT = 16 * 128, I_GLU = 4 * 8, I_BR = 4 * 4 * 32, I_WO_ = 16 * 32, I_UP = 16 * 176, I_DN = 44 * 32;
    constexpr int PER_L = I_ADA + I_IN1 + I_IN2 + I_GT + I_GLU + I_BR + I_WO_ + I_UP + I_DN;
    for (int it = gw; it < DEPTH * PER_L; it += NGW) {
        const int l = it / PER_L; int r = it % PER_L; unsigned char* wl = A.ws + WS_W + (size_t)l * WL_SIZE;
        if (r < I_ADA) { const int kb = r / 192, nb = r % 192; tr_item(A.in[I_WADA] + (size_t)l * D * NMOD, NMOD, D, kb * 64, nb * 32, (bf16*)(wl + WL_ADA), nb * 32, scr, lane); continue; } r -= I_ADA;
        if (r < I_IN1) { const int kb = r / 64, nb = r % 64; tr_item(A.in[I_WIN] + (size_t)l * D * NIN, NIN, D, kb * 64, nb * 32, (bf16*)(wl + WL_W1), nb * 32, scr, lane); continue; } r -= I_IN1;
        if (r < I_IN2) { const int kb = r / 24, nb = r % 24; tr_item(A.in[I_WIN] + (size_t)l * D * NIN, NIN, D, kb * 64, 2056 + nb * 32, (bf16*)(wl + WL_W1), 2048 + nb * 32, scr, lane); continue; } r -= I_IN2;
        if (r < I_GT) { const int kb = r / 128, nb = r % 128; tr_item(A.in[I_WGATE] + (size_t)l * D * NGATE, NGATE, D, kb * 64, nb * 32, (bf16*)(wl + WL_W1), NPROJ + nb * 32, scr, lane); continue; } r -= I_GT;
        if (r < I_GLU) { const int kb = r / 8, nb = r % 8; tr_item(A.in[I_WGLU] + (size_t)l * 256 * 256, 256, 256, kb * 64, nb * 32, (bf16*)(wl + WL_GLU), nb * 32, scr, lane); continue; } r -= I_GLU;
        if (r < I_BR) { const int n = r / 128, r2 = r % 128, kb = r2 / 32, nb = r2 % 32; tr_item(A.in[I_WBR] + (size_t)(l * 4 + n) * 256 * D, D, 256, kb * 64, nb * 32, (bf16*)(wl + WL_BR), n * D + nb * 32, scr, lane); continue; } r -= I_BR;
        if (r < I_WO_) { const int kb = r / 32, nb = r % 32; tr_item(A.in[I_WO] + (size_t)l * D * D, D, D, kb * 64, nb * 32, (bf16*)(wl + WL_WO), nb * 32, scr, lane); continue; } r -= I_WO_;
        if (r < I_UP) { const int kb = r / 176, nb = r % 176; const int c0 = nb * 32, j = c0 < DFF ? c0 : c0 - DFF; const int drow = (j / 128) * 256 + (c0 < DFF ? 0 : 128) + (j % 128);
            tr_item(A.in[I_WUP] + (size_t)l * D * NUP, NUP, D, kb * 64, c0, (bf16*)(wl + WL_UP), drow, scr, lane); continue; } r -= I_UP;
        { const int kb = r / 32, nb = r % 32; tr_item(A.in[I_WDN] + (size_t)l * DFF * D, D, DFF, kb * 64, nb * 32, (bf16*)(wl + WL_DN), nb * 32, scr, lane); }
    }
    const int gt = bid * (NWAVES * 64) + tid, NGT = G * NWAVES * 64;
    for (int i = gt; i < DEPTH * 8 * D; i += NGT) { const int l = i / (8 * D), j = (i / D) % 8, k = i % D; ((float*)(A.ws + WS_W + (size_t)l * WL_SIZE + WL_LOG))[j * D + k] = A.in[I_WIN][((size_t)l * D + k) * NIN + 2048 + j]; }
    for (int i = gt; i < 256 * D; i += NGT) { const int r = i / D, k = i % D; float v = 0.f;
        if (r < NB) v = siluf_(A.in[I_CP][r * D + k]); else if (r < NSEQ) v = siluf_(A.in[I_CS][(r - NB) * D + k]);
        wsb(A, WS_CSILU)[i] = (bf16)f2bf(v); }
}
struct ModOrder {
    int G, c;
    __host__ __device__ bool next(int i, pg8::Unit& u) const { const int L = i * G + c; if (L >= 24 * DEPTH) return false; const int l = L / 24, pn = L % 24;
        u.pm = 0; u.pn = l * (int)(WL_SIZE / (512 * 1024)) + pn; u.ka = 0; u.aux = pn | (l << 8); return true; }
    __device__ __forceinline__ void a_ready(const pg8::Unit&) const {}
    __device__ __forceinline__ void done(const pg8::Unit&) const {}
};
struct EpiMod2 { static constexpr bool PERM = false; typedef pg8::NoState State; float* C; const float* bias;
    __device__ __forceinline__ void operator()(const f32x4 (&acc)[2][2][4][2], State& st, const pg8::Unit& u, int wr, int wc, int fr, int fq) const {
        const int l = u.aux >> 8; pg8::Unit u2 = u; u2.aux = u.aux & 255; pg8::EpiMod e{C + (size_t)l * 256 * NMOD, bias + (size_t)l * NMOD}; e(acc, st, u2, wr, wc, fr, fq); } };
template <int MODE> __device__ __forceinline__ void ph_rows(const Args& A, int l) {
    TIDS;
    const float* MOD = wsf(A, WS_MOD);
    for (int m = gw; m < M; m += NGW) {
        const float* src; float* dstx = nullptr;
        if (MODE == 0) src = m < MP ? A.in[I_XP] + (size_t)m * D : A.in[I_XS] + (size_t)(m - MP) * D;
        else if (MODE == 1) { src = wsf(A, WS_X1) + (size_t)m * D; dstx = wsf(A, WS_X1) + (size_t)m * D; }
        else { src = wsf(A, WS_X2) + (size_t)m * D; dstx = (l == DEPTH - 1) ? A.out + O_Y + (size_t)m * D : wsf(A, WS_X2) + (size_t)m * D; }
        f32x4 v[4];
#pragma unroll
        for (int j = 0; j < 4; ++j) v[j] = ((const f32x4*)src)[lane + 64 * j];
        if (MODE != 0) {
            float s = 0.f;
#pragma unroll
            for (int j = 0; j < 4; ++j) s += (v[j][0] + v[j][1]) + (v[j][2] + v[j][3]);
            const float mean = wave_sum(s) * (1.f / D); float s2 = 0.f;
#pragma unroll
            for (int j = 0; j < 4; ++j) { v[j] = v[j] - mean; s2 += (v[j][0] * v[j][0] + v[j][1] * v[j][1]) + (v[j][2] * v[j][2] + v[j][3] * v[j][3]); }
            const float rstd = 1.f / sqrtf(wave_sum(s2) * (1.f / D) + LN_EPS);
            const float* gp = A.in[MODE == 1 ? I_L1G : I_L2G] + (size_t)l * D; const float* bp = A.in[MODE == 1 ? I_L1B : I_L2B] + (size_t)l * D;
#pragma unroll
            for (int j = 0; j < 4; ++j) { const f32x4 g = ((const f32x4*)gp)[lane + 64 * j], b = ((const f32x4*)bp)[lane + 64 * j]; v[j] = v[j] * rstd * g + b; ((f32x4*)dstx)[lane + 64 * j] = v[j]; }
            if (MODE == 2 && l == DEPTH - 1) continue;
        }
        const int ln = (MODE == 2) ? l + 1 : l;
        const float* mr = MOD + ((size_t)ln * 256 + seq_of(m)) * NMOD + (MODE == 1 ? 3 * D : 0);
        float s = 0.f;
#pragma unroll
        for (int j = 0; j < 4; ++j) s += (v[j][0] + v[j][1]) + (v[j][2] + v[j][3]);
        const float mean = wave_sum(s) * (1.f / D); float s2 = 0.f;
#pragma unroll
        for (int j = 0; j < 4; ++j) { v[j] = v[j] - mean; s2 += (v[j][0] * v[j][0] + v[j][1] * v[j][1]) + (v[j][2] * v[j][2] + v[j][3] * v[j][3]); }
        const float rstd = 1.f / sqrtf(wave_sum(s2) * (1.f / D) + LN_EPS);
        v2u* hrow = (v2u*)(wsb(A, WS_H) + (size_t)m * D);
#pragma unroll
        for (int j = 0; j < 4; ++j) { const f32x4 sh = ((const f32x4*)mr)[lane + 64 * j], sc = ((const f32x4*)(mr + D))[lane + 64 * j]; v[j] = v[j] * rstd * (sc + 1.0f) + sh;
            v2u o; o.x = pk2(v[j][0], v[j][1]); o.y = pk2(v[j][2], v[j][3]); hrow[lane + 64 * j] = o; }
        if (MODE != 1) {
            const float* wl = (const float*)(A.ws + WS_W + (size_t)ln * WL_SIZE + WL_LOG);
            float lg[8];
#pragma unroll
            for (int jj = 0; jj < 8; ++jj) { float t = 0.f;
#pragma unroll
                for (int j = 0; j < 4; ++j) { const f32x4 w = ((const f32x4*)(wl + jj * D))[lane + 64 * j]; t += (v[j][0] * w[0] + v[j][1] * w[1]) + (v[j][2] * w[2] + v[j][3] * w[3]); }
                lg[jj] = wave_sum(t); }
            if (lane == 0) { float* o = wsf(A, WS_LOG8) + (size_t)m * 8; *(f32x4*)o = (f32x4){lg[0], lg[1], lg[2], lg[3]}; *(f32x4*)(o + 4) = (f32x4){lg[4], lg[5], lg[6], lg[7]}; }
        }
    }
}
struct SsmC { float abr, abi, bbr[16], bbi[16]; };
__device__ __forceinline__ void ssm_consts(const Args& A, int l, int g, int p, SsmC& c) {
    const int gi = l * 16 + g;
    const float dt = expf(A.in[I_LDT][gi]), ar = A.in[I_ARE][gi * 64 + p], ai = A.in[I_AIM][gi * 64 + p];
    const float mag = expf(dt * ar); c.abr = mag * cosf(dt * ai); c.abi = mag * sinf(dt * ai);
    const float den = ar * ar + ai * ai, fre = ((c.abr - 1.0f) * ar + c.abi * ai) / den, fim = (c.abi * ar - (c.abr - 1.0f) * ai) / den;
    const f32x4* br = (const f32x4*)(A.in[I_BRE] + (size_t)(gi * 64 + p) * 16); const f32x4* bi = (const f32x4*)(A.in[I_BIM] + (size_t)(gi * 64 + p) * 16);
#pragma unroll
    for (int q = 0; q < 4; ++q) { const f32x4 r = br[q], i = bi[q];
#pragma unroll
        for (int e = 0; e < 4; ++e) { c.bbr[4 * q + e] = fre * r[e] - fim * i[e]; c.bbi[4 * q + e] = fre * i[e] + fim * r[e]; } }
}
__device__ __forceinline__ void ssm_step(const SsmC& c, const bf16* urow, float& hr, float& hi) {
    const v4u u0 = *(const v4u*)urow, u1 = *(const v4u*)(urow + 8);
    float u[16] = {bflo(u0.x), bfhi(u0.x), bflo(u0.y), bfhi(u0.y), bflo(u0.z), bfhi(u0.z), bflo(u0.w), bfhi(u0.w), bflo(u1.x), bfhi(u1.x), bflo(u1.y), bfhi(u1.y), bflo(u1.z), bfhi(u1.z), bflo(u1.w), bfhi(u1.w)};
    float br = 0.f, bi = 0.f;
#pragma unroll
    for (int h = 0; h < 16; ++h) { br += c.bbr[h] * u[h]; bi += c.bbi[h] * u[h]; }
    const float nr = c.abr * hr - c.abi * hi + br, ni = c.abr * hi + c.abi * hr + bi; hr = nr; hi = ni;
}
__device__ __forceinline__ void ph_ssm1(const Args& A, int l) {
    TIDS;
    const bf16* proj = wsb(A, WS_PROJ);
    for (int un = gw; un < NB * 16 * SSM_NCH; un += NGW) {
        const int c = un % SSM_NCH, g = (un / SSM_NCH) % 16, b = un / (SSM_NCH * 16);
        SsmC k; ssm_consts(A, l, g, lane, k);
        float hr = 0.f, hi = 0.f;
        const bf16* up = proj + (size_t)(b * SEQ + c * SSM_CH) * NPROJ + PC_U + g * 16;
        for (int t = 0; t < SSM_CH; ++t) ssm_step(k, up + (size_t)t * NPROJ, hr, hi);
        float* o = wsf(A, WS_SEND) + (size_t)un * 128; o[lane] = hr; o[64 + lane] = hi;
    }
}
__device__ __forceinline__ void ph_ssm_carry(const Args& A, int l) {
    TIDS;
    const int gt = (G - 1 - bid) * (NWAVES * 64) + tid;
    if (gt < NB * 16 * 64) {
        const int p = gt & 63, g = (gt >> 6) & 15, b = gt >> 10; const int gi = l * 16 + g;
        const float dt = expf(A.in[I_LDT][gi]), ar = A.in[I_ARE][gi * 64 + p], ai = A.in[I_AIM][gi * 64 + p];
        const float mag = expf(dt * ar); float pr = mag * cosf(dt * ai), pi = mag * sinf(dt * ai);
        for (int s = 1; s < SSM_CH; s <<= 1) { const float nr = pr * pr - pi * pi, ni = 2.f * pr * pi; pr = nr; pi = ni; }
        float cr = 0.f, ci = 0.f;
        for (int c = 0; c < SSM_NCH; ++c) { const size_t un = ((size_t)(b * 16 + g) * SSM_NCH + c) * 128;
            wsf(A, WS_HIN)[un + p] = cr; wsf(A, WS_HIN)[un + 64 + p] = ci;
            const float sr = wsf(A, WS_SEND)[un + p], si = wsf(A, WS_SEND)[un + 64 + p];
            const float nr = pr * cr - pi * ci + sr, ni = pr * ci + pi * cr + si; cr = nr; ci = ni; }
    }
}
__device__ __forceinline__ float gelu_tanh(float x) { const float t = tanhf(0.7978845608028654f * (x + 0.044715f * x * x * x)); return 0.5f * x * (1.0f + t); }
__device__ __forceinline__ void ph_ssm2(const Args& A, LAS unsigned char* lds, int l) {
    TIDS;
    LAS float* ct = (LAS float*)(lds + wave * 16384);
    LAS float* ht = ct + 2048;
    const bf16* proj = wsb(A, WS_PROJ);
    constexpr int NPU = NB * 16 * SSM_NCH, NSU = DB * 16;
    for (int un = gw; un < NPU + NSU; un += NGW) {
        int g, m0, ntok; float hr, hi; float* fre = nullptr; float* fim = nullptr;
        if (un < NPU) { const int c = un % SSM_NCH; g = (un / SSM_NCH) % 16; const int b = un / (SSM_NCH * 16); m0 = b * SEQ + c * SSM_CH; ntok = SSM_CH;
            hr = wsf(A, WS_HIN)[(size_t)un * 128 + lane]; hi = wsf(A, WS_HIN)[(size_t)un * 128 + 64 + lane];
            if (c == SSM_NCH - 1) { fre = A.out + O_REP + ((size_t)(l * NB + b) * 16 + g) * 64; fim = A.out + O_IMP + ((size_t)(l * NB + b) * 16 + g) * 64; } }
        else { const int su = un - NPU; g = su & 15; const int s = su >> 4; m0 = MP + s * DEC_SEQ; ntok = DEC_SEQ;
            hr = A.in[I_SRE][((size_t)(l * DB + s) * 16 + g) * 64 + lane]; hi = A.in[I_SIM][((size_t)(l * DB + s) * 16 + g) * 64 + lane];
            fre = A.out + O_RES + ((size_t)(l * DB + s) * 16 + g) * 64; fim = A.out + O_IMS + ((size_t)(l * DB + s) * 16 + g) * 64; }
        SsmC k; ssm_consts(A, l, g, lane, k);
        const int gi = l * 16 + g;
        for (int ch = 0; ch < 16; ++ch) { ct[lane * 16 + ch] = A.in[I_CRE][((size_t)gi * 16 + ch) * 64 + lane]; ct[1024 + lane * 16 + ch] = A.in[I_CIM][((size_t)gi * 16 + ch) * 64 + lane]; }
        const float dd = A.in[I_SSD][l * 256 + g * 16 + (lane & 15)];
        for (int t0 = 0; t0 < ntok; t0 += 16) {
            const int nt = (ntok - t0) < 16 ? (ntok - t0) : 16;
            for (int t = 0; t < nt; ++t) { ssm_step(k, proj + (size_t)(m0 + t0 + t) * NPROJ + PC_U + g * 16, hr, hi); ht[t * 64 + lane] = hr; ht[1024 + t * 64 + lane] = hi; }
            WAVE_SYNC();
            const int ch = lane & 15, tq = lane >> 4;
#pragma unroll
            for (int i = 0; i < 4; ++i) { const int tt = tq + 4 * i;
                if (tt < nt) { float y = 0.f;
                    for (int p = 0; p < 64; ++p) y += ct[p * 16 + ch] * ht[tt * 64 + p] - ct[1024 + p * 16 + ch] * ht[1024 + tt * 64 + p];
                    const size_t m = (size_t)(m0 + t0 + tt);
                    y += dd * bf2f(proj[m * NPROJ + PC_U + g * 16 + ch]);
                    wsb(A, WS_YS)[m * 256 + g * 16 + ch] = (bf16)f2bf(gelu_tanh(y)); } }
            WAVE_SYNC();
        }
        if (fre) { fre[lane] = hr; fim[lane] = hi; }
    }
}
__device__ __forceinline__ void ph_conv(const Args& A, int l) {
    TIDS;
    const int gt = bid * (NWAVES * 64) + tid, NGT = G * NWAVES * 64;
    const bf16* proj = wsb(A, WS_PROJ);
    for (int i = gt; i < M * 128; i += NGT) {
        const int m = i >> 7, c = (i & 127) * 2;
        int t, L; const float* hist = nullptr; float* so;
        if (m < MP) { t = m % SEQ; L = SEQ; so = A.out + O_CBP + (size_t)(l * NB + m / SEQ) * 512; }
        else { const int s = (m - MP) / DEC_SEQ; t = (m - MP) % DEC_SEQ; L = DEC_SEQ; hist = A.in[I_SCB] + (size_t)(l * DB + s) * 512; so = A.out + O_CBS + (size_t)(l * DB + s) * 512; }
        float cx0[3], cx1[3];
#pragma unroll
        for (int j = 0; j < 3; ++j) { const int tt = t - 2 + j;
            if (tt >= 0) { const bf16* r = proj + (size_t)(m - 2 + j) * NPROJ; const unsigned cg = *(const unsigned*)(r + PC_CG + c), xc = *(const unsigned*)(r + PC_XC + c); cx0[j] = bflo(cg) * bflo(xc); cx1[j] = bfhi(cg) * bfhi(xc); }
            else if (hist) { cx0[j] = hist[(2 + tt) * 256 + c]; cx1[j] = hist[(2 + tt) * 256 + c + 1]; }
            else { cx0[j] = 0.f; cx1[j] = 0.f; } }
        const float* w = A.in[I_CBW] + (size_t)l * 3 * 256;
        const float o0 = w[c] * cx0[0] + w[256 + c] * cx0[1] + w[512 + c] * cx0[2], o1 = w[c + 1] * cx1[0] + w[256 + c + 1] * cx1[1] + w[512 + c + 1] * cx1[2];
        const unsigned bg = *(const unsigned*)(proj + (size_t)m * NPROJ + PC_BG + c);
        *(unsigned*)(wsb(A, WS_Y) + (size_t)m * D + 256 + c) = pk2(bflo(bg) * o0, bfhi(bg) * o1);
        if (t >= L - 2) { so[(t - (L - 2)) * 256 + c] = cx0[2]; so[(t - (L - 2)) * 256 + c + 1] = cx1[2]; }
    }
}
__device__ __forceinline__ void ph_gdn_c1(const Args& A, LAS unsigned char* lds, int l) {
    TIDS;
    constexpr int RS = 65;
    LAS float* q = (LAS float*)lds; LAS float* k = q + 64 * RS; LAS float* v = k + 64 * RS; LAS float* MM = v + 64 * RS; LAS float* QK = MM + 4096; LAS float* sol = QK + 4096;
    LAS float* gcs = sol + 8192; LAS float* bet = gcs + 64; LAS float* egc = bet + 64;
    const bf16* proj = wsb(A, WS_PROJ); const float* cw = A.in[I_DCW] + (size_t)l * 4 * GQKV; const float* lg8 = wsf(A, WS_LOG8);
    for (int un = bid; un < NB * GH * GNCH; un += G) {
        const int c = un % GNCH, h = (un / GNCH) % GH, b = un / (GNCH * GH); const int m0 = b * SEQ + c * GCH;
        for (int idx = tid; idx < 64 * 192; idx += 512) {
            const int i = idx / 192, cc = idx % 192, sec = cc >> 6, d = cc & 63, src = sec * 256 + h * 64 + d, t = c * GCH + i;
            float acc = 0.f, cur = 0.f;
#pragma unroll
            for (int j = 0; j < 4; ++j) { const int tt = t - 3 + j; const float x = tt >= 0 ? bf2f(proj[(size_t)(b * SEQ + tt) * NPROJ + PC_QKV + src]) : 0.f; acc += cw[j * GQKV + src] * x; cur = x; }
            (sec == 0 ? q : sec == 1 ? k : v)[i * RS + d] = siluf_(acc);
            if (t >= SEQ - 3) A.out[O_CDP + ((size_t)(l * NB + b) * 3 + (t - (SEQ - 3))) * GQKV + src] = cur;
        }
        __syncthreads();
        for (int r = 0; r < 8; ++r) { const int i = wave * 8 + r;
            const float qv = q[i * RS + lane], kv = k[i * RS + lane];
            const float sq = wave_sum(qv * qv), sk = wave_sum(kv * kv);
            q[i * RS + lane] = qv * (1.0f / sqrtf(sq + RMS_EPS)) * 0.125f; k[i * RS + lane] = kv * (1.0f / sqrtf(sk + RMS_EPS)); }
        if (tid < 64) { const float* lr = lg8 + (size_t)(m0 + tid) * 8; bet[tid] = sigmoidf_(lr[h]); gcs[tid] = -expf(A.in[I_DAL][l * 4 + h]) * softplusf_(lr[4 + h] + A.in[I_DDT][l * 4 + h]); }
        __syncthreads();
        if (tid == 0) { float s = 0.f; for (int i = 0; i < 64; ++i) { s += gcs[i]; gcs[i] = s; } }
        __syncthreads();
        if (tid < 64) egc[tid] = expf(gcs[tid]);
        __syncthreads();
        for (int idx = tid; idx < 4096; idx += 512) { const int i = idx >> 6, j = idx & 63; float kk = 0.f, qk = 0.f;
            for (int d = 0; d < 64; ++d) { const float kj = k[j * RS + d]; kk += k[i * RS + d] * kj; qk += q[i * RS + d] * kj; }
            const float dec = i >= j ? expf(gcs[i] - gcs[j]) : 0.f;
            MM[idx] = i > j ? bet[i] * kk * dec : 0.f; QK[idx] = qk * dec; }
        for (int idx = tid; idx < 64 * 128; idx += 512) { const int i = idx >> 7, cc = idx & 127; sol[idx] = cc < 64 ? bet[i] * v[i * RS + cc] : bet[i] * egc[i] * k[i * RS + cc - 64]; }
        __syncthreads();
        for (int i = 0; i < 63; ++i) {
            for (int idx = tid; idx < (63 - i) * 128; idx += 512) { const int r = i + 1 + (idx >> 7), cc = idx & 127; sol[r * 128 + cc] -= MM[r * 64 + i] * sol[i * 128 + cc]; }
            __syncthreads();
        }
        unsigned char* gd = A.ws + WS_GD + (size_t)un * GD_UNIT; const float gl = gcs[63];
        for (int idx = tid; idx < 4096; idx += 512) { const int f = idx >> 9, ln = (idx >> 3) & 63, j = idx & 7, row = 16 * (f >> 1) + (ln & 15), kx = 32 * (f & 1) + 16 * (j >> 2) + 4 * (ln >> 4) + (j & 3);
            ((bf16*)gd)[idx] = (bf16)f2bf(-sol[row * 128 + 64 + kx]); ((bf16*)gd)[4096 + idx] = (bf16)f2bf(q[row * RS + kx] * egc[row]); ((bf16*)gd)[8192 + idx] = (bf16)f2bf(QK[row * 64 + kx]);
            ((bf16*)gd)[12288 + idx] = (bf16)f2bf(k[kx * RS + row] * expf(gl - gcs[kx])); }
        for (int idx = tid; idx < 4096; idx += 512) { const int r = idx & 3, ln = (idx >> 2) & 63, T = (idx >> 8) & 3, vs = idx >> 10; ((float*)(gd + 32768))[idx] = sol[(16 * T + 4 * (ln >> 4) + r) * 128 + 16 * vs + (ln & 15)]; }
        if (tid == 0) wsf(A, WS_EGL)[un] = expf(gl);
        __syncthreads();
    }
}
__device__ __forceinline__ bf16x8 acc2b(const f32x4& lo, const f32x4& hi) { v4u w; w.x = pk2(lo[0], lo[1]); w.y = pk2(lo[2], lo[3]); w.z = pk2(hi[0], hi[1]); w.w = pk2(hi[2], hi[3]); return __builtin_bit_cast(bf16x8, w); }
__device__ __forceinline__ void ph_gdn_scan(const Args& A, int l) {
    TIDS;
    if (wave >= 4) return;
    for (int grp = bid; grp < NB * GH; grp += G) {
        const int vs = wave, h = grp % GH, b = grp / GH; const int g = lane >> 4, cc = lane & 15;
        f32x4 S[4];
#pragma unroll
        for (int T = 0; T < 4; ++T) S[T] = (f32x4){0.f, 0.f, 0.f, 0.f};
        for (int c = 0; c < GNCH; ++c) {
            const size_t cu = (size_t)(b * GH + h) * GNCH + c; const unsigned char* gd = A.ws + WS_GD + cu * GD_UNIT; const float egl = wsf(A, WS_EGL)[cu];
            const bf16x8* fr = (const bf16x8*)gd + lane;
            const f32x4* uvp = (const f32x4*)(gd + 32768) + (vs * 4) * 64 + lane;
            bf16x8 Sb[2] = {acc2b(S[0], S[1]), acc2b(S[2], S[3])};
            f32x4 u[4], o[4];
#pragma unroll
            for (int T = 0; T < 4; ++T) { u[T] = uvp[T * 64]; o[T] = (f32x4){0.f, 0.f, 0.f, 0.f};
#pragma unroll
                for (int s = 0; s < 2; ++s) { u[T] = __builtin_amdgcn_mfma_f32_16x16x32_bf16(fr[(0 * 8 + 2 * T + s) * 64], Sb[s], u[T], 0, 0, 0); o[T] = __builtin_amdgcn_mfma_f32_16x16x32_bf16(fr[(1 * 8 + 2 * T + s) * 64], Sb[s], o[T], 0, 0, 0); } }
            bf16x8 ub[2] = {acc2b(u[0], u[1]), acc2b(u[2], u[3])};
#pragma unroll
            for (int T = 0; T < 4; ++T) { S[T] = S[T] * egl;
#pragma unroll
                for (int s = 0; s < 2; ++s) { o[T] = __builtin_amdgcn_mfma_f32_16x16x32_bf16(fr[(2 * 8 + 2 * T + s) * 64], ub[s], o[T], 0, 0, 0); S[T] = __builtin_amdgcn_mfma_f32_16x16x32_bf16(fr[(3 * 8 + 2 * T + s) * 64], ub[s], S[T], 0, 0, 0); } }
            float* od = wsf(A, WS_ODRAW) + (size_t)(b * SEQ + c * GCH + 4 * g) * 256 + h * 64 + vs * 16 + cc;
#pragma unroll
            for (int T = 0; T < 4; ++T)
#pragma unroll
                for (int r = 0; r < 4; ++r) od[(size_t)(16 * T + r) * 256] = o[T][r];
        }
        float* so = A.out + O_DP + (((size_t)(l * NB + b) * GH + h) * 64 + 4 * g) * 64 + vs * 16 + cc;
#pragma unroll
        for (int T = 0; T < 4; ++T)
#pragma unroll
            for (int r = 0; r < 4; ++r) so[(16 * T + r) * 64] = S[T][r];
    }
}
__device__ __forceinline__ void ph_gdn_sample(const Args& A, LAS unsigned char* lds, int l) {
    TIDS;
    LAS float* S = (LAS float*)(lds + wave * 16384);
    LAS float* kq = (LAS float*)(lds + MISC_OFF + 1024 + wave * 512);
    const bf16* proj = wsb(A, WS_PROJ); const float* cw = A.in[I_DCW] + (size_t)l * 4 * GQKV; const float* lg8 = wsf(A, WS_LOG8);
    if (wave < 4 || wave >= 6) return;
    for (int un = (wave - 4) * G + bid; un < DB * GH; un += 2 * G) {
        const int h = un % GH, s = un / GH;
        const float* s0 = A.in[I_SD] + ((size_t)(l * DB + s) * GH + h) * 4096;
#pragma unroll 8
        for (int kk = 0; kk < 64; ++kk) S[kk * 64 + lane] = s0[kk * 64 + lane];
        const float* hist = A.in[I_SCD] + (size_t)(l * DB + s) * 3 * GQKV;
        for (int t = 0; t < DEC_SEQ; ++t) {
            const size_t m = (size_t)MP + s * DEC_SEQ + t;
            float val[3];
#pragma unroll
            for (int sec = 0; sec < 3; ++sec) { const int src = sec * 256 + h * 64 + lane; float acc = 0.f, cur = 0.f;
#pragma unroll
                for (int j = 0; j < 4; ++j) { const int tt = t - 3 + j; const float x = tt >= 0 ? bf2f(proj[(size_t)(MP + s * DEC_SEQ + tt) * NPROJ + PC_QKV + src]) : hist[(3 + tt) * GQKV + src]; acc += cw[j * GQKV + src] * x; cur = x; }
                val[sec] = siluf_(acc);
                if (t >= 1) A.out[O_CDS + ((size_t)(l * DB + s) * 3 + (t - 1)) * GQKV + src] = cur; }
            const float sq = wave_sum(val[0] * val[0]), sk = wave_sum(val[1] * val[1]);
            const float qv = val[0] * (1.0f / sqrtf(sq + RMS_EPS)) * 0.125f, kv = val[1] * (1.0f / sqrtf(sk + RMS_EPS)), vv = val[2];
            const float* lr = lg8 + m * 8; const float beta = sigmoidf_(lr[h]); const float a = expf(-expf(A.in[I_DAL][l * 4 + h]) * softplusf_(lr[4 + h] + A.in[I_DDT][l * 4 + h]));
            kq[lane] = kv; kq[64 + lane] = qv;
            WAVE_SYNC();
            float kS = 0.f;
#pragma unroll 8
            for (int kk = 0; kk < 64; ++kk) kS += kq[kk] * S[kk * 64 + lane];
            float o = 0.f;
#pragma unroll 8
            for (int kk = 0; kk < 64; ++kk) { const float bk = beta * kq[kk]; const float sn = a * (S[kk * 64 + lane] - bk * kS) + bk * vv; S[kk * 64 + lane] = sn; o += kq[64 + kk] * sn; }
            wsf(A, WS_ODRAW)[m * 256 + h * 64 + lane] = o;
            WAVE_SYNC();
        }
        float* so = A.out + O_DS + ((size_t)(l * DB + s) * GH + h) * 4096;
#pragma unroll 8
        for (int kk = 0; kk < 64; ++kk) so[kk * 64 + lane] = S[kk * 64 + lane];
    }
}
__device__ __forceinline__ void ph_gdn_out(const Args& A, int l) {
    TIDS;
    for (int idx = gw; idx < M * GH; idx += NGW) { const size_t m = idx >> 2; const int h = idx & 3;
        const float o = wsf(A, WS_ODRAW)[m * 256 + h * 64 + lane];
        const float ms = wave_sum(o * o) * (1.0f / 64.0f);
        const float z = bf2f(wsb(A, WS_PROJ)[m * NPROJ + PC_Z + h * 64 + lane]);
        wsb(A, WS_Y)[m * D + 512 + h * 64 + lane] = (bf16)f2bf(o * (1.0f / sqrtf(ms + RMS_EPS)) * A.in[I_DNW][l * 64 + lane] * siluf_(z)); }
}
__device__ __forceinline__ void sb_terms(float z, float& ls, float& ln) { const float L = log1pf(__expf(-fabsf(z))); ls = fminf(z, 0.f) - L; ln = -fmaxf(z, 0.f) - L; }
constexpr float SB_CUT = -105.0f;
__device__ __forceinline__ void ph_sb_prompt(const Args& A, LAS unsigned char* lds, int l) {
    TIDS; (void)l;
    LAS float* kt = (LAS float*)(lds + wave * 16384); LAS float* vt = kt + 2048;
    const bf16* proj = wsb(A, WS_PROJ);
    constexpr int NQB = SEQ / 32;
    for (int un0 = gw; un0 < NB * SBH * NQB; un0 += NGW) {
        const int un = NB * SBH * NQB - 1 - un0;
        const int qb = un / (NB * SBH), h = un % SBH, b = (un / SBH) % NB;
        const int i = lane & 31, half = lane >> 5, qi = qb * 32 + i; const size_t m = (size_t)b * SEQ + qi;
        float q[32], acc[32];
        { const v4u* qp = (const v4u*)(proj + m * NPROJ + PC_Q + h * 64 + half * 32);
#pragma unroll
          for (int x = 0; x < 4; ++x) { const v4u w = qp[x]; q[8 * x] = bflo(w.x) * 0.125f; q[8 * x + 1] = bfhi(w.x) * 0.125f; q[8 * x + 2] = bflo(w.y) * 0.125f; q[8 * x + 3] = bfhi(w.y) * 0.125f;
              q[8 * x + 4] = bflo(w.z) * 0.125f; q[8 * x + 5] = bfhi(w.z) * 0.125f; q[8 * x + 6] = bflo(w.w) * 0.125f; q[8 * x + 7] = bfhi(w.w) * 0.125f; } }
#pragma unroll
        for (int d = 0; d < 32; ++d) acc[d] = 0.f;
        float R = 0.f;
        for (int kb = qb; kb >= 0; --kb) {
            { const int row = lane >> 1, hr = lane & 1; const bf16* rp = proj + ((size_t)b * SEQ + kb * 32 + row) * NPROJ + h * 64 + hr * 32;
              const v4u* kp = (const v4u*)(rp + PC_K); const v4u* vp = (const v4u*)(rp + PC_V);
#pragma unroll
              for (int x = 0; x < 4; ++x) { const v4u w = kp[x], u = vp[x]; LAS float* kd = kt + row * 64 + hr * 32 + 8 * x; LAS float* vd = vt + row * 64 + hr * 32 + 8 * x;
                  kd[0] = bflo(w.x); kd[1] = bfhi(w.x); kd[2] = bflo(w.y); kd[3] = bfhi(w.y); kd[4] = bflo(w.z); kd[5] = bfhi(w.z); kd[6] = bflo(w.w); kd[7] = bfhi(w.w);
                  vd[0] = bflo(u.x); vd[1] = bfhi(u.x); vd[2] = bflo(u.y); vd[3] = bfhi(u.y); vd[4] = bflo(u.z); vd[5] = bfhi(u.z); vd[6] = bflo(u.w); vd[7] = bfhi(u.w); } }
            WAVE_SYNC();
            for (int jj = 31; jj >= 0; --jj) {
                const LAS float* kr = kt + jj * 64 + half * 32; float zp = 0.f;
#pragma unroll
                for (int d = 0; d < 32; ++d) zp += q[d] * kr[d];
                const float z = zp + __shfl_xor(zp, 32);
                float ls, ln; sb_terms(z, ls, ln);
                const bool valid = (kb * 32 + jj) < qi;
                const float w = valid ? __expf(ls + R) : 0.f;
                const LAS float* vr = vt + jj * 64 + half * 32;
#pragma unroll
                for (int d = 0; d < 32; ++d) acc[d] += w * vr[d];
                R += valid ? ln : 0.f;
            }
            WAVE_SYNC();
            if (kb < qb && __all(R < SB_CUT)) break;
        }
        v4u* yp = (v4u*)(wsb(A, WS_Y) + m * D + 768 + h * 64 + half * 32);
#pragma unroll
        for (int x = 0; x < 4; ++x) { v4u o; o.x = pk2(acc[8 * x], acc[8 * x + 1]); o.y = pk2(acc[8 * x + 2], acc[8 * x + 3]); o.z = pk2(acc[8 * x + 4], acc[8 * x + 5]); o.w = pk2(acc[8 * x + 6], acc[8 * x + 7]); yp[x] = o; }
    }
}
__device__ __forceinline__ void ph_sb_sample(const Args& A, LAS unsigned char* lds, int l) {
    TIDS;
    if (wave >= 2) return;
    LAS float* vt = (LAS float*)(lds + wave * 32768);
    LAS float* qs = vt + 64 * 68;
    LAS float* wq = qs + 256;
    const bf16* proj = wsb(A, WS_PROJ); const int* pt = (const int*)A.in[I_PT];
    for (int un = wave * G + bid; un < DB * SBH; un += 2 * G) {
        const int h = un % SBH, s = un / SBH;
#pragma unroll
        for (int qi = 0; qi < 4; ++qi) qs[qi * 64 + lane] = bf2f(proj[((size_t)MP + s * DEC_SEQ + qi) * NPROJ + PC_Q + h * 64 + lane]) * 0.125f;
        WAVE_SYNC();
        float R[4] = {0.f, 0.f, 0.f, 0.f}; f32x4 acc = {0.f, 0.f, 0.f, 0.f};
        const int qi_b = lane & 3, ds = lane >> 2;
        for (int tile = 0; tile * 64 < PAST + DEC_SEQ; ++tile) {
            const int p = PAST + DEC_SEQ - 1 - (tile * 64 + lane);
            f32x4 kr[16], vr[16];
            if (p >= PAST) { const bf16* rp = proj + ((size_t)MP + s * DEC_SEQ + (p - PAST)) * NPROJ + h * 64;
#pragma unroll
                for (int x = 0; x < 8; ++x) { const v4u kw = ((const v4u*)(rp + PC_K))[x], vw = ((const v4u*)(rp + PC_V))[x];
                    kr[2 * x] = (f32x4){bflo(kw.x), bfhi(kw.x), bflo(kw.y), bfhi(kw.y)}; kr[2 * x + 1] = (f32x4){bflo(kw.z), bfhi(kw.z), bflo(kw.w), bfhi(kw.w)};
                    vr[2 * x] = (f32x4){bflo(vw.x), bfhi(vw.x), bflo(vw.y), bfhi(vw.y)}; vr[2 * x + 1] = (f32x4){bflo(vw.z), bfhi(vw.z), bflo(vw.w), bfhi(vw.w)}; } }
            else if (p >= 0) { const int page = pt[s * NPAGES + p / PAGE]; const size_t off = ((((size_t)l * NPOOL + page) * PAGE + p % PAGE) * SBH + h) * 64;
#pragma unroll
                for (int x = 0; x < 16; ++x) { kr[x] = ((const f32x4*)(A.in[I_CK] + off))[x]; vr[x] = ((const f32x4*)(A.in[I_CV] + off))[x]; } }
            else {
#pragma unroll
                for (int x = 0; x < 16; ++x) { kr[x] = (f32x4){0.f, 0.f, 0.f, 0.f}; vr[x] = (f32x4){0.f, 0.f, 0.f, 0.f}; } }
#pragma unroll
            for (int x = 0; x < 16; ++x) *(LAS f32x4*)(vt + lane * 68 + 4 * x) = vr[x];
#pragma unroll
            for (int qi = 0; qi < 4; ++qi) { float z = 0.f;
#pragma unroll
                for (int x = 0; x < 16; ++x) { const f32x4 qv = *(const LAS f32x4*)(qs + qi * 64 + 4 * x); z += (kr[x][0] * qv[0] + kr[x][1] * qv[1]) + (kr[x][2] * qv[2] + kr[x][3] * qv[3]); }
                float ls, ln; sb_terms(z, ls, ln);
                const bool valid = p >= 0 && p < PAST + qi; const float lnv = valid ? ln : 0.f;
                float incl = lnv;
#pragma unroll
                for (int o = 1; o < 64; o <<= 1) { const float t = __shfl_up(incl, o); if (lane >= o) incl += t; }
                wq[qi * 64 + lane] = valid ? __expf(ls + R[qi] + (incl - lnv)) : 0.f;
                R[qi] += __shfl(incl, 63); }
            WAVE_SYNC();
#pragma unroll 8
            for (int key = 0; key < 64; ++key) acc += *(const LAS f32x4*)(vt + key * 68 + 4 * ds) * wq[qi_b * 64 + key];
            WAVE_SYNC();
            if (R[0] < SB_CUT && R[1] < SB_CUT && R[2] < SB_CUT && R[3] < SB_CUT) break;
        }
        v2u o; o.x = pk2(acc[0], acc[1]); o.y = pk2(acc[2], acc[3]);
        *(v2u*)(wsb(A, WS_Y) + ((size_t)MP + s * DEC_SEQ + qi_b) * D + 768 + h * 64 + ds * 4) = o;
    }
}
constexpr int PH_PER_LAYER = 12, NPHASE = 2 + PH_PER_LAYER * DEPTH;
#ifndef DUP_MASK
#define DUP_MASK 0
#endif
#if DUP_MASK
__device__ __forceinline__ int rep_n(int k) { int n = ((DUP_MASK >> k) & 1) ? 2 : 1; asm volatile("" : "+s"(n)); return n; }
#define REP(k) _Pragma("nounroll") for (int rep_ = 0, repn_ = rep_n(k); rep_ < repn_; ++rep_)
#else
#define REP(k)
#endif
#ifndef TIME_SUB
#define TIME_SUB 0
#endif
#ifndef TIME_MASK
#define TIME_MASK 0
#endif
#ifndef MK_N_LAUNCHES
#define MK_N_LAUNCHES 1
#endif
__global__ void __launch_bounds__(NWAVES * 64, 2) fwd_kernel(Args A) {
#ifndef CPU_EMU
    extern __shared__ __attribute__((aligned(16))) unsigned char lds_raw[];
    LAS unsigned char* lds = (LAS unsigned char*)lds_raw;
    volatile LAS unsigned* MISC = (volatile LAS unsigned*)(lds + MISC_OFF);
    for (int u = threadIdx.x; u < (LDS_BYTES - MISC_OFF) / 4; u += NWAVES * 64) ((LAS unsigned*)(lds + MISC_OFF))[u] = 0u;
    __syncthreads();
    XcdBarrier bar; bar.bar = (unsigned*)(A.ws + WS_CTL) + CW_BAR + A.li * XCD_BAR_WORDS; bar.x = 0; bar.st = nullptr;
    if (A.ph_hi - A.ph_lo > 1) bar = xcd_barrier_post((unsigned*)(A.ws + WS_CTL) + CW_BAR + A.li * XCD_BAR_WORDS, MISC + 8);
#else
    unsigned char* lds = emu::B->lds; XcdBarrier bar{0};
#endif
    const int lo = A.ph_lo, hi = A.ph_hi, G = gridDim.x, bid = blockIdx.x;
#define IN(k) (lo <= (k) && (k) < hi)
#if TIME_MASK || TIME_SUB
    unsigned long long tp_ = __builtin_amdgcn_s_memrealtime(), tacc_ = 0;
#define SEAM(k) do { if (IN((k) + 1)) xcd_barrier(bar); { const unsigned long long tn_ = __builtin_amdgcn_s_memrealtime(); if ((TIME_MASK >> (k)) & 1) tacc_ += tn_ - tp_; tp_ = tn_; } } while (0)
#else
#define SEAM(k) do { if (IN((k) + 1)) xcd_barrier(bar); } while (0)
#endif
    if (IN(0)) { REP(9) ph_prologue(A, lds); SEAM(0); }
    if (IN(1)) {
        pg8::Gemm g{wsb(A, WS_CSILU), (const bf16*)(A.ws + WS_W + WL_ADA), D, D}; ModOrder S{G, bid}; EpiMod2 E{wsf(A, WS_MOD), A.in[I_BADA]};
        pg8::gemm_phase<EpiMod2, ModOrder, true, true>(lds, g, S, E); SEAM(1);
    }
    for (int l = 0; l < DEPTH; ++l) {
        const int pb = 2 + PH_PER_LAYER * l;
        unsigned char* wl = A.ws + WS_W + (size_t)l * WL_SIZE;
        if (IN(pb + 0)) { if (l == 0) ph_rows<0>(A, 0); SEAM(pb + 0); }
        if (IN(pb + 1)) {
            pg8::Gemm g{wsb(A, WS_H), (const bf16*)(wl + WL_W1), D, D}; pg8::GridOrder S; S.init(M / 256, N1 / 256, G, bid);
            pg8::EpiProj E{wsb(A, WS_PROJ), wsb(A, WS_GATE), A.out + O_KP + (size_t)l * MP * 256, A.out + O_VP + (size_t)l * MP * 256, A.out + O_KS + (size_t)l * MS * 256, A.out + O_VS + (size_t)l * MS * 256};
            REP(5) pg8::gemm_phase<pg8::EpiProj, pg8::GridOrder, true, true>(lds, g, S, E); SEAM(pb + 1);
        }
        if (IN(pb + 2)) {
#if TIME_SUB
#define SUBT(k, call) do { const unsigned long long ts_ = __builtin_amdgcn_s_memrealtime(); call; if ((TIME_SUB >> (k)) & 1) tacc_ += __builtin_amdgcn_s_memrealtime() - ts_; } while (0)
#else
#define SUBT(k, call) do { call; } while (0)
#endif
            SUBT(0, REP(3) ph_gdn_c1(A, lds, l)); SUBT(1, REP(2) ph_sb_prompt(A, lds, l)); __syncthreads(); SUBT(2, REP(10) ph_gdn_sample(A, lds, l)); SUBT(3, REP(1) ph_sb_sample(A, lds, l));
            SUBT(4, REP(4) ph_ssm1(A, l)); SUBT(5, REP(10) ph_conv(A, l)); SUBT(6, SEAM(pb + 2)); }
        if (IN(pb + 3)) { REP(0) ph_gdn_scan(A, l); REP(10) ph_ssm_carry(A, l); SEAM(pb + 3); }
        if (IN(pb + 4)) { REP(4) ph_ssm2(A, lds, l); REP(10) ph_gdn_out(A, l); SEAM(pb + 4); }
        if (IN(pb + 5)) {
            pg8::Gemm g{wsb(A, WS_YS), (const bf16*)(wl + WL_GLU), 256, 256}; pg8::GridOrder S; S.init(M / 256, 1, G, bid);
            pg8::EpiGlu E{wsb(A, WS_YS), wsb(A, WS_Y)};
            REP(8) pg8::gemm_phase<pg8::EpiGlu, pg8::GridOrder, true, true>(lds, g, S, E); SEAM(pb + 5);
        }
        if (IN(pb + 6)) {
            pg8::Gemm g{wsb(A, WS_Y), (const bf16*)(wl + WL_BR), D, 256}; pg8::MergeOrder S; S.init(M / 256, 8, G, bid);
            pg8::EpiMerge E; E.gate = wsb(A, WS_GATE); E.mgb = wsb(A, WS_MERGEB);
            REP(6) pg8::gemm_phase<pg8::EpiMerge, pg8::MergeOrder, true, true, true>(lds, g, S, E); SEAM(pb + 6);
        }
        if (IN(pb + 7)) {
            pg8::Gemm g{wsb(A, WS_MERGEB), (const bf16*)(wl + WL_WO), D, D}; pg8::GridOrder S; S.init(M / 256, 4, G, bid);
            pg8::EpiRes E{l == 0 ? A.in[I_XP] : wsf(A, WS_X2), l == 0 ? A.in[I_XS] : wsf(A, WS_X2) + (size_t)MP * D, wsf(A, WS_MOD) + (size_t)l * 256 * NMOD + 2 * D, wsf(A, WS_X1)};
            REP(8) pg8::gemm_phase<pg8::EpiRes, pg8::GridOrder, true, true>(lds, g, S, E); SEAM(pb + 7);
        }
        if (IN(pb + 8)) { ph_rows<1>(A, l); SEAM(pb + 8); }
        if (IN(pb + 9)) {
            pg8::Gemm g{wsb(A, WS_H), (const bf16*)(wl + WL_UP), D, D}; pg8::GridOrder S; S.init(M / 256, NUP / 256, G, bid);
            pg8::EpiUp E{wsb(A, WS_ACT)};
            REP(7) pg8::gemm_phase<pg8::EpiUp, pg8::GridOrder, true, true>(lds, g, S, E); SEAM(pb + 9);
        }
        if (IN(pb + 10)) {
            pg8::Gemm g{wsb(A, WS_ACT), (const bf16*)(wl + WL_DN), DFF, DFF}; pg8::GridOrder S; S.init(M / 256, 4, G, bid);
            pg8::EpiRes E{wsf(A, WS_X1), wsf(A, WS_X1) + (size_t)MP * D, wsf(A, WS_MOD) + (size_t)l * 256 * NMOD + 5 * D, wsf(A, WS_X2)};
            REP(7) pg8::gemm_phase<pg8::EpiRes, pg8::GridOrder, true, true>(lds, g, S, E); SEAM(pb + 10);
        }
        if (IN(pb + 11)) { ph_rows<2>(A, l); SEAM(pb + 11); }
    }
#if TIME_MASK || TIME_SUB
    if (blockIdx.x == 0 && threadIdx.x == 0) { const unsigned long long t0_ = __builtin_amdgcn_s_memrealtime(); while (__builtin_amdgcn_s_memrealtime() - t0_ < 4 * tacc_) __builtin_amdgcn_s_sleep(8); }
#endif
#undef IN
#undef SEAM
}
#ifndef CPU_EMU
extern "C" void kernel_launch(void* const* d_in, const int* in_sizes, int n_in, void* d_out, int out_size, void* d_ws, size_t ws_size, hipStream_t stream) {
    static int grid = 0;
    if (grid == 0) {
        if (n_in != 38 || (size_t)out_size != O_END || ws_size < WS_END) { fprintf(stderr, "kernel_launch: unexpected shapes (n_in %d out %d ws %zu; want 38, %zu, >= %zu)\n", n_in, out_size, ws_size, (size_t)O_END, (size_t)WS_END); grid = -1; return; }
        int dev = 0, cus = 0, per_cu = 0;
        if (hipGetDevice(&dev) != hipSuccess || hipDeviceGetAttribute(&cus, hipDeviceAttributeMultiprocessorCount, dev) != hipSuccess) { grid = -1; return; }
        if (hipFuncSetAttribute((const void*)fwd_kernel, hipFuncAttributeMaxDynamicSharedMemorySize, LDS_BYTES) != hipSuccess) { fprintf(stderr, "kernel_launch: hipFuncSetAttribute failed\n"); grid = -1; return; }
        if (hipOccupancyMaxActiveBlocksPerMultiprocessor(&per_cu, (const void*)fwd_kernel, NWAVES * 64, LDS_BYTES) != hipSuccess || per_cu < 1) { fprintf(stderr, "kernel_launch: occupancy query says %d\n", per_cu); }
        (void)hipGetLastError();
        grid = cus;
    }
    if (grid < 0) return;
    if (hipMemsetAsync((char*)d_ws + WS_CTL, 0, CTL_ZERO_BYTES, stream) != hipSuccess) return;
    Args a{};
    for (int i = 0; i < 38; ++i) a.in[i] = (const float*)d_in[i];
    a.out = (float*)d_out; a.ws = (unsigned char*)d_ws;
    if (MK_N_LAUNCHES == 1) { a.ph_lo = 0; a.ph_hi = NPHASE; a.li = 0; hipLaunchKernelGGL(fwd_kernel, dim3(grid), dim3(NWAVES * 64), LDS_BYTES, stream, a); }
    else for (int p = 0; p < NPHASE; ++p) { if (p == 2 + PH_PER_LAYER) continue; a.ph_lo = p; a.ph_hi = p + 1; a.li = 0; hipLaunchKernelGGL(fwd_kernel, dim3(grid), dim3(NWAVES * 64), LDS_BYTES, stream, a); }
}
#endif
```

```cpp
#ifndef CPU_EMU
#include <hip/hip_runtime.h>
#endif
#include <cstdio>
#include <cstdint>
#include <cmath>

constexpr int D = 1024, NB = 2, DEPTH = 2, DEC_SEQ = 4, PAGE = 128;
#ifdef CPU_EMU
#ifndef EMU_SEQ
#define EMU_SEQ 512
#endif
#ifndef EMU_DB
#define EMU_DB 64
#endif
#ifndef EMU_PAST
#define EMU_PAST 512
#endif
constexpr int SEQ = EMU_SEQ, DB = EMU_DB, PAST = EMU_PAST;
#else
constexpr int SEQ = 8192, DB = 128, PAST = 2048;
#endif
constexpr int NPAGES = PAST / PAGE, NUSED = DB * NPAGES, NPOOL = NUSED + (NUSED / 4 > 1 ? NUSED / 4 : 1);
constexpr int MP = NB * SEQ, MS = DB * DEC_SEQ, M = MP + MS, NSEQ = NB + DB;
constexpr int WMIX = 256, NPROJ = 2816, NIN = 2824, NGATE = 4096, N1 = NPROJ + NGATE, DFF = 2816, NUP = 2 * DFF, NMOD = 6 * D;
constexpr int SSM_G = 16, SSM_P = 64, SSM_CH = 128, SSM_NCH = SEQ / SSM_CH;
constexpr int GH = 4, GDK = 64, GCH = 64, GNCH = SEQ / GCH, GQKV = 768;
constexpr int SBH = 4;
constexpr int PC_U = 0, PC_BG = 256, PC_CG = 512, PC_XC = 768, PC_QKV = 1024, PC_Z = 1792, PC_Q = 2048, PC_K = 2304, PC_V = 2560;
constexpr float LN_EPS = 1e-5f, RMS_EPS = 1e-6f, ALPHA = 1.41421356237309515f  ;
static_assert(M % 256 == 0 && MP % 256 == 0 && SEQ % 256 == 0 && NSEQ <= 256, "tile shapes");
constexpr size_t O_Y = 0, O_KP = (size_t)M * D, O_VP = O_KP + (size_t)DEPTH * MP * 256, O_KS = O_VP + (size_t)DEPTH * MP * 256, O_VS = O_KS + (size_t)DEPTH * MS * 256,
    O_REP = O_VS + (size_t)DEPTH * MS * 256, O_IMP = O_REP + DEPTH * NB * 1024, O_RES = O_IMP + DEPTH * NB * 1024, O_IMS = O_RES + (size_t)DEPTH * DB * 1024,
    O_CBP = O_IMS + (size_t)DEPTH * DB * 1024, O_CBS = O_CBP + DEPTH * NB * 512, O_DP = O_CBS + (size_t)DEPTH * DB * 512, O_DS = O_DP + (size_t)DEPTH * NB * 16384,
    O_CDP = O_DS + (size_t)DEPTH * DB * 16384, O_CDS = O_CDP + DEPTH * NB * 2304, O_END = O_CDS + (size_t)DEPTH * DB * 2304;

constexpr size_t MiB = 1u << 20;
constexpr size_t al(size_t x) { return (x + 4095) & ~(size_t)4095; }
constexpr size_t WS_CTL = 0, CTL_ZERO_BYTES = 1 * MiB;
constexpr size_t WL_ADA = 0, WL_W1 = WL_ADA + (size_t)NMOD * D * 2, WL_GLU = WL_W1 + (size_t)N1 * D * 2, WL_BR = WL_GLU + 256 * 256 * 2, WL_WO = WL_BR + (size_t)4 * D * 256 * 2,
    WL_UP = WL_WO + (size_t)D * D * 2, WL_DN = WL_UP + (size_t)NUP * D * 2, WL_LOG = WL_DN + (size_t)D * DFF * 2, WL_SIZE = (WL_LOG + 8 * D * 4 + 524287) & ~(size_t)524287;
constexpr size_t WS_W = 1 * MiB, WS_CSILU = WS_W + DEPTH * WL_SIZE, WS_MOD = WS_CSILU + 256 * D * 2, WS_H = WS_MOD + (size_t)DEPTH * 256 * NMOD * 4,
    WS_PROJ = WS_H + (size_t)M * D * 2, WS_GATE = al(WS_PROJ + (size_t)M * NPROJ * 2), WS_LOG8 = WS_GATE + (size_t)M * NGATE * 2, WS_Y = WS_LOG8 + (size_t)M * 8 * 4,
    WS_YS = WS_Y + (size_t)M * D * 2, WS_MERGE = WS_YS + (size_t)M * 256 * 2, WS_MERGEB = WS_MERGE + (size_t)M * D * 4, WS_X1 = WS_MERGEB + (size_t)M * D * 2,
    WS_ACT = WS_X1 + (size_t)M * D * 4, WS_X2 = al(WS_ACT + (size_t)M * DFF * 2), WS_SEND = WS_X2 + (size_t)M * D * 4, WS_HIN = WS_SEND + (size_t)NB * 16 * SSM_NCH * 128 * 4,
    WS_GD = WS_HIN + (size_t)NB * 16 * SSM_NCH * 128 * 4, WS_EGL = WS_GD + (size_t)NB * GH * GNCH * 49152, WS_ODRAW = al(WS_EGL + (size_t)NB * GH * GNCH * 4),
    WS_END = WS_ODRAW + (size_t)M * 256 * 4;
constexpr int CW_TMO = 0, CW_BAR = 4096;
constexpr size_t GD_UNIT = 49152;

#define LAS_HW __attribute__((address_space(3)))
#ifdef CPU_EMU
#define LAS
#else
#define LAS LAS_HW
#endif
typedef unsigned short bf16;
typedef unsigned v4u __attribute__((ext_vector_type(4)));
typedef unsigned v2u __attribute__((ext_vector_type(2)));
typedef float f32x4 __attribute__((ext_vector_type(4)));
typedef float f32x2 __attribute__((ext_vector_type(2)));
typedef short bf16x8 __attribute__((ext_vector_type(8)));
#ifdef CPU_EMU
#define LDS_WAIT() do {} while (0)
#define VM_WAIT() do {} while (0)
#define WAVE_SYNC() emu::wave_sync()
#define CFENCE() do {} while (0)
#else
#define LDS_WAIT() asm volatile("s_waitcnt lgkmcnt(0)" ::: "memory")
#define VM_WAIT() asm volatile("s_waitcnt vmcnt(0)" ::: "memory")
#define WAVE_SYNC() do { asm volatile("s_waitcnt lgkmcnt(0)" ::: "memory"); __builtin_amdgcn_wave_barrier(); } while (0)
#define CFENCE() asm volatile("" ::: "memory")
#endif
#ifdef CPU_EMU
#define OPAQUE_V(x) do {} while (0)
#else
#define OPAQUE_V(x) asm volatile("" : "+v"(x))
#endif
__device__ __forceinline__ unsigned f2bf(float f) { unsigned u = __builtin_bit_cast(unsigned, f); return (u + 0x7fffu + ((u >> 16) & 1u)) >> 16; }
__device__ __forceinline__ unsigned pk2(float lo, float hi) { return f2bf(lo) | (f2bf(hi) << 16); }
__device__ __forceinline__ float bf2f(unsigned b) { return __builtin_bit_cast(float, b << 16); }
__device__ __forceinline__ float bflo(unsigned w) { return __builtin_bit_cast(float, w << 16); }
__device__ __forceinline__ float bfhi(unsigned w) { return __builtin_bit_cast(float, w & 0xffff0000u); }
__device__ __forceinline__ float sigmoidf_(float x) { return 1.0f / (1.0f + __expf(-x)); }
__device__ __forceinline__ float siluf_(float x) { return x / (1.0f + __expf(-x)); }
__device__ __forceinline__ float wave_sum(float v) {
#pragma unroll
    for (int o = 1; o < 64; o <<= 1) v += __shfl_xor(v, o);
    return v;
}
__device__ __forceinline__ int seq_of(int m) { return m < MP ? m / SEQ : NB + (m - MP) / DEC_SEQ; }
namespace pg8 {
typedef unsigned short bf16_t;
constexpr int BM = 256, BK = 64, HALF = 128, HTB = HALF * BK * 2, STAGE_BYTES = 8 * HTB, NXCD = 8, WGM = 8;
__host__ __device__ __forceinline__ int lds_byte(int r, int c) { const int st = (r >> 4) * 2 + (c >> 5), rr = r & 15, cc = c & 31, ob = rr * 64 + cc * 2; return st * 1024 + (ob ^ (((ob >> 9) & 1) << 5)); }
__host__ __device__ __forceinline__ void stage_rc(int b, int& R, int& C) { const int st = b / 1024, sb = b % 1024, swz = sb ^ (((sb >> 9) & 1) << 5); R = (st >> 1) * 16 + swz / 64; C = (st & 1) * 32 + (swz % 64) / 2; }
__host__ __device__ __forceinline__ int perm32(int rho) { const int n = rho >> 4, i = rho & 15; return 8 * (i >> 2) + 4 * n + (i & 3); }
struct Unit { int pm, pn, ka, aux; };
struct NoState {};
struct Gemm { const bf16_t* A; const bf16_t* Bt; int lda, K; };
struct GridOrder {
    int nM, nN, nwg, G, c, pn0;
    __host__ __device__ void init(int nM_, int nN_, int G_, int c_, int pn0_ = 0) { nM = nM_; nN = nN_; nwg = nM * nN; G = G_; c = c_; pn0 = pn0_; }
    __host__ __device__ bool tile(long L, int& pm, int& pn) const {
        if (L >= nwg) return false;
        int wgid = (int)L; { const int q = nwg / NXCD, r = nwg % NXCD, xcd = wgid % NXCD, off = wgid / NXCD; wgid = (xcd < r ? xcd * (q + 1) : r * (q + 1) + (xcd - r) * q) + off; }
        const int nig = WGM * nN, gid = wgid / nig, fm = gid * WGM, gsz = (nM - fm) < WGM ? (nM - fm) : WGM;
        pm = fm + ((wgid % nig) % gsz); pn = (wgid % nig) / gsz; return true;
    }
    __host__ __device__ bool next(int i, Unit& u) const { int pm, pn; if (!tile((long)i * G + c, pm, pn)) return false; u.pm = pm; u.pn = pn0 + pn; u.ka = 0; u.aux = pn; return true; }
    __device__ __forceinline__ void a_ready(const Unit&) const {}
    __device__ __forceinline__ void done(const Unit&) const {}
};
struct MergeOrder : GridOrder {
    __host__ __device__ bool next(int i, Unit& u) const { int pm, pc; if (!tile((long)(i >> 2) * G + c, pm, pc)) return false; const int n = i & 3; u.pm = pm; u.pn = 8 * n + pc; u.ka = 256 * n; u.aux = (n << 8) | pc; return true; }
};
#ifndef CPU_EMU
#define PG8_LAS __attribute__((address_space(3)))
template <class Epi, class Sched, bool ALIGN_EPI = false, bool SP2 = false, bool HALFN = false>
__device__ __forceinline__ void gemm_phase(PG8_LAS unsigned char* lds, const Gemm g, const Sched& S, const Epi& E) {
    int tid = threadIdx.x; asm volatile("" : "+v"(tid));
    const int wid = __builtin_amdgcn_readfirstlane(tid >> 6), lane = tid & 63, wr = wid >> 2, wc = wid & 3, fr = lane & 15, fq = lane >> 4;
    int K = g.K; asm volatile("" : "+s"(K));
    const int nt = K / BK, lda = g.lda;
    unsigned voffA[2], voffB[2];
#pragma unroll
    for (int i = 0; i < 2; ++i) { int R, C; stage_rc(tid * 16 + i * 8192, R, C); const int Rb = Epi::PERM ? ((R & ~31) + perm32(R & 31)) : R;
        voffA[i] = (unsigned)(R * lda + C) * 2u; voffB[i] = (unsigned)(Rb * K + C) * 2u; }
    const size_t kstep = (size_t)(BK * 2);
    const size_t hstepA = (size_t)HALF * lda * 2, hstepB = HALFN ? (size_t)0 : (size_t)HALF * K * 2;
    const size_t tstepA = 2 * hstepA, tstepB = HALFN ? (size_t)HALF * K * 2 : 2 * hstepB;
    const unsigned ldsw = (unsigned)wid * 1024u;
    const int aoff = lds_byte(wr * 64 + fr, fq * 8), boff = lds_byte(wc * 32 + fr, fq * 8);
#define PG8_SA(b, h) (((b) * 2 + (h)) * HTB)
#define PG8_SB(b, h) ((4 + (b) * 2 + (h)) * HTB)
#define PG8_STAGE(bufoff, gbase, voff) do { _Pragma("unroll") for (int _i = 0; _i < 2; ++_i) \
        __builtin_amdgcn_global_load_lds((const unsigned*)((const char*)(gbase) + (voff)[_i]), (PG8_LAS unsigned*)(lds + (bufoff) + ldsw + _i * 8192), 16, 0, 0); } while (0)
#define PG8_LDA(dst, b, h) do { _Pragma("unroll") for (int m = 0; m < 4; ++m) _Pragma("unroll") for (int k = 0; k < 2; ++k) dst[m][k] = *(const PG8_LAS bf16x8*)(lds + PG8_SA(b, h) + aoff + m * 2048 + k * 1024); } while (0)
#define PG8_LDB(dst, b, h) do { _Pragma("unroll") for (int n = 0; n < 2; ++n) _Pragma("unroll") for (int k = 0; k < 2; ++k) dst[n][k] = *(const PG8_LAS bf16x8*)(lds + PG8_SB(b, h) + boff + n * 2048 + k * 1024); } while (0)
#define PG8_MMA(ai, bj, At, Bt) do { __builtin_amdgcn_s_setprio(1); _Pragma("unroll") for (int m = 0; m < 4; ++m) _Pragma("unroll") for (int n = 0; n < 2; ++n) _Pragma("unroll") for (int k = 0; k < 2; ++k) \
        acc[ai][bj][m][n] = __builtin_amdgcn_mfma_f32_16x16x32_bf16(Bt[n][k], At[m][k], acc[ai][bj][m][n], 0, 0, 0); __builtin_amdgcn_s_setprio(0); } while (0)
#define PG8_WAIT_V(n) asm volatile("s_waitcnt vmcnt(" #n ")" ::: "memory")
#define PG8_WAIT_L(n) asm volatile("s_waitcnt lgkmcnt(" #n ")" ::: "memory")
#define PG8_BAR __builtin_amdgcn_s_barrier()
#define PG8_SCHED __builtin_amdgcn_sched_barrier(0)
    Unit cur, nxt; int ui = 0;
    if (!S.next(0, cur)) return;
    f32x4 acc[2][2][4][2];
    typename Epi::State est;
#pragma unroll
    for (int a = 0; a < 2; ++a)
#pragma unroll
        for (int b = 0; b < 2; ++b)
#pragma unroll
            for (int m = 0; m < 4; ++m)
#pragma unroll
                for (int n = 0; n < 2; ++n) acc[a][b][m][n] = (f32x4){0.f, 0.f, 0.f, 0.f};
    static_assert(!HALFN || SP2, "HALFN is written for the SP2 loop");
    bf16x8 At[4][2], B0[2][2], B1[2][2];
    const char* cA = (const char*)g.A + (size_t)cur.pm * tstepA + (size_t)cur.ka * 2; const char* cB = (const char*)g.Bt + (size_t)cur.pn * tstepB;
    S.a_ready(cur);
    if constexpr (SP2) {
        PG8_STAGE(PG8_SB(0, 0), cB, voffB); PG8_STAGE(PG8_SB(0, 1), cB + hstepB, voffB); PG8_STAGE(PG8_SA(0, 0), cA, voffA); PG8_STAGE(PG8_SA(0, 1), cA + hstepA, voffA);
        if (wr == 1) PG8_BAR;
        PG8_WAIT_V(2); PG8_BAR;
        PG8_STAGE(PG8_SB(1, 0), cB + kstep, voffB); PG8_STAGE(PG8_SA(1, 0), cA + kstep, voffA); PG8_STAGE(PG8_SB(1, 1), cB + hstepB + kstep, voffB);
        PG8_WAIT_V(6); PG8_BAR;
    } else {
        PG8_STAGE(PG8_SB(0, 0), cB, voffB); PG8_STAGE(PG8_SA(0, 0), cA, voffA); PG8_STAGE(PG8_SB(0, 1), cB + hstepB, voffB); PG8_STAGE(PG8_SA(0, 1), cA + hstepA, voffA);
        if (wr == 1) PG8_BAR;
        PG8_WAIT_V(4); PG8_BAR;
        PG8_STAGE(PG8_SB(1, 0), cB + kstep, voffB); PG8_STAGE(PG8_SA(1, 0), cA + kstep, voffA); PG8_STAGE(PG8_SB(1, 1), cB + hstepB + kstep, voffB);
        PG8_WAIT_V(6); PG8_BAR;
    }
    for (;;) {
        const bool has_next = S.next(ui + 1, nxt);
        const char* nA = has_next ? (const char*)g.A + (size_t)nxt.pm * tstepA + (size_t)nxt.ka * 2 : cA; const char* nB = has_next ? (const char*)g.Bt + (size_t)nxt.pn * tstepB : cB;
        for (int t = 0; t < nt; t += 2) {
            const bool last = (t == nt - 2);
            const char* a1 = cA + (size_t)(t + 1) * kstep;
            const char* a2 = last ? nA : cA + (size_t)(t + 2) * kstep; const char* b2 = last ? nB : cB + (size_t)(t + 2) * kstep;
            const char* a3 = a2 + kstep; const char* b3 = b2 + kstep;
            if (last && has_next) S.a_ready(nxt);
            if constexpr (SP2) {
            PG8_LDB(B0, 0, 0); if constexpr (!HALFN) PG8_LDB(B1, 0, 1); PG8_SCHED; PG8_LDA(At, 0, 0); PG8_STAGE(PG8_SA(1, 1), a1 + hstepA, voffA);
            PG8_WAIT_V(8); PG8_WAIT_L(0); PG8_BAR; PG8_MMA(0, 0, At, B0); if constexpr (!HALFN) PG8_MMA(0, 1, At, B1); PG8_BAR; PG8_SCHED;
            PG8_LDA(At, 0, 1); PG8_STAGE(PG8_SB(0, 0), b2, voffB); PG8_STAGE(PG8_SB(0, 1), b2 + hstepB, voffB); PG8_STAGE(PG8_SA(0, 0), a2, voffA);
            PG8_WAIT_V(8); PG8_WAIT_L(0); PG8_BAR; PG8_MMA(1, 0, At, B0); if constexpr (!HALFN) PG8_MMA(1, 1, At, B1); PG8_BAR; PG8_SCHED;
            PG8_LDB(B0, 1, 0); if constexpr (!HALFN) PG8_LDB(B1, 1, 1); PG8_SCHED; PG8_LDA(At, 1, 0); PG8_STAGE(PG8_SA(0, 1), a2 + hstepA, voffA);
            PG8_WAIT_V(8); PG8_WAIT_L(0); PG8_BAR; PG8_MMA(0, 0, At, B0); if constexpr (!HALFN) PG8_MMA(0, 1, At, B1); PG8_BAR; PG8_SCHED;
            PG8_LDA(At, 1, 1); PG8_STAGE(PG8_SB(1, 0), b3, voffB); PG8_STAGE(PG8_SB(1, 1), b3 + hstepB, voffB); PG8_STAGE(PG8_SA(1, 0), a3, voffA);
            PG8_WAIT_V(8); PG8_WAIT_L(0); PG8_BAR; PG8_MMA(1, 0, At, B0); if constexpr (!HALFN) PG8_MMA(1, 1, At, B1); PG8_BAR; PG8_SCHED;
            } else {
            PG8_LDB(B0, 0, 0); PG8_SCHED; PG8_LDA(At, 0, 0); PG8_STAGE(PG8_SA(1, 1), a1 + hstepA, voffA);
            PG8_WAIT_L(8); PG8_BAR; PG8_WAIT_L(0); PG8_MMA(0, 0, At, B0); PG8_BAR; PG8_SCHED;
            PG8_LDB(B1, 0, 1); PG8_STAGE(PG8_SB(0, 0), b2, voffB);
            PG8_BAR; PG8_WAIT_L(0); PG8_MMA(0, 1, At, B1); PG8_BAR;
            PG8_LDA(At, 0, 1); PG8_STAGE(PG8_SA(0, 0), a2, voffA);
            PG8_BAR; PG8_WAIT_L(0); PG8_MMA(1, 0, At, B0); PG8_BAR; PG8_SCHED;
            PG8_STAGE(PG8_SB(0, 1), b2 + hstepB, voffB);
            PG8_WAIT_V(6); PG8_BAR; PG8_MMA(1, 1, At, B1); PG8_BAR;
            PG8_LDB(B0, 1, 0); PG8_SCHED; PG8_LDA(At, 1, 0); PG8_STAGE(PG8_SA(0, 1), a2 + hstepA, voffA);
            PG8_WAIT_L(8); PG8_BAR; PG8_WAIT_L(0); PG8_MMA(0, 0, At, B0); PG8_BAR; PG8_SCHED;
            PG8_LDB(B1, 1, 1); PG8_STAGE(PG8_SB(1, 0), b3, voffB);
            PG8_BAR; PG8_WAIT_L(0); PG8_MMA(0, 1, At, B1); PG8_BAR;
            PG8_LDA(At, 1, 1); PG8_STAGE(PG8_SA(1, 0), a3, voffA);
            PG8_BAR; PG8_WAIT_L(0); PG8_MMA(1, 0, At, B0); PG8_BAR; PG8_SCHED;
            PG8_STAGE(PG8_SB(1, 1), b3 + hstepB, voffB);
            PG8_WAIT_V(6); PG8_BAR; PG8_MMA(1, 1, At, B1); PG8_BAR;
            }
        }
        if constexpr (ALIGN_EPI) { if (wr == 0) PG8_BAR; }
        E(acc, est, cur, wr, wc, fr, fq); S.done(cur);
        if (!has_next) break;
#pragma unroll
        for (int a = 0; a < 2; ++a)
#pragma unroll
            for (int b = 0; b < 2; ++b)
#pragma unroll
                for (int m = 0; m < 4; ++m)
#pragma unroll
                    for (int n = 0; n < 2; ++n) acc[a][b][m][n] = (f32x4){0.f, 0.f, 0.f, 0.f};
        cur = nxt; cA = nA; cB = nB; ++ui;
        if constexpr (ALIGN_EPI) { if (wr == 1) PG8_BAR; }
    }
    PG8_WAIT_V(0);
    if constexpr (!ALIGN_EPI) { if (wr == 0) PG8_BAR; }
    PG8_BAR;
#undef PG8_SA
#undef PG8_SB
#undef PG8_STAGE
#undef PG8_LDA
#undef PG8_LDB
#undef PG8_MMA
#undef PG8_WAIT_V
#undef PG8_WAIT_L
#undef PG8_BAR
#undef PG8_SCHED
}
#else
template <class Epi, class Sched, bool ALIGN_EPI = false, bool SP2 = false, bool HALFN = false>
void gemm_phase(unsigned char* lds, const Gemm g, const Sched& S, const Epi& E) {
    const int tid = threadIdx.x, wid = tid >> 6, lane = tid & 63, wr = wid >> 2, wc = wid & 3, fr = lane & 15, fq = lane >> 4;
    static thread_local float* Ct = nullptr; static thread_local float* Af = nullptr; static thread_local float* Bf = nullptr;
    Unit u; typename Epi::State est;
    for (int i = 0; S.next(i, u); ++i) {
        S.a_ready(u);
        __syncthreads();
        if (tid == 0) {
            if (!Ct) { Ct = new float[256 * 256]; Af = new float[256 * 4096]; Bf = new float[256 * 4096]; }
            const int K = g.K;
            for (int r = 0; r < 256; ++r) for (int k = 0; k < K; ++k) { Af[r * K + k] = bf2f(g.A[(size_t)(u.pm * 256 + r) * g.lda + u.ka + k]); Bf[r * K + k] = HALFN ? (r < 128 ? bf2f(g.Bt[(size_t)(u.pn * 128 + r) * K + k]) : 0.f) : bf2f(g.Bt[(size_t)(u.pn * 256 + r) * K + k]); }
            for (int r = 0; r < 256; ++r) for (int c = 0; c < 256; ++c) { float s = 0.f; const float* a = Af + r * K; const float* b = Bf + c * K; for (int k = 0; k < K; ++k) s += a[k] * b[k]; Ct[r * 256 + c] = s; }
        }
        __syncthreads();
        f32x4 acc[2][2][4][2];
        for (int ai = 0; ai < 2; ++ai) for (int bj = 0; bj < 2; ++bj) for (int m = 0; m < 4; ++m) for (int n = 0; n < 2; ++n) for (int e = 0; e < 4; ++e) {
            const int r = 128 * ai + 64 * wr + 16 * m + fr; const int c = Epi::PERM ? (128 * bj + 32 * wc + 8 * fq + 4 * n + e) : (128 * bj + 32 * wc + 16 * n + 4 * fq + e);
            acc[ai][bj][m][n][e] = Ct[r * 256 + c]; }
        E(acc, est, u, wr, wc, fr, fq); S.done(u);
    }
    __syncthreads();
}
#endif
}
namespace pg8 {
struct EpiMod {
    static constexpr bool PERM = false; typedef NoState State;
    float* C; const float* bias;
    __device__ __forceinline__ void operator()(const f32x4 (&acc)[2][2][4][2], State& st, const Unit& u, int wr, int wc, int fr_in, int fq_in) const {
        int fr = fr_in, fq = fq_in; OPAQUE_V(fr); OPAQUE_V(fq);
        const int row0 = wr * 64 + fr, col0 = u.aux * BM + wc * 32 + 4 * fq;
#pragma unroll
        for (int ai = 0; ai < 2; ++ai)
#pragma unroll
            for (int m = 0; m < 4; ++m) { float* rowp = C + (size_t)(row0 + ai * HALF + m * 16) * NMOD + col0;
#pragma unroll
                for (int bj = 0; bj < 2; ++bj)
#pragma unroll
                    for (int n = 0; n < 2; ++n) *(f32x4*)(rowp + bj * HALF + n * 16) = acc[ai][bj][m][n] + *(const f32x4*)(bias + col0 + bj * HALF + n * 16); }
    }
};
struct EpiProj {
    static constexpr bool PERM = true; typedef NoState State;
    bf16* proj; bf16* gate; float* outk_p; float* outv_p; float* outk_s; float* outv_s;
    __device__ __forceinline__ void operator()(const f32x4 (&acc)[2][2][4][2], State& st, const Unit& u, int wr, int wc, int fr_in, int fq_in) const {
        int fr = fr_in, fq = fq_in; OPAQUE_V(fr); OPAQUE_V(fq);
        const int t = u.aux; const bool isg = t >= 11;
        const int row0 = u.pm * BM + wr * 64 + fr, colt = wc * 32 + 8 * fq;
        bf16* base = isg ? gate + (size_t)(t - 11) * 256 : proj + (size_t)t * 256; const int ldc = isg ? NGATE : NPROJ;
#pragma unroll
        for (int ai = 0; ai < 2; ++ai)
#pragma unroll
            for (int m = 0; m < 4; ++m) { const int row = row0 + ai * HALF + m * 16; bf16* rowp = base + (size_t)row * ldc + colt;
#pragma unroll
                for (int bj = 0; bj < 2; ++bj) { f32x4 v0 = acc[ai][bj][m][0], v1 = acc[ai][bj][m][1];
                    if (isg) {
#pragma unroll
                        for (int e = 0; e < 4; ++e) { v0[e] = sigmoidf_(v0[e]); v1[e] = sigmoidf_(v1[e]); } }
                    else if (t >= 9) { float* o = (row < MP) ? ((t == 9 ? outk_p : outv_p) + (size_t)row * 256) : ((t == 9 ? outk_s : outv_s) + (size_t)(row - MP) * 256);
                        *(f32x4*)(o + colt + bj * HALF) = v0; *(f32x4*)(o + colt + bj * HALF + 4) = v1; }
                    v4u w; w.x = pk2(v0[0], v0[1]); w.y = pk2(v0[2], v0[3]); w.z = pk2(v1[0], v1[1]); w.w = pk2(v1[2], v1[3]);
                    *(v4u*)(rowp + bj * HALF) = w; } }
    }
};
struct EpiGlu {
    static constexpr bool PERM = true; typedef NoState State;
    const bf16* ys; bf16* y;
    __device__ __forceinline__ void operator()(const f32x4 (&acc)[2][2][4][2], State& st, const Unit& u, int wr, int wc, int fr_in, int fq_in) const {
        int fr = fr_in, fq = fq_in; OPAQUE_V(fr); OPAQUE_V(fq);
        const int row0 = u.pm * BM + wr * 64 + fr, colt = wc * 32 + 8 * fq;
#pragma unroll
        for (int ai = 0; ai < 2; ++ai)
#pragma unroll
            for (int m = 0; m < 4; ++m) { const int row = row0 + ai * HALF + m * 16;
#pragma unroll
                for (int bj = 0; bj < 2; ++bj) { const f32x4 v0 = acc[ai][bj][m][0], v1 = acc[ai][bj][m][1];
                    const v4u s = *(const v4u*)(ys + (size_t)row * 256 + colt + bj * HALF);
                    v4u w; w.x = pk2(bflo(s.x) * sigmoidf_(v0[0]), bfhi(s.x) * sigmoidf_(v0[1])); w.y = pk2(bflo(s.y) * sigmoidf_(v0[2]), bfhi(s.y) * sigmoidf_(v0[3]));
                    w.z = pk2(bflo(s.z) * sigmoidf_(v1[0]), bfhi(s.z) * sigmoidf_(v1[1])); w.w = pk2(bflo(s.w) * sigmoidf_(v1[2]), bfhi(s.w) * sigmoidf_(v1[3]));
                    *(v4u*)(y + (size_t)row * D + colt + bj * HALF) = w; } CFENCE(); }
    }
};
struct EpiMerge {
    static constexpr bool PERM = false; struct State { f32x4 macc[2][4][2]; };
    const bf16* gate; bf16* mgb;
    __device__ __forceinline__ void operator()(const f32x4 (&acc)[2][2][4][2], State& st, const Unit& u, int wr, int wc, int fr_in, int fq_in) const {
        int fr = fr_in, fq = fq_in; OPAQUE_V(fr); OPAQUE_V(fq);
        const int n_ = u.aux >> 8, pc = u.aux & 255;
        const int row0 = u.pm * BM + wr * 64 + fr, col0 = pc * HALF + wc * 32 + 4 * fq;
        v2u gw[2][4][2];
#pragma unroll
        for (int ai = 0; ai < 2; ++ai)
#pragma unroll
            for (int m = 0; m < 4; ++m)
#pragma unroll
                for (int n = 0; n < 2; ++n) gw[ai][m][n] = *(const v2u*)(gate + (size_t)(row0 + ai * HALF + m * 16) * NGATE + n_ * D + col0 + n * 16);
        CFENCE();
#pragma unroll
        for (int ai = 0; ai < 2; ++ai)
#pragma unroll
            for (int m = 0; m < 4; ++m) { const int row = row0 + ai * HALF + m * 16;
#pragma unroll
                for (int n = 0; n < 2; ++n) { const int col = col0 + n * 16; const v2u g2 = gw[ai][m][n];
                    f32x4 v = acc[ai][0][m][n]; v[0] *= bflo(g2.x); v[1] *= bfhi(g2.x); v[2] *= bflo(g2.y); v[3] *= bfhi(g2.y);
                    if (n_ > 0) v += st.macc[ai][m][n];
                    st.macc[ai][m][n] = v;
                    if (n_ == 3) { v2u o; o.x = pk2(v[0], v[1]); o.y = pk2(v[2], v[3]); *(v2u*)(mgb + (size_t)row * D + col) = o; } } }
    }
};
struct EpiRes {
    static constexpr bool PERM = false; typedef NoState State;
    const float* xP; const float* xS; const float* gmod; float* out;
    __device__ __forceinline__ void operator()(const f32x4 (&acc)[2][2][4][2], State& st, const Unit& u, int wr, int wc, int fr_in, int fq_in) const {
        int fr = fr_in, fq = fq_in; OPAQUE_V(fr); OPAQUE_V(fq);
        const int row0 = u.pm * BM + wr * 64 + fr, col0 = u.aux * BM + wc * 32 + 4 * fq;
#pragma unroll
        for (int ai = 0; ai < 2; ++ai)
#pragma unroll
            for (int m = 0; m < 4; ++m) { const int row = row0 + ai * HALF + m * 16; const float* xr = row < MP ? xP + (size_t)row * D : xS + (size_t)(row - MP) * D;
                const float* gr = gmod + (size_t)seq_of(row) * NMOD;
#pragma unroll
                for (int bj = 0; bj < 2; ++bj)
#pragma unroll
                    for (int n = 0; n < 2; ++n) { const int col = col0 + bj * HALF + n * 16;
                        const f32x4 xv = *(const f32x4*)(xr + col), gv = *(const f32x4*)(gr + col);
                        *(f32x4*)(out + (size_t)row * D + col) = xv * ALPHA + (gv + 1.0f) * acc[ai][bj][m][n]; } CFENCE(); }
    }
};
struct EpiUp {
    static constexpr bool PERM = true; typedef NoState State;
    bf16* act;
    __device__ __forceinline__ void operator()(const f32x4 (&acc)[2][2][4][2], State& st, const Unit& u, int wr, int wc, int fr_in, int fq_in) const {
        int fr = fr_in, fq = fq_in; OPAQUE_V(fr); OPAQUE_V(fq);
        const int row0 = u.pm * BM + wr * 64 + fr, col0 = u.aux * HALF + wc * 32 + 8 * fq;
#pragma unroll
        for (int ai = 0; ai < 2; ++ai)
#pragma unroll
            for (int m = 0; m < 4; ++m) { const int row = row0 + ai * HALF + m * 16;
                const f32x4 a0 = acc[ai][0][m][0], a1 = acc[ai][0][m][1], b0 = acc[ai][1][m][0], b1 = acc[ai][1][m][1];
                v4u w; w.x = pk2(siluf_(a0[0]) * b0[0], siluf_(a0[1]) * b0[1]); w.y = pk2(siluf_(a0[2]) * b0[2], siluf_(a0[3]) * b0[3]);
                w.z = pk2(siluf_(a1[0]) * b1[0], siluf_(a1[1]) * b1[1]); w.w = pk2(siluf_(a1[2]) * b1[2], siluf_(a1[3]) * b1[3]);
                *(v4u*)(act + (size_t)row * DFF + col0) = w; }
    }
};
}
struct Args { const float* in[38]; float* out; unsigned char* ws; int ph_lo, ph_hi, li, pad; };
enum { I_XP = 0, I_XS, I_CK, I_CV, I_SRE, I_SIM, I_SCB, I_SD, I_SCD, I_PT, I_CP, I_CS, I_WADA, I_BADA, I_WIN, I_ARE, I_AIM, I_LDT, I_BRE, I_BIM, I_CRE, I_CIM, I_SSD, I_WGLU,
       I_CBW, I_DCW, I_DAL, I_DDT, I_DNW, I_WBR, I_WGATE, I_WO, I_L1G, I_L1B, I_WUP, I_WDN, I_L2G, I_L2B };
constexpr int NWAVES = 8, RING_BYTES = 131072, MISC_OFF = RING_BYTES, LDS_BYTES = 147456;
#ifndef CPU_EMU
#define XB_TMO      128
#define XB_XCNT(j)  (256  + 64 * (j))
#define XB_XSUB(j)  (1280 + 64 * (j))
#define XB_XGEN(j)  (2304 + 64 * (j))
#define XB_TOP      3328
#define XB_TOPGEN   3392
#define XCD_BAR_WORDS 3456
#define XB_SPIN_CAP (1u << 18)
__device__ __forceinline__ unsigned xb_ld(unsigned* p)              { return __hip_atomic_load(p, __ATOMIC_RELAXED, __HIP_MEMORY_SCOPE_AGENT); }
__device__ __forceinline__ unsigned xb_add(unsigned* p, unsigned v) { return __hip_atomic_fetch_add(p, v, __ATOMIC_RELAXED, __HIP_MEMORY_SCOPE_AGENT); }
__device__ __forceinline__ unsigned xb_xcc_id() { return (unsigned)__builtin_amdgcn_s_getreg((3 << 11) | 20) & 0xFu; }
#define XB_SPIN(cond, bar) do { unsigned _sp = 0; while (cond) { __builtin_amdgcn_s_sleep(1); \
    if ((++_sp & 255u) == 0u) { if (xb_ld(&(bar)[XB_TMO])) break; if (_sp > XB_SPIN_CAP) { atomicAdd(&(bar)[XB_TMO], 1u); break; } } } } while (0)
struct XcdBarrier { unsigned* bar; unsigned x; volatile LAS_HW unsigned* st; };
__device__ __forceinline__ XcdBarrier xcd_barrier_post(unsigned* bar, volatile LAS_HW unsigned* st) {
    XcdBarrier b; b.bar = bar; b.x = xb_xcc_id(); b.st = st;
    if (threadIdx.x == 0) (void)xb_add(&bar[XB_XCNT(b.x)], 1u);
    return b;
}
__device__ __forceinline__ void xcd_barrier_complete(unsigned* bar, unsigned x, unsigned& nloc, unsigned& nx) {
    const unsigned G = gridDim.x * gridDim.y * gridDim.z;
    unsigned sum, cnt, mine, sp = 0u;
    for (;;) {
        sum = 0u; cnt = 0u; mine = 0u;
#pragma unroll
        for (unsigned j = 0; j < 16; ++j) { const unsigned c = xb_ld(&bar[XB_XCNT(j)]); sum += c; cnt += (c > 0u) ? 1u : 0u; mine = (j == x) ? c : mine; }
        if (sum == G) break;
        __builtin_amdgcn_s_sleep(1);
        if ((++sp & 255u) == 0u) { if (xb_ld(&bar[XB_TMO])) break; if (sp > XB_SPIN_CAP) { atomicAdd(&bar[XB_TMO], 1u); break; } }
    }
    nloc = mine > 0u ? mine : 1u; nx = cnt > 0u ? cnt : 1u;
}
__device__ __forceinline__ void xcd_barrier(const XcdBarrier& b) {
    asm volatile("s_waitcnt vmcnt(0)" ::: "memory");
    __syncthreads();
    if (threadIdx.x == 0) {
        unsigned* bar = b.bar;
        __builtin_amdgcn_s_waitcnt(0);
        unsigned nloc = b.st[0], nx = b.st[1];
        if (nloc == 0u) { xcd_barrier_complete(bar, b.x, nloc, nx); b.st[0] = nloc; b.st[1] = nx; }
        const unsigned old = xb_add(&bar[XB_XSUB(b.x)], 1u);
        const unsigned gen = old / nloc;
        if (old + 1u == (gen + 1u) * nloc) {
            __builtin_amdgcn_fence(__ATOMIC_RELEASE, "agent");
            asm volatile("s_waitcnt vmcnt(0)" ::: "memory");
            const unsigned og = xb_add(&bar[XB_TOP], 1u);
            const unsigned tg = og / nx;
            if (og + 1u == (tg + 1u) * nx) xb_add(&bar[XB_TOPGEN], 1u);
            else XB_SPIN(xb_ld(&bar[XB_TOPGEN]) == tg, bar);
            __builtin_amdgcn_fence(__ATOMIC_ACQUIRE, "agent");
            xb_add(&bar[XB_XGEN(b.x)], 1u);
            asm volatile("s_waitcnt vmcnt(0)" ::: "memory");
        } else {
            XB_SPIN(xb_ld(&bar[XB_XGEN(b.x)]) == gen, bar);
            __builtin_amdgcn_fence(__ATOMIC_ACQUIRE, "agent");
            asm volatile("s_waitcnt vmcnt(0)" ::: "memory");
        }
    }
    __syncthreads();
}
#else
#define XCD_BAR_WORDS 3456
struct XcdBarrier { int dummy; };
inline void xcd_barrier(const XcdBarrier&) { emu::grid_sync(); }
#endif

#define TIDS int tid_ = threadIdx.x; OPAQUE_V(tid_); const int tid = tid_, lane = tid & 63, wave = __builtin_amdgcn_readfirstlane(tid >> 6), G = gridDim.x, bid = blockIdx.x, gw = bid * NWAVES + wave, NGW = G * NWAVES; (void)lane; (void)wave; (void)gw; (void)NGW; (void)G; (void)bid
__device__ __forceinline__ bf16* wsb(const Args& A, size_t off) { return (bf16*)(A.ws + off); }
__device__ __forceinline__ float* wsf(const Args& A, size_t off) { return (float*)(A.ws + off); }
__device__ __forceinline__ float softplusf_(float x) { return fmaxf(x, 0.f) + log1pf(__expf(-fabsf(x))); }
__device__ __forceinline__ void tr_item(const float* W, int N, int K, int k0, int c0, bf16* WT, int drow0, LAS float* scr, int lane) {
#pragma unroll 8
    for (int i = 0; i < 32; ++i) { const int kk = 2 * i + (lane >> 5); scr[kk * 33 + (lane & 31)] = W[(size_t)(k0 + kk) * N + c0 + (lane & 31)]; }
    WAVE_SYNC();
    const int c = lane & 7;
#pragma unroll
    for (int j = 0; j < 4; ++j) { const int n = (lane >> 3) + 8 * j; const LAS float* s = scr + (8 * c) * 33 + n;
        v4u o; o.x = pk2(s[0 * 33], s[1 * 33]); o.y = pk2(s[2 * 33], s[3 * 33]); o.z = pk2(s[4 * 33], s[5 * 33]); o.w = pk2(s[6 * 33], s[7 * 33]);
        *(v4u*)(WT + (size_t)(drow0 + n) * K + k0 + 8 * c) = o; }
    WAVE_SYNC();
}
__device__ __forceinline__ void ph_prologue(const Args& A, LAS unsigned char* lds) {
    TIDS;
    LAS float* scr = (LAS float*)(lds + wave * 16384);
    constexpr int I_ADA = 16 * 192, I_IN1 = 16 * 64, I_IN2 = 16 * 24, I_GT = 16 * 128, I_GLU = 4 * 8, I_BR = 4 * 4 * 32, I_WO_ = 16 * 32, I_UP = 16 * 176, I_DN = 44 * 32;
    constexpr int PER_L = I_ADA + I_IN1 + I_IN2 + I_GT + I_GLU + I_BR + I_WO_ + I_UP + I_DN;
    for (int it = gw; it < DEPTH * PER_L; it += NGW) {
        const int l = it / PER_L; int r = it % PER_L; unsigned char* wl = A.ws + WS_W + (size_t)l * WL_SIZE;
        if (r < I_ADA) { const int kb = r / 192, nb = r % 192; tr_item(A.in[I_WADA] + (size_t)l * D * NMOD, NMOD, D, kb * 64, nb * 32, (bf16*)(wl + WL_ADA), nb * 32, scr, lane); continue; } r -= I_ADA;
        if (r < I_IN1) { const int kb = r / 64, nb = r % 64; tr_item(A.in[I_WIN] + (size_t)l * D * NIN, NIN, D, kb * 64, nb * 32, (bf16*)(wl + WL_W1), nb * 32, scr, lane); continue; } r -= I_IN1;
        if (r < I_IN2) { const int kb = r / 24, nb = r % 24; tr_item(A.in[I_WIN] + (size_t)l * D * NIN, NIN, D, kb * 64, 2056 + nb * 32, (bf16*)(wl + WL_W1), 2048 + nb * 32, scr, lane); continue; } r -= I_IN2;
        if (r < I_GT) { const int kb = r / 128, nb = r % 128; tr_item(A.in[I_WGATE] + (size_t)l * D * NGATE, NGATE, D, kb * 64, nb * 32, (bf16*)(wl + WL_W1), NPROJ + nb * 32, scr, lane); continue; } r -= I_GT;
        if (r < I_GLU) { const int kb = r / 8, nb = r % 8; tr_item(A.in[I_WGLU] + (size_t)l * 256 * 256, 256, 256, kb * 64, nb * 32, (bf16*)(wl + WL_GLU), nb * 32, scr, lane); continue; } r -= I_GLU;
        if (r < I_BR) { const int n = r / 128, r2 = r % 128, kb = r2 / 32, nb = r2 % 32; tr_item(A.in[I_WBR] + (size_t)(l * 4 + n) * 256 * D, D, 256, kb * 64, nb * 32, (bf16*)(wl + WL_BR), n * D + nb * 32, scr, lane); continue; } r -= I_BR;
        if (r < I_WO_) { const int kb = r / 32, nb = r % 32; tr_item(A.in[I_WO] + (size_t)l * D * D, D, D, kb * 64, nb * 32, (bf16*)(wl + WL_WO), nb * 32, scr, lane); continue; } r -= I_WO_;
        if (r < I_UP) { const int kb = r / 176, nb = r % 176; const int c0 = nb * 32, j = c0 < DFF ? c0 : c0 - DFF; const int drow = (j / 128) * 256 + (c0 < DFF ? 0 : 128) + (j % 128);
            tr_item(A.in[I_WUP] + (size_t)l * D * NUP, NUP, D, kb * 64, c0, (bf16*)(wl + WL_UP), drow, scr, lane); continue; } r -= I_UP;
        { const int kb = r / 32, nb = r % 32; tr_item(A.in[I_WDN] + (size_t)l * DFF * D, D, DFF, kb * 64, nb * 32, (bf16*)(wl + WL_DN), nb * 32, scr, lane); }
    }
    const int gt = bid * (NWAVES * 64) + tid, NGT = G * NWAVES * 64;
    for (int i = gt; i < DEPTH * 8 * D; i += NGT) { const int l = i / (8 * D), j = (i / D) % 8, k = i % D; ((float*)(A.ws + WS_W + (size_t)l * WL_SIZE + WL_LOG))[j * D + k] = A.in[I_WIN][((size_t)l * D + k) * NIN + 2048 + j]; }
    for (int i = gt; i < 256 * D; i += NGT) { const int r = i / D, k = i % D; float v = 0.f;
        if (r < NB) v = siluf_(A.in[I_CP][r * D + k]); else if (r < NSEQ) v = siluf_(A.in[I_CS][(r - NB) * D + k]);
        wsb(A, WS_CSILU)[i] = (bf16)f2bf(v); }
}
struct ModOrder {
    int G, c;
    __host__ __device__ bool next(int i, pg8::Unit& u) const { const int L = i * G + c; if (L >= 24 * DEPTH) return false; const int l = L / 24, pn = L % 24;
        u.pm = 0; u.pn = l * (int)(WL_SIZE / (512 * 1024)) + pn; u.ka = 0; u.aux = pn | (l << 8); return true; }
    __device__ __forceinline__ void a_ready(const pg8::Unit&) const {}
    __device__ __forceinline__ void done(const pg8::Unit&) const {}
};
struct EpiMod2 { static constexpr bool PERM = false; typedef pg8::NoState State; float* C; const float* bias;
    __device__ __forceinline__ void operator()(const f32x4 (&acc)[2][2][4][2], State& st, const pg8::Unit& u, int wr, int wc, int fr, int fq) const {
        const int l = u.aux >> 8; pg8::Unit u2 = u; u2.aux = u.aux & 255; pg8::EpiMod e{C + (size_t)l * 256 * NMOD, bias + (size_t)l * NMOD}; e(acc, st, u2, wr, wc, fr, fq); } };
template <int MODE> __device__ __forceinline__ void ph_rows(const Args& A, int l) {
    TIDS;
    const float* MOD = wsf(A, WS_MOD);
    for (int m = gw; m < M; m += NGW) {
        const float* src; float* dstx = nullptr;
        if (MODE == 0) src = m < MP ? A.in[I_XP] + (size_t)m * D : A.in[I_XS] + (size_t)(m - MP) * D;
        else if (MODE == 1) { src = wsf(A, WS_X1) + (size_t)m * D; dstx = wsf(A, WS_X1) + (size_t)m * D; }
        else { src = wsf(A, WS_X2) + (size_t)m * D; dstx = (l == DEPTH - 1) ? A.out + O_Y + (size_t)m * D : wsf(A, WS_X2) + (size_t)m * D; }
        f32x4 v[4];
#pragma unroll
        for (int j = 0; j < 4; ++j) v[j] = ((const f32x4*)src)[lane + 64 * j];
        if (MODE != 0) {
            float s = 0.f;
#pragma unroll
            for (int j = 0; j < 4; ++j) s += (v[j][0] + v[j][1]) + (v[j][2] + v[j][3]);
            const float mean = wave_sum(s) * (1.f / D); float s2 = 0.f;
#pragma unroll
            for (int j = 0; j < 4; ++j) { v[j] = v[j] - mean; s2 += (v[j][0] * v[j][0] + v[j][1] * v[j][1]) + (v[j][2] * v[j][2] + v[j][3] * v[j][3]); }
            const float rstd = 1.f / sqrtf(wave_sum(s2) * (1.f / D) + LN_EPS);
            const float* gp = A.in[MODE == 1 ? I_L1G : I_L2G] + (size_t)l * D; const float* bp = A.in[MODE == 1 ? I_L1B : I_L2B] + (size_t)l * D;
#pragma unroll
            for (int j = 0; j < 4; ++j) { const f32x4 g = ((const f32x4*)gp)[lane + 64 * j], b = ((const f32x4*)bp)[lane + 64 * j]; v[j] = v[j] * rstd * g + b; ((f32x4*)dstx)[lane + 64 * j] = v[j]; }
            if (MODE == 2 && l == DEPTH - 1) continue;
        }
        const int ln = (MODE == 2) ? l + 1 : l;
        const float* mr = MOD + ((size_t)ln * 256 + seq_of(m)) * NMOD + (MODE == 1 ? 3 * D : 0);
        float s = 0.f;
#pragma unroll
        for (int j = 0; j < 4; ++j) s += (v[j][0] + v[j][1]) + (v[j][2] + v[j][3]);
        const float mean = wave_sum(s) * (1.f / D); float s2 = 0.f;
#pragma unroll
        for (int j = 0; j < 4; ++j) { v[j] = v[j] - mean; s2 += (v[j][0] * v[j][0] + v[j][1] * v[j][1]) + (v[j][2] * v[j][2] + v[j][3] * v[j][3]); }
        const float rstd = 1.f / sqrtf(wave_sum(s2) * (1.f / D) + LN_EPS);
        v2u* hrow = (v2u*)(wsb(A, WS_H) + (size_t)m * D);
#pragma unroll
        for (int j = 0; j < 4; ++j) { const f32x4 sh = ((const f32x4*)mr)[lane + 64 * j], sc = ((const f32x4*)(mr + D))[lane + 64 * j]; v[j] = v[j] * rstd * (sc + 1.0f) + sh;
            v2u o; o.x = pk2(v[j][0], v[j][1]); o.y = pk2(v[j][2], v[j][3]); hrow[lane + 64 * j] = o; }
        if (MODE != 1) {
            const float* wl = (const float*)(A.ws + WS_W + (size_t)ln * WL_SIZE + WL_LOG);
            float lg[8];
#pragma unroll
            for (int jj = 0; jj < 8; ++jj) { float t = 0.f;
#pragma unroll
                for (int j = 0; j < 4; ++j) { const f32x4 w = ((const f32x4*)(wl + jj * D))[lane + 64 * j]; t += (v[j][0] * w[0] + v[j][1] * w[1]) + (v[j][2] * w[2] + v[j][3] * w[3]); }
                lg[jj] = wave_sum(t); }
            if (lane == 0) { float* o = wsf(A, WS_LOG8) + (size_t)m * 8; *(f32x4*)o = (f32x4){lg[0], lg[1], lg[2], lg[3]}; *(f32x4*)(o + 4) = (f32x4){lg[4], lg[5], lg[6], lg[7]}; }
        }
    }
}
struct SsmC { float abr, abi, bbr[16], bbi[16]; };
__device__ __forceinline__ void ssm_consts(const Args& A, int l, int g, int p, SsmC& c) {
    const int gi = l * 16 + g;
    const float dt = expf(A.in[I_LDT][gi]), ar = A.in[I_ARE][gi * 64 + p], ai = A.in[I_AIM][gi * 64 + p];
    const float mag = expf(dt * ar); c.abr = mag * cosf(dt * ai); c.abi = mag * sinf(dt * ai);
    const float den = ar * ar + ai * ai, fre = ((c.abr - 1.0f) * ar + c.abi * ai) / den, fim = (c.abi * ar - (c.abr - 1.0f) * ai) / den;
    const f32x4* br = (const f32x4*)(A.in[I_BRE] + (size_t)(gi * 64 + p) * 16); const f32x4* bi = (const f32x4*)(A.in[I_BIM] + (size_t)(gi * 64 + p) * 16);
#pragma unroll
    for (int q = 0; q < 4; ++q) { const f32x4 r = br[q], i = bi[q];
#pragma unroll
        for (int e = 0; e < 4; ++e) { c.bbr[4 * q + e] = fre * r[e] - fim * i[e]; c.bbi[4 * q + e] = fre * i[e] + fim * r[e]; } }
}
__device__ __forceinline__ void ssm_step(const SsmC& c, const bf16* urow, float& hr, float& hi) {
    const v4u u0 = *(const v4u*)urow, u1 = *(const v4u*)(urow + 8);
    float u[16] = {bflo(u0.x), bfhi(u0.x), bflo(u0.y), bfhi(u0.y), bflo(u0.z), bfhi(u0.z), bflo(u0.w), bfhi(u0.w), bflo(u1.x), bfhi(u1.x), bflo(u1.y), bfhi(u1.y), bflo(u1.z), bfhi(u1.z), bflo(u1.w), bfhi(u1.w)};
    float br = 0.f, bi = 0.f;
#pragma unroll
    for (int h = 0; h < 16; ++h) { br += c.bbr[h] * u[h]; bi += c.bbi[h] * u[h]; }
    const float nr = c.abr * hr - c.abi * hi + br, ni = c.abr * hi + c.abi * hr + bi; hr = nr; hi = ni;
}
__device__ __forceinline__ void ph_ssm1(const Args& A, int l) {
    TIDS;
    const bf16* proj = wsb(A, WS_PROJ);
    for (int un = gw; un < NB * 16 * SSM_NCH; un += NGW) {
        const int c = un % SSM_NCH, g = (un / SSM_NCH) % 16, b = un / (SSM_NCH * 16);
        SsmC k; ssm_consts(A, l, g, lane, k);
        float hr = 0.f, hi = 0.f;
        const bf16* up = proj + (size_t)(b * SEQ + c * SSM_CH) * NPROJ + PC_U + g * 16;
        for (int t = 0; t < SSM_CH; ++t) ssm_step(k, up + (size_t)t * NPROJ, hr, hi);
        float* o = wsf(A, WS_SEND) + (size_t)un * 128; o[lane] = hr; o[64 + lane] = hi;
    }
}
__device__ __forceinline__ void ph_ssm_carry(const Args& A, int l) {
    TIDS;
    const int gt = (G - 1 - bid) * (NWAVES * 64) + tid;
    if (gt < NB * 16 * 64) {
        const int p = gt & 63, g = (gt >> 6) & 15, b = gt >> 10; const int gi = l * 16 + g;
        const float dt = expf(A.in[I_LDT][gi]), ar = A.in[I_ARE][gi * 64 + p], ai = A.in[I_AIM][gi * 64 + p];
        const float mag = expf(dt * ar); float pr = mag * cosf(dt * ai), pi = mag * sinf(dt * ai);
        for (int s = 1; s < SSM_CH; s <<= 1) { const float nr = pr * pr - pi * pi, ni = 2.f * pr * pi; pr = nr; pi = ni; }
        float cr = 0.f, ci = 0.f;
        for (int c = 0; c < SSM_NCH; ++c) { const size_t un = ((size_t)(b * 16 + g) * SSM_NCH + c) * 128;
            wsf(A, WS_HIN)[un + p] = cr; wsf(A, WS_HIN)[un + 64 + p] = ci;
            const float sr = wsf(A, WS_SEND)[un + p], si = wsf(A, WS_SEND)[un + 64 + p];
            const float nr = pr * cr - pi * ci + sr, ni = pr * ci + pi * cr + si; cr = nr; ci = ni; }
    }
}
__device__ __forceinline__ float gelu_tanh(float x) { const float t = tanhf(0.7978845608028654f * (x + 0.044715f * x * x * x)); return 0.5f * x * (1.0f + t); }
__device__ __forceinline__ void ph_ssm2(const Args& A, LAS unsigned char* lds, int l) {
    TIDS;
    LAS float* ct = (LAS float*)(lds + wave * 16384);
    LAS float* ht = ct + 2048;
    const bf16* proj = wsb(A, WS_PROJ);
    constexpr int NPU = NB * 16 * SSM_NCH, NSU = DB * 16;
    for (int un = gw; un < NPU + NSU; un += NGW) {
        int g, m0, ntok; float hr, hi; float* fre = nullptr; float* fim = nullptr;
        if (un < NPU) { const int c = un % SSM_NCH; g = (un / SSM_NCH) % 16; const int b = un / (SSM_NCH * 16); m0 = b * SEQ + c * SSM_CH; ntok = SSM_CH;
            hr = wsf(A, WS_HIN)[(size_t)un * 128 + lane]; hi = wsf(A, WS_HIN)[(size_t)un * 128 + 64 + lane];
            if (c == SSM_NCH - 1) { fre = A.out + O_REP + ((size_t)(l * NB + b) * 16 + g) * 64; fim = A.out + O_IMP + ((size_t)(l * NB + b) * 16 + g) * 64; } }
        else { const int su = un - NPU; g = su & 15; const int s = su >> 4; m0 = MP + s * DEC_SEQ; ntok = DEC_SEQ;
            hr = A.in[I_SRE][((size_t)(l * DB + s) * 16 + g) * 64 + lane]; hi = A.in[I_SIM][((size_t)(l * DB + s) * 16 + g) * 64 + lane];
            fre = A.out + O_RES + ((size_t)(l * DB + s) * 16 + g) * 64; fim = A.out + O_IMS + ((size_t)(l * DB + s) * 16 + g) * 64; }
        SsmC k; ssm_consts(A, l, g, lane, k);
        const int gi = l * 16 + g;
        for (int ch = 0; ch < 16; ++ch) { ct[lane * 16 + ch] = A.in[I_CRE][((size_t)gi * 16 + ch) * 64 + lane]; ct[1024 + lane * 16 + ch] = A.in[I_CIM][((size_t)gi * 16 + ch) * 64 + lane]; }
        const float dd = A.in[I_SSD][l * 256 + g * 16 + (lane & 15)];
        for (int t0 = 0; t0 < ntok; t0 += 16) {
            const int nt = (ntok - t0) < 16 ? (ntok - t0) : 16;
            for (int t = 0; t < nt; ++t) { ssm_step(k, proj + (size_t)(m0 + t0 + t) * NPROJ + PC_U + g * 16, hr, hi); ht[t * 64 + lane] = hr; ht[1024 + t * 64 + lane] = hi; }
            WAVE_SYNC();
            const int ch = lane & 15, tq = lane >> 4;
#pragma unroll
            for (int i = 0; i < 4; ++i) { const int tt = tq + 4 * i;
                if (tt < nt) { float y = 0.f;
                    for (int p = 0; p < 64; ++p) y += ct[p * 16 + ch] * ht[tt * 64 + p] - ct[1024 + p * 16 + ch] * ht[1024 + tt * 64 + p];
                    const size_t m = (size_t)(m0 + t0 + tt);
                    y += dd * bf2f(proj[m * NPROJ + PC_U + g * 16 + ch]);
                    wsb(A, WS_YS)[m * 256 + g * 16 + ch] = (bf16)f2bf(gelu_tanh(y)); } }
            WAVE_SYNC();
        }
        if (fre) { fre[lane] = hr; fim[lane] = hi; }
    }
}
__device__ __forceinline__ void ph_conv(const Args& A, int l) {
    TIDS;
    const int gt = bid * (NWAVES * 64) + tid, NGT = G * NWAVES * 64;
    const bf16* proj = wsb(A, WS_PROJ);
    for (int i = gt; i < M * 128; i += NGT) {
        const int m = i >> 7, c = (i & 127) * 2;
        int t, L; const float* hist = nullptr; float* so;
        if (m < MP) { t = m % SEQ; L = SEQ; so = A.out + O_CBP + (size_t)(l * NB + m / SEQ) * 512; }
        else { const int s = (m - MP) / DEC_SEQ; t = (m - MP) % DEC_SEQ; L = DEC_SEQ; hist = A.in[I_SCB] + (size_t)(l * DB + s) * 512; so = A.out + O_CBS + (size_t)(l * DB + s) * 512; }
        float cx0[3], cx1[3];
#pragma unroll
        for (int j = 0; j < 3; ++j) { const int tt = t - 2 + j;
            if (tt >= 0) { const bf16* r = proj + (size_t)(m - 2 + j) * NPROJ; const unsigned cg = *(const unsigned*)(r + PC_CG + c), xc = *(const unsigned*)(r + PC_XC + c); cx0[j] = bflo(cg) * bflo(xc); cx1[j] = bfhi(cg) * bfhi(xc); }
            else if (hist) { cx0[j] = hist[(2 + tt) * 256 + c]; cx1[j] = hist[(2 + tt) * 256 + c + 1]; }
            else { cx0[j] = 0.f; cx1[j] = 0.f; } }
        const float* w = A.in[I_CBW] + (size_t)l * 3 * 256;
        const float o0 = w[c] * cx0[0] + w[256 + c] * cx0[1] + w[512 + c] * cx0[2], o1 = w[c + 1] * cx1[0] + w[256 + c + 1] * cx1[1] + w[512 + c + 1] * cx1[2];
        const unsigned bg = *(const unsigned*)(proj + (size_t)m * NPROJ + PC_BG + c);
        *(unsigned*)(wsb(A, WS_Y) + (size_t)m * D + 256 + c) = pk2(bflo(bg) * o0, bfhi(bg) * o1);
        if (t >= L - 2) { so[(t - (L - 2)) * 256 + c] = cx0[2]; so[(t - (L - 2)) * 256 + c + 1] = cx1[2]; }
    }
}
__device__ __forceinline__ bf16x8 acc2b(const f32x4& lo, const f32x4& hi) { v4u w; w.x = pk2(lo[0], lo[1]); w.y = pk2(lo[2], lo[3]); w.z = pk2(hi[0], hi[1]); w.w = pk2(hi[2], hi[3]); return __builtin_bit_cast(bf16x8, w); }
__device__ __forceinline__ void ph_gdn_c1(const Args& A, LAS unsigned char* lds, int l) {
    TIDS;
    constexpr int XS = 72, GS = 68, RS = 132;
    LAS bf16* Qs = (LAS bf16*)lds; LAS bf16* Ks = Qs + 64 * XS; LAS bf16* Vs = Ks + 64 * XS;
    LAS float* GKK = (LAS float*)(lds + 27648); LAS float* GQK = GKK + 64 * GS; LAS float* rhs = GQK + 64 * GS;
    LAS float* Linv = rhs + 64 * RS; LAS float* sc = Linv + 1024;
    LAS float* DQ = sc, *DK = sc + 64, *RQ = sc + 128, *RK = sc + 192, *BET = sc + 256, *GC = sc + 320, *EGC = sc + 384, *EK = sc + 448;
    LAS float* Wst = GQK;
    const bf16* proj = wsb(A, WS_PROJ); const float* cw = A.in[I_DCW] + (size_t)l * 4 * GQKV; const float* lg8 = wsf(A, WS_LOG8);
    const int g = lane >> 4, i16 = lane & 15;
    for (int un = bid; un < NB * GH * GNCH; un += G) {
        const int c = un % GNCH, h = (un / GNCH) % GH, b = un / (GNCH * GH); const int m0 = b * SEQ + c * GCH;
        unsigned char* gd = A.ws + WS_GD + (size_t)un * GD_UNIT;
        if (wave < 6) { const int sec = wave >> 1, th = wave & 1, src = sec * 256 + h * 64 + lane, t0 = c * GCH + th * 32;
            const float w0 = cw[src], w1 = cw[GQKV + src], w2 = cw[2 * GQKV + src], w3 = cw[3 * GQKV + src];
            float x[35];
#pragma unroll
            for (int k = 0; k < 35; ++k) { const int tt = t0 - 3 + k; x[k] = tt >= 0 ? bf2f(proj[(size_t)(b * SEQ + tt) * NPROJ + PC_QKV + src]) : 0.f; }
            LAS bf16* X = sec == 0 ? Qs : (sec == 1 ? Ks : Vs);
#pragma unroll
            for (int k = 0; k < 32; ++k) X[(th * 32 + k) * XS + lane] = (bf16)f2bf(siluf_(w0 * x[k] + w1 * x[k + 1] + w2 * x[k + 2] + w3 * x[k + 3]));
            if (c == GNCH - 1 && th == 1) {
#pragma unroll
                for (int k = 0; k < 3; ++k) A.out[O_CDP + ((size_t)(l * NB + b) * 3 + k) * GQKV + src] = x[32 + k]; } }
        __syncthreads();
#pragma unroll
        for (int q2 = 0; q2 < 2; ++q2) { const int tt = 2 * wave + q2, rt = tt >> 2, ct = tt & 3;
            f32x4 akk = {0.f, 0.f, 0.f, 0.f}, aqk = {0.f, 0.f, 0.f, 0.f};
#pragma unroll
            for (int s = 0; s < 2; ++s) { const bf16x8 kc = *(const LAS bf16x8*)(Ks + (16 * ct + i16) * XS + 32 * s + 8 * g), kr = *(const LAS bf16x8*)(Ks + (16 * rt + i16) * XS + 32 * s + 8 * g),
                                                         qr = *(const LAS bf16x8*)(Qs + (16 * rt + i16) * XS + 32 * s + 8 * g);
                akk = __builtin_amdgcn_mfma_f32_16x16x32_bf16(kr, kc, akk, 0, 0, 0); aqk = __builtin_amdgcn_mfma_f32_16x16x32_bf16(qr, kc, aqk, 0, 0, 0); }
#pragma unroll
            for (int r = 0; r < 4; ++r) { GKK[(16 * rt + 4 * g + r) * GS + 16 * ct + i16] = akk[r]; GQK[(16 * rt + 4 * g + r) * GS + 16 * ct + i16] = aqk[r]; }
            if (rt == ct && g == (i16 >> 2)) { const int r = i16 & 3; DK[16 * rt + i16] = r == 0 ? akk[0] : r == 1 ? akk[1] : r == 2 ? akk[2] : akk[3]; } }
        if (wave < 4) { f32x4 aqq = {0.f, 0.f, 0.f, 0.f};
#pragma unroll
            for (int s = 0; s < 2; ++s) { const bf16x8 qr = *(const LAS bf16x8*)(Qs + (16 * wave + i16) * XS + 32 * s + 8 * g); aqq = __builtin_amdgcn_mfma_f32_16x16x32_bf16(qr, qr, aqq, 0, 0, 0); }
            if (g == (i16 >> 2)) { const int r = i16 & 3; DQ[16 * wave + i16] = r == 0 ? aqq[0] : r == 1 ? aqq[1] : r == 2 ? aqq[2] : aqq[3]; } }
        __syncthreads();
        if (wave == 0) { const float* lr = lg8 + (size_t)(m0 + lane) * 8;
            const float gv = -expf(A.in[I_DAL][l * 4 + h]) * softplusf_(lr[4 + h] + A.in[I_DDT][l * 4 + h]);
            float gc = gv;
#pragma unroll
            for (int o = 1; o < 64; o <<= 1) { const float t = __shfl_up(gc, o); if (lane >= o) gc += t; }
            const float gl = __shfl(gc, 63);
            RK[lane] = 1.0f / sqrtf(DK[lane] + RMS_EPS); RQ[lane] = 0.125f / sqrtf(DQ[lane] + RMS_EPS); BET[lane] = sigmoidf_(lr[h]); GC[lane] = gc; EGC[lane] = expf(gc); EK[lane] = expf(gl - gc);
            if (lane == 0) wsf(A, WS_EGL)[un] = expf(gl); }
        __syncthreads();
        for (int idx = tid; idx < 4096; idx += 512) { const int i = idx >> 6, j = idx & 63; GKK[i * GS + j] = i > j ? BET[i] * RK[i] * RK[j] * GKK[i * GS + j] * expf(GC[i] - GC[j]) : 0.f; }
        for (int idx = tid; idx < 64 * 128; idx += 512) { const int i = idx >> 7, cc = idx & 127; rhs[i * RS + cc] = cc < 64 ? BET[i] * bf2f(Vs[i * XS + cc]) : BET[i] * EGC[i] * RK[i] * bf2f(Ks[i * XS + cc - 64]); }
        for (int idx = tid; idx < 4096; idx += 512) { const int f = idx >> 9, ln = (idx >> 3) & 63, j = idx & 7, row = 16 * (f >> 1) + (ln & 15), kx = 32 * (f & 1) + 16 * (j >> 2) + 4 * (ln >> 4) + (j & 3);
            ((bf16*)gd)[8192 + idx] = (bf16)f2bf(row >= kx ? RQ[row] * RK[kx] * GQK[row * GS + kx] * expf(GC[row] - GC[kx]) : 0.f);
            ((bf16*)gd)[4096 + idx] = (bf16)f2bf(bf2f(Qs[row * XS + kx]) * RQ[row] * EGC[row]);
            ((bf16*)gd)[12288 + idx] = (bf16)f2bf(bf2f(Ks[kx * XS + row]) * RK[kx] * EK[kx]); }
        __syncthreads();
        if (wave == 0) { const int blk = lane >> 4, cI = lane & 15; float x[16];
            x[0] = cI == 0 ? 1.f : 0.f;
#pragma unroll
            for (int i = 1; i < 16; ++i) { float sacc = cI == i ? 1.f : 0.f;
#pragma unroll
                for (int j = 0; j < i; ++j) sacc -= GKK[(16 * blk + i) * GS + 16 * blk + j] * x[j];
                x[i] = sacc; }
#pragma unroll
            for (int i = 0; i < 16; ++i) Linv[blk * 256 + i * 16 + cI] = x[i]; }
        __syncthreads();
        { const f32x4 Z = {0.f, 0.f, 0.f, 0.f}; f32x4 X[4];
#define C1_LD4(p) ((f32x4)(*(const LAS f32x4*)(p)) * 1.0f)
#define C1_LF(I) acc2b(C1_LD4(Linv + (I) * 256 + i16 * 16 + 4 * g), Z)
#define C1_MF2(I, J) acc2b(-*(const LAS f32x4*)(GKK + (16 * (I) + i16) * GS + 16 * (J) + 4 * g), -*(const LAS f32x4*)(GKK + (16 * (I) + i16) * GS + 16 * ((J) + 1) + 4 * g))
#define C1_MF1(I, J) acc2b(-*(const LAS f32x4*)(GKK + (16 * (I) + i16) * GS + 16 * (J) + 4 * g), Z)
#define C1_R(I) (f32x4){rhs[(16 * (I) + 4 * g) * RS + 16 * wave + i16], rhs[(16 * (I) + 4 * g + 1) * RS + 16 * wave + i16], rhs[(16 * (I) + 4 * g + 2) * RS + 16 * wave + i16], rhs[(16 * (I) + 4 * g + 3) * RS + 16 * wave + i16]}
            f32x4 R = C1_R(0);
            X[0] = __builtin_amdgcn_mfma_f32_16x16x32_bf16(C1_LF(0), acc2b(R, Z), Z, 0, 0, 0);
            R = C1_R(1); R = __builtin_amdgcn_mfma_f32_16x16x32_bf16(C1_MF1(1, 0), acc2b(X[0], Z), R, 0, 0, 0);
            X[1] = __builtin_amdgcn_mfma_f32_16x16x32_bf16(C1_LF(1), acc2b(R, Z), Z, 0, 0, 0);
            const bf16x8 X01 = acc2b(X[0], X[1]);
            R = C1_R(2); R = __builtin_amdgcn_mfma_f32_16x16x32_bf16(C1_MF2(2, 0), X01, R, 0, 0, 0);
            X[2] = __builtin_amdgcn_mfma_f32_16x16x32_bf16(C1_LF(2), acc2b(R, Z), Z, 0, 0, 0);
            R = C1_R(3); R = __builtin_amdgcn_mfma_f32_16x16x32_bf16(C1_MF2(3, 0), X01, R, 0, 0, 0); R = __builtin_amdgcn_mfma_f32_16x16x32_bf16(C1_MF1(3, 2), acc2b(X[2], Z), R, 0, 0, 0);
            X[3] = __builtin_amdgcn_mfma_f32_16x16x32_bf16(C1_LF(3), acc2b(R, Z), Z, 0, 0, 0);
#undef C1_LF
#undef C1_LD4
#undef C1_MF2
#undef C1_MF1
#undef C1_R
            if (wave < 4) {
#pragma unroll
                for (int I = 0; I < 4; ++I) ((f32x4*)(gd + 32768))[(wave * 4 + I) * 64 + lane] = X[I]; }
            else {
#pragma unroll
                for (int I = 0; I < 4; ++I)
#pragma unroll
                    for (int r = 0; r < 4; ++r) Wst[(16 * I + 4 * g + r) * GS + 16 * (wave - 4) + i16] = -X[I][r]; } }
        __syncthreads();
        for (int idx = tid; idx < 4096; idx += 512) { const int f = idx >> 9, ln = (idx >> 3) & 63, j = idx & 7, row = 16 * (f >> 1) + (ln & 15), kx = 32 * (f & 1) + 16 * (j >> 2) + 4 * (ln >> 4) + (j & 3);
            ((bf16*)gd)[idx] = (bf16)f2bf(Wst[row * GS + kx]); }
        __syncthreads();
    }
}
__device__ __forceinline__ void ph_gdn_scan(const Args& A, int l) {
    TIDS;
    if (wave >= 4) return;
    for (int grp = bid; grp < NB * GH; grp += G) {
        const int vs = wave, h = grp % GH, b = grp / GH; const int g = lane >> 4, cc = lane & 15;
        f32x4 S[4];
#pragma unroll
        for (int T = 0; T < 4; ++T) S[T] = (f32x4){0.f, 0.f, 0.f, 0.f};
        for (int c = 0; c < GNCH; ++c) {
            const size_t cu = (size_t)(b * GH + h) * GNCH + c; const unsigned char* gd = A.ws + WS_GD + cu * GD_UNIT; const float egl = wsf(A, WS_EGL)[cu];
            const bf16x8* fr = (const bf16x8*)gd + lane;
            const f32x4* uvp = (const f32x4*)(gd + 32768) + (vs * 4) * 64 + lane;
            bf16x8 Sb[2] = {acc2b(S[0], S[1]), acc2b(S[2], S[3])};
            f32x4 u[4], o[4];
#pragma unroll
            for (int T = 0; T < 4; ++T) { u[T] = uvp[T * 64]; o[T] = (f32x4){0.f, 0.f, 0.f, 0.f};
#pragma unroll
                for (int s = 0; s < 2; ++s) { u[T] = __builtin_amdgcn_mfma_f32_16x16x32_bf16(fr[(0 * 8 + 2 * T + s) * 64], Sb[s], u[T], 0, 0, 0); o[T] = __builtin_amdgcn_mfma_f32_16x16x32_bf16(fr[(1 * 8 + 2 * T + s) * 64], Sb[s], o[T], 0, 0, 0); } }
            bf16x8 ub[2] = {acc2b(u[0], u[1]), acc2b(u[2], u[3])};
#pragma unroll
            for (int T = 0; T < 4; ++T) { S[T] = S[T] * egl;
#pragma unroll
                for (int s = 0; s < 2; ++s) { o[T] = __builtin_amdgcn_mfma_f32_16x16x32_bf16(fr[(2 * 8 + 2 * T + s) * 64], ub[s], o[T], 0, 0, 0); S[T] = __builtin_amdgcn_mfma_f32_16x16x32_bf16(fr[(3 * 8 + 2 * T + s) * 64], ub[s], S[T], 0, 0, 0); } }
            float* od = wsf(A, WS_ODRAW) + (size_t)(b * SEQ + c * GCH + 4 * g) * 256 + h * 64 + vs * 16 + cc;
#pragma unroll
            for (int T = 0; T < 4; ++T)
#pragma unroll
                for (int r = 0; r < 4; ++r) od[(size_t)(16 * T + r) * 256] = o[T][r];
        }
        float* so = A.out + O_DP + (((size_t)(l * NB + b) * GH + h) * 64 + 4 * g) * 64 + vs * 16 + cc;
#pragma unroll
        for (int T = 0; T < 4; ++T)
#pragma unroll
            for (int r = 0; r < 4; ++r) so[(16 * T + r) * 64] = S[T][r];
    }
}
__device__ __forceinline__ void ph_gdn_sample(const Args& A, LAS unsigned char* lds, int l) {
    TIDS;
    LAS float* S = (LAS float*)(lds + wave * 16384);
    LAS float* kq = (LAS float*)(lds + MISC_OFF + 1024 + wave * 512);
    const bf16* proj = wsb(A, WS_PROJ); const float* cw = A.in[I_DCW] + (size_t)l * 4 * GQKV; const float* lg8 = wsf(A, WS_LOG8);
    if (wave < 4 || wave >= 6) return;
    for (int un = (wave - 4) * G + bid; un < DB * GH; un += 2 * G) {
        const int h = un % GH, s = un / GH;
        const float* s0 = A.in[I_SD] + ((size_t)(l * DB + s) * GH + h) * 4096;
#pragma unroll 8
        for (int kk = 0; kk < 64; ++kk) S[kk * 64 + lane] = s0[kk * 64 + lane];
        const float* hist = A.in[I_SCD] + (size_t)(l * DB + s) * 3 * GQKV;
        for (int t = 0; t < DEC_SEQ; ++t) {
            const size_t m = (size_t)MP + s * DEC_SEQ + t;
            float val[3];
#pragma unroll
            for (int sec = 0; sec < 3; ++sec) { const int src = sec * 256 + h * 64 + lane; float acc = 0.f, cur = 0.f;
#pragma unroll
                for (int j = 0; j < 4; ++j) { const int tt = t - 3 + j; const float x = tt >= 0 ? bf2f(proj[(size_t)(MP + s * DEC_SEQ + tt) * NPROJ + PC_QKV + src]) : hist[(3 + tt) * GQKV + src]; acc += cw[j * GQKV + src] * x; cur = x; }
                val[sec] = siluf_(acc);
                if (t >= 1) A.out[O_CDS + ((size_t)(l * DB + s) * 3 + (t - 1)) * GQKV + src] = cur; }
            const float sq = wave_sum(val[0] * val[0]), sk = wave_sum(val[1] * val[1]);
            const float qv = val[0] * (1.0f / sqrtf(sq + RMS_EPS)) * 0.125f, kv = val[1] * (1.0f / sqrtf(sk + RMS_EPS)), vv = val[2];
            const float* lr = lg8 + m * 8; const float beta = sigmoidf_(lr[h]); const float a = expf(-expf(A.in[I_DAL][l * 4 + h]) * softplusf_(lr[4 + h] + A.in[I_DDT][l * 4 + h]));
            kq[lane] = kv; kq[64 + lane] = qv;
            WAVE_SYNC();
            float kS = 0.f;
#pragma unroll 8
            for (int kk = 0; kk < 64; ++kk) kS += kq[kk] * S[kk * 64 + lane];
            float o = 0.f;
#pragma unroll 8
            for (int kk = 0; kk < 64; ++kk) { const float bk = beta * kq[kk]; const float sn = a * (S[kk * 64 + lane] - bk * kS) + bk * vv; S[kk * 64 + lane] = sn; o += kq[64 + kk] * sn; }
            wsf(A, WS_ODRAW)[m * 256 + h * 64 + lane] = o;
            WAVE_SYNC();
        }
        float* so = A.out + O_DS + ((size_t)(l * DB + s) * GH + h) * 4096;
#pragma unroll 8
        for (int kk = 0; kk < 64; ++kk) so[kk * 64 + lane] = S[kk * 64 + lane];
    }
}
__device__ __forceinline__ void ph_gdn_out(const Args& A, int l) {
    TIDS;
    for (int idx = gw; idx < M * GH; idx += NGW) { const size_t m = idx >> 2; const int h = idx & 3;
        const float o = wsf(A, WS_ODRAW)[m * 256 + h * 64 + lane];
        const float ms = wave_sum(o * o) * (1.0f / 64.0f);
        const float z = bf2f(wsb(A, WS_PROJ)[m * NPROJ + PC_Z + h * 64 + lane]);
        wsb(A, WS_Y)[m * D + 512 + h * 64 + lane] = (bf16)f2bf(o * (1.0f / sqrtf(ms + RMS_EPS)) * A.in[I_DNW][l * 64 + lane] * siluf_(z)); }
}
__device__ __forceinline__ void sb_terms(float z, float& ls, float& ln) { const float L = log1pf(__expf(-fabsf(z))); ls = fminf(z, 0.f) - L; ln = -fmaxf(z, 0.f) - L; }
constexpr float SB_CUT = -105.0f;
__device__ __forceinline__ void ph_sb_prompt(const Args& A, LAS unsigned char* lds, int l) {
    TIDS; (void)l;
    LAS float* kt = (LAS float*)(lds + wave * 16384); LAS float* vt = kt + 2048;
    const bf16* proj = wsb(A, WS_PROJ);
    constexpr int NQB = SEQ / 32;
    for (int un0 = gw; un0 < NB * SBH * NQB; un0 += NGW) {
        const int un = NB * SBH * NQB - 1 - un0;
        const int qb = un / (NB * SBH), h = un % SBH, b = (un / SBH) % NB;
        const int i = lane & 31, half = lane >> 5, qi = qb * 32 + i; const size_t m = (size_t)b * SEQ + qi;
        float q[32], acc[32];
        { const v4u* qp = (const v4u*)(proj + m * NPROJ + PC_Q + h * 64 + half * 32);
#pragma unroll
          for (int x = 0; x < 4; ++x) { const v4u w = qp[x]; q[8 * x] = bflo(w.x) * 0.125f; q[8 * x + 1] = bfhi(w.x) * 0.125f; q[8 * x + 2] = bflo(w.y) * 0.125f; q[8 * x + 3] = bfhi(w.y) * 0.125f;
              q[8 * x + 4] = bflo(w.z) * 0.125f; q[8 * x + 5] = bfhi(w.z) * 0.125f; q[8 * x + 6] = bflo(w.w) * 0.125f; q[8 * x + 7] = bfhi(w.w) * 0.125f; } }
#pragma unroll
        for (int d = 0; d < 32; ++d) acc[d] = 0.f;
        float R = 0.f;
        for (int kb = qb; kb >= 0; --kb) {
            { const int row = lane >> 1, hr = lane & 1; const bf16* rp = proj + ((size_t)b * SEQ + kb * 32 + row) * NPROJ + h * 64 + hr * 32;
              const v4u* kp = (const v4u*)(rp + PC_K); const v4u* vp = (const v4u*)(rp + PC_V);
#pragma unroll
              for (int x = 0; x < 4; ++x) { const v4u w = kp[x], u = vp[x]; LAS float* kd = kt + row * 64 + hr * 32 + 8 * x; LAS float* vd = vt + row * 64 + hr * 32 + 8 * x;
                  kd[0] = bflo(w.x); kd[1] = bfhi(w.x); kd[2] = bflo(w.y); kd[3] = bfhi(w.y); kd[4] = bflo(w.z); kd[5] = bfhi(w.z); kd[6] = bflo(w.w); kd[7] = bfhi(w.w);
                  vd[0] = bflo(u.x); vd[1] = bfhi(u.x); vd[2] = bflo(u.y); vd[3] = bfhi(u.y); vd[4] = bflo(u.z); vd[5] = bfhi(u.z); vd[6] = bflo(u.w); vd[7] = bfhi(u.w); } }
            WAVE_SYNC();
            for (int jj = 31; jj >= 0; --jj) {
                const LAS float* kr = kt + jj * 64 + half * 32; float zp = 0.f;
#pragma unroll
                for (int d = 0; d < 32; ++d) zp += q[d] * kr[d];
                const float z = zp + __shfl_xor(zp, 32);
                float ls, ln; sb_terms(z, ls, ln);
                const bool valid = (kb * 32 + jj) < qi;
                const float w = valid ? __expf(ls + R) : 0.f;
                const LAS float* vr = vt + jj * 64 + half * 32;
#pragma unroll
                for (int d = 0; d < 32; ++d) acc[d] += w * vr[d];
                R += valid ? ln : 0.f;
            }
            WAVE_SYNC();
            if (kb < qb && __all(R < SB_CUT)) break;
        }
        v4u* yp = (v4u*)(wsb(A, WS_Y) + m * D + 768 + h * 64 + half * 32);
#pragma unroll
        for (int x = 0; x < 4; ++x) { v4u o; o.x = pk2(acc[8 * x], acc[8 * x + 1]); o.y = pk2(acc[8 * x + 2], acc[8 * x + 3]); o.z = pk2(acc[8 * x + 4], acc[8 * x + 5]); o.w = pk2(acc[8 * x + 6], acc[8 * x + 7]); yp[x] = o; }
    }
}
__device__ __forceinline__ void ph_sb_sample(const Args& A, LAS unsigned char* lds, int l) {
    TIDS;
    if (wave >= 2) return;
    LAS float* vt = (LAS float*)(lds + wave * 32768);
    LAS float* qs = vt + 64 * 68;
    LAS float* wq = qs + 256;
    const bf16* proj = wsb(A, WS_PROJ); const int* pt = (const int*)A.in[I_PT];
    for (int un = wave * G + bid; un < DB * SBH; un += 2 * G) {
        const int h = un % SBH, s = un / SBH;
#pragma unroll
        for (int qi = 0; qi < 4; ++qi) qs[qi * 64 + lane] = bf2f(proj[((size_t)MP + s * DEC_SEQ + qi) * NPROJ + PC_Q + h * 64 + lane]) * 0.125f;
        WAVE_SYNC();
        float R[4] = {0.f, 0.f, 0.f, 0.f}; f32x4 acc = {0.f, 0.f, 0.f, 0.f};
        const int qi_b = lane & 3, ds = lane >> 2;
        for (int tile = 0; tile * 64 < PAST + DEC_SEQ; ++tile) {
            const int p = PAST + DEC_SEQ - 1 - (tile * 64 + lane);
            f32x4 kr[16], vr[16];
            if (p >= PAST) { const bf16* rp = proj + ((size_t)MP + s * DEC_SEQ + (p - PAST)) * NPROJ + h * 64;
#pragma unroll
                for (int x = 0; x < 8; ++x) { const v4u kw = ((const v4u*)(rp + PC_K))[x], vw = ((const v4u*)(rp + PC_V))[x];
                    kr[2 * x] = (f32x4){bflo(kw.x), bfhi(kw.x), bflo(kw.y), bfhi(kw.y)}; kr[2 * x + 1] = (f32x4){bflo(kw.z), bfhi(kw.z), bflo(kw.w), bfhi(kw.w)};
                    vr[2 * x] = (f32x4){bflo(vw.x), bfhi(vw.x), bflo(vw.y), bfhi(vw.y)}; vr[2 * x + 1] = (f32x4){bflo(vw.z), bfhi(vw.z), bflo(vw.w), bfhi(vw.w)}; } }
            else if (p >= 0) { const int page = pt[s * NPAGES + p / PAGE]; const size_t off = ((((size_t)l * NPOOL + page) * PAGE + p % PAGE) * SBH + h) * 64;
#pragma unroll
                for (int x = 0; x < 16; ++x) { kr[x] = ((const f32x4*)(A.in[I_CK] + off))[x]; vr[x] = ((const f32x4*)(A.in[I_CV] + off))[x]; } }
            else {
#pragma unroll
                for (int x = 0; x < 16; ++x) { kr[x] = (f32x4){0.f, 0.f, 0.f, 0.f}; vr[x] = (f32x4){0.f, 0.f, 0.f, 0.f}; } }
#pragma unroll
            for (int x = 0; x < 16; ++x) *(LAS f32x4*)(vt + lane * 68 + 4 * x) = vr[x];
#pragma unroll
            for (int qi = 0; qi < 4; ++qi) { float z = 0.f;
#pragma unroll
                for (int x = 0; x < 16; ++x) { const f32x4 qv = *(const LAS f32x4*)(qs + qi * 64 + 4 * x); z += (kr[x][0] * qv[0] + kr[x][1] * qv[1]) + (kr[x][2] * qv[2] + kr[x][3] * qv[3]); }
                float ls, ln; sb_terms(z, ls, ln);
                const bool valid = p >= 0 && p < PAST + qi; const float lnv = valid ? ln : 0.f;
                float incl = lnv;
#pragma unroll
                for (int o = 1; o < 64; o <<= 1) { const float t = __shfl_up(incl, o); if (lane >= o) incl += t; }
                wq[qi * 64 + lane] = valid ? __expf(ls + R[qi] + (incl - lnv)) : 0.f;
                R[qi] += __shfl(incl, 63); }
            WAVE_SYNC();
#pragma unroll 8
            for (int key = 0; key < 64; ++key) acc += *(const LAS f32x4*)(vt + key * 68 + 4 * ds) * wq[qi_b * 64 + key];
            WAVE_SYNC();
            if (R[0] < SB_CUT && R[1] < SB_CUT && R[2] < SB_CUT && R[3] < SB_CUT) break;
        }
        v2u o; o.x = pk2(acc[0], acc[1]); o.y = pk2(acc[2], acc[3]);
        *(v2u*)(wsb(A, WS_Y) + ((size_t)MP + s * DEC_SEQ + qi_b) * D + 768 + h * 64 + ds * 4) = o;
    }
}
constexpr int PH_PER_LAYER = 12, NPHASE = 2 + PH_PER_LAYER * DEPTH;
#ifndef DUP_MASK
#define DUP_MASK 0
#endif
#if DUP_MASK
__device__ __forceinline__ int rep_n(int k) { int n = ((DUP_MASK >> k) & 1) ? 2 : 1; asm volatile("" : "+s"(n)); return n; }
#define REP(k) _Pragma("nounroll") for (int rep_ = 0, repn_ = rep_n(k); rep_ < repn_; ++rep_)
#else
#define REP(k)
#endif
#ifndef TIME_SUB
#define TIME_SUB 0
#endif
#ifndef TIME_MASK
#define TIME_MASK 0
#endif
#ifndef MK_N_LAUNCHES
#define MK_N_LAUNCHES 1
#endif
__global__ void __launch_bounds__(NWAVES * 64, 2) fwd_kernel(Args A) {
#ifndef CPU_EMU
    extern __shared__ __attribute__((aligned(16))) unsigned char lds_raw[];
    LAS unsigned char* lds = (LAS unsigned char*)lds_raw;
    volatile LAS unsigned* MISC = (volatile LAS unsigned*)(lds + MISC_OFF);
    for (int u = threadIdx.x; u < (LDS_BYTES - MISC_OFF) / 4; u += NWAVES * 64) ((LAS unsigned*)(lds + MISC_OFF))[u] = 0u;
    __syncthreads();
    XcdBarrier bar; bar.bar = (unsigned*)(A.ws + WS_CTL) + CW_BAR + A.li * XCD_BAR_WORDS; bar.x = 0; bar.st = nullptr;
    if (A.ph_hi - A.ph_lo > 1) bar = xcd_barrier_post((unsigned*)(A.ws + WS_CTL) + CW_BAR + A.li * XCD_BAR_WORDS, MISC + 8);
#else
    unsigned char* lds = emu::B->lds; XcdBarrier bar{0};
#endif
    const int lo = A.ph_lo, hi = A.ph_hi, G = gridDim.x, bid = blockIdx.x;
#define IN(k) (lo <= (k) && (k) < hi)
#if TIME_MASK || TIME_SUB
    unsigned long long tp_ = __builtin_amdgcn_s_memrealtime(), tacc_ = 0;
#define SEAM(k) do { if (IN((k) + 1)) xcd_barrier(bar); { const unsigned long long tn_ = __builtin_amdgcn_s_memrealtime(); if ((TIME_MASK >> (k)) & 1) tacc_ += tn_ - tp_; tp_ = tn_; } } while (0)
#else
#define SEAM(k) do { if (IN((k) + 1)) xcd_barrier(bar); } while (0)
#endif
    if (IN(0)) { REP(9) ph_prologue(A, lds); SEAM(0); }
    if (IN(1)) {
        pg8::Gemm g{wsb(A, WS_CSILU), (const bf16*)(A.ws + WS_W + WL_ADA), D, D}; ModOrder S{G, bid}; EpiMod2 E{wsf(A, WS_MOD), A.in[I_BADA]};
        pg8::gemm_phase<EpiMod2, ModOrder, true, true>(lds, g, S, E); SEAM(1);
    }
    for (int l = 0; l < DEPTH; ++l) {
        const int pb = 2 + PH_PER_LAYER * l;
        unsigned char* wl = A.ws + WS_W + (size_t)l * WL_SIZE;
        if (IN(pb + 0)) { if (l == 0) ph_rows<0>(A, 0); SEAM(pb + 0); }
        if (IN(pb + 1)) {
            pg8::Gemm g{wsb(A, WS_H), (const bf16*)(wl + WL_W1), D, D}; pg8::GridOrder S; S.init(M / 256, N1 / 256, G, bid);
            pg8::EpiProj E{wsb(A, WS_PROJ), wsb(A, WS_GATE), A.out + O_KP + (size_t)l * MP * 256, A.out + O_VP + (size_t)l * MP * 256, A.out + O_KS + (size_t)l * MS * 256, A.out + O_VS + (size_t)l * MS * 256};
            REP(5) pg8::gemm_phase<pg8::EpiProj, pg8::GridOrder, true, true>(lds, g, S, E); SEAM(pb + 1);
        }
        if (IN(pb + 2)) {
#if TIME_SUB
#define SUBT(k, call) do { const unsigned long long ts_ = __builtin_amdgcn_s_memrealtime(); call; if ((TIME_SUB >> (k)) & 1) tacc_ += __builtin_amdgcn_s_memrealtime() - ts_; } while (0)
#else
#define SUBT(k, call) do { call; } while (0)
#endif
            SUBT(0, REP(3) ph_gdn_c1(A, lds, l)); SUBT(1, REP(2) ph_sb_prompt(A, lds, l)); __syncthreads(); SUBT(2, REP(10) ph_gdn_sample(A, lds, l)); SUBT(3, REP(1) ph_sb_sample(A, lds, l));
            SUBT(4, REP(4) ph_ssm1(A, l)); SUBT(5, REP(10) ph_conv(A, l)); SUBT(6, SEAM(pb + 2)); }
        if (IN(pb + 3)) { REP(0) ph_gdn_scan(A, l); REP(10) ph_ssm_carry(A, l); SEAM(pb + 3); }
        if (IN(pb + 4)) { REP(4) ph_ssm2(A, lds, l); REP(10) ph_gdn_out(A, l); SEAM(pb + 4); }
        if (IN(pb + 5)) {
            pg8::Gemm g{wsb(A, WS_YS), (const bf16*)(wl + WL_GLU), 256, 256}; pg8::GridOrder S; S.init(M / 256, 1, G, bid);
            pg8::EpiGlu E{wsb(A, WS_YS), wsb(A, WS_Y)};
            REP(8) pg8::gemm_phase<pg8::EpiGlu, pg8::GridOrder, true, true>(lds, g, S, E); SEAM(pb + 5);
        }
        if (IN(pb + 6)) {
            pg8::Gemm g{wsb(A, WS_Y), (const bf16*)(wl + WL_BR), D, 256}; pg8::MergeOrder S; S.init(M / 256, 8, G, bid);
            pg8::EpiMerge E; E.gate = wsb(A, WS_GATE); E.mgb = wsb(A, WS_MERGEB);
            REP(6) pg8::gemm_phase<pg8::EpiMerge, pg8::MergeOrder, true, true, true>(lds, g, S, E); SEAM(pb + 6);
        }
        if (IN(pb + 7)) {
            pg8::Gemm g{wsb(A, WS_MERGEB), (const bf16*)(wl + WL_WO), D, D}; pg8::GridOrder S; S.init(M / 256, 4, G, bid);
            pg8::EpiRes E{l == 0 ? A.in[I_XP] : wsf(A, WS_X2), l == 0 ? A.in[I_XS] : wsf(A, WS_X2) + (size_t)MP * D, wsf(A, WS_MOD) + (size_t)l * 256 * NMOD + 2 * D, wsf(A, WS_X1)};
            REP(8) pg8::gemm_phase<pg8::EpiRes, pg8::GridOrder, true, true>(lds, g, S, E); SEAM(pb + 7);
        }
        if (IN(pb + 8)) { ph_rows<1>(A, l); SEAM(pb + 8); }
        if (IN(pb + 9)) {
            pg8::Gemm g{wsb(A, WS_H), (const bf16*)(wl + WL_UP), D, D}; pg8::GridOrder S; S.init(M / 256, NUP / 256, G, bid);
            pg8::EpiUp E{wsb(A, WS_ACT)};
            REP(7) pg8::gemm_phase<pg8::EpiUp, pg8::GridOrder, true, true>(lds, g, S, E); SEAM(pb + 9);
        }
        if (IN(pb + 10)) {
            pg8::Gemm g{wsb(A, WS_ACT), (const bf16*)(wl + WL_DN), DFF, DFF}; pg8::GridOrder S; S.init(M / 256, 4, G, bid);
            pg8::EpiRes E{wsf(A, WS_X1), wsf(A, WS_X1) + (size_t)MP * D, wsf(A, WS_MOD) + (size_t)l * 256 * NMOD + 5 * D, wsf(A, WS_X2)};
            REP(7) pg8::gemm_phase<pg8::EpiRes, pg8::GridOrder, true, true>(lds, g, S, E); SEAM(pb + 10);
        }
        if (IN(pb + 11)) { ph_rows<2>(A, l); SEAM(pb + 11); }
    }
#if TIME_MASK || TIME_SUB
    if (blockIdx.x == 0 && threadIdx.x == 0) { const unsigned long long t0_ = __builtin_amdgcn_s_memrealtime(); while (__builtin_amdgcn_s_memrealtime() - t0_ < 4 * tacc_) __builtin_amdgcn_s_sleep(8); }
#endif
#undef IN
#undef SEAM
}
#ifndef CPU_EMU
extern "C" void kernel_launch(void* const* d_in, const int* in_sizes, int n_in, void* d_out, int out_size, void* d_ws, size_t ws_size, hipStream_t stream) {
    static int grid = 0;
    if (grid == 0) {
        if (n_in != 38 || (size_t)out_size != O_END || ws_size < WS_END) { fprintf(stderr, "kernel_launch: unexpected shapes (n_in %d out %d ws %zu; want 38, %zu, >= %zu)\n", n_in, out_size, ws_size, (size_t)O_END, (size_t)WS_END); grid = -1; return; }
        int dev = 0, cus = 0, per_cu = 0;
        if (hipGetDevice(&dev) != hipSuccess || hipDeviceGetAttribute(&cus, hipDeviceAttributeMultiprocessorCount, dev) != hipSuccess) { grid = -1; return; }
        if (hipFuncSetAttribute((const void*)fwd_kernel, hipFuncAttributeMaxDynamicSharedMemorySize, LDS_BYTES) != hipSuccess) { fprintf(stderr, "kernel_launch: hipFuncSetAttribute failed\n"); grid = -1; return; }
        if (hipOccupancyMaxActiveBlocksPerMultiprocessor(&per_cu, (const void*)fwd_kernel, NWAVES * 64, LDS_BYTES) != hipSuccess || per_cu < 1) { fprintf(stderr, "kernel_launch: occupancy query says %d\n", per_cu); }
        (void)hipGetLastError();
        grid = cus;
    }
    if (grid < 0) return;
    if (hipMemsetAsync((char*)d_ws + WS_CTL, 0, CTL_ZERO_BYTES, stream) != hipSuccess) return;
    Args a{};
    for (int i = 0; i < 38; ++i) a.in[i] = (const float*)d_in[i];
    a.out = (float*)d_out; a.ws = (unsigned char*)d_ws;
    if (MK_N_LAUNCHES == 1) { a.ph_lo = 0; a.ph_hi = NPHASE; a.li = 0; hipLaunchKernelGGL(fwd_kernel, dim3(grid), dim3(NWAVES * 64), LDS_BYTES, stream, a); }
    else for (int p = 0; p < NPHASE; ++p) { if (p == 2 + PH_PER_LAYER) continue; a.ph_lo = p; a.ph_hi = p + 1; a.li = 0; hipLaunchKernelGGL(fwd_kernel, dim3(grid), dim3(NWAVES * 64), LDS_BYTES, stream, a); }
}
#endif
```

```cpp
#ifndef CPU_EMU
#include <hip/hip_runtime.h>
#endif
#include <cstdio>
#include <cstdint>
#include <cmath>

constexpr int D = 1024, NB = 2, DEPTH = 2, DEC_SEQ = 4, PAGE = 128;
#ifdef CPU_EMU
#ifndef EMU_SEQ
#define EMU_SEQ 512
#endif
#ifndef EMU_DB
#define EMU_DB 64
#endif
#ifndef EMU_PAST
#define EMU_PAST 512
#endif
constexpr int SEQ = EMU_SEQ, DB = EMU_DB, PAST = EMU_PAST;
#else
constexpr int SEQ = 8192, DB = 128, PAST = 2048;
#endif
constexpr int NPAGES = PAST / PAGE, NUSED = DB * NPAGES, NPOOL = NUSED + (NUSED / 4 > 1 ? NUSED / 4 : 1);
constexpr int MP = NB * SEQ, MS = DB * DEC_SEQ, M = MP + MS, NSEQ = NB + DB;
constexpr int WMIX = 256, NPROJ = 2816, NIN = 2824, NGATE = 4096, N1 = NPROJ + NGATE, DFF = 2816, NUP = 2 * DFF, NMOD = 6 * D;
constexpr int SSM_G = 16, SSM_P = 64, SSM_CH = 128, SSM_NCH = SEQ / SSM_CH;
constexpr int GH = 4, GDK = 64, GCH = 64, GNCH = SEQ / GCH, GQKV = 768;
constexpr int SBH = 4;
constexpr int PC_U = 0, PC_BG = 256, PC_CG = 512, PC_XC = 768, PC_QKV = 1024, PC_Z = 1792, PC_Q = 2048, PC_K = 2304, PC_V = 2560;
constexpr float LN_EPS = 1e-5f, RMS_EPS = 1e-6f, ALPHA = 1.41421356237309515f  ;
static_assert(M % 256 == 0 && MP % 256 == 0 && SEQ % 256 == 0 && NSEQ <= 256, "tile shapes");
constexpr size_t O_Y = 0, O_KP = (size_t)M * D, O_VP = O_KP + (size_t)DEPTH * MP * 256, O_KS = O_VP + (size_t)DEPTH * MP * 256, O_VS = O_KS + (size_t)DEPTH * MS * 256,
    O_REP = O_VS + (size_t)DEPTH * MS * 256, O_IMP = O_REP + DEPTH * NB * 1024, O_RES = O_IMP + DEPTH * NB * 1024, O_IMS = O_RES + (size_t)DEPTH * DB * 1024,
    O_CBP = O_IMS + (size_t)DEPTH * DB * 1024, O_CBS = O_CBP + DEPTH * NB * 512, O_DP = O_CBS + (size_t)DEPTH * DB * 512, O_DS = O_DP + (size_t)DEPTH * NB * 16384,
    O_CDP = O_DS + (size_t)DEPTH * DB * 16384, O_CDS = O_CDP + DEPTH * NB * 2304, O_END = O_CDS + (size_t)DEPTH * DB * 2304;

constexpr size_t MiB = 1u << 20;
constexpr size_t al(size_t x) { return (x + 4095) & ~(size_t)4095; }
constexpr size_t WS_CTL = 0, CTL_ZERO_BYTES = 1 * MiB;
constexpr size_t WL_ADA = 0, WL_W1 = WL_ADA + (size_t)NMOD * D * 2, WL_GLU = WL_W1 + (size_t)N1 * D * 2, WL_BR = WL_GLU + 256 * 256 * 2, WL_WO = WL_BR + (size_t)4 * D * 256 * 2,
    WL_UP = WL_WO + (size_t)D * D * 2, WL_DN = WL_UP + (size_t)NUP * D * 2, WL_LOG = WL_DN + (size_t)D * DFF * 2, WL_SIZE = (WL_LOG + 8 * D * 4 + 524287) & ~(size_t)524287;
constexpr size_t WS_W = 1 * MiB, WS_CSILU = WS_W + DEPTH * WL_SIZE, WS_MOD = WS_CSILU + 256 * D * 2, WS_H = WS_MOD + (size_t)DEPTH * 256 * NMOD * 4,
    WS_PROJ = WS_H + (size_t)M * D * 2, WS_GATE = al(WS_PROJ + (size_t)M * NPROJ * 2), WS_LOG8 = WS_GATE + (size_t)M * NGATE * 2, WS_Y = WS_LOG8 + (size_t)M * 8 * 4,
    WS_YS = WS_Y + (size_t)M * D * 2, WS_MERGE = WS_YS + (size_t)M * 256 * 2, WS_MERGEB = WS_MERGE + (size_t)M * D * 4, WS_X1 = WS_MERGEB + (size_t)M * D * 2,
    WS_ACT = WS_X1 + (size_t)M * D * 4, WS_X2 = al(WS_ACT + (size_t)M * DFF * 2), WS_SEND = WS_X2 + (size_t)M * D * 4, WS_HIN = WS_SEND + (size_t)NB * 16 * SSM_NCH * 128 * 4,
    WS_GD = WS_HIN + (size_t)NB * 16 * SSM_NCH * 128 * 4, WS_EGL = WS_GD + (size_t)NB * GH * GNCH * 49152, WS_ODRAW = al(WS_EGL + (size_t)NB * GH * GNCH * 4),
    WS_END = WS_ODRAW + (size_t)M * 256 * 4;
constexpr int CW_TMO = 0, CW_BAR = 4096;
constexpr size_t GD_UNIT = 49152;

#define LAS_HW __attribute__((address_space(3)))
#ifdef CPU_EMU
#define LAS
#else
#define LAS LAS_HW
#endif
typedef unsigned short bf16;
typedef unsigned v4u __attribute__((ext_vector_type(4)));
typedef unsigned v2u __attribute__((ext_vector_type(2)));
typedef float f32x4 __attribute__((ext_vector_type(4)));
typedef float f32x2 __attribute__((ext_vector_type(2)));
typedef short bf16x8 __attribute__((ext_vector_type(8)));
#ifdef CPU_EMU
#define LDS_WAIT() do {} while (0)
#define VM_WAIT() do {} while (0)
#define WAVE_SYNC() emu::wave_sync()
#define CFENCE() do {} while (0)
#define RAW_BAR() emu::block_sync()
#else
#define LDS_WAIT() asm volatile("s_waitcnt lgkmcnt(0)" ::: "memory")
#define VM_WAIT() asm volatile("s_waitcnt vmcnt(0)" ::: "memory")
#define WAVE_SYNC() do { asm volatile("s_waitcnt lgkmcnt(0)" ::: "memory"); __builtin_amdgcn_wave_barrier(); } while (0)
#define CFENCE() asm volatile("" ::: "memory")
#define RAW_BAR() do { asm volatile("s_waitcnt lgkmcnt(0)" ::: "memory"); __builtin_amdgcn_s_barrier(); asm volatile("" ::: "memory"); } while (0)
#endif
#ifdef CPU_EMU
#define OPAQUE_V(x) do {} while (0)
#else
#define OPAQUE_V(x) asm volatile("" : "+v"(x))
#endif
__device__ __forceinline__ unsigned f2bf(float f) { unsigned u = __builtin_bit_cast(unsigned, f); return (u + 0x7fffu + ((u >> 16) & 1u)) >> 16; }
__device__ __forceinline__ unsigned pk2(float lo, float hi) { return f2bf(lo) | (f2bf(hi) << 16); }
__device__ __forceinline__ float bf2f(unsigned b) { return __builtin_bit_cast(float, b << 16); }
__device__ __forceinline__ float bflo(unsigned w) { return __builtin_bit_cast(float, w << 16); }
__device__ __forceinline__ float bfhi(unsigned w) { return __builtin_bit_cast(float, w & 0xffff0000u); }
__device__ __forceinline__ float sigmoidf_(float x) { return 1.0f / (1.0f + __expf(-x)); }
__device__ __forceinline__ float siluf_(float x) { return x / (1.0f + __expf(-x)); }
__device__ __forceinline__ float wave_sum(float v) {
#pragma unroll
    for (int o = 1; o < 64; o <<= 1) v += __shfl_xor(v, o);
    return v;
}
__device__ __forceinline__ int seq_of(int m) { return m < MP ? m / SEQ : NB + (m - MP) / DEC_SEQ; }
namespace pg8 {
typedef unsigned short bf16_t;
constexpr int BM = 256, BK = 64, HALF = 128, HTB = HALF * BK * 2, STAGE_BYTES = 8 * HTB, NXCD = 8, WGM = 8;
__host__ __device__ __forceinline__ int lds_byte(int r, int c) { const int st = (r >> 4) * 2 + (c >> 5), rr = r & 15, cc = c & 31, ob = rr * 64 + cc * 2; return st * 1024 + (ob ^ (((ob >> 9) & 1) << 5)); }
__host__ __device__ __forceinline__ void stage_rc(int b, int& R, int& C) { const int st = b / 1024, sb = b % 1024, swz = sb ^ (((sb >> 9) & 1) << 5); R = (st >> 1) * 16 + swz / 64; C = (st & 1) * 32 + (swz % 64) / 2; }
__host__ __device__ __forceinline__ int perm32(int rho) { const int n = rho >> 4, i = rho & 15; return 8 * (i >> 2) + 4 * n + (i & 3); }
struct Unit { int pm, pn, ka, aux; };
struct NoState {};
struct Gemm { const bf16_t* A; const bf16_t* Bt; int lda, K; };
struct GridOrder {
    int nM, nN, nwg, G, c, pn0;
    __host__ __device__ void init(int nM_, int nN_, int G_, int c_, int pn0_ = 0) { nM = nM_; nN = nN_; nwg = nM * nN; G = G_; c = c_; pn0 = pn0_; }
    __host__ __device__ bool tile(long L, int& pm, int& pn) const {
        if (L >= nwg) return false;
        int wgid = (int)L; { const int q = nwg / NXCD, r = nwg % NXCD, xcd = wgid % NXCD, off = wgid / NXCD; wgid = (xcd < r ? xcd * (q + 1) : r * (q + 1) + (xcd - r) * q) + off; }
        const int nig = WGM * nN, gid = wgid / nig, fm = gid * WGM, gsz = (nM - fm) < WGM ? (nM - fm) : WGM;
        pm = fm + ((wgid % nig) % gsz); pn = (wgid % nig) / gsz; return true;
    }
    __host__ __device__ bool next(int i, Unit& u) const { int pm, pn; if (!tile((long)i * G + c, pm, pn)) return false; u.pm = pm; u.pn = pn0 + pn; u.ka = 0; u.aux = pn; return true; }
    __device__ __forceinline__ void a_ready(const Unit&) const {}
    __device__ __forceinline__ void done(const Unit&) const {}
};
struct MergeOrder : GridOrder {
    __host__ __device__ bool next(int i, Unit& u) const { int pm, pc; if (!tile((long)(i >> 2) * G + c, pm, pc)) return false; const int n = i & 3; u.pm = pm; u.pn = 8 * n + pc; u.ka = 256 * n; u.aux = (n << 8) | pc; return true; }
};
#ifndef CPU_EMU
#define PG8_LAS __attribute__((address_space(3)))
template <class Epi, class Sched, bool ALIGN_EPI = false, bool SP2 = false, bool HALFN = false>
__device__ __forceinline__ void gemm_phase(PG8_LAS unsigned char* lds, const Gemm g, const Sched& S, const Epi& E) {
    int tid = threadIdx.x; asm volatile("" : "+v"(tid));
    const int wid = __builtin_amdgcn_readfirstlane(tid >> 6), lane = tid & 63, wr = wid >> 2, wc = wid & 3, fr = lane & 15, fq = lane >> 4;
    int K = g.K; asm volatile("" : "+s"(K));
    const int nt = K / BK, lda = g.lda;
    unsigned voffA[2], voffB[2];
#pragma unroll
    for (int i = 0; i < 2; ++i) { int R, C; stage_rc(tid * 16 + i * 8192, R, C); const int Rb = Epi::PERM ? ((R & ~31) + perm32(R & 31)) : R;
        voffA[i] = (unsigned)(R * lda + C) * 2u; voffB[i] = (unsigned)(Rb * K + C) * 2u; }
    const size_t kstep = (size_t)(BK * 2);
    const size_t hstepA = (size_t)HALF * lda * 2, hstepB = HALFN ? (size_t)0 : (size_t)HALF * K * 2;
    const size_t tstepA = 2 * hstepA, tstepB = HALFN ? (size_t)HALF * K * 2 : 2 * hstepB;
    const unsigned ldsw = (unsigned)wid * 1024u;
    const int aoff = lds_byte(wr * 64 + fr, fq * 8), boff = lds_byte(wc * 32 + fr, fq * 8);
#define PG8_SA(b, h) (((b) * 2 + (h)) * HTB)
#define PG8_SB(b, h) ((4 + (b) * 2 + (h)) * HTB)
#define PG8_STAGE(bufoff, gbase, voff) do { _Pragma("unroll") for (int _i = 0; _i < 2; ++_i) \
        __builtin_amdgcn_global_load_lds((const unsigned*)((const char*)(gbase) + (voff)[_i]), (PG8_LAS unsigned*)(lds + (bufoff) + ldsw + _i * 8192), 16, 0, 0); } while (0)
#define PG8_LDA(dst, b, h) do { _Pragma("unroll") for (int m = 0; m < 4; ++m) _Pragma("unroll") for (int k = 0; k < 2; ++k) dst[m][k] = *(const PG8_LAS bf16x8*)(lds + PG8_SA(b, h) + aoff + m * 2048 + k * 1024); } while (0)
#define PG8_LDB(dst, b, h) do { _Pragma("unroll") for (int n = 0; n < 2; ++n) _Pragma("unroll") for (int k = 0; k < 2; ++k) dst[n][k] = *(const PG8_LAS bf16x8*)(lds + PG8_SB(b, h) + boff + n * 2048 + k * 1024); } while (0)
#define PG8_MMA(ai, bj, At, Bt) do { __builtin_amdgcn_s_setprio(1); _Pragma("unroll") for (int m = 0; m < 4; ++m) _Pragma("unroll") for (int n = 0; n < 2; ++n) _Pragma("unroll") for (int k = 0; k < 2; ++k) \
        acc[ai][bj][m][n] = __builtin_amdgcn_mfma_f32_16x16x32_bf16(Bt[n][k], At[m][k], acc[ai][bj][m][n], 0, 0, 0); __builtin_amdgcn_s_setprio(0); } while (0)
#define PG8_WAIT_V(n) asm volatile("s_waitcnt vmcnt(" #n ")" ::: "memory")
#define PG8_WAIT_L(n) asm volatile("s_waitcnt lgkmcnt(" #n ")" ::: "memory")
#define PG8_BAR __builtin_amdgcn_s_barrier()
#define PG8_SCHED __builtin_amdgcn_sched_barrier(0)
    Unit cur, nxt; int ui = 0;
    if (!S.next(0, cur)) return;
    f32x4 acc[2][2][4][2];
    typename Epi::State est;
#pragma unroll
    for (int a = 0; a < 2; ++a)
#pragma unroll
        for (int b = 0; b < 2; ++b)
#pragma unroll
            for (int m = 0; m < 4; ++m)
#pragma unroll
                for (int n = 0; n < 2; ++n) acc[a][b][m][n] = (f32x4){0.f, 0.f, 0.f, 0.f};
    static_assert(!HALFN || SP2, "HALFN is written for the SP2 loop");
    bf16x8 At[4][2], B0[2][2], B1[2][2];
    const char* cA = (const char*)g.A + (size_t)cur.pm * tstepA + (size_t)cur.ka * 2; const char* cB = (const char*)g.Bt + (size_t)cur.pn * tstepB;
    S.a_ready(cur);
    if constexpr (SP2) {
        PG8_STAGE(PG8_SB(0, 0), cB, voffB); PG8_STAGE(PG8_SB(0, 1), cB + hstepB, voffB); PG8_STAGE(PG8_SA(0, 0), cA, voffA); PG8_STAGE(PG8_SA(0, 1), cA + hstepA, voffA);
        if (wr == 1) PG8_BAR;
        PG8_WAIT_V(2); PG8_BAR;
        PG8_STAGE(PG8_SB(1, 0), cB + kstep, voffB); PG8_STAGE(PG8_SA(1, 0), cA + kstep, voffA); PG8_STAGE(PG8_SB(1, 1), cB + hstepB + kstep, voffB);
        PG8_WAIT_V(6); PG8_BAR;
    } else {
        PG8_STAGE(PG8_SB(0, 0), cB, voffB); PG8_STAGE(PG8_SA(0, 0), cA, voffA); PG8_STAGE(PG8_SB(0, 1), cB + hstepB, voffB); PG8_STAGE(PG8_SA(0, 1), cA + hstepA, voffA);
        if (wr == 1) PG8_BAR;
        PG8_WAIT_V(4); PG8_BAR;
        PG8_STAGE(PG8_SB(1, 0), cB + kstep, voffB); PG8_STAGE(PG8_SA(1, 0), cA + kstep, voffA); PG8_STAGE(PG8_SB(1, 1), cB + hstepB + kstep, voffB);
        PG8_WAIT_V(6); PG8_BAR;
    }
    for (;;) {
        const bool has_next = S.next(ui + 1, nxt);
        const char* nA = has_next ? (const char*)g.A + (size_t)nxt.pm * tstepA + (size_t)nxt.ka * 2 : cA; const char* nB = has_next ? (const char*)g.Bt + (size_t)nxt.pn * tstepB : cB;
        for (int t = 0; t < nt; t += 2) {
            const bool last = (t == nt - 2);
            const char* a1 = cA + (size_t)(t + 1) * kstep;
            const char* a2 = last ? nA : cA + (size_t)(t + 2) * kstep; const char* b2 = last ? nB : cB + (size_t)(t + 2) * kstep;
            const char* a3 = a2 + kstep; const char* b3 = b2 + kstep;
            if (last && has_next) S.a_ready(nxt);
            if constexpr (SP2) {
            PG8_LDB(B0, 0, 0); if constexpr (!HALFN) PG8_LDB(B1, 0, 1); PG8_SCHED; PG8_LDA(At, 0, 0); PG8_STAGE(PG8_SA(1, 1), a1 + hstepA, voffA);
            PG8_WAIT_V(8); PG8_WAIT_L(0); PG8_BAR; PG8_MMA(0, 0, At, B0); if constexpr (!HALFN) PG8_MMA(0, 1, At, B1); PG8_BAR; PG8_SCHED;
            PG8_LDA(At, 0, 1); PG8_STAGE(PG8_SB(0, 0), b2, voffB); PG8_STAGE(PG8_SB(0, 1), b2 + hstepB, voffB); PG8_STAGE(PG8_SA(0, 0), a2, voffA);
            PG8_WAIT_V(8); PG8_WAIT_L(0); PG8_BAR; PG8_MMA(1, 0, At, B0); if constexpr (!HALFN) PG8_MMA(1, 1, At, B1); PG8_BAR; PG8_SCHED;
            PG8_LDB(B0, 1, 0); if constexpr (!HALFN) PG8_LDB(B1, 1, 1); PG8_SCHED; PG8_LDA(At, 1, 0); PG8_STAGE(PG8_SA(0, 1), a2 + hstepA, voffA);
            PG8_WAIT_V(8); PG8_WAIT_L(0); PG8_BAR; PG8_MMA(0, 0, At, B0); if constexpr (!HALFN) PG8_MMA(0, 1, At, B1); PG8_BAR; PG8_SCHED;
            PG8_LDA(At, 1, 1); PG8_STAGE(PG8_SB(1, 0), b3, voffB); PG8_STAGE(PG8_SB(1, 1), b3 + hstepB, voffB); PG8_STAGE(PG8_SA(1, 0), a3, voffA);
            PG8_WAIT_V(8); PG8_WAIT_L(0); PG8_BAR; PG8_MMA(1, 0, At, B0); if constexpr (!HALFN) PG8_MMA(1, 1, At, B1); PG8_BAR; PG8_SCHED;
            } else {
            PG8_LDB(B0, 0, 0); PG8_SCHED; PG8_LDA(At, 0, 0); PG8_STAGE(PG8_SA(1, 1), a1 + hstepA, voffA);
            PG8_WAIT_L(8); PG8_BAR; PG8_WAIT_L(0); PG8_MMA(0, 0, At, B0); PG8_BAR; PG8_SCHED;
            PG8_LDB(B1, 0, 1); PG8_STAGE(PG8_SB(0, 0), b2, voffB);
            PG8_BAR; PG8_WAIT_L(0); PG8_MMA(0, 1, At, B1); PG8_BAR;
            PG8_LDA(At, 0, 1); PG8_STAGE(PG8_SA(0, 0), a2, voffA);
            PG8_BAR; PG8_WAIT_L(0); PG8_MMA(1, 0, At, B0); PG8_BAR; PG8_SCHED;
            PG8_STAGE(PG8_SB(0, 1), b2 + hstepB, voffB);
            PG8_WAIT_V(6); PG8_BAR; PG8_MMA(1, 1, At, B1); PG8_BAR;
            PG8_LDB(B0, 1, 0); PG8_SCHED; PG8_LDA(At, 1, 0); PG8_STAGE(PG8_SA(0, 1), a2 + hstepA, voffA);
            PG8_WAIT_L(8); PG8_BAR; PG8_WAIT_L(0); PG8_MMA(0, 0, At, B0); PG8_BAR; PG8_SCHED;
            PG8_LDB(B1, 1, 1); PG8_STAGE(PG8_SB(1, 0), b3, voffB);
            PG8_BAR; PG8_WAIT_L(0); PG8_MMA(0, 1, At, B1); PG8_BAR;
            PG8_LDA(At, 1, 1); PG8_STAGE(PG8_SA(1, 0), a3, voffA);
            PG8_BAR; PG8_WAIT_L(0); PG8_MMA(1, 0, At, B0); PG8_BAR; PG8_SCHED;
            PG8_STAGE(PG8_SB(1, 1), b3 + hstepB, voffB);
            PG8_WAIT_V(6); PG8_BAR; PG8_MMA(1, 1, At, B1); PG8_BAR;
            }
        }
        if constexpr (ALIGN_EPI) { if (wr == 0) PG8_BAR; }
        E(acc, est, cur, wr, wc, fr, fq); S.done(cur);
        if (!has_next) break;
#pragma unroll
        for (int a = 0; a < 2; ++a)
#pragma unroll
            for (int b = 0; b < 2; ++b)
#pragma unroll
                for (int m = 0; m < 4; ++m)
#pragma unroll
                    for (int n = 0; n < 2; ++n) acc[a][b][m][n] = (f32x4){0.f, 0.f, 0.f, 0.f};
        cur = nxt; cA = nA; cB = nB; ++ui;
        if constexpr (ALIGN_EPI) { if (wr == 1) PG8_BAR; }
    }
    PG8_WAIT_V(0);
    if constexpr (!ALIGN_EPI) { if (wr == 0) PG8_BAR; }
    PG8_BAR;
#undef PG8_SA
#undef PG8_SB
#undef PG8_STAGE
#undef PG8_LDA
#undef PG8_LDB
#undef PG8_MMA
#undef PG8_WAIT_V
#undef PG8_WAIT_L
#undef PG8_BAR
#undef PG8_SCHED
}
#else
template <class Epi, class Sched, bool ALIGN_EPI = false, bool SP2 = false, bool HALFN = false>
void gemm_phase(unsigned char* lds, const Gemm g, const Sched& S, const Epi& E) {
    const int tid = threadIdx.x, wid = tid >> 6, lane = tid & 63, wr = wid >> 2, wc = wid & 3, fr = lane & 15, fq = lane >> 4;
    static thread_local float* Ct = nullptr; static thread_local float* Af = nullptr; static thread_local float* Bf = nullptr;
    Unit u; typename Epi::State est;
    for (int i = 0; S.next(i, u); ++i) {
        S.a_ready(u);
        __syncthreads();
        if (tid == 0) {
            if (!Ct) { Ct = new float[256 * 256]; Af = new float[256 * 4096]; Bf = new float[256 * 4096]; }
            const int K = g.K;
            for (int r = 0; r < 256; ++r) for (int k = 0; k < K; ++k) { Af[r * K + k] = bf2f(g.A[(size_t)(u.pm * 256 + r) * g.lda + u.ka + k]); Bf[r * K + k] = HALFN ? (r < 128 ? bf2f(g.Bt[(size_t)(u.pn * 128 + r) * K + k]) : 0.f) : bf2f(g.Bt[(size_t)(u.pn * 256 + r) * K + k]); }
            for (int r = 0; r < 256; ++r) for (int c = 0; c < 256; ++c) { float s = 0.f; const float* a = Af + r * K; const float* b = Bf + c * K; for (int k = 0; k < K; ++k) s += a[k] * b[k]; Ct[r * 256 + c] = s; }
        }
        __syncthreads();
        f32x4 acc[2][2][4][2];
        for (int ai = 0; ai < 2; ++ai) for (int bj = 0; bj < 2; ++bj) for (int m = 0; m < 4; ++m) for (int n = 0; n < 2; ++n) for (int e = 0; e < 4; ++e) {
            const int r = 128 * ai + 64 * wr + 16 * m + fr; const int c = Epi::PERM ? (128 * bj + 32 * wc + 8 * fq + 4 * n + e) : (128 * bj + 32 * wc + 16 * n + 4 * fq + e);
            acc[ai][bj][m][n][e] = Ct[r * 256 + c]; }
        E(acc, est, u, wr, wc, fr, fq); S.done(u);
    }
    __syncthreads();
}
#endif
}
namespace pg8 {
struct EpiMod {
    static constexpr bool PERM = false; typedef NoState State;
    float* C; const float* bias;
    __device__ __forceinline__ void operator()(const f32x4 (&acc)[2][2][4][2], State& st, const Unit& u, int wr, int wc, int fr_in, int fq_in) const {
        int fr = fr_in, fq = fq_in; OPAQUE_V(fr); OPAQUE_V(fq);
        const int row0 = wr * 64 + fr, col0 = u.aux * BM + wc * 32 + 4 * fq;
#pragma unroll
        for (int ai = 0; ai < 2; ++ai)
#pragma unroll
            for (int m = 0; m < 4; ++m) { float* rowp = C + (size_t)(row0 + ai * HALF + m * 16) * NMOD + col0;
#pragma unroll
                for (int bj = 0; bj < 2; ++bj)
#pragma unroll
                    for (int n = 0; n < 2; ++n) *(f32x4*)(rowp + bj * HALF + n * 16) = acc[ai][bj][m][n] + *(const f32x4*)(bias + col0 + bj * HALF + n * 16); }
    }
};
struct EpiProj {
    static constexpr bool PERM = true; typedef NoState State;
    bf16* proj; bf16* gate; float* outk_p; float* outv_p; float* outk_s; float* outv_s;
    __device__ __forceinline__ void operator()(const f32x4 (&acc)[2][2][4][2], State& st, const Unit& u, int wr, int wc, int fr_in, int fq_in) const {
        int fr = fr_in, fq = fq_in; OPAQUE_V(fr); OPAQUE_V(fq);
        const int t = u.aux; const bool isg = t >= 11;
        const int row0 = u.pm * BM + wr * 64 + fr, colt = wc * 32 + 8 * fq;
        bf16* base = isg ? gate + (size_t)(t - 11) * 256 : proj + (size_t)t * 256; const int ldc = isg ? NGATE : NPROJ;
#pragma unroll
        for (int ai = 0; ai < 2; ++ai)
#pragma unroll
            for (int m = 0; m < 4; ++m) { const int row = row0 + ai * HALF + m * 16; bf16* rowp = base + (size_t)row * ldc + colt;
#pragma unroll
                for (int bj = 0; bj < 2; ++bj) { f32x4 v0 = acc[ai][bj][m][0], v1 = acc[ai][bj][m][1];
                    if (isg) {
#pragma unroll
                        for (int e = 0; e < 4; ++e) { v0[e] = sigmoidf_(v0[e]); v1[e] = sigmoidf_(v1[e]); } }
                    else if (t >= 9) { float* o = (row < MP) ? ((t == 9 ? outk_p : outv_p) + (size_t)row * 256) : ((t == 9 ? outk_s : outv_s) + (size_t)(row - MP) * 256);
                        *(f32x4*)(o + colt + bj * HALF) = v0; *(f32x4*)(o + colt + bj * HALF + 4) = v1; }
                    v4u w; w.x = pk2(v0[0], v0[1]); w.y = pk2(v0[2], v0[3]); w.z = pk2(v1[0], v1[1]); w.w = pk2(v1[2], v1[3]);
                    *(v4u*)(rowp + bj * HALF) = w; } }
    }
};
struct EpiGlu {
    static constexpr bool PERM = true; typedef NoState State;
    const bf16* ys; bf16* y;
    __device__ __forceinline__ void operator()(const f32x4 (&acc)[2][2][4][2], State& st, const Unit& u, int wr, int wc, int fr_in, int fq_in) const {
        int fr = fr_in, fq = fq_in; OPAQUE_V(fr); OPAQUE_V(fq);
        const int row0 = u.pm * BM + wr * 64 + fr, colt = wc * 32 + 8 * fq;
#pragma unroll
        for (int ai = 0; ai < 2; ++ai)
#pragma unroll
            for (int m = 0; m < 4; ++m) { const int row = row0 + ai * HALF + m * 16;
#pragma unroll
                for (int bj = 0; bj < 2; ++bj) { const f32x4 v0 = acc[ai][bj][m][0], v1 = acc[ai][bj][m][1];
                    const v4u s = *(const v4u*)(ys + (size_t)row * 256 + colt + bj * HALF);
                    v4u w; w.x = pk2(bflo(s.x) * sigmoidf_(v0[0]), bfhi(s.x) * sigmoidf_(v0[1])); w.y = pk2(bflo(s.y) * sigmoidf_(v0[2]), bfhi(s.y) * sigmoidf_(v0[3]));
                    w.z = pk2(bflo(s.z) * sigmoidf_(v1[0]), bfhi(s.z) * sigmoidf_(v1[1])); w.w = pk2(bflo(s.w) * sigmoidf_(v1[2]), bfhi(s.w) * sigmoidf_(v1[3]));
                    *(v4u*)(y + (size_t)row * D + colt + bj * HALF) = w; } CFENCE(); }
    }
};
struct EpiMerge {
    static constexpr bool PERM = false; struct State { f32x4 macc[2][4][2]; };
    const bf16* gate; bf16* mgb;
    __device__ __forceinline__ void operator()(const f32x4 (&acc)[2][2][4][2], State& st, const Unit& u, int wr, int wc, int fr_in, int fq_in) const {
        int fr = fr_in, fq = fq_in; OPAQUE_V(fr); OPAQUE_V(fq);
        const int n_ = u.aux >> 8, pc = u.aux & 255;
        const int row0 = u.pm * BM + wr * 64 + fr, col0 = pc * HALF + wc * 32 + 4 * fq;
        v2u gw[2][4][2];
#pragma unroll
        for (int ai = 0; ai < 2; ++ai)
#pragma unroll
            for (int m = 0; m < 4; ++m)
#pragma unroll
                for (int n = 0; n < 2; ++n) gw[ai][m][n] = *(const v2u*)(gate + (size_t)(row0 + ai * HALF + m * 16) * NGATE + n_ * D + col0 + n * 16);
        CFENCE();
#pragma unroll
        for (int ai = 0; ai < 2; ++ai)
#pragma unroll
            for (int m = 0; m < 4; ++m) { const int row = row0 + ai * HALF + m * 16;
#pragma unroll
                for (int n = 0; n < 2; ++n) { const int col = col0 + n * 16; const v2u g2 = gw[ai][m][n];
                    f32x4 v = acc[ai][0][m][n]; v[0] *= bflo(g2.x); v[1] *= bfhi(g2.x); v[2] *= bflo(g2.y); v[3] *= bfhi(g2.y);
                    if (n_ > 0) v += st.macc[ai][m][n];
                    st.macc[ai][m][n] = v;
                    if (n_ == 3) { v2u o; o.x = pk2(v[0], v[1]); o.y = pk2(v[2], v[3]); *(v2u*)(mgb + (size_t)row * D + col) = o; } } }
    }
};
struct EpiRes {
    static constexpr bool PERM = false; typedef NoState State;
    const float* xP; const float* xS; const float* gmod; float* out;
    __device__ __forceinline__ void operator()(const f32x4 (&acc)[2][2][4][2], State& st, const Unit& u, int wr, int wc, int fr_in, int fq_in) const {
        int fr = fr_in, fq = fq_in; OPAQUE_V(fr); OPAQUE_V(fq);
        const int row0 = u.pm * BM + wr * 64 + fr, col0 = u.aux * BM + wc * 32 + 4 * fq;
#pragma unroll
        for (int ai = 0; ai < 2; ++ai)
#pragma unroll
            for (int m = 0; m < 4; ++m) { const int row = row0 + ai * HALF + m * 16; const float* xr = row < MP ? xP + (size_t)row * D : xS + (size_t)(row - MP) * D;
                const float* gr = gmod + (size_t)seq_of(row) * NMOD;
#pragma unroll
                for (int bj = 0; bj < 2; ++bj)
#pragma unroll
                    for (int n = 0; n < 2; ++n) { const int col = col0 + bj * HALF + n * 16;
                        const f32x4 xv = *(const f32x4*)(xr + col), gv = *(const f32x4*)(gr + col);
                        *(f32x4*)(out + (size_t)row * D + col) = xv * ALPHA + (gv + 1.0f) * acc[ai][bj][m][n]; } CFENCE(); }
    }
};
struct EpiUp {
    static constexpr bool PERM = true; typedef NoState State;
    bf16* act;
    __device__ __forceinline__ void operator()(const f32x4 (&acc)[2][2][4][2], State& st, const Unit& u, int wr, int wc, int fr_in, int fq_in) const {
        int fr = fr_in, fq = fq_in; OPAQUE_V(fr); OPAQUE_V(fq);
        const int row0 = u.pm * BM + wr * 64 + fr, col0 = u.aux * HALF + wc * 32 + 8 * fq;
#pragma unroll
        for (int ai = 0; ai < 2; ++ai)
#pragma unroll
            for (int m = 0; m < 4; ++m) { const int row = row0 + ai * HALF + m * 16;
                const f32x4 a0 = acc[ai][0][m][0], a1 = acc[ai][0][m][1], b0 = acc[ai][1][m][0], b1 = acc[ai][1][m][1];
                v4u w; w.x = pk2(siluf_(a0[0]) * b0[0], siluf_(a0[1]) * b0[1]); w.y = pk2(siluf_(a0[2]) * b0[2], siluf_(a0[3]) * b0[3]);
                w.z = pk2(siluf_(a1[0]) * b1[0], siluf_(a1[1]) * b1[1]); w.w = pk2(siluf_(a1[2]) * b1[2], siluf_(a1[3]) * b1[3]);
                *(v4u*)(act + (size_t)row * DFF + col0) = w; }
    }
};
}
struct Args { const float* in[38]; float* out; unsigned char* ws; int ph_lo, ph_hi, li, pad; };
enum { I_XP = 0, I_XS, I_CK, I_CV, I_SRE, I_SIM, I_SCB, I_SD, I_SCD, I_PT, I_CP, I_CS, I_WADA, I_BADA, I_WIN, I_ARE, I_AIM, I_LDT, I_BRE, I_BIM, I_CRE, I_CIM, I_SSD, I_WGLU,
       I_CBW, I_DCW, I_DAL, I_DDT, I_DNW, I_WBR, I_WGATE, I_WO, I_L1G, I_L1B, I_WUP, I_WDN, I_L2G, I_L2B };
constexpr int NWAVES = 8, RING_BYTES = 131072, MISC_OFF = RING_BYTES, LDS_BYTES = 147456;
#ifndef CPU_EMU
#define XB_TMO      128
#define XB_XCNT(j)  (256  + 64 * (j))
#define XB_XSUB(j)  (1280 + 64 * (j))
#define XB_XGEN(j)  (2304 + 64 * (j))
#define XB_TOP      3328
#define XB_TOPGEN   3392
#define XCD_BAR_WORDS 3456
#define XB_SPIN_CAP (1u << 18)
__device__ __forceinline__ unsigned xb_ld(unsigned* p)              { return __hip_atomic_load(p, __ATOMIC_RELAXED, __HIP_MEMORY_SCOPE_AGENT); }
__device__ __forceinline__ unsigned xb_add(unsigned* p, unsigned v) { return __hip_atomic_fetch_add(p, v, __ATOMIC_RELAXED, __HIP_MEMORY_SCOPE_AGENT); }
__device__ __forceinline__ unsigned xb_xcc_id() { return (unsigned)__builtin_amdgcn_s_getreg((3 << 11) | 20) & 0xFu; }
#define XB_SPIN(cond, bar) do { unsigned _sp = 0; while (cond) { __builtin_amdgcn_s_sleep(1); \
    if ((++_sp & 255u) == 0u) { if (xb_ld(&(bar)[XB_TMO])) break; if (_sp > XB_SPIN_CAP) { atomicAdd(&(bar)[XB_TMO], 1u); break; } } } } while (0)
struct XcdBarrier { unsigned* bar; unsigned x; volatile LAS_HW unsigned* st; };
__device__ __forceinline__ XcdBarrier xcd_barrier_post(unsigned* bar, volatile LAS_HW unsigned* st) {
    XcdBarrier b; b.bar = bar; b.x = xb_xcc_id(); b.st = st;
    if (threadIdx.x == 0) (void)xb_add(&bar[XB_XCNT(b.x)], 1u);
    return b;
}
__device__ __forceinline__ void xcd_barrier_complete(unsigned* bar, unsigned x, unsigned& nloc, unsigned& nx) {
    const unsigned G = gridDim.x * gridDim.y * gridDim.z;
    unsigned sum, cnt, mine, sp = 0u;
    for (;;) {
        sum = 0u; cnt = 0u; mine = 0u;
#pragma unroll
        for (unsigned j = 0; j < 16; ++j) { const unsigned c = xb_ld(&bar[XB_XCNT(j)]); sum += c; cnt += (c > 0u) ? 1u : 0u; mine = (j == x) ? c : mine; }
        if (sum == G) break;
        __builtin_amdgcn_s_sleep(1);
        if ((++sp & 255u) == 0u) { if (xb_ld(&bar[XB_TMO])) break; if (sp > XB_SPIN_CAP) { atomicAdd(&bar[XB_TMO], 1u); break; } }
    }
    nloc = mine > 0u ? mine : 1u; nx = cnt > 0u ? cnt : 1u;
}
__device__ __forceinline__ void xcd_barrier(const XcdBarrier& b) {
    asm volatile("s_waitcnt vmcnt(0)" ::: "memory");
    __syncthreads();
    if (threadIdx.x == 0) {
        unsigned* bar = b.bar;
        __builtin_amdgcn_s_waitcnt(0);
        unsigned nloc = b.st[0], nx = b.st[1];
        if (nloc == 0u) { xcd_barrier_complete(bar, b.x, nloc, nx); b.st[0] = nloc; b.st[1] = nx; }
        const unsigned old = xb_add(&bar[XB_XSUB(b.x)], 1u);
        const unsigned gen = old / nloc;
        if (old + 1u == (gen + 1u) * nloc) {
            __builtin_amdgcn_fence(__ATOMIC_RELEASE, "agent");
            asm volatile("s_waitcnt vmcnt(0)" ::: "memory");
            const unsigned og = xb_add(&bar[XB_TOP], 1u);
            const unsigned tg = og / nx;
            if (og + 1u == (tg + 1u) * nx) xb_add(&bar[XB_TOPGEN], 1u);
            else XB_SPIN(xb_ld(&bar[XB_TOPGEN]) == tg, bar);
            __builtin_amdgcn_fence(__ATOMIC_ACQUIRE, "agent");
            xb_add(&bar[XB_XGEN(b.x)], 1u);
            asm volatile("s_waitcnt vmcnt(0)" ::: "memory");
        } else {
            XB_SPIN(xb_ld(&bar[XB_XGEN(b.x)]) == gen, bar);
            __builtin_amdgcn_fence(__ATOMIC_ACQUIRE, "agent");
            asm volatile("s_waitcnt vmcnt(0)" ::: "memory");
        }
    }
    __syncthreads();
}
#else
#define XCD_BAR_WORDS 3456
struct XcdBarrier { int dummy; };
inline void xcd_barrier(const XcdBarrier&) { emu::grid_sync(); }
#endif

#define TIDS int tid_ = threadIdx.x; OPAQUE_V(tid_); const int tid = tid_, lane = tid & 63, wave = __builtin_amdgcn_readfirstlane(tid >> 6), G = gridDim.x, bid = blockIdx.x, gw = bid * NWAVES + wave, NGW = G * NWAVES; (void)lane; (void)wave; (void)gw; (void)NGW; (void)G; (void)bid
__device__ __forceinline__ bf16* wsb(const Args& A, size_t off) { return (bf16*)(A.ws + off); }
__device__ __forceinline__ float* wsf(const Args& A, size_t off) { return (float*)(A.ws + off); }
__device__ __forceinline__ float softplusf_(float x) { return fmaxf(x, 0.f) + log1pf(__expf(-fabsf(x))); }
__device__ __forceinline__ void tr_item(const float* W, int N, int K, int k0, int c0, bf16* WT, int drow0, LAS float* scr, int lane) {
#pragma unroll 8
    for (int i = 0; i < 32; ++i) { const int kk = 2 * i + (lane >> 5); scr[kk * 33 + (lane & 31)] = W[(size_t)(k0 + kk) * N + c0 + (lane & 31)]; }
    WAVE_SYNC();
    const int c = lane & 7;
#pragma unroll
    for (int j = 0; j < 4; ++j) { const int n = (lane >> 3) + 8 * j; const LAS float* s = scr + (8 * c) * 33 + n;
        v4u o; o.x = pk2(s[0 * 33], s[1 * 33]); o.y = pk2(s[2 * 33], s[3 * 33]); o.z = pk2(s[4 * 33], s[5 * 33]); o.w = pk2(s[6 * 33], s[7 * 33]);
        *(v4u*)(WT + (size_t)(drow0 + n) * K + k0 + 8 * c) = o; }
    WAVE_SYNC();
}
__device__ __forceinline__ void ph_prologue(const Args& A, LAS unsigned char* lds) {
    TIDS;
    LAS float* scr = (LAS float*)(lds + wave * 16384);
    constexpr int I_ADA = 16 * 192, I_IN1 = 16 * 64, I_IN2 = 16 * 24, I_GT = 16 * 128, I_GLU = 4 * 8, I_BR = 4 * 4 * 32, I_WO_ = 16 * 32, I_UP = 16 * 176, I_DN = 44 * 32;
    constexpr int PER_L = I_ADA + I_IN1 + I_IN2 + I_GT + I_GLU + I_BR + I_WO_ + I_UP + I_DN;
    for (int it = gw; it < DEPTH * PER_L; it += NGW) {
        const int l = it / PER_L; int r = it % PER_L; unsigned char* wl = A.ws + WS_W + (size_t)l * WL_SIZE;
        if (r < I_ADA) { const int kb = r / 192, nb = r % 192; tr_item(A.in[I_WADA] + (size_t)l * D * NMOD, NMOD, D, kb * 64, nb * 32, (bf16*)(wl + WL_ADA), nb * 32, scr, lane); continue; } r -= I_ADA;
        if (r < I_IN1) { const int kb = r / 64, nb = r % 64; tr_item(A.in[I_WIN] + (size_t)l * D * NIN, NIN, D, kb * 64, nb * 32, (bf16*)(wl + WL_W1), nb * 32, scr, lane); continue; } r -= I_IN1;
        if (r < I_IN2) { const int kb = r / 24, nb = r % 24; tr_item(A.in[I_WIN] + (size_t)l * D * NIN, NIN, D, kb * 64, 2056 + nb * 32, (bf16*)(wl + WL_W1), 2048 + nb * 32, scr, lane); continue; } r -= I_IN2;
        if (r < I_GT) { const int kb = r / 128, nb = r % 128; tr_item(A.in[I_WGATE] + (size_t)l * D * NGATE, NGATE, D, kb * 64, nb * 32, (bf16*)(wl + WL_W1), NPROJ + nb * 32, scr, lane); continue; } r -= I_GT;
        if (r < I_GLU) { const int kb = r / 8, nb = r % 8; tr_item(A.in[I_WGLU] + (size_t)l * 256 * 256, 256, 256, kb * 64, nb * 32, (bf16*)(wl + WL_GLU), nb * 32, scr, lane); continue; } r -= I_GLU;
        if (r < I_BR) { const int n = r / 128, r2 = r % 128, kb = r2 / 32, nb = r2 % 32; tr_item(A.in[I_WBR] + (size_t)(l * 4 + n) * 256 * D, D, 256, kb * 64, nb * 32, (bf16*)(wl + WL_BR), n * D + nb * 32, scr, lane); continue; } r -= I_BR;
        if (r < I_WO_) { const int kb = r / 32, nb = r % 32; tr_item(A.in[I_WO] + (size_t)l * D * D, D, D, kb * 64, nb * 32, (bf16*)(wl + WL_WO), nb * 32, scr, lane); continue; } r -= I_WO_;
        if (r < I_UP) { const int kb = r / 176, nb = r % 176; const int c0 = nb * 32, j = c0 < DFF ? c0 : c0 - DFF; const int drow = (j / 128) * 256 + (c0 < DFF ? 0 : 128) + (j % 128);
            tr_item(A.in[I_WUP] + (size_t)l * D * NUP, NUP, D, kb * 64, c0, (bf16*)(wl + WL_UP), drow, scr, lane); continue; } r -= I_UP;
        { const int kb = r / 32, nb = r % 32; tr_item(A.in[I_WDN] + (size_t)l * DFF * D, D, DFF, kb * 64, nb * 32, (bf16*)(wl + WL_DN), nb * 32, scr, lane); }
    }
    const int gt = bid * (NWAVES * 64) + tid, NGT = G * NWAVES * 64;
    for (int i = gt; i < DEPTH * 8 * D; i += NGT) { const int l = i / (8 * D), j = (i / D) % 8, k = i % D; ((float*)(A.ws + WS_W + (size_t)l * WL_SIZE + WL_LOG))[j * D + k] = A.in[I_WIN][((size_t)l * D + k) * NIN + 2048 + j]; }
    for (int i = gt; i < 256 * D; i += NGT) { const int r = i / D, k = i % D; float v = 0.f;
        if (r < NB) v = siluf_(A.in[I_CP][r * D + k]); else if (r < NSEQ) v = siluf_(A.in[I_CS][(r - NB) * D + k]);
        wsb(A, WS_CSILU)[i] = (bf16)f2bf(v); }
}
struct ModOrder {
    int G, c;
    __host__ __device__ bool next(int i, pg8::Unit& u) const { const int L = i * G + c; if (L >= 24 * DEPTH) return false; const int l = L / 24, pn = L % 24;
        u.pm = 0; u.pn = l * (int)(WL_SIZE / (512 * 1024)) + pn; u.ka = 0; u.aux = pn | (l << 8); return true; }
    __device__ __forceinline__ void a_ready(const pg8::Unit&) const {}
    __device__ __forceinline__ void done(const pg8::Unit&) const {}
};
struct EpiMod2 { static constexpr bool PERM = false; typedef pg8::NoState State; float* C; const float* bias;
    __device__ __forceinline__ void operator()(const f32x4 (&acc)[2][2][4][2], State& st, const pg8::Unit& u, int wr, int wc, int fr, int fq) const {
        const int l = u.aux >> 8; pg8::Unit u2 = u; u2.aux = u.aux & 255; pg8::EpiMod e{C + (size_t)l * 256 * NMOD, bias + (size_t)l * NMOD}; e(acc, st, u2, wr, wc, fr, fq); } };
template <int MODE> __device__ __forceinline__ void ph_rows(const Args& A, int l) {
    TIDS;
    const float* MOD = wsf(A, WS_MOD);
    for (int m = gw; m < M; m += NGW) {
        const float* src; float* dstx = nullptr;
        if (MODE == 0) src = m < MP ? A.in[I_XP] + (size_t)m * D : A.in[I_XS] + (size_t)(m - MP) * D;
        else if (MODE == 1) { src = wsf(A, WS_X1) + (size_t)m * D; dstx = wsf(A, WS_X1) + (size_t)m * D; }
        else { src = wsf(A, WS_X2) + (size_t)m * D; dstx = (l == DEPTH - 1) ? A.out + O_Y + (size_t)m * D : wsf(A, WS_X2) + (size_t)m * D; }
        f32x4 v[4];
#pragma unroll
        for (int j = 0; j < 4; ++j) v[j] = ((const f32x4*)src)[lane + 64 * j];
        if (MODE != 0) {
            float s = 0.f;
#pragma unroll
            for (int j = 0; j < 4; ++j) s += (v[j][0] + v[j][1]) + (v[j][2] + v[j][3]);
            const float mean = wave_sum(s) * (1.f / D); float s2 = 0.f;
#pragma unroll
            for (int j = 0; j < 4; ++j) { v[j] = v[j] - mean; s2 += (v[j][0] * v[j][0] + v[j][1] * v[j][1]) + (v[j][2] * v[j][2] + v[j][3] * v[j][3]); }
            const float rstd = 1.f / sqrtf(wave_sum(s2) * (1.f / D) + LN_EPS);
            const float* gp = A.in[MODE == 1 ? I_L1G : I_L2G] + (size_t)l * D; const float* bp = A.in[MODE == 1 ? I_L1B : I_L2B] + (size_t)l * D;
#pragma unroll
            for (int j = 0; j < 4; ++j) { const f32x4 g = ((const f32x4*)gp)[lane + 64 * j], b = ((const f32x4*)bp)[lane + 64 * j]; v[j] = v[j] * rstd * g + b; ((f32x4*)dstx)[lane + 64 * j] = v[j]; }
            if (MODE == 2 && l == DEPTH - 1) continue;
        }
        const int ln = (MODE == 2) ? l + 1 : l;
        const float* mr = MOD + ((size_t)ln * 256 + seq_of(m)) * NMOD + (MODE == 1 ? 3 * D : 0);
        float s = 0.f;
#pragma unroll
        for (int j = 0; j < 4; ++j) s += (v[j][0] + v[j][1]) + (v[j][2] + v[j][3]);
        const float mean = wave_sum(s) * (1.f / D); float s2 = 0.f;
#pragma unroll
        for (int j = 0; j < 4; ++j) { v[j] = v[j] - mean; s2 += (v[j][0] * v[j][0] + v[j][1] * v[j][1]) + (v[j][2] * v[j][2] + v[j][3] * v[j][3]); }
        const float rstd = 1.f / sqrtf(wave_sum(s2) * (1.f / D) + LN_EPS);
        v2u* hrow = (v2u*)(wsb(A, WS_H) + (size_t)m * D);
#pragma unroll
        for (int j = 0; j < 4; ++j) { const f32x4 sh = ((const f32x4*)mr)[lane + 64 * j], sc = ((const f32x4*)(mr + D))[lane + 64 * j]; v[j] = v[j] * rstd * (sc + 1.0f) + sh;
            v2u o; o.x = pk2(v[j][0], v[j][1]); o.y = pk2(v[j][2], v[j][3]); hrow[lane + 64 * j] = o; }
        if (MODE != 1) {
            const float* wl = (const float*)(A.ws + WS_W + (size_t)ln * WL_SIZE + WL_LOG);
            float lg[8];
#pragma unroll
            for (int jj = 0; jj < 8; ++jj) { float t = 0.f;
#pragma unroll
                for (int j = 0; j < 4; ++j) { const f32x4 w = ((const f32x4*)(wl + jj * D))[lane + 64 * j]; t += (v[j][0] * w[0] + v[j][1] * w[1]) + (v[j][2] * w[2] + v[j][3] * w[3]); }
                lg[jj] = wave_sum(t); }
            if (lane == 0) { float* o = wsf(A, WS_LOG8) + (size_t)m * 8; *(f32x4*)o = (f32x4){lg[0], lg[1], lg[2], lg[3]}; *(f32x4*)(o + 4) = (f32x4){lg[4], lg[5], lg[6], lg[7]}; }
        }
    }
}
struct SsmC { float abr, abi, bbr[16], bbi[16]; };
__device__ __forceinline__ void ssm_consts(const Args& A, int l, int g, int p, SsmC& c) {
    const int gi = l * 16 + g;
    const float dt = expf(A.in[I_LDT][gi]), ar = A.in[I_ARE][gi * 64 + p], ai = A.in[I_AIM][gi * 64 + p];
    const float mag = expf(dt * ar); c.abr = mag * cosf(dt * ai); c.abi = mag * sinf(dt * ai);
    const float den = ar * ar + ai * ai, fre = ((c.abr - 1.0f) * ar + c.abi * ai) / den, fim = (c.abi * ar - (c.abr - 1.0f) * ai) / den;
    const f32x4* br = (const f32x4*)(A.in[I_BRE] + (size_t)(gi * 64 + p) * 16); const f32x4* bi = (const f32x4*)(A.in[I_BIM] + (size_t)(gi * 64 + p) * 16);
#pragma unroll
    for (int q = 0; q < 4; ++q) { const f32x4 r = br[q], i = bi[q];
#pragma unroll
        for (int e = 0; e < 4; ++e) { c.bbr[4 * q + e] = fre * r[e] - fim * i[e]; c.bbi[4 * q + e] = fre * i[e] + fim * r[e]; } }
}
__device__ __forceinline__ void ssm_step(const SsmC& c, const bf16* urow, float& hr, float& hi) {
    const v4u u0 = *(const v4u*)urow, u1 = *(const v4u*)(urow + 8);
    float u[16] = {bflo(u0.x), bfhi(u0.x), bflo(u0.y), bfhi(u0.y), bflo(u0.z), bfhi(u0.z), bflo(u0.w), bfhi(u0.w), bflo(u1.x), bfhi(u1.x), bflo(u1.y), bfhi(u1.y), bflo(u1.z), bfhi(u1.z), bflo(u1.w), bfhi(u1.w)};
    float br = 0.f, bi = 0.f;
#pragma unroll
    for (int h = 0; h < 16; ++h) { br += c.bbr[h] * u[h]; bi += c.bbi[h] * u[h]; }
    const float nr = c.abr * hr - c.abi * hi + br, ni = c.abr * hi + c.abi * hr + bi; hr = nr; hi = ni;
}
__device__ __forceinline__ void ph_ssm1(const Args& A, int l) {
    TIDS;
    const bf16* proj = wsb(A, WS_PROJ);
    for (int un = gw; un < NB * 16 * SSM_NCH; un += NGW) {
        const int c = un % SSM_NCH, g = (un / SSM_NCH) % 16, b = un / (SSM_NCH * 16);
        SsmC k; ssm_consts(A, l, g, lane, k);
        float hr = 0.f, hi = 0.f;
        const bf16* up = proj + (size_t)(b * SEQ + c * SSM_CH) * NPROJ + PC_U + g * 16;
        for (int t = 0; t < SSM_CH; ++t) ssm_step(k, up + (size_t)t * NPROJ, hr, hi);
        float* o = wsf(A, WS_SEND) + (size_t)un * 128; o[lane] = hr; o[64 + lane] = hi;
    }
}
__device__ __forceinline__ void ph_ssm_carry(const Args& A, int l) {
    TIDS;
    const int gt = (G - 1 - bid) * (NWAVES * 64) + tid;
    if (gt < NB * 16 * 64) {
        const int p = gt & 63, g = (gt >> 6) & 15, b = gt >> 10; const int gi = l * 16 + g;
        const float dt = expf(A.in[I_LDT][gi]), ar = A.in[I_ARE][gi * 64 + p], ai = A.in[I_AIM][gi * 64 + p];
        const float mag = expf(dt * ar); float pr = mag * cosf(dt * ai), pi = mag * sinf(dt * ai);
        for (int s = 1; s < SSM_CH; s <<= 1) { const float nr = pr * pr - pi * pi, ni = 2.f * pr * pi; pr = nr; pi = ni; }
        float cr = 0.f, ci = 0.f;
        for (int c = 0; c < SSM_NCH; ++c) { const size_t un = ((size_t)(b * 16 + g) * SSM_NCH + c) * 128;
            wsf(A, WS_HIN)[un + p] = cr; wsf(A, WS_HIN)[un + 64 + p] = ci;
            const float sr = wsf(A, WS_SEND)[un + p], si = wsf(A, WS_SEND)[un + 64 + p];
            const float nr = pr * cr - pi * ci + sr, ni = pr * ci + pi * cr + si; cr = nr; ci = ni; }
    }
}
__device__ __forceinline__ float gelu_tanh(float x) { const float t = tanhf(0.7978845608028654f * (x + 0.044715f * x * x * x)); return 0.5f * x * (1.0f + t); }
__device__ __forceinline__ void ph_ssm2(const Args& A, LAS unsigned char* lds, int l) {
    TIDS;
    LAS float* ct = (LAS float*)(lds + wave * 16384);
    LAS float* ht = ct + 2048;
    const bf16* proj = wsb(A, WS_PROJ);
    constexpr int NPU = NB * 16 * SSM_NCH, NSU = DB * 16;
    for (int un = gw; un < NPU + NSU; un += NGW) {
        int g, m0, ntok; float hr, hi; float* fre = nullptr; float* fim = nullptr;
        if (un < NPU) { const int c = un % SSM_NCH; g = (un / SSM_NCH) % 16; const int b = un / (SSM_NCH * 16); m0 = b * SEQ + c * SSM_CH; ntok = SSM_CH;
            hr = wsf(A, WS_HIN)[(size_t)un * 128 + lane]; hi = wsf(A, WS_HIN)[(size_t)un * 128 + 64 + lane];
            if (c == SSM_NCH - 1) { fre = A.out + O_REP + ((size_t)(l * NB + b) * 16 + g) * 64; fim = A.out + O_IMP + ((size_t)(l * NB + b) * 16 + g) * 64; } }
        else { const int su = un - NPU; g = su & 15; const int s = su >> 4; m0 = MP + s * DEC_SEQ; ntok = DEC_SEQ;
            hr = A.in[I_SRE][((size_t)(l * DB + s) * 16 + g) * 64 + lane]; hi = A.in[I_SIM][((size_t)(l * DB + s) * 16 + g) * 64 + lane];
            fre = A.out + O_RES + ((size_t)(l * DB + s) * 16 + g) * 64; fim = A.out + O_IMS + ((size_t)(l * DB + s) * 16 + g) * 64; }
        SsmC k; ssm_consts(A, l, g, lane, k);
        const int gi = l * 16 + g;
        for (int ch = 0; ch < 16; ++ch) { ct[lane * 16 + ch] = A.in[I_CRE][((size_t)gi * 16 + ch) * 64 + lane]; ct[1024 + lane * 16 + ch] = A.in[I_CIM][((size_t)gi * 16 + ch) * 64 + lane]; }
        const float dd = A.in[I_SSD][l * 256 + g * 16 + (lane & 15)];
        for (int t0 = 0; t0 < ntok; t0 += 16) {
            const int nt = (ntok - t0) < 16 ? (ntok - t0) : 16;
            for (int t = 0; t < nt; ++t) { ssm_step(k, proj + (size_t)(m0 + t0 + t) * NPROJ + PC_U + g * 16, hr, hi); ht[t * 64 + lane] = hr; ht[1024 + t * 64 + lane] = hi; }
            WAVE_SYNC();
            const int ch = lane & 15, tq = lane >> 4;
#pragma unroll
            for (int i = 0; i < 4; ++i) { const int tt = tq + 4 * i;
                if (tt < nt) { float y = 0.f;
                    for (int p = 0; p < 64; ++p) y += ct[p * 16 + ch] * ht[tt * 64 + p] - ct[1024 + p * 16 + ch] * ht[1024 + tt * 64 + p];
                    const size_t m = (size_t)(m0 + t0 + tt);
                    y += dd * bf2f(proj[m * NPROJ + PC_U + g * 16 + ch]);
                    wsb(A, WS_YS)[m * 256 + g * 16 + ch] = (bf16)f2bf(gelu_tanh(y)); } }
            WAVE_SYNC();
        }
        if (fre) { fre[lane] = hr; fim[lane] = hi; }
    }
}
__device__ __forceinline__ void ph_conv(const Args& A, int l) {
    TIDS;
    const int gt = bid * (NWAVES * 64) + tid, NGT = G * NWAVES * 64;
    const bf16* proj = wsb(A, WS_PROJ);
    for (int i = gt; i < M * 128; i += NGT) {
        const int m = i >> 7, c = (i & 127) * 2;
        int t, L; const float* hist = nullptr; float* so;
        if (m < MP) { t = m % SEQ; L = SEQ; so = A.out + O_CBP + (size_t)(l * NB + m / SEQ) * 512; }
        else { const int s = (m - MP) / DEC_SEQ; t = (m - MP) % DEC_SEQ; L = DEC_SEQ; hist = A.in[I_SCB] + (size_t)(l * DB + s) * 512; so = A.out + O_CBS + (size_t)(l * DB + s) * 512; }
        float cx0[3], cx1[3];
#pragma unroll
        for (int j = 0; j < 3; ++j) { const int tt = t - 2 + j;
            if (tt >= 0) { const bf16* r = proj + (size_t)(m - 2 + j) * NPROJ; const unsigned cg = *(const unsigned*)(r + PC_CG + c), xc = *(const unsigned*)(r + PC_XC + c); cx0[j] = bflo(cg) * bflo(xc); cx1[j] = bfhi(cg) * bfhi(xc); }
            else if (hist) { cx0[j] = hist[(2 + tt) * 256 + c]; cx1[j] = hist[(2 + tt) * 256 + c + 1]; }
            else { cx0[j] = 0.f; cx1[j] = 0.f; } }
        const float* w = A.in[I_CBW] + (size_t)l * 3 * 256;
        const float o0 = w[c] * cx0[0] + w[256 + c] * cx0[1] + w[512 + c] * cx0[2], o1 = w[c + 1] * cx1[0] + w[256 + c + 1] * cx1[1] + w[512 + c + 1] * cx1[2];
        const unsigned bg = *(const unsigned*)(proj + (size_t)m * NPROJ + PC_BG + c);
        *(unsigned*)(wsb(A, WS_Y) + (size_t)m * D + 256 + c) = pk2(bflo(bg) * o0, bfhi(bg) * o1);
        if (t >= L - 2) { so[(t - (L - 2)) * 256 + c] = cx0[2]; so[(t - (L - 2)) * 256 + c + 1] = cx1[2]; }
    }
}
__device__ __forceinline__ bf16x8 acc2b(const f32x4& lo, const f32x4& hi) { v4u w; w.x = pk2(lo[0], lo[1]); w.y = pk2(lo[2], lo[3]); w.z = pk2(hi[0], hi[1]); w.w = pk2(hi[2], hi[3]); return __builtin_bit_cast(bf16x8, w); }
__device__ __forceinline__ void ph_gdn_c1(const Args& A, LAS unsigned char* lds, int l) {
    TIDS;
    constexpr int XS = 72, GS = 68, RS = 132;
    LAS bf16* Qs = (LAS bf16*)lds; LAS bf16* Ks = Qs + 64 * XS; LAS bf16* Vs = Ks + 64 * XS;
    LAS float* GKK = (LAS float*)(lds + 27648); LAS float* GQK = GKK + 64 * GS; LAS float* rhs = GQK + 64 * GS;
    LAS float* Linv = rhs + 64 * RS; LAS float* sc = Linv + 1024;
    LAS float* DQ = sc, *DK = sc + 64, *RQ = sc + 128, *RK = sc + 192, *BET = sc + 256, *GC = sc + 320, *EGC = sc + 384, *EK = sc + 448;
    LAS float* Wst = GQK;
    const bf16* proj = wsb(A, WS_PROJ); const float* cw = A.in[I_DCW] + (size_t)l * 4 * GQKV; const float* lg8 = wsf(A, WS_LOG8);
    const int g = lane >> 4, i16 = lane & 15;
    for (int un = bid; un < NB * GH * GNCH; un += G) {
        const int c = un % GNCH, h = (un / GNCH) % GH, b = un / (GNCH * GH); const int m0 = b * SEQ + c * GCH;
        unsigned char* gd = A.ws + WS_GD + (size_t)un * GD_UNIT;
        if (wave < 6) { const int sec = wave >> 1, th = wave & 1, src = sec * 256 + h * 64 + lane, t0 = c * GCH + th * 32;
            const float w0 = cw[src], w1 = cw[GQKV + src], w2 = cw[2 * GQKV + src], w3 = cw[3 * GQKV + src];
            float x[35];
#pragma unroll
            for (int k = 0; k < 35; ++k) { const int tt = t0 - 3 + k; x[k] = tt >= 0 ? bf2f(proj[(size_t)(b * SEQ + tt) * NPROJ + PC_QKV + src]) : 0.f; }
            LAS bf16* X = sec == 0 ? Qs : (sec == 1 ? Ks : Vs);
#pragma unroll
            for (int k = 0; k < 32; ++k) X[(th * 32 + k) * XS + lane] = (bf16)f2bf(siluf_(w0 * x[k] + w1 * x[k + 1] + w2 * x[k + 2] + w3 * x[k + 3]));
            if (c == GNCH - 1 && th == 1) {
#pragma unroll
                for (int k = 0; k < 3; ++k) A.out[O_CDP + ((size_t)(l * NB + b) * 3 + k) * GQKV + src] = x[32 + k]; } }
        __syncthreads();
#pragma unroll
        for (int q2 = 0; q2 < 2; ++q2) { const int tt = 2 * wave + q2, rt = tt >> 2, ct = tt & 3;
            f32x4 akk = {0.f, 0.f, 0.f, 0.f}, aqk = {0.f, 0.f, 0.f, 0.f};
#pragma unroll
            for (int s = 0; s < 2; ++s) { const bf16x8 kc = *(const LAS bf16x8*)(Ks + (16 * ct + i16) * XS + 32 * s + 8 * g), kr = *(const LAS bf16x8*)(Ks + (16 * rt + i16) * XS + 32 * s + 8 * g),
                                                         qr = *(const LAS bf16x8*)(Qs + (16 * rt + i16) * XS + 32 * s + 8 * g);
                akk = __builtin_amdgcn_mfma_f32_16x16x32_bf16(kr, kc, akk, 0, 0, 0); aqk = __builtin_amdgcn_mfma_f32_16x16x32_bf16(qr, kc, aqk, 0, 0, 0); }
#pragma unroll
            for (int r = 0; r < 4; ++r) { GKK[(16 * rt + 4 * g + r) * GS + 16 * ct + i16] = akk[r]; GQK[(16 * rt + 4 * g + r) * GS + 16 * ct + i16] = aqk[r]; }
            if (rt == ct && g == (i16 >> 2)) { const int r = i16 & 3; DK[16 * rt + i16] = r == 0 ? akk[0] : r == 1 ? akk[1] : r == 2 ? akk[2] : akk[3]; } }
        if (wave < 4) { f32x4 aqq = {0.f, 0.f, 0.f, 0.f};
#pragma unroll
            for (int s = 0; s < 2; ++s) { const bf16x8 qr = *(const LAS bf16x8*)(Qs + (16 * wave + i16) * XS + 32 * s + 8 * g); aqq = __builtin_amdgcn_mfma_f32_16x16x32_bf16(qr, qr, aqq, 0, 0, 0); }
            if (g == (i16 >> 2)) { const int r = i16 & 3; DQ[16 * wave + i16] = r == 0 ? aqq[0] : r == 1 ? aqq[1] : r == 2 ? aqq[2] : aqq[3]; } }
        __syncthreads();
        if (wave == 0) { const float* lr = lg8 + (size_t)(m0 + lane) * 8;
            const float gv = -expf(A.in[I_DAL][l * 4 + h]) * softplusf_(lr[4 + h] + A.in[I_DDT][l * 4 + h]);
            float gc = gv;
#pragma unroll
            for (int o = 1; o < 64; o <<= 1) { const float t = __shfl_up(gc, o); if (lane >= o) gc += t; }
            const float gl = __shfl(gc, 63);
            RK[lane] = 1.0f / sqrtf(DK[lane] + RMS_EPS); RQ[lane] = 0.125f / sqrtf(DQ[lane] + RMS_EPS); BET[lane] = sigmoidf_(lr[h]); GC[lane] = gc; EGC[lane] = expf(gc); EK[lane] = expf(gl - gc);
            if (lane == 0) wsf(A, WS_EGL)[un] = expf(gl); }
        __syncthreads();
        for (int idx = tid; idx < 4096; idx += 512) { const int i = idx >> 6, j = idx & 63; GKK[i * GS + j] = i > j ? BET[i] * RK[i] * RK[j] * GKK[i * GS + j] * expf(GC[i] - GC[j]) : 0.f; }
        for (int idx = tid; idx < 64 * 128; idx += 512) { const int i = idx >> 7, cc = idx & 127; rhs[i * RS + cc] = cc < 64 ? BET[i] * bf2f(Vs[i * XS + cc]) : BET[i] * EGC[i] * RK[i] * bf2f(Ks[i * XS + cc - 64]); }
        for (int idx = tid; idx < 4096; idx += 512) { const int f = idx >> 9, ln = (idx >> 3) & 63, j = idx & 7, row = 16 * (f >> 1) + (ln & 15), kx = 32 * (f & 1) + 16 * (j >> 2) + 4 * (ln >> 4) + (j & 3);
            ((bf16*)gd)[8192 + idx] = (bf16)f2bf(row >= kx ? RQ[row] * RK[kx] * GQK[row * GS + kx] * expf(GC[row] - GC[kx]) : 0.f);
            ((bf16*)gd)[4096 + idx] = (bf16)f2bf(bf2f(Qs[row * XS + kx]) * RQ[row] * EGC[row]);
            ((bf16*)gd)[12288 + idx] = (bf16)f2bf(bf2f(Ks[kx * XS + row]) * RK[kx] * EK[kx]); }
        __syncthreads();
        if (wave == 0) { const int blk = lane >> 4, cI = lane & 15; float x[16];
            x[0] = cI == 0 ? 1.f : 0.f;
#pragma unroll
            for (int i = 1; i < 16; ++i) { float sacc = cI == i ? 1.f : 0.f;
#pragma unroll
                for (int j = 0; j < i; ++j) sacc -= GKK[(16 * blk + i) * GS + 16 * blk + j] * x[j];
                x[i] = sacc; }
#pragma unroll
            for (int i = 0; i < 16; ++i) Linv[blk * 256 + i * 16 + cI] = x[i]; }
        __syncthreads();
        { const f32x4 Z = {0.f, 0.f, 0.f, 0.f}; f32x4 X[4];
#define C1_LD4(p) ((f32x4)(*(const LAS f32x4*)(p)) * 1.0f)
#define C1_LF(I) acc2b(C1_LD4(Linv + (I) * 256 + i16 * 16 + 4 * g), Z)
#define C1_MF2(I, J) acc2b(-*(const LAS f32x4*)(GKK + (16 * (I) + i16) * GS + 16 * (J) + 4 * g), -*(const LAS f32x4*)(GKK + (16 * (I) + i16) * GS + 16 * ((J) + 1) + 4 * g))
#define C1_MF1(I, J) acc2b(-*(const LAS f32x4*)(GKK + (16 * (I) + i16) * GS + 16 * (J) + 4 * g), Z)
#define C1_R(I) (f32x4){rhs[(16 * (I) + 4 * g) * RS + 16 * wave + i16], rhs[(16 * (I) + 4 * g + 1) * RS + 16 * wave + i16], rhs[(16 * (I) + 4 * g + 2) * RS + 16 * wave + i16], rhs[(16 * (I) + 4 * g + 3) * RS + 16 * wave + i16]}
            f32x4 R = C1_R(0);
            X[0] = __builtin_amdgcn_mfma_f32_16x16x32_bf16(C1_LF(0), acc2b(R, Z), Z, 0, 0, 0);
            R = C1_R(1); R = __builtin_amdgcn_mfma_f32_16x16x32_bf16(C1_MF1(1, 0), acc2b(X[0], Z), R, 0, 0, 0);
            X[1] = __builtin_amdgcn_mfma_f32_16x16x32_bf16(C1_LF(1), acc2b(R, Z), Z, 0, 0, 0);
            const bf16x8 X01 = acc2b(X[0], X[1]);
            R = C1_R(2); R = __builtin_amdgcn_mfma_f32_16x16x32_bf16(C1_MF2(2, 0), X01, R, 0, 0, 0);
            X[2] = __builtin_amdgcn_mfma_f32_16x16x32_bf16(C1_LF(2), acc2b(R, Z), Z, 0, 0, 0);
            R = C1_R(3); R = __builtin_amdgcn_mfma_f32_16x16x32_bf16(C1_MF2(3, 0), X01, R, 0, 0, 0); R = __builtin_amdgcn_mfma_f32_16x16x32_bf16(C1_MF1(3, 2), acc2b(X[2], Z), R, 0, 0, 0);
            X[3] = __builtin_amdgcn_mfma_f32_16x16x32_bf16(C1_LF(3), acc2b(R, Z), Z, 0, 0, 0);
#undef C1_LF
#undef C1_LD4
#undef C1_MF2
#undef C1_MF1
#undef C1_R
            if (wave < 4) {
#pragma unroll
                for (int I = 0; I < 4; ++I) ((f32x4*)(gd + 32768))[(wave * 4 + I) * 64 + lane] = X[I]; }
            else {
#pragma unroll
                for (int I = 0; I < 4; ++I)
#pragma unroll
                    for (int r = 0; r < 4; ++r) Wst[(16 * I + 4 * g + r) * GS + 16 * (wave - 4) + i16] = -X[I][r]; } }
        __syncthreads();
        for (int idx = tid; idx < 4096; idx += 512) { const int f = idx >> 9, ln = (idx >> 3) & 63, j = idx & 7, row = 16 * (f >> 1) + (ln & 15), kx = 32 * (f & 1) + 16 * (j >> 2) + 4 * (ln >> 4) + (j & 3);
            ((bf16*)gd)[idx] = (bf16)f2bf(Wst[row * GS + kx]); }
        __syncthreads();
    }
}
__device__ __forceinline__ void ph_gdn_scan(const Args& A, LAS unsigned char* lds, int l) {
    TIDS;
    for (int grp = bid; grp < NB * GH; grp += G) {
        const int h = grp % GH, b = grp / GH;
        const unsigned char* gbase = A.ws + WS_GD + (size_t)(b * GH + h) * GNCH * GD_UNIT;
        if (wave >= 4) {
            const int lw = wave - 4; v4u ra[12], rb[12];
            const v4u* src = (const v4u*)gbase + lw * 12 * 64 + lane;
            LAS v4u* dst0 = (LAS v4u*)lds + lw * 12 * 64 + lane;
#define SC_LOAD(R, c) do { if ((c) < GNCH) { _Pragma("unroll") for (int k = 0; k < 12; ++k) R[k] = src[(size_t)(c) * (GD_UNIT / 16) + k * 64]; } } while (0)
#define SC_STORE(R, c) do { if ((c) < GNCH) { LAS v4u* d_ = dst0 + ((c) & 1) * (GD_UNIT / 16); _Pragma("unroll") for (int k = 0; k < 12; ++k) d_[k * 64] = R[k]; } } while (0)
            SC_LOAD(ra, 0); SC_STORE(ra, 0); SC_LOAD(ra, 1); SC_LOAD(rb, 2);
            RAW_BAR();
            for (int c = 0; c < GNCH; c += 2) {
                SC_STORE(ra, c + 1); SC_LOAD(ra, c + 3);
                RAW_BAR();
                if (c + 1 < GNCH) { SC_STORE(rb, c + 2); SC_LOAD(rb, c + 4); RAW_BAR(); }
            }
#undef SC_LOAD
#undef SC_STORE
        } else {
            const int vs = wave, g = lane >> 4, cc = lane & 15;
            f32x4 S[4];
#pragma unroll
            for (int T = 0; T < 4; ++T) S[T] = (f32x4){0.f, 0.f, 0.f, 0.f};
            const float* eglp = wsf(A, WS_EGL) + (size_t)(b * GH + h) * GNCH;
            float egl_n = eglp[0];
            RAW_BAR();
            for (int c = 0; c < GNCH; ++c) {
                const float egl = egl_n; if (c + 1 < GNCH) egl_n = eglp[c + 1];
                const LAS unsigned char* slot = lds + (c & 1) * GD_UNIT;
                const LAS bf16x8* fr = (const LAS bf16x8*)slot + lane;
                const LAS f32x4* uvp = (const LAS f32x4*)(slot + 32768) + (vs * 4) * 64 + lane;
                bf16x8 Sb[2] = {acc2b(S[0], S[1]), acc2b(S[2], S[3])};
                f32x4 u[4], o[4];
#pragma unroll
                for (int T = 0; T < 4; ++T) { u[T] = uvp[T * 64]; o[T] = (f32x4){0.f, 0.f, 0.f, 0.f};
#pragma unroll
                    for (int s = 0; s < 2; ++s) { u[T] = __builtin_amdgcn_mfma_f32_16x16x32_bf16(fr[(0 * 8 + 2 * T + s) * 64], Sb[s], u[T], 0, 0, 0); o[T] = __builtin_amdgcn_mfma_f32_16x16x32_bf16(fr[(1 * 8 + 2 * T + s) * 64], Sb[s], o[T], 0, 0, 0); } }
                bf16x8 ub[2] = {acc2b(u[0], u[1]), acc2b(u[2], u[3])};
#pragma unroll
                for (int T = 0; T < 4; ++T) { S[T] = S[T] * egl;
#pragma unroll
                    for (int s = 0; s < 2; ++s) { S[T] = __builtin_amdgcn_mfma_f32_16x16x32_bf16(fr[(3 * 8 + 2 * T + s) * 64], ub[s], S[T], 0, 0, 0); o[T] = __builtin_amdgcn_mfma_f32_16x16x32_bf16(fr[(2 * 8 + 2 * T + s) * 64], ub[s], o[T], 0, 0, 0); } }
                float* od = wsf(A, WS_ODRAW) + (size_t)(b * SEQ + c * GCH + 4 * g) * 256 + h * 64 + vs * 16 + cc;
#pragma unroll
                for (int T = 0; T < 4; ++T)
#pragma unroll
                    for (int r = 0; r < 4; ++r) od[(size_t)(16 * T + r) * 256] = o[T][r];
                RAW_BAR();
            }
            float* so = A.out + O_DP + (((size_t)(l * NB + b) * GH + h) * 64 + 4 * g) * 64 + vs * 16 + cc;
#pragma unroll
            for (int T = 0; T < 4; ++T)
#pragma unroll
                for (int r = 0; r < 4; ++r) so[(16 * T + r) * 64] = S[T][r];
        }
        __syncthreads();
    }
}
__device__ __forceinline__ void ph_gdn_sample(const Args& A, LAS unsigned char* lds, int l) {
    TIDS;
    LAS float* S = (LAS float*)(lds + wave * 16384);
    LAS float* kq = (LAS float*)(lds + MISC_OFF + 1024 + wave * 512);
    const bf16* proj = wsb(A, WS_PROJ); const float* cw = A.in[I_DCW] + (size_t)l * 4 * GQKV; const float* lg8 = wsf(A, WS_LOG8);
    if (wave < 4 || wave >= 6) return;
    for (int un = (wave - 4) * G + bid; un < DB * GH; un += 2 * G) {
        const int h = un % GH, s = un / GH;
        const float* s0 = A.in[I_SD] + ((size_t)(l * DB + s) * GH + h) * 4096;
#pragma unroll 8
        for (int kk = 0; kk < 64; ++kk) S[kk * 64 + lane] = s0[kk * 64 + lane];
        const float* hist = A.in[I_SCD] + (size_t)(l * DB + s) * 3 * GQKV;
        for (int t = 0; t < DEC_SEQ; ++t) {
            const size_t m = (size_t)MP + s * DEC_SEQ + t;
            float val[3];
#pragma unroll
            for (int sec = 0; sec < 3; ++sec) { const int src = sec * 256 + h * 64 + lane; float acc = 0.f, cur = 0.f;
#pragma unroll
                for (int j = 0; j < 4; ++j) { const int tt = t - 3 + j; const float x = tt >= 0 ? bf2f(proj[(size_t)(MP + s * DEC_SEQ + tt) * NPROJ + PC_QKV + src]) : hist[(3 + tt) * GQKV + src]; acc += cw[j * GQKV + src] * x; cur = x; }
                val[sec] = siluf_(acc);
                if (t >= 1) A.out[O_CDS + ((size_t)(l * DB + s) * 3 + (t - 1)) * GQKV + src] = cur; }
            const float sq = wave_sum(val[0] * val[0]), sk = wave_sum(val[1] * val[1]);
            const float qv = val[0] * (1.0f / sqrtf(sq + RMS_EPS)) * 0.125f, kv = val[1] * (1.0f / sqrtf(sk + RMS_EPS)), vv = val[2];
            const float* lr = lg8 + m * 8; const float beta = sigmoidf_(lr[h]); const float a = expf(-expf(A.in[I_DAL][l * 4 + h]) * softplusf_(lr[4 + h] + A.in[I_DDT][l * 4 + h]));
            kq[lane] = kv; kq[64 + lane] = qv;
            WAVE_SYNC();
            float kS = 0.f;
#pragma unroll 8
            for (int kk = 0; kk < 64; ++kk) kS += kq[kk] * S[kk * 64 + lane];
            float o = 0.f;
#pragma unroll 8
            for (int kk = 0; kk < 64; ++kk) { const float bk = beta * kq[kk]; const float sn = a * (S[kk * 64 + lane] - bk * kS) + bk * vv; S[kk * 64 + lane] = sn; o += kq[64 + kk] * sn; }
            wsf(A, WS_ODRAW)[m * 256 + h * 64 + lane] = o;
            WAVE_SYNC();
        }
        float* so = A.out + O_DS + ((size_t)(l * DB + s) * GH + h) * 4096;
#pragma unroll 8
        for (int kk = 0; kk < 64; ++kk) so[kk * 64 + lane] = S[kk * 64 + lane];
    }
}
__device__ __forceinline__ void ph_gdn_out(const Args& A, int l) {
    TIDS;
    for (int idx = gw; idx < M * GH; idx += NGW) { const size_t m = idx >> 2; const int h = idx & 3;
        const float o = wsf(A, WS_ODRAW)[m * 256 + h * 64 + lane];
        const float ms = wave_sum(o * o) * (1.0f / 64.0f);
        const float z = bf2f(wsb(A, WS_PROJ)[m * NPROJ + PC_Z + h * 64 + lane]);
        wsb(A, WS_Y)[m * D + 512 + h * 64 + lane] = (bf16)f2bf(o * (1.0f / sqrtf(ms + RMS_EPS)) * A.in[I_DNW][l * 64 + lane] * siluf_(z)); }
}
__device__ __forceinline__ void sb_terms(float z, float& ls, float& ln) { const float L = log1pf(__expf(-fabsf(z))); ls = fminf(z, 0.f) - L; ln = -fmaxf(z, 0.f) - L; }
constexpr float SB_CUT = -105.0f;
__device__ __forceinline__ void ph_sb_prompt(const Args& A, LAS unsigned char* lds, int l) {
    TIDS; (void)l;
    LAS float* kt = (LAS float*)(lds + wave * 16384); LAS float* vt = kt + 2048;
    const bf16* proj = wsb(A, WS_PROJ);
    constexpr int NQB = SEQ / 32;
    for (int un0 = gw; un0 < NB * SBH * NQB; un0 += NGW) {
        const int un = NB * SBH * NQB - 1 - un0;
        const int qb = un / (NB * SBH), h = un % SBH, b = (un / SBH) % NB;
        const int i = lane & 31, half = lane >> 5, qi = qb * 32 + i; const size_t m = (size_t)b * SEQ + qi;
        float q[32], acc[32];
        { const v4u* qp = (const v4u*)(proj + m * NPROJ + PC_Q + h * 64 + half * 32);
#pragma unroll
          for (int x = 0; x < 4; ++x) { const v4u w = qp[x]; q[8 * x] = bflo(w.x) * 0.125f; q[8 * x + 1] = bfhi(w.x) * 0.125f; q[8 * x + 2] = bflo(w.y) * 0.125f; q[8 * x + 3] = bfhi(w.y) * 0.125f;
              q[8 * x + 4] = bflo(w.z) * 0.125f; q[8 * x + 5] = bfhi(w.z) * 0.125f; q[8 * x + 6] = bflo(w.w) * 0.125f; q[8 * x + 7] = bfhi(w.w) * 0.125f; } }
#pragma unroll
        for (int d = 0; d < 32; ++d) acc[d] = 0.f;
        float R = 0.f;
        for (int kb = qb; kb >= 0; --kb) {
            { const int row = lane >> 1, hr = lane & 1; const bf16* rp = proj + ((size_t)b * SEQ + kb * 32 + row) * NPROJ + h * 64 + hr * 32;
              const v4u* kp = (const v4u*)(rp + PC_K); const v4u* vp = (const v4u*)(rp + PC_V);
#pragma unroll
              for (int x = 0; x < 4; ++x) { const v4u w = kp[x], u = vp[x]; LAS float* kd = kt + row * 64 + hr * 32 + 8 * x; LAS float* vd = vt + row * 64 + hr * 32 + 8 * x;
                  kd[0] = bflo(w.x); kd[1] = bfhi(w.x); kd[2] = bflo(w.y); kd[3] = bfhi(w.y); kd[4] = bflo(w.z); kd[5] = bfhi(w.z); kd[6] = bflo(w.w); kd[7] = bfhi(w.w);
                  vd[0] = bflo(u.x); vd[1] = bfhi(u.x); vd[2] = bflo(u.y); vd[3] = bfhi(u.y); vd[4] = bflo(u.z); vd[5] = bfhi(u.z); vd[6] = bflo(u.w); vd[7] = bfhi(u.w); } }
            WAVE_SYNC();
            for (int jj = 31; jj >= 0; --jj) {
                const LAS float* kr = kt + jj * 64 + half * 32; float zp = 0.f;
#pragma unroll
                for (int d = 0; d < 32; ++d) zp += q[d] * kr[d];
                const float z = zp + __shfl_xor(zp, 32);
                float ls, ln; sb_terms(z, ls, ln);
                const bool valid = (kb * 32 + jj) < qi;
                const float w = valid ? __expf(ls + R) : 0.f;
                const LAS float* vr = vt + jj * 64 + half * 32;
#pragma unroll
                for (int d = 0; d < 32; ++d) acc[d] += w * vr[d];
                R += valid ? ln : 0.f;
            }
            WAVE_SYNC();
            if (kb < qb && __all(R < SB_CUT)) break;
        }
        v4u* yp = (v4u*)(wsb(A, WS_Y) + m * D + 768 + h * 64 + half * 32);
#pragma unroll
        for (int x = 0; x < 4; ++x) { v4u o; o.x = pk2(acc[8 * x], acc[8 * x + 1]); o.y = pk2(acc[8 * x + 2], acc[8 * x + 3]); o.z = pk2(acc[8 * x + 4], acc[8 * x + 5]); o.w = pk2(acc[8 * x + 6], acc[8 * x + 7]); yp[x] = o; }
    }
}
__device__ __forceinline__ void ph_sb_sample(const Args& A, LAS unsigned char* lds, int l) {
    TIDS;
    if (wave >= 2) return;
    LAS float* vt = (LAS float*)(lds + wave * 32768);
    LAS float* qs = vt + 64 * 68;
    LAS float* wq = qs + 256;
    const bf16* proj = wsb(A, WS_PROJ); const int* pt = (const int*)A.in[I_PT];
    for (int un = wave * G + bid; un < DB * SBH; un += 2 * G) {
        const int h = un % SBH, s = un / SBH;
#pragma unroll
        for (int qi = 0; qi < 4; ++qi) qs[qi * 64 + lane] = bf2f(proj[((size_t)MP + s * DEC_SEQ + qi) * NPROJ + PC_Q + h * 64 + lane]) * 0.125f;
        WAVE_SYNC();
        float R[4] = {0.f, 0.f, 0.f, 0.f}; f32x4 acc = {0.f, 0.f, 0.f, 0.f};
        const int qi_b = lane & 3, ds = lane >> 2;
        for (int tile = 0; tile * 64 < PAST + DEC_SEQ; ++tile) {
            const int p = PAST + DEC_SEQ - 1 - (tile * 64 + lane);
            f32x4 kr[16], vr[16];
            if (p >= PAST) { const bf16* rp = proj + ((size_t)MP + s * DEC_SEQ + (p - PAST)) * NPROJ + h * 64;
#pragma unroll
                for (int x = 0; x < 8; ++x) { const v4u kw = ((const v4u*)(rp + PC_K))[x], vw = ((const v4u*)(rp + PC_V))[x];
                    kr[2 * x] = (f32x4){bflo(kw.x), bfhi(kw.x), bflo(kw.y), bfhi(kw.y)}; kr[2 * x + 1] = (f32x4){bflo(kw.z), bfhi(kw.z), bflo(kw.w), bfhi(kw.w)};
                    vr[2 * x] = (f32x4){bflo(vw.x), bfhi(vw.x), bflo(vw.y), bfhi(vw.y)}; vr[2 * x + 1] = (f32x4){bflo(vw.z), bfhi(vw.z), bflo(vw.w), bfhi(vw.w)}; } }
            else if (p >= 0) { const int page = pt[s * NPAGES + p / PAGE]; const size_t off = ((((size_t)l * NPOOL + page) * PAGE + p % PAGE) * SBH + h) * 64;
#pragma unroll
                for (int x = 0; x < 16; ++x) { kr[x] = ((const f32x4*)(A.in[I_CK] + off))[x]; vr[x] = ((const f32x4*)(A.in[I_CV] + off))[x]; } }
            else {
#pragma unroll
                for (int x = 0; x < 16; ++x) { kr[x] = (f32x4){0.f, 0.f, 0.f, 0.f}; vr[x] = (f32x4){0.f, 0.f, 0.f, 0.f}; } }
#pragma unroll
            for (int x = 0; x < 16; ++x) *(LAS f32x4*)(vt + lane * 68 + 4 * x) = vr[x];
#pragma unroll
            for (int qi = 0; qi < 4; ++qi) { float z = 0.f;
#pragma unroll
                for (int x = 0; x < 16; ++x) { const f32x4 qv = *(const LAS f32x4*)(qs + qi * 64 + 4 * x); z += (kr[x][0] * qv[0] + kr[x][1] * qv[1]) + (kr[x][2] * qv[2] + kr[x][3] * qv[3]); }
                float ls, ln; sb_terms(z, ls, ln);
                const bool valid = p >= 0 && p < PAST + qi; const float lnv = valid ? ln : 0.f;
                float incl = lnv;
#pragma unroll
                for (int o = 1; o < 64; o <<= 1) { const float t = __shfl_up(incl, o); if (lane >= o) incl += t; }
                wq[qi * 64 + lane] = valid ? __expf(ls + R[qi] + (incl - lnv)) : 0.f;
                R[qi] += __shfl(incl, 63); }
            WAVE_SYNC();
#pragma unroll 8
            for (int key = 0; key < 64; ++key) acc += *(const LAS f32x4*)(vt + key * 68 + 4 * ds) * wq[qi_b * 64 + key];
            WAVE_SYNC();
            if (R[0] < SB_CUT && R[1] < SB_CUT && R[2] < SB_CUT && R[3] < SB_CUT) break;
        }
        v2u o; o.x = pk2(acc[0], acc[1]); o.y = pk2(acc[2], acc[3]);
        *(v2u*)(wsb(A, WS_Y) + ((size_t)MP + s * DEC_SEQ + qi_b) * D + 768 + h * 64 + ds * 4) = o;
    }
}
constexpr int PH_PER_LAYER = 12, NPHASE = 2 + PH_PER_LAYER * DEPTH;
#ifndef DUP_MASK
#define DUP_MASK 0
#endif
#if DUP_MASK
__device__ __forceinline__ int rep_n(int k) { int n = ((DUP_MASK >> k) & 1) ? 2 : 1; asm volatile("" : "+s"(n)); return n; }
#define REP(k) _Pragma("nounroll") for (int rep_ = 0, repn_ = rep_n(k); rep_ < repn_; ++rep_)
#else
#define REP(k)
#endif
#ifndef TIME_SUB
#define TIME_SUB 0
#endif
#ifndef TIME_MASK
#define TIME_MASK 0
#endif
#ifndef MK_N_LAUNCHES
#define MK_N_LAUNCHES 1
#endif
__global__ void __launch_bounds__(NWAVES * 64, 2) fwd_kernel(Args A) {
#ifndef CPU_EMU
    extern __shared__ __attribute__((aligned(16))) unsigned char lds_raw[];
    LAS unsigned char* lds = (LAS unsigned char*)lds_raw;
    volatile LAS unsigned* MISC = (volatile LAS unsigned*)(lds + MISC_OFF);
    for (int u = threadIdx.x; u < (LDS_BYTES - MISC_OFF) / 4; u += NWAVES * 64) ((LAS unsigned*)(lds + MISC_OFF))[u] = 0u;
    __syncthreads();
    XcdBarrier bar; bar.bar = (unsigned*)(A.ws + WS_CTL) + CW_BAR + A.li * XCD_BAR_WORDS; bar.x = 0; bar.st = nullptr;
    if (A.ph_hi - A.ph_lo > 1) bar = xcd_barrier_post((unsigned*)(A.ws + WS_CTL) + CW_BAR + A.li * XCD_BAR_WORDS, MISC + 8);
#else
    unsigned char* lds = emu::B->lds; XcdBarrier bar{0};
#endif
    const int lo = A.ph_lo, hi = A.ph_hi, G = gridDim.x, bid = blockIdx.x;
#define IN(k) (lo <= (k) && (k) < hi)
#if TIME_MASK || TIME_SUB
    unsigned long long tp_ = __builtin_amdgcn_s_memrealtime(), tacc_ = 0;
#define SEAM(k) do { if (IN((k) + 1)) xcd_barrier(bar); { const unsigned long long tn_ = __builtin_amdgcn_s_memrealtime(); if ((TIME_MASK >> (k)) & 1) tacc_ += tn_ - tp_; tp_ = tn_; } } while (0)
#else
#define SEAM(k) do { if (IN((k) + 1)) xcd_barrier(bar); } while (0)
#endif
    if (IN(0)) { REP(9) ph_prologue(A, lds); SEAM(0); }
    if (IN(1)) {
        pg8::Gemm g{wsb(A, WS_CSILU), (const bf16*)(A.ws + WS_W + WL_ADA), D, D}; ModOrder S{G, bid}; EpiMod2 E{wsf(A, WS_MOD), A.in[I_BADA]};
        pg8::gemm_phase<EpiMod2, ModOrder, true, true>(lds, g, S, E); SEAM(1);
    }
    for (int l = 0; l < DEPTH; ++l) {
        const int pb = 2 + PH_PER_LAYER * l;
        unsigned char* wl = A.ws + WS_W + (size_t)l * WL_SIZE;
        if (IN(pb + 0)) { if (l == 0) ph_rows<0>(A, 0); SEAM(pb + 0); }
        if (IN(pb + 1)) {
            pg8::Gemm g{wsb(A, WS_H), (const bf16*)(wl + WL_W1), D, D}; pg8::GridOrder S; S.init(M / 256, N1 / 256, G, bid);
            pg8::EpiProj E{wsb(A, WS_PROJ), wsb(A, WS_GATE), A.out + O_KP + (size_t)l * MP * 256, A.out + O_VP + (size_t)l * MP * 256, A.out + O_KS + (size_t)l * MS * 256, A.out + O_VS + (size_t)l * MS * 256};
            REP(5) pg8::gemm_phase<pg8::EpiProj, pg8::GridOrder, true, true>(lds, g, S, E); SEAM(pb + 1);
        }
        if (IN(pb + 2)) {
#if TIME_SUB
#define SUBT(k, call) do { const unsigned long long ts_ = __builtin_amdgcn_s_memrealtime(); call; if ((TIME_SUB >> (k)) & 1) tacc_ += __builtin_amdgcn_s_memrealtime() - ts_; } while (0)
#else
#define SUBT(k, call) do { call; } while (0)
#endif
            SUBT(0, REP(3) ph_gdn_c1(A, lds, l)); SUBT(1, REP(2) ph_sb_prompt(A, lds, l)); __syncthreads(); SUBT(2, REP(10) ph_gdn_sample(A, lds, l)); SUBT(3, REP(1) ph_sb_sample(A, lds, l));
            SUBT(4, REP(4) ph_ssm1(A, l)); SUBT(5, REP(10) ph_conv(A, l)); SUBT(6, SEAM(pb + 2)); }
        if (IN(pb + 3)) { REP(0) ph_gdn_scan(A, lds, l); REP(10) ph_ssm_carry(A, l); SEAM(pb + 3); }
        if (IN(pb + 4)) { REP(4) ph_ssm2(A, lds, l); REP(10) ph_gdn_out(A, l); SEAM(pb + 4); }
        if (IN(pb + 5)) {
            pg8::Gemm g{wsb(A, WS_YS), (const bf16*)(wl + WL_GLU), 256, 256}; pg8::GridOrder S; S.init(M / 256, 1, G, bid);
            pg8::EpiGlu E{wsb(A, WS_YS), wsb(A, WS_Y)};
            REP(8) pg8::gemm_phase<pg8::EpiGlu, pg8::GridOrder, true, true>(lds, g, S, E); SEAM(pb + 5);
        }
        if (IN(pb + 6)) {
            pg8::Gemm g{wsb(A, WS_Y), (const bf16*)(wl + WL_BR), D, 256}; pg8::MergeOrder S; S.init(M / 256, 8, G, bid);
            pg8::EpiMerge E; E.gate = wsb(A, WS_GATE); E.mgb = wsb(A, WS_MERGEB);
            REP(6) pg8::gemm_phase<pg8::EpiMerge, pg8::MergeOrder, true, true, true>(lds, g, S, E); SEAM(pb + 6);
        }
        if (IN(pb + 7)) {
            pg8::Gemm g{wsb(A, WS_MERGEB), (const bf16*)(wl + WL_WO), D, D}; pg8::GridOrder S; S.init(M / 256, 4, G, bid);
            pg8::EpiRes E{l == 0 ? A.in[I_XP] : wsf(A, WS_X2), l == 0 ? A.in[I_XS] : wsf(A, WS_X2) + (size_t)MP * D, wsf(A, WS_MOD) + (size_t)l * 256 * NMOD + 2 * D, wsf(A, WS_X1)};
            REP(8) pg8::gemm_phase<pg8::EpiRes, pg8::GridOrder, true, true>(lds, g, S, E); SEAM(pb + 7);
        }
        if (IN(pb + 8)) { ph_rows<1>(A, l); SEAM(pb + 8); }
        if (IN(pb + 9)) {
            pg8::Gemm g{wsb(A, WS_H), (const bf16*)(wl + WL_UP), D, D}; pg8::GridOrder S; S.init(M / 256, NUP / 256, G, bid);
            pg8::EpiUp E{wsb(A, WS_ACT)};
            REP(7) pg8::gemm_phase<pg8::EpiUp, pg8::GridOrder, true, true>(lds, g, S, E); SEAM(pb + 9);
        }
        if (IN(pb + 10)) {
            pg8::Gemm g{wsb(A, WS_ACT), (const bf16*)(wl + WL_DN), DFF, DFF}; pg8::GridOrder S; S.init(M / 256, 4, G, bid);
            pg8::EpiRes E{wsf(A, WS_X1), wsf(A, WS_X1) + (size_t)MP * D, wsf(A, WS_MOD) + (size_t)l * 256 * NMOD + 5 * D, wsf(A, WS_X2)};
            REP(7) pg8::gemm_phase<pg8::EpiRes, pg8::GridOrder, true, true>(lds, g, S, E); SEAM(pb + 10);
        }
        if (IN(pb + 11)) { ph_rows<2>(A, l); SEAM(pb + 11); }
    }
#if TIME_MASK || TIME_SUB
    if (blockIdx.x == 0 && threadIdx.x == 0) { const unsigned long long t0_ = __builtin_amdgcn_s_memrealtime(); while (__builtin_amdgcn_s_memrealtime() - t0_ < 4 * tacc_) __builtin_amdgcn_s_sleep(8); }
#endif
#undef IN
#undef SEAM
}
#ifndef CPU_EMU
extern "C" void kernel_launch(void* const* d_in, const int* in_sizes, int n_in, void* d_out, int out_size, void* d_ws, size_t ws_size, hipStream_t stream) {
    static int grid = 0;
    if (grid == 0) {
        if (n_in != 38 || (size_t)out_size != O_END || ws_size < WS_END) { fprintf(stderr, "kernel_launch: unexpected shapes (n_in %d out %d ws %zu; want 38, %zu, >= %zu)\n", n_in, out_size, ws_size, (size_t)O_END, (size_t)WS_END); grid = -1; return; }
        int dev = 0, cus = 0, per_cu = 0;
        if (hipGetDevice(&dev) != hipSuccess || hipDeviceGetAttribute(&cus, hipDeviceAttributeMultiprocessorCount, dev) != hipSuccess) { grid = -1; return; }
        if (hipFuncSetAttribute((const void*)fwd_kernel, hipFuncAttributeMaxDynamicSharedMemorySize, LDS_BYTES) != hipSuccess) { fprintf(stderr, "kernel_launch: hipFuncSetAttribute failed\n"); grid = -1; return; }
        if (hipOccupancyMaxActiveBlocksPerMultiprocessor(&per_cu, (const void*)fwd_kernel, NWAVES * 64, LDS_BYTES) != hipSuccess || per_cu < 1) { fprintf(stderr, "kernel_launch: occupancy query says %d\n", per_cu); }
        (void)hipGetLastError();
        grid = cus;
    }
    if (grid < 0) return;
    if (hipMemsetAsync((char*)d_ws + WS_CTL, 0, CTL_ZERO_BYTES, stream) != hipSuccess) return;
    Args a{};
    for (int i = 0; i < 38; ++i) a.in[i] = (const float*)d_in[i];
    a.out = (float*)d_out; a.ws = (unsigned char*)d_ws;
    if (MK_N_LAUNCHES == 1) { a.ph_lo = 0; a.ph_hi = NPHASE; a.li = 0; hipLaunchKernelGGL(fwd_kernel, dim3(grid), dim3(NWAVES * 64), LDS_BYTES, stream, a); }
    else for (int p = 0; p < NPHASE; ++p) { if (p == 2 + PH_PER_LAYER) continue; a.ph_lo = p; a.ph_hi = p + 1; a.li = 0; hipLaunchKernelGGL(fwd_kernel, dim3(grid), dim3(NWAVES * 64), LDS_BYTES, stream, a); }
}
#endif
```

```cpp
#ifndef CPU_EMU
#include <hip/hip_runtime.h>
#endif
#include <cstdio>
#include <cstdint>
#include <cmath>

constexpr int D = 1024, NB = 2, DEPTH = 2, DEC_SEQ = 4, PAGE = 128;
#ifdef CPU_EMU
#ifndef EMU_SEQ
#define EMU_SEQ 512
#endif
#ifndef EMU_DB
#define EMU_DB 64
#endif
#ifndef EMU_PAST
#define EMU_PAST 512
#endif
constexpr int SEQ = EMU_SEQ, DB = EMU_DB, PAST = EMU_PAST;
#else
constexpr int SEQ = 8192, DB = 128, PAST = 2048;
#endif
constexpr int NPAGES = PAST / PAGE, NUSED = DB * NPAGES, NPOOL = NUSED + (NUSED / 4 > 1 ? NUSED / 4 : 1);
constexpr int MP = NB * SEQ, MS = DB * DEC_SEQ, M = MP + MS, NSEQ = NB + DB;
constexpr int WMIX = 256, NPROJ = 2816, NIN = 2824, NGATE = 4096, N1 = NPROJ + NGATE, DFF = 2816, NUP = 2 * DFF, NMOD = 6 * D;
constexpr int SSM_G = 16, SSM_P = 64, SSM_CH = 128, SSM_NCH = SEQ / SSM_CH;
constexpr int GH = 4, GDK = 64, GCH = 64, GNCH = SEQ / GCH, GQKV = 768;
constexpr int SBH = 4;
constexpr int PC_U = 0, PC_BG = 256, PC_CG = 512, PC_XC = 768, PC_QKV = 1024, PC_Z = 1792, PC_Q = 2048, PC_K = 2304, PC_V = 2560;
constexpr float LN_EPS = 1e-5f, RMS_EPS = 1e-6f, ALPHA = 1.41421356237309515f  ;
static_assert(M % 256 == 0 && MP % 256 == 0 && SEQ % 256 == 0 && NSEQ <= 256, "tile shapes");
constexpr size_t O_Y = 0, O_KP = (size_t)M * D, O_VP = O_KP + (size_t)DEPTH * MP * 256, O_KS = O_VP + (size_t)DEPTH * MP * 256, O_VS = O_KS + (size_t)DEPTH * MS * 256,
    O_REP = O_VS + (size_t)DEPTH * MS * 256, O_IMP = O_REP + DEPTH * NB * 1024, O_RES = O_IMP + DEPTH * NB * 1024, O_IMS = O_RES + (size_t)DEPTH * DB * 1024,
    O_CBP = O_IMS + (size_t)DEPTH * DB * 1024, O_CBS = O_CBP + DEPTH * NB * 512, O_DP = O_CBS + (size_t)DEPTH * DB * 512, O_DS = O_DP + (size_t)DEPTH * NB * 16384,
    O_CDP = O_DS + (size_t)DEPTH * DB * 16384, O_CDS = O_CDP + DEPTH * NB * 2304, O_END = O_CDS + (size_t)DEPTH * DB * 2304;

constexpr size_t MiB = 1u << 20;
constexpr size_t al(size_t x) { return (x + 4095) & ~(size_t)4095; }
constexpr size_t WS_CTL = 0, CTL_ZERO_BYTES = 1 * MiB;
constexpr size_t WL_ADA = 0, WL_W1 = WL_ADA + (size_t)NMOD * D * 2, WL_GLU = WL_W1 + (size_t)N1 * D * 2, WL_BR = WL_GLU + 256 * 256 * 2, WL_WO = WL_BR + (size_t)4 * D * 256 * 2,
    WL_UP = WL_WO + (size_t)D * D * 2, WL_DN = WL_UP + (size_t)NUP * D * 2, WL_LOG = WL_DN + (size_t)D * DFF * 2, WL_SIZE = (WL_LOG + 8 * D * 4 + 524287) & ~(size_t)524287;
constexpr size_t WS_W = 1 * MiB, WS_CSILU = WS_W + DEPTH * WL_SIZE, WS_MOD = WS_CSILU + 256 * D * 2, WS_H = WS_MOD + (size_t)DEPTH * 256 * NMOD * 4,
    WS_PROJ = WS_H + (size_t)M * D * 2, WS_GATE = al(WS_PROJ + (size_t)M * NPROJ * 2), WS_LOG8 = WS_GATE + (size_t)M * NGATE * 2, WS_Y = WS_LOG8 + (size_t)M * 8 * 4,
    WS_YS = WS_Y + (size_t)M * D * 2, WS_MERGE = WS_YS + (size_t)M * 256 * 2, WS_MERGEB = WS_MERGE + (size_t)M * D * 4, WS_X1 = WS_MERGEB + (size_t)M * D * 2,
    WS_ACT = WS_X1 + (size_t)M * D * 4, WS_X2 = al(WS_ACT + (size_t)M * DFF * 2), WS_SEND = WS_X2 + (size_t)M * D * 4, WS_HIN = WS_SEND + (size_t)NB * 16 * SSM_NCH * 128 * 4,
    WS_GD = WS_HIN + (size_t)NB * 16 * SSM_NCH * 128 * 4, WS_EGL = WS_GD + (size_t)NB * GH * GNCH * 49152, WS_ODRAW = al(WS_EGL + (size_t)NB * GH * GNCH * 4),
    WS_VT = al(WS_ODRAW + (size_t)M * 256 * 4), WS_END = WS_VT + (size_t)NB * SBH * 64 * SEQ * 2;
constexpr int CW_TMO = 0, CW_BAR = 4096;
constexpr size_t GD_UNIT = 49152;

#define LAS_HW __attribute__((address_space(3)))
#ifdef CPU_EMU
#define LAS
#else
#define LAS LAS_HW
#endif
typedef unsigned short bf16;
typedef unsigned v4u __attribute__((ext_vector_type(4)));
typedef unsigned v2u __attribute__((ext_vector_type(2)));
typedef float f32x4 __attribute__((ext_vector_type(4)));
typedef float f32x2 __attribute__((ext_vector_type(2)));
typedef short bf16x8 __attribute__((ext_vector_type(8)));
#ifdef CPU_EMU
#define LDS_WAIT() do {} while (0)
#define VM_WAIT() do {} while (0)
#define WAVE_SYNC() emu::wave_sync()
#define CFENCE() do {} while (0)
#define RAW_BAR() emu::block_sync()
#else
#define LDS_WAIT() asm volatile("s_waitcnt lgkmcnt(0)" ::: "memory")
#define VM_WAIT() asm volatile("s_waitcnt vmcnt(0)" ::: "memory")
#define WAVE_SYNC() do { asm volatile("s_waitcnt lgkmcnt(0)" ::: "memory"); __builtin_amdgcn_wave_barrier(); } while (0)
#define CFENCE() asm volatile("" ::: "memory")
#define RAW_BAR() do { asm volatile("s_waitcnt lgkmcnt(0)" ::: "memory"); __builtin_amdgcn_s_barrier(); asm volatile("" ::: "memory"); } while (0)
#endif
#ifdef CPU_EMU
#define OPAQUE_V(x) do {} while (0)
#else
#define OPAQUE_V(x) asm volatile("" : "+v"(x))
#endif
__device__ __forceinline__ unsigned f2bf(float f) { unsigned u = __builtin_bit_cast(unsigned, f); return (u + 0x7fffu + ((u >> 16) & 1u)) >> 16; }
__device__ __forceinline__ unsigned pk2(float lo, float hi) { return f2bf(lo) | (f2bf(hi) << 16); }
__device__ __forceinline__ float bf2f(unsigned b) { return __builtin_bit_cast(float, b << 16); }
__device__ __forceinline__ float bflo(unsigned w) { return __builtin_bit_cast(float, w << 16); }
__device__ __forceinline__ float bfhi(unsigned w) { return __builtin_bit_cast(float, w & 0xffff0000u); }
__device__ __forceinline__ float sigmoidf_(float x) { return 1.0f / (1.0f + __expf(-x)); }
__device__ __forceinline__ float siluf_(float x) { return x / (1.0f + __expf(-x)); }
__device__ __forceinline__ float wave_sum(float v) {
#pragma unroll
    for (int o = 1; o < 64; o <<= 1) v += __shfl_xor(v, o);
    return v;
}
__device__ __forceinline__ int seq_of(int m) { return m < MP ? m / SEQ : NB + (m - MP) / DEC_SEQ; }
namespace pg8 {
typedef unsigned short bf16_t;
constexpr int BM = 256, BK = 64, HALF = 128, HTB = HALF * BK * 2, STAGE_BYTES = 8 * HTB, NXCD = 8, WGM = 8;
__host__ __device__ __forceinline__ int lds_byte(int r, int c) { const int st = (r >> 4) * 2 + (c >> 5), rr = r & 15, cc = c & 31, ob = rr * 64 + cc * 2; return st * 1024 + (ob ^ (((ob >> 9) & 1) << 5)); }
__host__ __device__ __forceinline__ void stage_rc(int b, int& R, int& C) { const int st = b / 1024, sb = b % 1024, swz = sb ^ (((sb >> 9) & 1) << 5); R = (st >> 1) * 16 + swz / 64; C = (st & 1) * 32 + (swz % 64) / 2; }
__host__ __device__ __forceinline__ int perm32(int rho) { const int n = rho >> 4, i = rho & 15; return 8 * (i >> 2) + 4 * n + (i & 3); }
struct Unit { int pm, pn, ka, aux; };
struct NoState {};
struct Gemm { const bf16_t* A; const bf16_t* Bt; int lda, K; };
struct GridOrder {
    int nM, nN, nwg, G, c, pn0;
    __host__ __device__ void init(int nM_, int nN_, int G_, int c_, int pn0_ = 0) { nM = nM_; nN = nN_; nwg = nM * nN; G = G_; c = c_; pn0 = pn0_; }
    __host__ __device__ bool tile(long L, int& pm, int& pn) const {
        if (L >= nwg) return false;
        int wgid = (int)L; { const int q = nwg / NXCD, r = nwg % NXCD, xcd = wgid % NXCD, off = wgid / NXCD; wgid = (xcd < r ? xcd * (q + 1) : r * (q + 1) + (xcd - r) * q) + off; }
        const int nig = WGM * nN, gid = wgid / nig, fm = gid * WGM, gsz = (nM - fm) < WGM ? (nM - fm) : WGM;
        pm = fm + ((wgid % nig) % gsz); pn = (wgid % nig) / gsz; return true;
    }
    __host__ __device__ bool next(int i, Unit& u) const { int pm, pn; if (!tile((long)i * G + c, pm, pn)) return false; u.pm = pm; u.pn = pn0 + pn; u.ka = 0; u.aux = pn; return true; }
    __device__ __forceinline__ void a_ready(const Unit&) const {}
    __device__ __forceinline__ void done(const Unit&) const {}
};
struct MergeOrder : GridOrder {
    __host__ __device__ bool next(int i, Unit& u) const { int pm, pc; if (!tile((long)(i >> 2) * G + c, pm, pc)) return false; const int n = i & 3; u.pm = pm; u.pn = 8 * n + pc; u.ka = 256 * n; u.aux = (n << 8) | pc; return true; }
};
#ifndef CPU_EMU
#define PG8_LAS __attribute__((address_space(3)))
template <class Epi, class Sched, bool ALIGN_EPI = false, bool SP2 = false, bool HALFN = false>
__device__ __forceinline__ void gemm_phase(PG8_LAS unsigned char* lds, const Gemm g, const Sched& S, const Epi& E) {
    int tid = threadIdx.x; asm volatile("" : "+v"(tid));
    const int wid = __builtin_amdgcn_readfirstlane(tid >> 6), lane = tid & 63, wr = wid >> 2, wc = wid & 3, fr = lane & 15, fq = lane >> 4;
    int K = g.K; asm volatile("" : "+s"(K));
    const int nt = K / BK, lda = g.lda;
    unsigned voffA[2], voffB[2];
#pragma unroll
    for (int i = 0; i < 2; ++i) { int R, C; stage_rc(tid * 16 + i * 8192, R, C); const int Rb = Epi::PERM ? ((R & ~31) + perm32(R & 31)) : R;
        voffA[i] = (unsigned)(R * lda + C) * 2u; voffB[i] = (unsigned)(Rb * K + C) * 2u; }
    const size_t kstep = (size_t)(BK * 2);
    const size_t hstepA = (size_t)HALF * lda * 2, hstepB = HALFN ? (size_t)0 : (size_t)HALF * K * 2;
    const size_t tstepA = 2 * hstepA, tstepB = HALFN ? (size_t)HALF * K * 2 : 2 * hstepB;
    const unsigned ldsw = (unsigned)wid * 1024u;
    const int aoff = lds_byte(wr * 64 + fr, fq * 8), boff = lds_byte(wc * 32 + fr, fq * 8);
#define PG8_SA(b, h) (((b) * 2 + (h)) * HTB)
#define PG8_SB(b, h) ((4 + (b) * 2 + (h)) * HTB)
#define PG8_STAGE(bufoff, gbase, voff) do { _Pragma("unroll") for (int _i = 0; _i < 2; ++_i) \
        __builtin_amdgcn_global_load_lds((const unsigned*)((const char*)(gbase) + (voff)[_i]), (PG8_LAS unsigned*)(lds + (bufoff) + ldsw + _i * 8192), 16, 0, 0); } while (0)
#define PG8_LDA(dst, b, h) do { _Pragma("unroll") for (int m = 0; m < 4; ++m) _Pragma("unroll") for (int k = 0; k < 2; ++k) dst[m][k] = *(const PG8_LAS bf16x8*)(lds + PG8_SA(b, h) + aoff + m * 2048 + k * 1024); } while (0)
#define PG8_LDB(dst, b, h) do { _Pragma("unroll") for (int n = 0; n < 2; ++n) _Pragma("unroll") for (int k = 0; k < 2; ++k) dst[n][k] = *(const PG8_LAS bf16x8*)(lds + PG8_SB(b, h) + boff + n * 2048 + k * 1024); } while (0)
#define PG8_MMA(ai, bj, At, Bt) do { __builtin_amdgcn_s_setprio(1); _Pragma("unroll") for (int m = 0; m < 4; ++m) _Pragma("unroll") for (int n = 0; n < 2; ++n) _Pragma("unroll") for (int k = 0; k < 2; ++k) \
        acc[ai][bj][m][n] = __builtin_amdgcn_mfma_f32_16x16x32_bf16(Bt[n][k], At[m][k], acc[ai][bj][m][n], 0, 0, 0); __builtin_amdgcn_s_setprio(0); } while (0)
#define PG8_WAIT_V(n) asm volatile("s_waitcnt vmcnt(" #n ")" ::: "memory")
#define PG8_WAIT_L(n) asm volatile("s_waitcnt lgkmcnt(" #n ")" ::: "memory")
#define PG8_BAR __builtin_amdgcn_s_barrier()
#define PG8_SCHED __builtin_amdgcn_sched_barrier(0)
    Unit cur, nxt; int ui = 0;
    if (!S.next(0, cur)) return;
    f32x4 acc[2][2][4][2];
    typename Epi::State est;
#pragma unroll
    for (int a = 0; a < 2; ++a)
#pragma unroll
        for (int b = 0; b < 2; ++b)
#pragma unroll
            for (int m = 0; m < 4; ++m)
#pragma unroll
                for (int n = 0; n < 2; ++n) acc[a][b][m][n] = (f32x4){0.f, 0.f, 0.f, 0.f};
    static_assert(!HALFN || SP2, "HALFN is written for the SP2 loop");
    bf16x8 At[4][2], B0[2][2], B1[2][2];
    const char* cA = (const char*)g.A + (size_t)cur.pm * tstepA + (size_t)cur.ka * 2; const char* cB = (const char*)g.Bt + (size_t)cur.pn * tstepB;
    S.a_ready(cur);
    if constexpr (SP2) {
        PG8_STAGE(PG8_SB(0, 0), cB, voffB); PG8_STAGE(PG8_SB(0, 1), cB + hstepB, voffB); PG8_STAGE(PG8_SA(0, 0), cA, voffA); PG8_STAGE(PG8_SA(0, 1), cA + hstepA, voffA);
        if (wr == 1) PG8_BAR;
        PG8_WAIT_V(2); PG8_BAR;
        PG8_STAGE(PG8_SB(1, 0), cB + kstep, voffB); PG8_STAGE(PG8_SA(1, 0), cA + kstep, voffA); PG8_STAGE(PG8_SB(1, 1), cB + hstepB + kstep, voffB);
        PG8_WAIT_V(6); PG8_BAR;
    } else {
        PG8_STAGE(PG8_SB(0, 0), cB, voffB); PG8_STAGE(PG8_SA(0, 0), cA, voffA); PG8_STAGE(PG8_SB(0, 1), cB + hstepB, voffB); PG8_STAGE(PG8_SA(0, 1), cA + hstepA, voffA);
        if (wr == 1) PG8_BAR;
        PG8_WAIT_V(4); PG8_BAR;
        PG8_STAGE(PG8_SB(1, 0), cB + kstep, voffB); PG8_STAGE(PG8_SA(1, 0), cA + kstep, voffA); PG8_STAGE(PG8_SB(1, 1), cB + hstepB + kstep, voffB);
        PG8_WAIT_V(6); PG8_BAR;
    }
    for (;;) {
        const bool has_next = S.next(ui + 1, nxt);
        const char* nA = has_next ? (const char*)g.A + (size_t)nxt.pm * tstepA + (size_t)nxt.ka * 2 : cA; const char* nB = has_next ? (const char*)g.Bt + (size_t)nxt.pn * tstepB : cB;
        for (int t = 0; t < nt; t += 2) {
            const bool last = (t == nt - 2);
            const char* a1 = cA + (size_t)(t + 1) * kstep;
            const char* a2 = last ? nA : cA + (size_t)(t + 2) * kstep; const char* b2 = last ? nB : cB + (size_t)(t + 2) * kstep;
            const char* a3 = a2 + kstep; const char* b3 = b2 + kstep;
            if (last && has_next) S.a_ready(nxt);
            if constexpr (SP2) {
            PG8_LDB(B0, 0, 0); if constexpr (!HALFN) PG8_LDB(B1, 0, 1); PG8_SCHED; PG8_LDA(At, 0, 0); PG8_STAGE(PG8_SA(1, 1), a1 + hstepA, voffA);
            PG8_WAIT_V(8); PG8_WAIT_L(0); PG8_BAR; PG8_MMA(0, 0, At, B0); if constexpr (!HALFN) PG8_MMA(0, 1, At, B1); PG8_BAR; PG8_SCHED;
            PG8_LDA(At, 0, 1); PG8_STAGE(PG8_SB(0, 0), b2, voffB); PG8_STAGE(PG8_SB(0, 1), b2 + hstepB, voffB); PG8_STAGE(PG8_SA(0, 0), a2, voffA);
            PG8_WAIT_V(8); PG8_WAIT_L(0); PG8_BAR; PG8_MMA(1, 0, At, B0); if constexpr (!HALFN) PG8_MMA(1, 1, At, B1); PG8_BAR; PG8_SCHED;
            PG8_LDB(B0, 1, 0); if constexpr (!HALFN) PG8_LDB(B1, 1, 1); PG8_SCHED; PG8_LDA(At, 1, 0); PG8_STAGE(PG8_SA(0, 1), a2 + hstepA, voffA);
            PG8_WAIT_V(8); PG8_WAIT_L(0); PG8_BAR; PG8_MMA(0, 0, At, B0); if constexpr (!HALFN) PG8_MMA(0, 1, At, B1); PG8_BAR; PG8_SCHED;
            PG8_LDA(At, 1, 1); PG8_STAGE(PG8_SB(1, 0), b3, voffB); PG8_STAGE(PG8_SB(1, 1), b3 + hstepB, voffB); PG8_STAGE(PG8_SA(1, 0), a3, voffA);
            PG8_WAIT_V(8); PG8_WAIT_L(0); PG8_BAR; PG8_MMA(1, 0, At, B0); if constexpr (!HALFN) PG8_MMA(1, 1, At, B1); PG8_BAR; PG8_SCHED;
            } else {
            PG8_LDB(B0, 0, 0); PG8_SCHED; PG8_LDA(At, 0, 0); PG8_STAGE(PG8_SA(1, 1), a1 + hstepA, voffA);
            PG8_WAIT_L(8); PG8_BAR; PG8_WAIT_L(0); PG8_MMA(0, 0, At, B0); PG8_BAR; PG8_SCHED;
            PG8_LDB(B1, 0, 1); PG8_STAGE(PG8_SB(0, 0), b2, voffB);
            PG8_BAR; PG8_WAIT_L(0); PG8_MMA(0, 1, At, B1); PG8_BAR;
            PG8_LDA(At, 0, 1); PG8_STAGE(PG8_SA(0, 0), a2, voffA);
            PG8_BAR; PG8_WAIT_L(0); PG8_MMA(1, 0, At, B0); PG8_BAR; PG8_SCHED;
            PG8_STAGE(PG8_SB(0, 1), b2 + hstepB, voffB);
            PG8_WAIT_V(6); PG8_BAR; PG8_MMA(1, 1, At, B1); PG8_BAR;
            PG8_LDB(B0, 1, 0); PG8_SCHED; PG8_LDA(At, 1, 0); PG8_STAGE(PG8_SA(0, 1), a2 + hstepA, voffA);
            PG8_WAIT_L(8); PG8_BAR; PG8_WAIT_L(0); PG8_MMA(0, 0, At, B0); PG8_BAR; PG8_SCHED;
            PG8_LDB(B1, 1, 1); PG8_STAGE(PG8_SB(1, 0), b3, voffB);
            PG8_BAR; PG8_WAIT_L(0); PG8_MMA(0, 1, At, B1); PG8_BAR;
            PG8_LDA(At, 1, 1); PG8_STAGE(PG8_SA(1, 0), a3, voffA);
            PG8_BAR; PG8_WAIT_L(0); PG8_MMA(1, 0, At, B0); PG8_BAR; PG8_SCHED;
            PG8_STAGE(PG8_SB(1, 1), b3 + hstepB, voffB);
            PG8_WAIT_V(6); PG8_BAR; PG8_MMA(1, 1, At, B1); PG8_BAR;
            }
        }
        if constexpr (ALIGN_EPI) { if (wr == 0) PG8_BAR; }
        E(acc, est, cur, wr, wc, fr, fq); S.done(cur);
        if (!has_next) break;
#pragma unroll
        for (int a = 0; a < 2; ++a)
#pragma unroll
            for (int b = 0; b < 2; ++b)
#pragma unroll
                for (int m = 0; m < 4; ++m)
#pragma unroll
                    for (int n = 0; n < 2; ++n) acc[a][b][m][n] = (f32x4){0.f, 0.f, 0.f, 0.f};
        cur = nxt; cA = nA; cB = nB; ++ui;
        if constexpr (ALIGN_EPI) { if (wr == 1) PG8_BAR; }
    }
    PG8_WAIT_V(0);
    if constexpr (!ALIGN_EPI) { if (wr == 0) PG8_BAR; }
    PG8_BAR;
#undef PG8_SA
#undef PG8_SB
#undef PG8_STAGE
#undef PG8_LDA
#undef PG8_LDB
#undef PG8_MMA
#undef PG8_WAIT_V
#undef PG8_WAIT_L
#undef PG8_BAR
#undef PG8_SCHED
}
#else
template <class Epi, class Sched, bool ALIGN_EPI = false, bool SP2 = false, bool HALFN = false>
void gemm_phase(unsigned char* lds, const Gemm g, const Sched& S, const Epi& E) {
    const int tid = threadIdx.x, wid = tid >> 6, lane = tid & 63, wr = wid >> 2, wc = wid & 3, fr = lane & 15, fq = lane >> 4;
    static thread_local float* Ct = nullptr; static thread_local float* Af = nullptr; static thread_local float* Bf = nullptr;
    Unit u; typename Epi::State est;
    for (int i = 0; S.next(i, u); ++i) {
        S.a_ready(u);
        __syncthreads();
        if (tid == 0) {
            if (!Ct) { Ct = new float[256 * 256]; Af = new float[256 * 4096]; Bf = new float[256 * 4096]; }
            const int K = g.K;
            for (int r = 0; r < 256; ++r) for (int k = 0; k < K; ++k) { Af[r * K + k] = bf2f(g.A[(size_t)(u.pm * 256 + r) * g.lda + u.ka + k]); Bf[r * K + k] = HALFN ? (r < 128 ? bf2f(g.Bt[(size_t)(u.pn * 128 + r) * K + k]) : 0.f) : bf2f(g.Bt[(size_t)(u.pn * 256 + r) * K + k]); }
            for (int r = 0; r < 256; ++r) for (int c = 0; c < 256; ++c) { float s = 0.f; const float* a = Af + r * K; const float* b = Bf + c * K; for (int k = 0; k < K; ++k) s += a[k] * b[k]; Ct[r * 256 + c] = s; }
        }
        __syncthreads();
        f32x4 acc[2][2][4][2];
        for (int ai = 0; ai < 2; ++ai) for (int bj = 0; bj < 2; ++bj) for (int m = 0; m < 4; ++m) for (int n = 0; n < 2; ++n) for (int e = 0; e < 4; ++e) {
            const int r = 128 * ai + 64 * wr + 16 * m + fr; const int c = Epi::PERM ? (128 * bj + 32 * wc + 8 * fq + 4 * n + e) : (128 * bj + 32 * wc + 16 * n + 4 * fq + e);
            acc[ai][bj][m][n][e] = Ct[r * 256 + c]; }
        E(acc, est, u, wr, wc, fr, fq); S.done(u);
    }
    __syncthreads();
}
#endif
}
namespace pg8 {
struct EpiMod {
    static constexpr bool PERM = false; typedef NoState State;
    float* C; const float* bias;
    __device__ __forceinline__ void operator()(const f32x4 (&acc)[2][2][4][2], State& st, const Unit& u, int wr, int wc, int fr_in, int fq_in) const {
        int fr = fr_in, fq = fq_in; OPAQUE_V(fr); OPAQUE_V(fq);
        const int row0 = wr * 64 + fr, col0 = u.aux * BM + wc * 32 + 4 * fq;
#pragma unroll
        for (int ai = 0; ai < 2; ++ai)
#pragma unroll
            for (int m = 0; m < 4; ++m) { float* rowp = C + (size_t)(row0 + ai * HALF + m * 16) * NMOD + col0;
#pragma unroll
                for (int bj = 0; bj < 2; ++bj)
#pragma unroll
                    for (int n = 0; n < 2; ++n) *(f32x4*)(rowp + bj * HALF + n * 16) = acc[ai][bj][m][n] + *(const f32x4*)(bias + col0 + bj * HALF + n * 16); }
    }
};
struct EpiProj {
    static constexpr bool PERM = true; typedef NoState State;
    bf16* proj; bf16* gate; float* outk_p; float* outv_p; float* outk_s; float* outv_s; bf16* vt;
    __device__ __forceinline__ void operator()(const f32x4 (&acc)[2][2][4][2], State& st, const Unit& u, int wr, int wc, int fr_in, int fq_in) const {
        int fr = fr_in, fq = fq_in; OPAQUE_V(fr); OPAQUE_V(fq);
        const int t = u.aux; const bool isg = t >= 11;
        const int row0 = u.pm * BM + wr * 64 + fr, colt = wc * 32 + 8 * fq;
        bf16* base = isg ? gate + (size_t)(t - 11) * 256 : proj + (size_t)t * 256; const int ldc = isg ? NGATE : NPROJ;
#pragma unroll
        for (int ai = 0; ai < 2; ++ai)
#pragma unroll
            for (int m = 0; m < 4; ++m) { const int row = row0 + ai * HALF + m * 16; bf16* rowp = base + (size_t)row * ldc + colt;
#pragma unroll
                for (int bj = 0; bj < 2; ++bj) { f32x4 v0 = acc[ai][bj][m][0], v1 = acc[ai][bj][m][1];
                    if (isg) {
#pragma unroll
                        for (int e = 0; e < 4; ++e) { v0[e] = sigmoidf_(v0[e]); v1[e] = sigmoidf_(v1[e]); } }
                    else if (t >= 9) { if (t == 10 && row < MP) { const int cv = colt + bj * HALF, bb = row / SEQ, tt = row % SEQ; bf16* vp = vt + ((size_t)(bb * SBH + (cv >> 6)) * 64 + (cv & 63)) * SEQ + tt;
#pragma unroll
                            for (int e = 0; e < 4; ++e) { vp[(size_t)e * SEQ] = (bf16)f2bf(v0[e]); vp[(size_t)(4 + e) * SEQ] = (bf16)f2bf(v1[e]); } }
                        float* o = (row < MP) ? ((t == 9 ? outk_p : outv_p) + (size_t)row * 256) : ((t == 9 ? outk_s : outv_s) + (size_t)(row - MP) * 256);
                        *(f32x4*)(o + colt + bj * HALF) = v0; *(f32x4*)(o + colt + bj * HALF + 4) = v1; }
                    v4u w; w.x = pk2(v0[0], v0[1]); w.y = pk2(v0[2], v0[3]); w.z = pk2(v1[0], v1[1]); w.w = pk2(v1[2], v1[3]);
                    *(v4u*)(rowp + bj * HALF) = w; } }
    }
};
struct EpiGlu {
    static constexpr bool PERM = true; typedef NoState State;
    const bf16* ys; bf16* y;
    __device__ __forceinline__ void operator()(const f32x4 (&acc)[2][2][4][2], State& st, const Unit& u, int wr, int wc, int fr_in, int fq_in) const {
        int fr = fr_in, fq = fq_in; OPAQUE_V(fr); OPAQUE_V(fq);
        const int row0 = u.pm * BM + wr * 64 + fr, colt = wc * 32 + 8 * fq;
#pragma unroll
        for (int ai = 0; ai < 2; ++ai)
#pragma unroll
            for (int m = 0; m < 4; ++m) { const int row = row0 + ai * HALF + m * 16;
#pragma unroll
                for (int bj = 0; bj < 2; ++bj) { const f32x4 v0 = acc[ai][bj][m][0], v1 = acc[ai][bj][m][1];
                    const v4u s = *(const v4u*)(ys + (size_t)row * 256 + colt + bj * HALF);
                    v4u w; w.x = pk2(bflo(s.x) * sigmoidf_(v0[0]), bfhi(s.x) * sigmoidf_(v0[1])); w.y = pk2(bflo(s.y) * sigmoidf_(v0[2]), bfhi(s.y) * sigmoidf_(v0[3]));
                    w.z = pk2(bflo(s.z) * sigmoidf_(v1[0]), bfhi(s.z) * sigmoidf_(v1[1])); w.w = pk2(bflo(s.w) * sigmoidf_(v1[2]), bfhi(s.w) * sigmoidf_(v1[3]));
                    *(v4u*)(y + (size_t)row * D + colt + bj * HALF) = w; } CFENCE(); }
    }
};
struct EpiMerge {
    static constexpr bool PERM = false; struct State { f32x4 macc[2][4][2]; };
    const bf16* gate; bf16* mgb;
    __device__ __forceinline__ void operator()(const f32x4 (&acc)[2][2][4][2], State& st, const Unit& u, int wr, int wc, int fr_in, int fq_in) const {
        int fr = fr_in, fq = fq_in; OPAQUE_V(fr); OPAQUE_V(fq);
        const int n_ = u.aux >> 8, pc = u.aux & 255;
        const int row0 = u.pm * BM + wr * 64 + fr, col0 = pc * HALF + wc * 32 + 4 * fq;
        v2u gw[2][4][2];
#pragma unroll
        for (int ai = 0; ai < 2; ++ai)
#pragma unroll
            for (int m = 0; m < 4; ++m)
#pragma unroll
                for (int n = 0; n < 2; ++n) gw[ai][m][n] = *(const v2u*)(gate + (size_t)(row0 + ai * HALF + m * 16) * NGATE + n_ * D + col0 + n * 16);
        CFENCE();
#pragma unroll
        for (int ai = 0; ai < 2; ++ai)
#pragma unroll
            for (int m = 0; m < 4; ++m) { const int row = row0 + ai * HALF + m * 16;
#pragma unroll
                for (int n = 0; n < 2; ++n) { const int col = col0 + n * 16; const v2u g2 = gw[ai][m][n];
                    f32x4 v = acc[ai][0][m][n]; v[0] *= bflo(g2.x); v[1] *= bfhi(g2.x); v[2] *= bflo(g2.y); v[3] *= bfhi(g2.y);
                    if (n_ > 0) v += st.macc[ai][m][n];
                    st.macc[ai][m][n] = v;
                    if (n_ == 3) { v2u o; o.x = pk2(v[0], v[1]); o.y = pk2(v[2], v[3]); *(v2u*)(mgb + (size_t)row * D + col) = o; } } }
    }
};
struct EpiRes {
    static constexpr bool PERM = false; typedef NoState State;
    const float* xP; const float* xS; const float* gmod; float* out;
    __device__ __forceinline__ void operator()(const f32x4 (&acc)[2][2][4][2], State& st, const Unit& u, int wr, int wc, int fr_in, int fq_in) const {
        int fr = fr_in, fq = fq_in; OPAQUE_V(fr); OPAQUE_V(fq);
        const int row0 = u.pm * BM + wr * 64 + fr, col0 = u.aux * BM + wc * 32 + 4 * fq;
#pragma unroll
        for (int ai = 0; ai < 2; ++ai)
#pragma unroll
            for (int m = 0; m < 4; ++m) { const int row = row0 + ai * HALF + m * 16; const float* xr = row < MP ? xP + (size_t)row * D : xS + (size_t)(row - MP) * D;
                const float* gr = gmod + (size_t)seq_of(row) * NMOD;
#pragma unroll
                for (int bj = 0; bj < 2; ++bj)
#pragma unroll
                    for (int n = 0; n < 2; ++n) { const int col = col0 + bj * HALF + n * 16;
                        const f32x4 xv = *(const f32x4*)(xr + col), gv = *(const f32x4*)(gr + col);
                        *(f32x4*)(out + (size_t)row * D + col) = xv * ALPHA + (gv + 1.0f) * acc[ai][bj][m][n]; } CFENCE(); }
    }
};
struct EpiUp {
    static constexpr bool PERM = true; typedef NoState State;
    bf16* act;
    __device__ __forceinline__ void operator()(const f32x4 (&acc)[2][2][4][2], State& st, const Unit& u, int wr, int wc, int fr_in, int fq_in) const {
        int fr = fr_in, fq = fq_in; OPAQUE_V(fr); OPAQUE_V(fq);
        const int row0 = u.pm * BM + wr * 64 + fr, col0 = u.aux * HALF + wc * 32 + 8 * fq;
#pragma unroll
        for (int ai = 0; ai < 2; ++ai)
#pragma unroll
            for (int m = 0; m < 4; ++m) { const int row = row0 + ai * HALF + m * 16;
                const f32x4 a0 = acc[ai][0][m][0], a1 = acc[ai][0][m][1], b0 = acc[ai][1][m][0], b1 = acc[ai][1][m][1];
                v4u w; w.x = pk2(siluf_(a0[0]) * b0[0], siluf_(a0[1]) * b0[1]); w.y = pk2(siluf_(a0[2]) * b0[2], siluf_(a0[3]) * b0[3]);
                w.z = pk2(siluf_(a1[0]) * b1[0], siluf_(a1[1]) * b1[1]); w.w = pk2(siluf_(a1[2]) * b1[2], siluf_(a1[3]) * b1[3]);
                *(v4u*)(act + (size_t)row * DFF + col0) = w; }
    }
};
}
struct Args { const float* in[38]; float* out; unsigned char* ws; int ph_lo, ph_hi, li, pad; };
enum { I_XP = 0, I_XS, I_CK, I_CV, I_SRE, I_SIM, I_SCB, I_SD, I_SCD, I_PT, I_CP, I_CS, I_WADA, I_BADA, I_WIN, I_ARE, I_AIM, I_LDT, I_BRE, I_BIM, I_CRE, I_CIM, I_SSD, I_WGLU,
       I_CBW, I_DCW, I_DAL, I_DDT, I_DNW, I_WBR, I_WGATE, I_WO, I_L1G, I_L1B, I_WUP, I_WDN, I_L2G, I_L2B };
constexpr int NWAVES = 8, RING_BYTES = 131072, MISC_OFF = RING_BYTES, LDS_BYTES = 147456;
#ifndef CPU_EMU
#define XB_TMO      128
#define XB_XCNT(j)  (256  + 64 * (j))
#define XB_XSUB(j)  (1280 + 64 * (j))
#define XB_XGEN(j)  (2304 + 64 * (j))
#define XB_TOP      3328
#define XB_TOPGEN   3392
#define XCD_BAR_WORDS 3456
#define XB_SPIN_CAP (1u << 18)
__device__ __forceinline__ unsigned xb_ld(unsigned* p)              { return __hip_atomic_load(p, __ATOMIC_RELAXED, __HIP_MEMORY_SCOPE_AGENT); }
__device__ __forceinline__ unsigned xb_add(unsigned* p, unsigned v) { return __hip_atomic_fetch_add(p, v, __ATOMIC_RELAXED, __HIP_MEMORY_SCOPE_AGENT); }
__device__ __forceinline__ unsigned xb_xcc_id() { return (unsigned)__builtin_amdgcn_s_getreg((3 << 11) | 20) & 0xFu; }
#define XB_SPIN(cond, bar) do { unsigned _sp = 0; while (cond) { __builtin_amdgcn_s_sleep(1); \
    if ((++_sp & 255u) == 0u) { if (xb_ld(&(bar)[XB_TMO])) break; if (_sp > XB_SPIN_CAP) { atomicAdd(&(bar)[XB_TMO], 1u); break; } } } } while (0)
struct XcdBarrier { unsigned* bar; unsigned x; volatile LAS_HW unsigned* st; };
__device__ __forceinline__ XcdBarrier xcd_barrier_post(unsigned* bar, volatile LAS_HW unsigned* st) {
    XcdBarrier b; b.bar = bar; b.x = xb_xcc_id(); b.st = st;
    if (threadIdx.x == 0) (void)xb_add(&bar[XB_XCNT(b.x)], 1u);
    return b;
}
__device__ __forceinline__ void xcd_barrier_complete(unsigned* bar, unsigned x, unsigned& nloc, unsigned& nx) {
    const unsigned G = gridDim.x * gridDim.y * gridDim.z;
    unsigned sum, cnt, mine, sp = 0u;
    for (;;) {
        sum = 0u; cnt = 0u; mine = 0u;
#pragma unroll
        for (unsigned j = 0; j < 16; ++j) { const unsigned c = xb_ld(&bar[XB_XCNT(j)]); sum += c; cnt += (c > 0u) ? 1u : 0u; mine = (j == x) ? c : mine; }
        if (sum == G) break;
        __builtin_amdgcn_s_sleep(1);
        if ((++sp & 255u) == 0u) { if (xb_ld(&bar[XB_TMO])) break; if (sp > XB_SPIN_CAP) { atomicAdd(&bar[XB_TMO], 1u); break; } }
    }
    nloc = mine > 0u ? mine : 1u; nx = cnt > 0u ? cnt : 1u;
}
__device__ __forceinline__ void xcd_barrier(const XcdBarrier& b) {
    asm volatile("s_waitcnt vmcnt(0)" ::: "memory");
    __syncthreads();
    if (threadIdx.x == 0) {
        unsigned* bar = b.bar;
        __builtin_amdgcn_s_waitcnt(0);
        unsigned nloc = b.st[0], nx = b.st[1];
        if (nloc == 0u) { xcd_barrier_complete(bar, b.x, nloc, nx); b.st[0] = nloc; b.st[1] = nx; }
        const unsigned old = xb_add(&bar[XB_XSUB(b.x)], 1u);
        const unsigned gen = old / nloc;
        if (old + 1u == (gen + 1u) * nloc) {
            __builtin_amdgcn_fence(__ATOMIC_RELEASE, "agent");
            asm volatile("s_waitcnt vmcnt(0)" ::: "memory");
            const unsigned og = xb_add(&bar[XB_TOP], 1u);
            const unsigned tg = og / nx;
            if (og + 1u == (tg + 1u) * nx) xb_add(&bar[XB_TOPGEN], 1u);
            else XB_SPIN(xb_ld(&bar[XB_TOPGEN]) == tg, bar);
            __builtin_amdgcn_fence(__ATOMIC_ACQUIRE, "agent");
            xb_add(&bar[XB_XGEN(b.x)], 1u);
            asm volatile("s_waitcnt vmcnt(0)" ::: "memory");
        } else {
            XB_SPIN(xb_ld(&bar[XB_XGEN(b.x)]) == gen, bar);
            __builtin_amdgcn_fence(__ATOMIC_ACQUIRE, "agent");
            asm volatile("s_waitcnt vmcnt(0)" ::: "memory");
        }
    }
    __syncthreads();
}
#else
#define XCD_BAR_WORDS 3456
struct XcdBarrier { int dummy; };
inline void xcd_barrier(const XcdBarrier&) { emu::grid_sync(); }
#endif

#define TIDS int tid_ = threadIdx.x; OPAQUE_V(tid_); const int tid = tid_, lane = tid & 63, wave = __builtin_amdgcn_readfirstlane(tid >> 6), G = gridDim.x, bid = blockIdx.x, gw = bid * NWAVES + wave, NGW = G * NWAVES; (void)lane; (void)wave; (void)gw; (void)NGW; (void)G; (void)bid
__device__ __forceinline__ bf16* wsb(const Args& A, size_t off) { return (bf16*)(A.ws + off); }
__device__ __forceinline__ float* wsf(const Args& A, size_t off) { return (float*)(A.ws + off); }
__device__ __forceinline__ float softplusf_(float x) { return fmaxf(x, 0.f) + log1pf(__expf(-fabsf(x))); }
__device__ __forceinline__ void tr_item(const float* W, int N, int K, int k0, int c0, bf16* WT, int drow0, LAS float* scr, int lane) {
#pragma unroll 8
    for (int i = 0; i < 32; ++i) { const int kk = 2 * i + (lane >> 5); scr[kk * 33 + (lane & 31)] = W[(size_t)(k0 + kk) * N + c0 + (lane & 31)]; }
    WAVE_SYNC();
    const int c = lane & 7;
#pragma unroll
    for (int j = 0; j < 4; ++j) { const int n = (lane >> 3) + 8 * j; const LAS float* s = scr + (8 * c) * 33 + n;
        v4u o; o.x = pk2(s[0 * 33], s[1 * 33]); o.y = pk2(s[2 * 33], s[3 * 33]); o.z = pk2(s[4 * 33], s[5 * 33]); o.w = pk2(s[6 * 33], s[7 * 33]);
        *(v4u*)(WT + (size_t)(drow0 + n) * K + k0 + 8 * c) = o; }
    WAVE_SYNC();
}
__device__ __forceinline__ void ph_prologue(const Args& A, LAS unsigned char* lds) {
    TIDS;
    LAS float* scr = (LAS float*)(lds + wave * 16384);
    constexpr int I_ADA = 16 * 192, I_IN1 = 16 * 64, I_IN2 = 16 * 24, I_GT = 16 * 128, I_GLU = 4 * 8, I_BR = 4 * 4 * 32, I_WO_ = 16 * 32, I_UP = 16 * 176, I_DN = 44 * 32;
    constexpr int PER_L = I_ADA + I_IN1 + I_IN2 + I_GT + I_GLU + I_BR + I_WO_ + I_UP + I_DN;
    for (int it = gw; it < DEPTH * PER_L; it += NGW) {
        const int l = it / PER_L; int r = it % PER_L; unsigned char* wl = A.ws + WS_W + (size_t)l * WL_SIZE;
        if (r < I_ADA) { const int kb = r / 192, nb = r % 192; tr_item(A.in[I_WADA] + (size_t)l * D * NMOD, NMOD, D, kb * 64, nb * 32, (bf16*)(wl + WL_ADA), nb * 32, scr, lane); continue; } r -= I_ADA;
        if (r < I_IN1) { const int kb = r / 64, nb = r % 64; tr_item(A.in[I_WIN] + (size_t)l * D * NIN, NIN, D, kb * 64, nb * 32, (bf16*)(wl + WL_W1), nb * 32, scr, lane); continue; } r -= I_IN1;
        if (r < I_IN2) { const int kb = r / 24, nb = r % 24; tr_item(A.in[I_WIN] + (size_t)l * D * NIN, NIN, D, kb * 64, 2056 + nb * 32, (bf16*)(wl + WL_W1), 2048 + nb * 32, scr, lane); continue; } r -= I_IN2;
        if (r < I_GT) { const int kb = r / 128, nb = r % 128; tr_item(A.in[I_WGATE] + (size_t)l * D * NGATE, NGATE, D, kb * 64, nb * 32, (bf16*)(wl + WL_W1), NPROJ + nb * 32, scr, lane); continue; } r -= I_GT;
        if (r < I_GLU) { const int kb = r / 8, nb = r % 8; tr_item(A.in[I_WGLU] + (size_t)l * 256 * 256, 256, 256, kb * 64, nb * 32, (bf16*)(wl + WL_GLU), nb * 32, scr, lane); continue; } r -= I_GLU;
        if (r < I_BR) { const int n = r / 128, r2 = r % 128, kb = r2 / 32, nb = r2 % 32; tr_item(A.in[I_WBR] + (size_t)(l * 4 + n) * 256 * D, D, 256, kb * 64, nb * 32, (bf16*)(wl + WL_BR), n * D + nb * 32, scr, lane); continue; } r -= I_BR;
        if (r < I_WO_) { const int kb = r / 32, nb = r % 32; tr_item(A.in[I_WO] + (size_t)l * D * D, D, D, kb * 64, nb * 32, (bf16*)(wl + WL_WO), nb * 32, scr, lane); continue; } r -= I_WO_;
        if (r < I_UP) { const int kb = r / 176, nb = r % 176; const int c0 = nb * 32, j = c0 < DFF ? c0 : c0 - DFF; const int drow = (j / 128) * 256 + (c0 < DFF ? 0 : 128) + (j % 128);
            tr_item(A.in[I_WUP] + (size_t)l * D * NUP, NUP, D, kb * 64, c0, (bf16*)(wl + WL_UP), drow, scr, lane); continue; } r -= I_UP;
        { const int kb = r / 32, nb = r % 32; tr_item(A.in[I_WDN] + (size_t)l * DFF * D, D, DFF, kb * 64, nb * 32, (bf16*)(wl + WL_DN), nb * 32, scr, lane); }
    }
    const int gt = bid * (NWAVES * 64) + tid, NGT = G * NWAVES * 64;
    for (int i = gt; i < DEPTH * 8 * D; i += NGT) { const int l = i / (8 * D), j = (i / D) % 8, k = i % D; ((float*)(A.ws + WS_W + (size_t)l * WL_SIZE + WL_LOG))[j * D + k] = A.in[I_WIN][((size_t)l * D + k) * NIN + 2048 + j]; }
    for (int i = gt; i < 256 * D; i += NGT) { const int r = i / D, k = i % D; float v = 0.f;
        if (r < NB) v = siluf_(A.in[I_CP][r * D + k]); else if (r < NSEQ) v = siluf_(A.in[I_CS][(r - NB) * D + k]);
        wsb(A, WS_CSILU)[i] = (bf16)f2bf(v); }
}
struct ModOrder {
    int G, c;
    __host__ __device__ bool next(int i, pg8::Unit& u) const { const int L = i * G + c; if (L >= 24 * DEPTH) return false; const int l = L / 24, pn = L % 24;
        u.pm = 0; u.pn = l * (int)(WL_SIZE / (512 * 1024)) + pn; u.ka = 0; u.aux = pn | (l << 8); return true; }
    __device__ __forceinline__ void a_ready(const pg8::Unit&) const {}
    __device__ __forceinline__ void done(const pg8::Unit&) const {}
};
struct EpiMod2 { static constexpr bool PERM = false; typedef pg8::NoState State; float* C; const float* bias;
    __device__ __forceinline__ void operator()(const f32x4 (&acc)[2][2][4][2], State& st, const pg8::Unit& u, int wr, int wc, int fr, int fq) const {
        const int l = u.aux >> 8; pg8::Unit u2 = u; u2.aux = u.aux & 255; pg8::EpiMod e{C + (size_t)l * 256 * NMOD, bias + (size_t)l * NMOD}; e(acc, st, u2, wr, wc, fr, fq); } };
template <int MODE> __device__ __forceinline__ void ph_rows(const Args& A, int l) {
    TIDS;
    const float* MOD = wsf(A, WS_MOD);
    for (int m = gw; m < M; m += NGW) {
        const float* src; float* dstx = nullptr;
        if (MODE == 0) src = m < MP ? A.in[I_XP] + (size_t)m * D : A.in[I_XS] + (size_t)(m - MP) * D;
        else if (MODE == 1) { src = wsf(A, WS_X1) + (size_t)m * D; dstx = wsf(A, WS_X1) + (size_t)m * D; }
        else { src = wsf(A, WS_X2) + (size_t)m * D; dstx = (l == DEPTH - 1) ? A.out + O_Y + (size_t)m * D : wsf(A, WS_X2) + (size_t)m * D; }
        f32x4 v[4];
#pragma unroll
        for (int j = 0; j < 4; ++j) v[j] = ((const f32x4*)src)[lane + 64 * j];
        if (MODE != 0) {
            float s = 0.f;
#pragma unroll
            for (int j = 0; j < 4; ++j) s += (v[j][0] + v[j][1]) + (v[j][2] + v[j][3]);
            const float mean = wave_sum(s) * (1.f / D); float s2 = 0.f;
#pragma unroll
            for (int j = 0; j < 4; ++j) { v[j] = v[j] - mean; s2 += (v[j][0] * v[j][0] + v[j][1] * v[j][1]) + (v[j][2] * v[j][2] + v[j][3] * v[j][3]); }
            const float rstd = 1.f / sqrtf(wave_sum(s2) * (1.f / D) + LN_EPS);
            const float* gp = A.in[MODE == 1 ? I_L1G : I_L2G] + (size_t)l * D; const float* bp = A.in[MODE == 1 ? I_L1B : I_L2B] + (size_t)l * D;
#pragma unroll
            for (int j = 0; j < 4; ++j) { const f32x4 g = ((const f32x4*)gp)[lane + 64 * j], b = ((const f32x4*)bp)[lane + 64 * j]; v[j] = v[j] * rstd * g + b; ((f32x4*)dstx)[lane + 64 * j] = v[j]; }
            if (MODE == 2 && l == DEPTH - 1) continue;
        }
        const int ln = (MODE == 2) ? l + 1 : l;
        const float* mr = MOD + ((size_t)ln * 256 + seq_of(m)) * NMOD + (MODE == 1 ? 3 * D : 0);
        float s = 0.f;
#pragma unroll
        for (int j = 0; j < 4; ++j) s += (v[j][0] + v[j][1]) + (v[j][2] + v[j][3]);
        const float mean = wave_sum(s) * (1.f / D); float s2 = 0.f;
#pragma unroll
        for (int j = 0; j < 4; ++j) { v[j] = v[j] - mean; s2 += (v[j][0] * v[j][0] + v[j][1] * v[j][1]) + (v[j][2] * v[j][2] + v[j][3] * v[j][3]); }
        const float rstd = 1.f / sqrtf(wave_sum(s2) * (1.f / D) + LN_EPS);
        v2u* hrow = (v2u*)(wsb(A, WS_H) + (size_t)m * D);
#pragma unroll
        for (int j = 0; j < 4; ++j) { const f32x4 sh = ((const f32x4*)mr)[lane + 64 * j], sc = ((const f32x4*)(mr + D))[lane + 64 * j]; v[j] = v[j] * rstd * (sc + 1.0f) + sh;
            v2u o; o.x = pk2(v[j][0], v[j][1]); o.y = pk2(v[j][2], v[j][3]); hrow[lane + 64 * j] = o; }
        if (MODE != 1) {
            const float* wl = (const float*)(A.ws + WS_W + (size_t)ln * WL_SIZE + WL_LOG);
            float lg[8];
#pragma unroll
            for (int jj = 0; jj < 8; ++jj) { float t = 0.f;
#pragma unroll
                for (int j = 0; j < 4; ++j) { const f32x4 w = ((const f32x4*)(wl + jj * D))[lane + 64 * j]; t += (v[j][0] * w[0] + v[j][1] * w[1]) + (v[j][2] * w[2] + v[j][3] * w[3]); }
                lg[jj] = wave_sum(t); }
            if (lane == 0) { float* o = wsf(A, WS_LOG8) + (size_t)m * 8; *(f32x4*)o = (f32x4){lg[0], lg[1], lg[2], lg[3]}; *(f32x4*)(o + 4) = (f32x4){lg[4], lg[5], lg[6], lg[7]}; }
        }
    }
}
struct SsmC { float abr, abi, bbr[16], bbi[16]; };
__device__ __forceinline__ void ssm_consts(const Args& A, int l, int g, int p, SsmC& c) {
    const int gi = l * 16 + g;
    const float dt = expf(A.in[I_LDT][gi]), ar = A.in[I_ARE][gi * 64 + p], ai = A.in[I_AIM][gi * 64 + p];
    const float mag = expf(dt * ar); c.abr = mag * cosf(dt * ai); c.abi = mag * sinf(dt * ai);
    const float den = ar * ar + ai * ai, fre = ((c.abr - 1.0f) * ar + c.abi * ai) / den, fim = (c.abi * ar - (c.abr - 1.0f) * ai) / den;
    const f32x4* br = (const f32x4*)(A.in[I_BRE] + (size_t)(gi * 64 + p) * 16); const f32x4* bi = (const f32x4*)(A.in[I_BIM] + (size_t)(gi * 64 + p) * 16);
#pragma unroll
    for (int q = 0; q < 4; ++q) { const f32x4 r = br[q], i = bi[q];
#pragma unroll
        for (int e = 0; e < 4; ++e) { c.bbr[4 * q + e] = fre * r[e] - fim * i[e]; c.bbi[4 * q + e] = fre * i[e] + fim * r[e]; } }
}
__device__ __forceinline__ void ssm_step(const SsmC& c, const bf16* urow, float& hr, float& hi) {
    const v4u u0 = *(const v4u*)urow, u1 = *(const v4u*)(urow + 8);
    float u[16] = {bflo(u0.x), bfhi(u0.x), bflo(u0.y), bfhi(u0.y), bflo(u0.z), bfhi(u0.z), bflo(u0.w), bfhi(u0.w), bflo(u1.x), bfhi(u1.x), bflo(u1.y), bfhi(u1.y), bflo(u1.z), bfhi(u1.z), bflo(u1.w), bfhi(u1.w)};
    float br = 0.f, bi = 0.f;
#pragma unroll
    for (int h = 0; h < 16; ++h) { br += c.bbr[h] * u[h]; bi += c.bbi[h] * u[h]; }
    const float nr = c.abr * hr - c.abi * hi + br, ni = c.abr * hi + c.abi * hr + bi; hr = nr; hi = ni;
}
__device__ __forceinline__ void ph_ssm1(const Args& A, int l) {
    TIDS;
    const bf16* proj = wsb(A, WS_PROJ);
    for (int un = gw; un < NB * 16 * SSM_NCH; un += NGW) {
        const int c = un % SSM_NCH, g = (un / SSM_NCH) % 16, b = un / (SSM_NCH * 16);
        SsmC k; ssm_consts(A, l, g, lane, k);
        float hr = 0.f, hi = 0.f;
        const bf16* up = proj + (size_t)(b * SEQ + c * SSM_CH) * NPROJ + PC_U + g * 16;
        for (int t = 0; t < SSM_CH; ++t) ssm_step(k, up + (size_t)t * NPROJ, hr, hi);
        float* o = wsf(A, WS_SEND) + (size_t)un * 128; o[lane] = hr; o[64 + lane] = hi;
    }
}
__device__ __forceinline__ void ph_ssm_carry(const Args& A, int l) {
    TIDS;
    const int gt = (G - 1 - bid) * (NWAVES * 64) + tid;
    if (gt < NB * 16 * 64) {
        const int p = gt & 63, g = (gt >> 6) & 15, b = gt >> 10; const int gi = l * 16 + g;
        const float dt = expf(A.in[I_LDT][gi]), ar = A.in[I_ARE][gi * 64 + p], ai = A.in[I_AIM][gi * 64 + p];
        const float mag = expf(dt * ar); float pr = mag * cosf(dt * ai), pi = mag * sinf(dt * ai);
        for (int s = 1; s < SSM_CH; s <<= 1) { const float nr = pr * pr - pi * pi, ni = 2.f * pr * pi; pr = nr; pi = ni; }
        float cr = 0.f, ci = 0.f;
        for (int c = 0; c < SSM_NCH; ++c) { const size_t un = ((size_t)(b * 16 + g) * SSM_NCH + c) * 128;
            wsf(A, WS_HIN)[un + p] = cr; wsf(A, WS_HIN)[un + 64 + p] = ci;
            const float sr = wsf(A, WS_SEND)[un + p], si = wsf(A, WS_SEND)[un + 64 + p];
            const float nr = pr * cr - pi * ci + sr, ni = pr * ci + pi * cr + si; cr = nr; ci = ni; }
    }
}
__device__ __forceinline__ float gelu_tanh(float x) { const float t = tanhf(0.7978845608028654f * (x + 0.044715f * x * x * x)); return 0.5f * x * (1.0f + t); }
__device__ __forceinline__ void ph_ssm2(const Args& A, LAS unsigned char* lds, int l) {
    TIDS;
    LAS float* ct = (LAS float*)(lds + wave * 16384);
    LAS float* ht = ct + 2048;
    const bf16* proj = wsb(A, WS_PROJ);
    constexpr int NPU = NB * 16 * SSM_NCH, NSU = DB * 16;
    for (int un = gw; un < NPU + NSU; un += NGW) {
        int g, m0, ntok; float hr, hi; float* fre = nullptr; float* fim = nullptr;
        if (un < NPU) { const int c = un % SSM_NCH; g = (un / SSM_NCH) % 16; const int b = un / (SSM_NCH * 16); m0 = b * SEQ + c * SSM_CH; ntok = SSM_CH;
            hr = wsf(A, WS_HIN)[(size_t)un * 128 + lane]; hi = wsf(A, WS_HIN)[(size_t)un * 128 + 64 + lane];
            if (c == SSM_NCH - 1) { fre = A.out + O_REP + ((size_t)(l * NB + b) * 16 + g) * 64; fim = A.out + O_IMP + ((size_t)(l * NB + b) * 16 + g) * 64; } }
        else { const int su = un - NPU; g = su & 15; const int s = su >> 4; m0 = MP + s * DEC_SEQ; ntok = DEC_SEQ;
            hr = A.in[I_SRE][((size_t)(l * DB + s) * 16 + g) * 64 + lane]; hi = A.in[I_SIM][((size_t)(l * DB + s) * 16 + g) * 64 + lane];
            fre = A.out + O_RES + ((size_t)(l * DB + s) * 16 + g) * 64; fim = A.out + O_IMS + ((size_t)(l * DB + s) * 16 + g) * 64; }
        SsmC k; ssm_consts(A, l, g, lane, k);
        const int gi = l * 16 + g;
        for (int ch = 0; ch < 16; ++ch) { ct[lane * 16 + ch] = A.in[I_CRE][((size_t)gi * 16 + ch) * 64 + lane]; ct[1024 + lane * 16 + ch] = A.in[I_CIM][((size_t)gi * 16 + ch) * 64 + lane]; }
        const float dd = A.in[I_SSD][l * 256 + g * 16 + (lane & 15)];
        for (int t0 = 0; t0 < ntok; t0 += 16) {
            const int nt = (ntok - t0) < 16 ? (ntok - t0) : 16;
            for (int t = 0; t < nt; ++t) { ssm_step(k, proj + (size_t)(m0 + t0 + t) * NPROJ + PC_U + g * 16, hr, hi); ht[t * 64 + lane] = hr; ht[1024 + t * 64 + lane] = hi; }
            WAVE_SYNC();
            const int ch = lane & 15, tq = lane >> 4;
#pragma unroll
            for (int i = 0; i < 4; ++i) { const int tt = tq + 4 * i;
                if (tt < nt) { float y = 0.f;
                    for (int p = 0; p < 64; ++p) y += ct[p * 16 + ch] * ht[tt * 64 + p] - ct[1024 + p * 16 + ch] * ht[1024 + tt * 64 + p];
                    const size_t m = (size_t)(m0 + t0 + tt);
                    y += dd * bf2f(proj[m * NPROJ + PC_U + g * 16 + ch]);
                    wsb(A, WS_YS)[m * 256 + g * 16 + ch] = (bf16)f2bf(gelu_tanh(y)); } }
            WAVE_SYNC();
        }
        if (fre) { fre[lane] = hr; fim[lane] = hi; }
    }
}
__device__ __forceinline__ void ph_conv(const Args& A, int l) {
    TIDS;
    const int gt = bid * (NWAVES * 64) + tid, NGT = G * NWAVES * 64;
    const bf16* proj = wsb(A, WS_PROJ);
    for (int i = gt; i < M * 128; i += NGT) {
        const int m = i >> 7, c = (i & 127) * 2;
        int t, L; const float* hist = nullptr; float* so;
        if (m < MP) { t = m % SEQ; L = SEQ; so = A.out + O_CBP + (size_t)(l * NB + m / SEQ) * 512; }
        else { const int s = (m - MP) / DEC_SEQ; t = (m - MP) % DEC_SEQ; L = DEC_SEQ; hist = A.in[I_SCB] + (size_t)(l * DB + s) * 512; so = A.out + O_CBS + (size_t)(l * DB + s) * 512; }
        float cx0[3], cx1[3];
#pragma unroll
        for (int j = 0; j < 3; ++j) { const int tt = t - 2 + j;
            if (tt >= 0) { const bf16* r = proj + (size_t)(m - 2 + j) * NPROJ; const unsigned cg = *(const unsigned*)(r + PC_CG + c), xc = *(const unsigned*)(r + PC_XC + c); cx0[j] = bflo(cg) * bflo(xc); cx1[j] = bfhi(cg) * bfhi(xc); }
            else if (hist) { cx0[j] = hist[(2 + tt) * 256 + c]; cx1[j] = hist[(2 + tt) * 256 + c + 1]; }
            else { cx0[j] = 0.f; cx1[j] = 0.f; } }
        const float* w = A.in[I_CBW] + (size_t)l * 3 * 256;
        const float o0 = w[c] * cx0[0] + w[256 + c] * cx0[1] + w[512 + c] * cx0[2], o1 = w[c + 1] * cx1[0] + w[256 + c + 1] * cx1[1] + w[512 + c + 1] * cx1[2];
        const unsigned bg = *(const unsigned*)(proj + (size_t)m * NPROJ + PC_BG + c);
        *(unsigned*)(wsb(A, WS_Y) + (size_t)m * D + 256 + c) = pk2(bflo(bg) * o0, bfhi(bg) * o1);
        if (t >= L - 2) { so[(t - (L - 2)) * 256 + c] = cx0[2]; so[(t - (L - 2)) * 256 + c + 1] = cx1[2]; }
    }
}
__device__ __forceinline__ bf16x8 acc2b(const f32x4& lo, const f32x4& hi) { v4u w; w.x = pk2(lo[0], lo[1]); w.y = pk2(lo[2], lo[3]); w.z = pk2(hi[0], hi[1]); w.w = pk2(hi[2], hi[3]); return __builtin_bit_cast(bf16x8, w); }
__device__ __forceinline__ void ph_gdn_c1(const Args& A, LAS unsigned char* lds, int l) {
    TIDS;
    constexpr int XS = 72, GS = 68, RS = 132;
    LAS bf16* Qs = (LAS bf16*)lds; LAS bf16* Ks = Qs + 64 * XS; LAS bf16* Vs = Ks + 64 * XS;
    LAS float* GKK = (LAS float*)(lds + 27648); LAS float* GQK = GKK + 64 * GS; LAS float* rhs = GQK + 64 * GS;
    LAS float* Linv = rhs + 64 * RS; LAS float* sc = Linv + 1024;
    LAS float* DQ = sc, *DK = sc + 64, *RQ = sc + 128, *RK = sc + 192, *BET = sc + 256, *GC = sc + 320, *EGC = sc + 384, *EK = sc + 448;
    LAS float* Wst = GQK;
    const bf16* proj = wsb(A, WS_PROJ); const float* cw = A.in[I_DCW] + (size_t)l * 4 * GQKV; const float* lg8 = wsf(A, WS_LOG8);
    const int g = lane >> 4, i16 = lane & 15;
    for (int un = bid; un < NB * GH * GNCH; un += G) {
        const int c = un % GNCH, h = (un / GNCH) % GH, b = un / (GNCH * GH); const int m0 = b * SEQ + c * GCH;
        unsigned char* gd = A.ws + WS_GD + (size_t)un * GD_UNIT;
        if (wave < 6) { const int sec = wave >> 1, th = wave & 1, src = sec * 256 + h * 64 + lane, t0 = c * GCH + th * 32;
            const float w0 = cw[src], w1 = cw[GQKV + src], w2 = cw[2 * GQKV + src], w3 = cw[3 * GQKV + src];
            float x[35];
#pragma unroll
            for (int k = 0; k < 35; ++k) { const int tt = t0 - 3 + k; x[k] = tt >= 0 ? bf2f(proj[(size_t)(b * SEQ + tt) * NPROJ + PC_QKV + src]) : 0.f; }
            LAS bf16* X = sec == 0 ? Qs : (sec == 1 ? Ks : Vs);
#pragma unroll
            for (int k = 0; k < 32; ++k) X[(th * 32 + k) * XS + lane] = (bf16)f2bf(siluf_(w0 * x[k] + w1 * x[k + 1] + w2 * x[k + 2] + w3 * x[k + 3]));
            if (c == GNCH - 1 && th == 1) {
#pragma unroll
                for (int k = 0; k < 3; ++k) A.out[O_CDP + ((size_t)(l * NB + b) * 3 + k) * GQKV + src] = x[32 + k]; } }
        __syncthreads();
#pragma unroll
        for (int q2 = 0; q2 < 2; ++q2) { const int tt = 2 * wave + q2, rt = tt >> 2, ct = tt & 3;
            f32x4 akk = {0.f, 0.f, 0.f, 0.f}, aqk = {0.f, 0.f, 0.f, 0.f};
#pragma unroll
            for (int s = 0; s < 2; ++s) { const bf16x8 kc = *(const LAS bf16x8*)(Ks + (16 * ct + i16) * XS + 32 * s + 8 * g), kr = *(const LAS bf16x8*)(Ks + (16 * rt + i16) * XS + 32 * s + 8 * g),
                                                         qr = *(const LAS bf16x8*)(Qs + (16 * rt + i16) * XS + 32 * s + 8 * g);
                akk = __builtin_amdgcn_mfma_f32_16x16x32_bf16(kr, kc, akk, 0, 0, 0); aqk = __builtin_amdgcn_mfma_f32_16x16x32_bf16(qr, kc, aqk, 0, 0, 0); }
#pragma unroll
            for (int r = 0; r < 4; ++r) { GKK[(16 * rt + 4 * g + r) * GS + 16 * ct + i16] = akk[r]; GQK[(16 * rt + 4 * g + r) * GS + 16 * ct + i16] = aqk[r]; }
            if (rt == ct && g == (i16 >> 2)) { const int r = i16 & 3; DK[16 * rt + i16] = r == 0 ? akk[0] : r == 1 ? akk[1] : r == 2 ? akk[2] : akk[3]; } }
        if (wave < 4) { f32x4 aqq = {0.f, 0.f, 0.f, 0.f};
#pragma unroll
            for (int s = 0; s < 2; ++s) { const bf16x8 qr = *(const LAS bf16x8*)(Qs + (16 * wave + i16) * XS + 32 * s + 8 * g); aqq = __builtin_amdgcn_mfma_f32_16x16x32_bf16(qr, qr, aqq, 0, 0, 0); }
            if (g == (i16 >> 2)) { const int r = i16 & 3; DQ[16 * wave + i16] = r == 0 ? aqq[0] : r == 1 ? aqq[1] : r == 2 ? aqq[2] : aqq[3]; } }
        __syncthreads();
        if (wave == 0) { const float* lr = lg8 + (size_t)(m0 + lane) * 8;
            const float gv = -expf(A.in[I_DAL][l * 4 + h]) * softplusf_(lr[4 + h] + A.in[I_DDT][l * 4 + h]);
            float gc = gv;
#pragma unroll
            for (int o = 1; o < 64; o <<= 1) { const float t = __shfl_up(gc, o); if (lane >= o) gc += t; }
            const float gl = __shfl(gc, 63);
            RK[lane] = 1.0f / sqrtf(DK[lane] + RMS_EPS); RQ[lane] = 0.125f / sqrtf(DQ[lane] + RMS_EPS); BET[lane] = sigmoidf_(lr[h]); GC[lane] = gc; EGC[lane] = expf(gc); EK[lane] = expf(gl - gc);
            if (lane == 0) wsf(A, WS_EGL)[un] = expf(gl); }
        __syncthreads();
        for (int idx = tid; idx < 4096; idx += 512) { const int i = idx >> 6, j = idx & 63; GKK[i * GS + j] = i > j ? BET[i] * RK[i] * RK[j] * GKK[i * GS + j] * expf(GC[i] - GC[j]) : 0.f; }
        for (int idx = tid; idx < 64 * 128; idx += 512) { const int i = idx >> 7, cc = idx & 127; rhs[i * RS + cc] = cc < 64 ? BET[i] * bf2f(Vs[i * XS + cc]) : BET[i] * EGC[i] * RK[i] * bf2f(Ks[i * XS + cc - 64]); }
        for (int idx = tid; idx < 4096; idx += 512) { const int f = idx >> 9, ln = (idx >> 3) & 63, j = idx & 7, row = 16 * (f >> 1) + (ln & 15), kx = 32 * (f & 1) + 16 * (j >> 2) + 4 * (ln >> 4) + (j & 3);
            ((bf16*)gd)[8192 + idx] = (bf16)f2bf(row >= kx ? RQ[row] * RK[kx] * GQK[row * GS + kx] * expf(GC[row] - GC[kx]) : 0.f);
            ((bf16*)gd)[4096 + idx] = (bf16)f2bf(bf2f(Qs[row * XS + kx]) * RQ[row] * EGC[row]);
            ((bf16*)gd)[12288 + idx] = (bf16)f2bf(bf2f(Ks[kx * XS + row]) * RK[kx] * EK[kx]); }
        __syncthreads();
        if (wave == 0) { const int blk = lane >> 4, cI = lane & 15; float x[16];
            x[0] = cI == 0 ? 1.f : 0.f;
#pragma unroll
            for (int i = 1; i < 16; ++i) { float sacc = cI == i ? 1.f : 0.f;
#pragma unroll
                for (int j = 0; j < i; ++j) sacc -= GKK[(16 * blk + i) * GS + 16 * blk + j] * x[j];
                x[i] = sacc; }
#pragma unroll
            for (int i = 0; i < 16; ++i) Linv[blk * 256 + i * 16 + cI] = x[i]; }
        __syncthreads();
        { const f32x4 Z = {0.f, 0.f, 0.f, 0.f}; f32x4 X[4];
#define C1_LD4(p) ((f32x4)(*(const LAS f32x4*)(p)) * 1.0f)
#define C1_LF(I) acc2b(C1_LD4(Linv + (I) * 256 + i16 * 16 + 4 * g), Z)
#define C1_MF2(I, J) acc2b(-*(const LAS f32x4*)(GKK + (16 * (I) + i16) * GS + 16 * (J) + 4 * g), -*(const LAS f32x4*)(GKK + (16 * (I) + i16) * GS + 16 * ((J) + 1) + 4 * g))
#define C1_MF1(I, J) acc2b(-*(const LAS f32x4*)(GKK + (16 * (I) + i16) * GS + 16 * (J) + 4 * g), Z)
#define C1_R(I) (f32x4){rhs[(16 * (I) + 4 * g) * RS + 16 * wave + i16], rhs[(16 * (I) + 4 * g + 1) * RS + 16 * wave + i16], rhs[(16 * (I) + 4 * g + 2) * RS + 16 * wave + i16], rhs[(16 * (I) + 4 * g + 3) * RS + 16 * wave + i16]}
            f32x4 R = C1_R(0);
            X[0] = __builtin_amdgcn_mfma_f32_16x16x32_bf16(C1_LF(0), acc2b(R, Z), Z, 0, 0, 0);
            R = C1_R(1); R = __builtin_amdgcn_mfma_f32_16x16x32_bf16(C1_MF1(1, 0), acc2b(X[0], Z), R, 0, 0, 0);
            X[1] = __builtin_amdgcn_mfma_f32_16x16x32_bf16(C1_LF(1), acc2b(R, Z), Z, 0, 0, 0);
            const bf16x8 X01 = acc2b(X[0], X[1]);
            R = C1_R(2); R = __builtin_amdgcn_mfma_f32_16x16x32_bf16(C1_MF2(2, 0), X01, R, 0, 0, 0);
            X[2] = __builtin_amdgcn_mfma_f32_16x16x32_bf16(C1_LF(2), acc2b(R, Z), Z, 0, 0, 0);
            R = C1_R(3); R = __builtin_amdgcn_mfma_f32_16x16x32_bf16(C1_MF2(3, 0), X01, R, 0, 0, 0); R = __builtin_amdgcn_mfma_f32_16x16x32_bf16(C1_MF1(3, 2), acc2b(X[2], Z), R, 0, 0, 0);
            X[3] = __builtin_amdgcn_mfma_f32_16x16x32_bf16(C1_LF(3), acc2b(R, Z), Z, 0, 0, 0);
#undef C1_LF
#undef C1_LD4
#undef C1_MF2
#undef C1_MF1
#undef C1_R
            if (wave < 4) {
#pragma unroll
                for (int I = 0; I < 4; ++I) ((f32x4*)(gd + 32768))[(wave * 4 + I) * 64 + lane] = X[I]; }
            else {
#pragma unroll
                for (int I = 0; I < 4; ++I)
#pragma unroll
                    for (int r = 0; r < 4; ++r) Wst[(16 * I + 4 * g + r) * GS + 16 * (wave - 4) + i16] = -X[I][r]; } }
        __syncthreads();
        for (int idx = tid; idx < 4096; idx += 512) { const int f = idx >> 9, ln = (idx >> 3) & 63, j = idx & 7, row = 16 * (f >> 1) + (ln & 15), kx = 32 * (f & 1) + 16 * (j >> 2) + 4 * (ln >> 4) + (j & 3);
            ((bf16*)gd)[idx] = (bf16)f2bf(Wst[row * GS + kx]); }
        __syncthreads();
    }
}
__device__ __forceinline__ void ph_gdn_scan(const Args& A, LAS unsigned char* lds, int l) {
    TIDS;
    for (int grp = bid; grp < NB * GH; grp += G) {
        const int h = grp % GH, b = grp / GH;
        const unsigned char* gbase = A.ws + WS_GD + (size_t)(b * GH + h) * GNCH * GD_UNIT;
        if (wave >= 4) {
            const int lw = wave - 4; v4u ra[12], rb[12];
            const v4u* src = (const v4u*)gbase + lw * 12 * 64 + lane;
            LAS v4u* dst0 = (LAS v4u*)lds + lw * 12 * 64 + lane;
#define SC_LOAD(R, c) do { if ((c) < GNCH) { _Pragma("unroll") for (int k = 0; k < 12; ++k) R[k] = src[(size_t)(c) * (GD_UNIT / 16) + k * 64]; } } while (0)
#define SC_STORE(R, c) do { if ((c) < GNCH) { LAS v4u* d_ = dst0 + ((c) & 1) * (GD_UNIT / 16); _Pragma("unroll") for (int k = 0; k < 12; ++k) d_[k * 64] = R[k]; } } while (0)
            SC_LOAD(ra, 0); SC_STORE(ra, 0); SC_LOAD(ra, 1); SC_LOAD(rb, 2);
            RAW_BAR();
            for (int c = 0; c < GNCH; c += 2) {
                SC_STORE(ra, c + 1); SC_LOAD(ra, c + 3);
                RAW_BAR();
                if (c + 1 < GNCH) { SC_STORE(rb, c + 2); SC_LOAD(rb, c + 4); RAW_BAR(); }
            }
#undef SC_LOAD
#undef SC_STORE
        } else {
            const int vs = wave, g = lane >> 4, cc = lane & 15;
            f32x4 S[4];
#pragma unroll
            for (int T = 0; T < 4; ++T) S[T] = (f32x4){0.f, 0.f, 0.f, 0.f};
            const float* eglp = wsf(A, WS_EGL) + (size_t)(b * GH + h) * GNCH;
            float egl_n = eglp[0];
            RAW_BAR();
            for (int c = 0; c < GNCH; ++c) {
                const float egl = egl_n; if (c + 1 < GNCH) egl_n = eglp[c + 1];
                const LAS unsigned char* slot = lds + (c & 1) * GD_UNIT;
                const LAS bf16x8* fr = (const LAS bf16x8*)slot + lane;
                const LAS f32x4* uvp = (const LAS f32x4*)(slot + 32768) + (vs * 4) * 64 + lane;
                bf16x8 Sb[2] = {acc2b(S[0], S[1]), acc2b(S[2], S[3])};
                f32x4 u[4], o[4];
#pragma unroll
                for (int T = 0; T < 4; ++T) { u[T] = uvp[T * 64]; o[T] = (f32x4){0.f, 0.f, 0.f, 0.f};
#pragma unroll
                    for (int s = 0; s < 2; ++s) { u[T] = __builtin_amdgcn_mfma_f32_16x16x32_bf16(fr[(0 * 8 + 2 * T + s) * 64], Sb[s], u[T], 0, 0, 0); o[T] = __builtin_amdgcn_mfma_f32_16x16x32_bf16(fr[(1 * 8 + 2 * T + s) * 64], Sb[s], o[T], 0, 0, 0); } }
                bf16x8 ub[2] = {acc2b(u[0], u[1]), acc2b(u[2], u[3])};
#pragma unroll
                for (int T = 0; T < 4; ++T) { S[T] = S[T] * egl;
#pragma unroll
                    for (int s = 0; s < 2; ++s) { S[T] = __builtin_amdgcn_mfma_f32_16x16x32_bf16(fr[(3 * 8 + 2 * T + s) * 64], ub[s], S[T], 0, 0, 0); o[T] = __builtin_amdgcn_mfma_f32_16x16x32_bf16(fr[(2 * 8 + 2 * T + s) * 64], ub[s], o[T], 0, 0, 0); } }
                float* od = wsf(A, WS_ODRAW) + (size_t)(b * SEQ + c * GCH + 4 * g) * 256 + h * 64 + vs * 16 + cc;
#pragma unroll
                for (int T = 0; T < 4; ++T)
#pragma unroll
                    for (int r = 0; r < 4; ++r) od[(size_t)(16 * T + r) * 256] = o[T][r];
                RAW_BAR();
            }
            float* so = A.out + O_DP + (((size_t)(l * NB + b) * GH + h) * 64 + 4 * g) * 64 + vs * 16 + cc;
#pragma unroll
            for (int T = 0; T < 4; ++T)
#pragma unroll
                for (int r = 0; r < 4; ++r) so[(16 * T + r) * 64] = S[T][r];
        }
        __syncthreads();
    }
}
__device__ __forceinline__ void ph_gdn_sample(const Args& A, LAS unsigned char* lds, int l) {
    TIDS;
    LAS float* S = (LAS float*)(lds + wave * 16384);
    LAS float* kq = (LAS float*)(lds + MISC_OFF + 1024 + wave * 512);
    const bf16* proj = wsb(A, WS_PROJ); const float* cw = A.in[I_DCW] + (size_t)l * 4 * GQKV; const float* lg8 = wsf(A, WS_LOG8);
    if (wave < 4 || wave >= 6) return;
    for (int un = (wave - 4) * G + bid; un < DB * GH; un += 2 * G) {
        const int h = un % GH, s = un / GH;
        const float* s0 = A.in[I_SD] + ((size_t)(l * DB + s) * GH + h) * 4096;
#pragma unroll 8
        for (int kk = 0; kk < 64; ++kk) S[kk * 64 + lane] = s0[kk * 64 + lane];
        const float* hist = A.in[I_SCD] + (size_t)(l * DB + s) * 3 * GQKV;
        for (int t = 0; t < DEC_SEQ; ++t) {
            const size_t m = (size_t)MP + s * DEC_SEQ + t;
            float val[3];
#pragma unroll
            for (int sec = 0; sec < 3; ++sec) { const int src = sec * 256 + h * 64 + lane; float acc = 0.f, cur = 0.f;
#pragma unroll
                for (int j = 0; j < 4; ++j) { const int tt = t - 3 + j; const float x = tt >= 0 ? bf2f(proj[(size_t)(MP + s * DEC_SEQ + tt) * NPROJ + PC_QKV + src]) : hist[(3 + tt) * GQKV + src]; acc += cw[j * GQKV + src] * x; cur = x; }
                val[sec] = siluf_(acc);
                if (t >= 1) A.out[O_CDS + ((size_t)(l * DB + s) * 3 + (t - 1)) * GQKV + src] = cur; }
            const float sq = wave_sum(val[0] * val[0]), sk = wave_sum(val[1] * val[1]);
            const float qv = val[0] * (1.0f / sqrtf(sq + RMS_EPS)) * 0.125f, kv = val[1] * (1.0f / sqrtf(sk + RMS_EPS)), vv = val[2];
            const float* lr = lg8 + m * 8; const float beta = sigmoidf_(lr[h]); const float a = expf(-expf(A.in[I_DAL][l * 4 + h]) * softplusf_(lr[4 + h] + A.in[I_DDT][l * 4 + h]));
            kq[lane] = kv; kq[64 + lane] = qv;
            WAVE_SYNC();
            float kS = 0.f;
#pragma unroll 8
            for (int kk = 0; kk < 64; ++kk) kS += kq[kk] * S[kk * 64 + lane];
            float o = 0.f;
#pragma unroll 8
            for (int kk = 0; kk < 64; ++kk) { const float bk = beta * kq[kk]; const float sn = a * (S[kk * 64 + lane] - bk * kS) + bk * vv; S[kk * 64 + lane] = sn; o += kq[64 + kk] * sn; }
            wsf(A, WS_ODRAW)[m * 256 + h * 64 + lane] = o;
            WAVE_SYNC();
        }
        float* so = A.out + O_DS + ((size_t)(l * DB + s) * GH + h) * 4096;
#pragma unroll 8
        for (int kk = 0; kk < 64; ++kk) so[kk * 64 + lane] = S[kk * 64 + lane];
    }
}
__device__ __forceinline__ void ph_gdn_out(const Args& A, int l) {
    TIDS;
    for (int idx = gw; idx < M * GH; idx += NGW) { const size_t m = idx >> 2; const int h = idx & 3;
        const float o = wsf(A, WS_ODRAW)[m * 256 + h * 64 + lane];
        const float ms = wave_sum(o * o) * (1.0f / 64.0f);
        const float z = bf2f(wsb(A, WS_PROJ)[m * NPROJ + PC_Z + h * 64 + lane]);
        wsb(A, WS_Y)[m * D + 512 + h * 64 + lane] = (bf16)f2bf(o * (1.0f / sqrtf(ms + RMS_EPS)) * A.in[I_DNW][l * 64 + lane] * siluf_(z)); }
}
__device__ __forceinline__ void sb_terms(float z, float& ls, float& ln) { const float L = log1pf(__expf(-fabsf(z))); ls = fminf(z, 0.f) - L; ln = -fmaxf(z, 0.f) - L; }
constexpr float SB_CUT = -105.0f;
__device__ __forceinline__ void ph_sb_prompt(const Args& A, int l) {
    TIDS; (void)l;
    const bf16* proj = wsb(A, WS_PROJ); const bf16* vtg = wsb(A, WS_VT);
    constexpr int NQB = SEQ / 32;
    const int g = lane >> 4, i16 = lane & 15;
    for (int un0 = gw; un0 < NB * SBH * NQB; un0 += NGW) {
        const int un = NB * SBH * NQB - 1 - un0;
        const int qb = un / (NB * SBH), h = un % SBH, b = (un / SBH) % NB;
        const int q0 = qb * 32;
        bf16x8 Qb[2][2];
#pragma unroll
        for (int ct = 0; ct < 2; ++ct)
#pragma unroll
            for (int s = 0; s < 2; ++s) Qb[ct][s] = *(const bf16x8*)(proj + ((size_t)b * SEQ + q0 + 16 * ct + i16) * NPROJ + PC_Q + h * 64 + 32 * s + 8 * g);
        f32x4 O[4][2];
#pragma unroll
        for (int rt = 0; rt < 4; ++rt) { O[rt][0] = (f32x4){0.f, 0.f, 0.f, 0.f}; O[rt][1] = (f32x4){0.f, 0.f, 0.f, 0.f}; }
        float R[2] = {0.f, 0.f};
        const bf16* vth = vtg + ((size_t)(b * SBH + h) * 64) * SEQ;
        for (int kb = q0 >> 6; kb >= 0; --kb) {
            const int k0 = kb * 64;
            bf16x8 Ka[4][2], Va[4][2];
#pragma unroll
            for (int T = 0; T < 4; ++T)
#pragma unroll
                for (int s = 0; s < 2; ++s) { Ka[T][s] = *(const bf16x8*)(proj + ((size_t)b * SEQ + k0 + 16 * (i16 >> 2) + 4 * T + (i16 & 3)) * NPROJ + PC_K + h * 64 + 32 * s + 8 * g);
                                              Va[T][s] = *(const bf16x8*)(vth + (size_t)(16 * T + i16) * SEQ + k0 + 16 * g + 8 * s); }
            const bool diag = (k0 + 63 >= q0);
#pragma unroll
            for (int ct = 0; ct < 2; ++ct) {
                f32x4 z[4];
#pragma unroll
                for (int T = 0; T < 4; ++T) { z[T] = (f32x4){0.f, 0.f, 0.f, 0.f};
#pragma unroll
                    for (int s = 0; s < 2; ++s) z[T] = __builtin_amdgcn_mfma_f32_16x16x32_bf16(Ka[T][s], Qb[ct][s], z[T], 0, 0, 0); }
                const int qi = q0 + 16 * ct + i16;
                float run = 0.f; f32x4 lsv[4], sfx[4];
#pragma unroll
                for (int T = 3; T >= 0; --T)
#pragma unroll
                    for (int r = 3; r >= 0; --r) { const float zz = z[T][r] * 0.125f; const float L = __logf(1.0f + __expf(-fabsf(zz))); const float ls = fminf(zz, 0.f) - L;
                        const bool valid = !diag || (k0 + 16 * g + 4 * T + r) < qi;
                        lsv[T][r] = valid ? ls : -1e30f; sfx[T][r] = run; run += valid ? (ls - zz) : 0.f; }
                const float p1 = __shfl_down(run, 16), p2 = __shfl_down(run, 32), p3 = __shfl_down(run, 48);
                const float gs = (g < 3 ? p1 : 0.f) + (g < 2 ? p2 : 0.f) + (g < 1 ? p3 : 0.f);
                float tot = run + __shfl_xor(run, 16); tot += __shfl_xor(tot, 32);
                const float base = R[ct] + gs;
#pragma unroll
                for (int T = 0; T < 4; ++T)
#pragma unroll
                    for (int r = 0; r < 4; ++r) z[T][r] = __expf(lsv[T][r] + base + sfx[T][r]);
                R[ct] += tot;
                const bf16x8 Wb0 = acc2b(z[0], z[1]), Wb1 = acc2b(z[2], z[3]);
#pragma unroll
                for (int rt = 0; rt < 4; ++rt) { O[rt][ct] = __builtin_amdgcn_mfma_f32_16x16x32_bf16(Va[rt][0], Wb0, O[rt][ct], 0, 0, 0); O[rt][ct] = __builtin_amdgcn_mfma_f32_16x16x32_bf16(Va[rt][1], Wb1, O[rt][ct], 0, 0, 0); }
            }
            if (!diag && __all(R[0] < SB_CUT && R[1] < SB_CUT)) break;
        }
#pragma unroll
        for (int ct = 0; ct < 2; ++ct)
#pragma unroll
            for (int rt = 0; rt < 4; ++rt) { v2u o; o.x = pk2(O[rt][ct][0], O[rt][ct][1]); o.y = pk2(O[rt][ct][2], O[rt][ct][3]);
                *(v2u*)(wsb(A, WS_Y) + ((size_t)b * SEQ + q0 + 16 * ct + i16) * D + 768 + h * 64 + 16 * rt + 4 * g) = o; }
    }
}
__device__ __forceinline__ void ph_sb_sample(const Args& A, LAS unsigned char* lds, int l) {
    TIDS;
    if (wave >= 2) return;
    LAS float* vt = (LAS float*)(lds + wave * 32768);
    LAS float* qs = vt + 64 * 68;
    LAS float* wq = qs + 256;
    const bf16* proj = wsb(A, WS_PROJ); const int* pt = (const int*)A.in[I_PT];
    for (int un = wave * G + bid; un < DB * SBH; un += 2 * G) {
        const int h = un % SBH, s = un / SBH;
#pragma unroll
        for (int qi = 0; qi < 4; ++qi) qs[qi * 64 + lane] = bf2f(proj[((size_t)MP + s * DEC_SEQ + qi) * NPROJ + PC_Q + h * 64 + lane]) * 0.125f;
        WAVE_SYNC();
        float R[4] = {0.f, 0.f, 0.f, 0.f}; f32x4 acc = {0.f, 0.f, 0.f, 0.f};
        const int qi_b = lane & 3, ds = lane >> 2;
        for (int tile = 0; tile * 64 < PAST + DEC_SEQ; ++tile) {
            const int p = PAST + DEC_SEQ - 1 - (tile * 64 + lane);
            f32x4 kr[16], vr[16];
            if (p >= PAST) { const bf16* rp = proj + ((size_t)MP + s * DEC_SEQ + (p - PAST)) * NPROJ + h * 64;
#pragma unroll
                for (int x = 0; x < 8; ++x) { const v4u kw = ((const v4u*)(rp + PC_K))[x], vw = ((const v4u*)(rp + PC_V))[x];
                    kr[2 * x] = (f32x4){bflo(kw.x), bfhi(kw.x), bflo(kw.y), bfhi(kw.y)}; kr[2 * x + 1] = (f32x4){bflo(kw.z), bfhi(kw.z), bflo(kw.w), bfhi(kw.w)};
                    vr[2 * x] = (f32x4){bflo(vw.x), bfhi(vw.x), bflo(vw.y), bfhi(vw.y)}; vr[2 * x + 1] = (f32x4){bflo(vw.z), bfhi(vw.z), bflo(vw.w), bfhi(vw.w)}; } }
            else if (p >= 0) { const int page = pt[s * NPAGES + p / PAGE]; const size_t off = ((((size_t)l * NPOOL + page) * PAGE + p % PAGE) * SBH + h) * 64;
#pragma unroll
                for (int x = 0; x < 16; ++x) { kr[x] = ((const f32x4*)(A.in[I_CK] + off))[x]; vr[x] = ((const f32x4*)(A.in[I_CV] + off))[x]; } }
            else {
#pragma unroll
                for (int x = 0; x < 16; ++x) { kr[x] = (f32x4){0.f, 0.f, 0.f, 0.f}; vr[x] = (f32x4){0.f, 0.f, 0.f, 0.f}; } }
#pragma unroll
            for (int x = 0; x < 16; ++x) *(LAS f32x4*)(vt + lane * 68 + 4 * x) = vr[x];
#pragma unroll
            for (int qi = 0; qi < 4; ++qi) { float z = 0.f;
#pragma unroll
                for (int x = 0; x < 16; ++x) { const f32x4 qv = *(const LAS f32x4*)(qs + qi * 64 + 4 * x); z += (kr[x][0] * qv[0] + kr[x][1] * qv[1]) + (kr[x][2] * qv[2] + kr[x][3] * qv[3]); }
                float ls, ln; sb_terms(z, ls, ln);
                const bool valid = p >= 0 && p < PAST + qi; const float lnv = valid ? ln : 0.f;
                float incl = lnv;
#pragma unroll
                for (int o = 1; o < 64; o <<= 1) { const float t = __shfl_up(incl, o); if (lane >= o) incl += t; }
                wq[qi * 64 + lane] = valid ? __expf(ls + R[qi] + (incl - lnv)) : 0.f;
                R[qi] += __shfl(incl, 63); }
            WAVE_SYNC();
#pragma unroll 8
            for (int key = 0; key < 64; ++key) acc += *(const LAS f32x4*)(vt + key * 68 + 4 * ds) * wq[qi_b * 64 + key];
            WAVE_SYNC();
            if (R[0] < SB_CUT && R[1] < SB_CUT && R[2] < SB_CUT && R[3] < SB_CUT) break;
        }
        v2u o; o.x = pk2(acc[0], acc[1]); o.y = pk2(acc[2], acc[3]);
        *(v2u*)(wsb(A, WS_Y) + ((size_t)MP + s * DEC_SEQ + qi_b) * D + 768 + h * 64 + ds * 4) = o;
    }
}
constexpr int PH_PER_LAYER = 12, NPHASE = 2 + PH_PER_LAYER * DEPTH;
#ifndef DUP_MASK
#define DUP_MASK 0
#endif
#if DUP_MASK
__device__ __forceinline__ int rep_n(int k) { int n = ((DUP_MASK >> k) & 1) ? 2 : 1; asm volatile("" : "+s"(n)); return n; }
#define REP(k) _Pragma("nounroll") for (int rep_ = 0, repn_ = rep_n(k); rep_ < repn_; ++rep_)
#else
#define REP(k)
#endif
#ifndef TIME_SUB
#define TIME_SUB 0
#endif
#ifndef TIME_MASK
#define TIME_MASK 0
#endif
#ifndef MK_N_LAUNCHES
#define MK_N_LAUNCHES 1
#endif
__global__ void __launch_bounds__(NWAVES * 64, 2) fwd_kernel(Args A) {
#ifndef CPU_EMU
    extern __shared__ __attribute__((aligned(16))) unsigned char lds_raw[];
    LAS unsigned char* lds = (LAS unsigned char*)lds_raw;
    volatile LAS unsigned* MISC = (volatile LAS unsigned*)(lds + MISC_OFF);
    for (int u = threadIdx.x; u < (LDS_BYTES - MISC_OFF) / 4; u += NWAVES * 64) ((LAS unsigned*)(lds + MISC_OFF))[u] = 0u;
    __syncthreads();
    XcdBarrier bar; bar.bar = (unsigned*)(A.ws + WS_CTL) + CW_BAR + A.li * XCD_BAR_WORDS; bar.x = 0; bar.st = nullptr;
    if (A.ph_hi - A.ph_lo > 1) bar = xcd_barrier_post((unsigned*)(A.ws + WS_CTL) + CW_BAR + A.li * XCD_BAR_WORDS, MISC + 8);
#else
    unsigned char* lds = emu::B->lds; XcdBarrier bar{0};
#endif
    const int lo = A.ph_lo, hi = A.ph_hi, G = gridDim.x, bid = blockIdx.x;
#define IN(k) (lo <= (k) && (k) < hi)
#if TIME_MASK || TIME_SUB
    unsigned long long tp_ = __builtin_amdgcn_s_memrealtime(), tacc_ = 0;
#define SEAM(k) do { if (IN((k) + 1)) xcd_barrier(bar); { const unsigned long long tn_ = __builtin_amdgcn_s_memrealtime(); if ((TIME_MASK >> (k)) & 1) tacc_ += tn_ - tp_; tp_ = tn_; } } while (0)
#else
#define SEAM(k) do { if (IN((k) + 1)) xcd_barrier(bar); } while (0)
#endif
    if (IN(0)) { REP(9) ph_prologue(A, lds); SEAM(0); }
    if (IN(1)) {
        pg8::Gemm g{wsb(A, WS_CSILU), (const bf16*)(A.ws + WS_W + WL_ADA), D, D}; ModOrder S{G, bid}; EpiMod2 E{wsf(A, WS_MOD), A.in[I_BADA]};
        pg8::gemm_phase<EpiMod2, ModOrder, true, true>(lds, g, S, E); SEAM(1);
    }
    for (int l = 0; l < DEPTH; ++l) {
        const int pb = 2 + PH_PER_LAYER * l;
        unsigned char* wl = A.ws + WS_W + (size_t)l * WL_SIZE;
        if (IN(pb + 0)) { if (l == 0) ph_rows<0>(A, 0); SEAM(pb + 0); }
        if (IN(pb + 1)) {
            pg8::Gemm g{wsb(A, WS_H), (const bf16*)(wl + WL_W1), D, D}; pg8::GridOrder S; S.init(M / 256, N1 / 256, G, bid);
            pg8::EpiProj E{wsb(A, WS_PROJ), wsb(A, WS_GATE), A.out + O_KP + (size_t)l * MP * 256, A.out + O_VP + (size_t)l * MP * 256, A.out + O_KS + (size_t)l * MS * 256, A.out + O_VS + (size_t)l * MS * 256, wsb(A, WS_VT)};
            REP(5) pg8::gemm_phase<pg8::EpiProj, pg8::GridOrder, true, true>(lds, g, S, E); SEAM(pb + 1);
        }
        if (IN(pb + 2)) {
#if TIME_SUB
#define SUBT(k, call) do { const unsigned long long ts_ = __builtin_amdgcn_s_memrealtime(); call; if ((TIME_SUB >> (k)) & 1) tacc_ += __builtin_amdgcn_s_memrealtime() - ts_; } while (0)
#else
#define SUBT(k, call) do { call; } while (0)
#endif
            SUBT(0, REP(3) ph_gdn_c1(A, lds, l)); SUBT(1, REP(2) ph_sb_prompt(A, l)); __syncthreads(); SUBT(2, REP(10) ph_gdn_sample(A, lds, l)); SUBT(3, REP(1) ph_sb_sample(A, lds, l));
            SUBT(4, REP(4) ph_ssm1(A, l)); SUBT(5, REP(10) ph_conv(A, l)); SUBT(6, SEAM(pb + 2)); }
        if (IN(pb + 3)) { REP(0) ph_gdn_scan(A, lds, l); REP(10) ph_ssm_carry(A, l); SEAM(pb + 3); }
        if (IN(pb + 4)) { REP(4) ph_ssm2(A, lds, l); REP(10) ph_gdn_out(A, l); SEAM(pb + 4); }
        if (IN(pb + 5)) {
            pg8::Gemm g{wsb(A, WS_YS), (const bf16*)(wl + WL_GLU), 256, 256}; pg8::GridOrder S; S.init(M / 256, 1, G, bid);
            pg8::EpiGlu E{wsb(A, WS_YS), wsb(A, WS_Y)};
            REP(8) pg8::gemm_phase<pg8::EpiGlu, pg8::GridOrder, true, true>(lds, g, S, E); SEAM(pb + 5);
        }
        if (IN(pb + 6)) {
            pg8::Gemm g{wsb(A, WS_Y), (const bf16*)(wl + WL_BR), D, 256}; pg8::MergeOrder S; S.init(M / 256, 8, G, bid);
            pg8::EpiMerge E; E.gate = wsb(A, WS_GATE); E.mgb = wsb(A, WS_MERGEB);
            REP(6) pg8::gemm_phase<pg8::EpiMerge, pg8::MergeOrder, true, true, true>(lds, g, S, E); SEAM(pb + 6);
        }
        if (IN(pb + 7)) {
            pg8::Gemm g{wsb(A, WS_MERGEB), (const bf16*)(wl + WL_WO), D, D}; pg8::GridOrder S; S.init(M / 256, 4, G, bid);
            pg8::EpiRes E{l == 0 ? A.in[I_XP] : wsf(A, WS_X2), l == 0 ? A.in[I_XS] : wsf(A, WS_X2) + (size_t)MP * D, wsf(A, WS_MOD) + (size_t)l * 256 * NMOD + 2 * D, wsf(A, WS_X1)};
            REP(8) pg8::gemm_phase<pg8::EpiRes, pg8::GridOrder, true, true>(lds, g, S, E); SEAM(pb + 7);
        }
        if (IN(pb + 8)) { ph_rows<1>(A, l); SEAM(pb + 8); }
        if (IN(pb + 9)) {
            pg8::Gemm g{wsb(A, WS_H), (const bf16*)(wl + WL_UP), D, D}; pg8::GridOrder S; S.init(M / 256, NUP / 256, G, bid);
            pg8::EpiUp E{wsb(A, WS_ACT)};
            REP(7) pg8::gemm_phase<pg8::EpiUp, pg8::GridOrder, true, true>(lds, g, S, E); SEAM(pb + 9);
        }
        if (IN(pb + 10)) {
            pg8::Gemm g{wsb(A, WS_ACT), (const bf16*)(wl + WL_DN), DFF, DFF}; pg8::GridOrder S; S.init(M / 256, 4, G, bid);
            pg8::EpiRes E{wsf(A, WS_X1), wsf(A, WS_X1) + (size_t)MP * D, wsf(A, WS_MOD) + (size_t)l * 256 * NMOD + 5 * D, wsf(A, WS_X2)};
            REP(7) pg8::gemm_phase<pg8::EpiRes, pg8::GridOrder, true, true>(lds, g, S, E); SEAM(pb + 10);
        }
        if (IN(pb + 11)) { ph_rows<2>(A, l); SEAM(pb + 11); }
    }
#if TIME_MASK || TIME_SUB
    if (blockIdx.x == 0 && threadIdx.x == 0) { const unsigned long long t0_ = __builtin_amdgcn_s_memrealtime(); while (__builtin_amdgcn_s_memrealtime() - t0_ < 4 * tacc_) __builtin_amdgcn_s_sleep(8); }
#endif
#undef IN
#undef SEAM
}
#ifndef CPU_EMU
extern "C" void kernel_launch(void* const* d_in, const int* in_sizes, int n_in, void* d_out, int out_size, void* d_ws, size_t ws_size, hipStream_t stream) {
    static int grid = 0;
    if (grid == 0) {
        if (n_in != 38 || (size_t)out_size != O_END || ws_size < WS_END) { fprintf(stderr, "kernel_launch: unexpected shapes (n_in %d out %d ws %zu; want 38, %zu, >= %zu)\n", n_in, out_size, ws_size, (size_t)O_END, (size_t)WS_END); grid = -1; return; }
        int dev = 0, cus = 0, per_cu = 0;
        if (hipGetDevice(&dev) != hipSuccess || hipDeviceGetAttribute(&cus, hipDeviceAttributeMultiprocessorCount, dev) != hipSuccess) { grid = -1; return; }
        if (hipFuncSetAttribute((const void*)fwd_kernel, hipFuncAttributeMaxDynamicSharedMemorySize, LDS_BYTES) != hipSuccess) { fprintf(stderr, "kernel_launch: hipFuncSetAttribute failed\n"); grid = -1; return; }
        if (hipOccupancyMaxActiveBlocksPerMultiprocessor(&per_cu, (const void*)fwd_kernel, NWAVES * 64, LDS_BYTES) != hipSuccess || per_cu < 1) { fprintf(stderr, "kernel_launch: occupancy query says %d\n", per_cu); }
        (void)hipGetLastError();
        grid = cus;
    }
    if (grid < 0) return;
    if (hipMemsetAsync((char*)d_ws + WS_CTL, 0, CTL_ZERO_BYTES, stream) != hipSuccess) return;
    Args a{};
    for (int i = 0; i < 38; ++i) a.in[i] = (const float*)d_in[i];
    a.out = (float*)d_out; a.ws = (unsigned char*)d_ws;
    if (MK_N_LAUNCHES == 1) { a.ph_lo = 0; a.ph_hi = NPHASE; a.li = 0; hipLaunchKernelGGL(fwd_kernel, dim3(grid), dim3(NWAVES * 64), LDS_BYTES, stream, a); }
    else for (int p = 0; p < NPHASE; ++p) { if (p == 2 + PH_PER_LAYER) continue; a.ph_lo = p; a.ph_hi = p + 1; a.li = 0; hipLaunchKernelGGL(fwd_kernel, dim3(grid), dim3(NWAVES * 64), LDS_BYTES, stream, a); }
}
#endif
```

```cpp
#ifndef CPU_EMU
#include <hip/hip_runtime.h>
#endif
#include <cstdio>
#include <cstdint>
#include <cmath>

constexpr int D = 1024, NB = 2, DEPTH = 2, DEC_SEQ = 4, PAGE = 128;
#ifdef CPU_EMU
#ifndef EMU_SEQ
#define EMU_SEQ 512
#endif
#ifndef EMU_DB
#define EMU_DB 64
#endif
#ifndef EMU_PAST
#define EMU_PAST 512
#endif
constexpr int SEQ = EMU_SEQ, DB = EMU_DB, PAST = EMU_PAST;
#else
constexpr int SEQ = 8192, DB = 128, PAST = 2048;
#endif
constexpr int NPAGES = PAST / PAGE, NUSED = DB * NPAGES, NPOOL = NUSED + (NUSED / 4 > 1 ? NUSED / 4 : 1);
constexpr int MP = NB * SEQ, MS = DB * DEC_SEQ, M = MP + MS, NSEQ = NB + DB;
constexpr int WMIX = 256, NPROJ = 2816, NIN = 2824, NGATE = 4096, N1 = NPROJ + NGATE, DFF = 2816, NUP = 2 * DFF, NMOD = 6 * D;
constexpr int SSM_G = 16, SSM_P = 64, SSM_CH = 128, SSM_NCH = SEQ / SSM_CH;
constexpr int GH = 4, GDK = 64, GCH = 64, GNCH = SEQ / GCH, GQKV = 768;
constexpr int SBH = 4;
constexpr int PC_U = 0, PC_BG = 256, PC_CG = 512, PC_XC = 768, PC_QKV = 1024, PC_Z = 1792, PC_Q = 2048, PC_K = 2304, PC_V = 2560;
constexpr float LN_EPS = 1e-5f, RMS_EPS = 1e-6f, ALPHA = 1.41421356237309515f  ;
static_assert(M % 256 == 0 && MP % 256 == 0 && SEQ % 256 == 0 && NSEQ <= 256, "tile shapes");
constexpr size_t O_Y = 0, O_KP = (size_t)M * D, O_VP = O_KP + (size_t)DEPTH * MP * 256, O_KS = O_VP + (size_t)DEPTH * MP * 256, O_VS = O_KS + (size_t)DEPTH * MS * 256,
    O_REP = O_VS + (size_t)DEPTH * MS * 256, O_IMP = O_REP + DEPTH * NB * 1024, O_RES = O_IMP + DEPTH * NB * 1024, O_IMS = O_RES + (size_t)DEPTH * DB * 1024,
    O_CBP = O_IMS + (size_t)DEPTH * DB * 1024, O_CBS = O_CBP + DEPTH * NB * 512, O_DP = O_CBS + (size_t)DEPTH * DB * 512, O_DS = O_DP + (size_t)DEPTH * NB * 16384,
    O_CDP = O_DS + (size_t)DEPTH * DB * 16384, O_CDS = O_CDP + DEPTH * NB * 2304, O_END = O_CDS + (size_t)DEPTH * DB * 2304;

constexpr size_t MiB = 1u << 20;
constexpr size_t al(size_t x) { return (x + 4095) & ~(size_t)4095; }
constexpr size_t WS_CTL = 0, CTL_ZERO_BYTES = 1 * MiB;
constexpr size_t WL_ADA = 0, WL_W1 = WL_ADA + (size_t)NMOD * D * 2, WL_GLU = WL_W1 + (size_t)N1 * D * 2, WL_BR = WL_GLU + 256 * 256 * 2, WL_WO = WL_BR + (size_t)4 * D * 256 * 2,
    WL_UP = WL_WO + (size_t)D * D * 2, WL_DN = WL_UP + (size_t)NUP * D * 2, WL_LOG = WL_DN + (size_t)D * DFF * 2, WL_SIZE = (WL_LOG + 8 * D * 4 + 524287) & ~(size_t)524287;
constexpr size_t WS_W = 1 * MiB, WS_CSILU = WS_W + DEPTH * WL_SIZE, WS_MOD = WS_CSILU + 256 * D * 2, WS_H = WS_MOD + (size_t)DEPTH * 256 * NMOD * 4,
    WS_PROJ = WS_H + (size_t)M * D * 2, WS_GATE = al(WS_PROJ + (size_t)M * NPROJ * 2), WS_LOG8 = WS_GATE + (size_t)M * NGATE * 2, WS_Y = WS_LOG8 + (size_t)M * 8 * 4,
    WS_YS = WS_Y + (size_t)M * D * 2, WS_MERGE = WS_YS + (size_t)M * 256 * 2, WS_MERGEB = WS_MERGE + (size_t)M * D * 4, WS_X1 = WS_MERGEB + (size_t)M * D * 2,
    WS_ACT = WS_X1 + (size_t)M * D * 4, WS_X2 = al(WS_ACT + (size_t)M * DFF * 2), WS_SEND = WS_X2 + (size_t)M * D * 4, WS_HIN = WS_SEND + (size_t)NB * 16 * SSM_NCH * 128 * 4,
    WS_GD = WS_HIN + (size_t)NB * 16 * SSM_NCH * 128 * 4, WS_EGL = WS_GD + (size_t)NB * GH * GNCH * 49152, WS_ODRAW = al(WS_EGL + (size_t)NB * GH * GNCH * 4),
    WS_VT = al(WS_ODRAW + (size_t)M * 256 * 4), WS_SSMW = al(WS_VT + (size_t)NB * SBH * 64 * SEQ * 2), WS_END = WS_SSMW + (size_t)DEPTH * 16 * 8 * (SSM_CH / 2) * 64 * 16;
constexpr size_t SSMW_L = (size_t)16 * 8 * (SSM_CH / 2) * 64 * 16;
constexpr int CW_TMO = 0, CW_BAR = 4096;
constexpr size_t GD_UNIT = 49152;

#define LAS_HW __attribute__((address_space(3)))
#ifdef CPU_EMU
#define LAS
#else
#define LAS LAS_HW
#endif
typedef unsigned short bf16;
typedef unsigned v4u __attribute__((ext_vector_type(4)));
typedef unsigned v2u __attribute__((ext_vector_type(2)));
typedef float f32x4 __attribute__((ext_vector_type(4)));
typedef float f32x2 __attribute__((ext_vector_type(2)));
typedef short bf16x8 __attribute__((ext_vector_type(8)));
#ifdef CPU_EMU
#define LDS_WAIT() do {} while (0)
#define VM_WAIT() do {} while (0)
#define WAVE_SYNC() emu::wave_sync()
#define CFENCE() do {} while (0)
#define RAW_BAR() emu::block_sync()
#else
#define LDS_WAIT() asm volatile("s_waitcnt lgkmcnt(0)" ::: "memory")
#define VM_WAIT() asm volatile("s_waitcnt vmcnt(0)" ::: "memory")
#define WAVE_SYNC() do { asm volatile("s_waitcnt lgkmcnt(0)" ::: "memory"); __builtin_amdgcn_wave_barrier(); } while (0)
#define CFENCE() asm volatile("" ::: "memory")
#define RAW_BAR() do { asm volatile("s_waitcnt lgkmcnt(0)" ::: "memory"); __builtin_amdgcn_s_barrier(); asm volatile("" ::: "memory"); } while (0)
#endif
#ifdef CPU_EMU
#define OPAQUE_V(x) do {} while (0)
#else
#define OPAQUE_V(x) asm volatile("" : "+v"(x))
#endif
__device__ __forceinline__ unsigned f2bf(float f) { unsigned u = __builtin_bit_cast(unsigned, f); return (u + 0x7fffu + ((u >> 16) & 1u)) >> 16; }
__device__ __forceinline__ unsigned pk2(float lo, float hi) { return f2bf(lo) | (f2bf(hi) << 16); }
__device__ __forceinline__ float bf2f(unsigned b) { return __builtin_bit_cast(float, b << 16); }
__device__ __forceinline__ float bflo(unsigned w) { return __builtin_bit_cast(float, w << 16); }
__device__ __forceinline__ float bfhi(unsigned w) { return __builtin_bit_cast(float, w & 0xffff0000u); }
__device__ __forceinline__ float sigmoidf_(float x) { return 1.0f / (1.0f + __expf(-x)); }
__device__ __forceinline__ float siluf_(float x) { return x / (1.0f + __expf(-x)); }
__device__ __forceinline__ bf16x8 acc2b(const f32x4& lo, const f32x4& hi) { v4u w; w.x = pk2(lo[0], lo[1]); w.y = pk2(lo[2], lo[3]); w.z = pk2(hi[0], hi[1]); w.w = pk2(hi[2], hi[3]); return __builtin_bit_cast(bf16x8, w); }
__device__ __forceinline__ float wave_sum(float v) {
#pragma unroll
    for (int o = 1; o < 64; o <<= 1) v += __shfl_xor(v, o);
    return v;
}
__device__ __forceinline__ int seq_of(int m) { return m < MP ? m / SEQ : NB + (m - MP) / DEC_SEQ; }
namespace pg8 {
typedef unsigned short bf16_t;
constexpr int BM = 256, BK = 64, HALF = 128, HTB = HALF * BK * 2, STAGE_BYTES = 8 * HTB, NXCD = 8, WGM = 8;
__host__ __device__ __forceinline__ int lds_byte(int r, int c) { const int st = (r >> 4) * 2 + (c >> 5), rr = r & 15, cc = c & 31, ob = rr * 64 + cc * 2; return st * 1024 + (ob ^ (((ob >> 9) & 1) << 5)); }
__host__ __device__ __forceinline__ void stage_rc(int b, int& R, int& C) { const int st = b / 1024, sb = b % 1024, swz = sb ^ (((sb >> 9) & 1) << 5); R = (st >> 1) * 16 + swz / 64; C = (st & 1) * 32 + (swz % 64) / 2; }
__host__ __device__ __forceinline__ int perm32(int rho) { const int n = rho >> 4, i = rho & 15; return 8 * (i >> 2) + 4 * n + (i & 3); }
struct Unit { int pm, pn, ka, aux; };
struct NoState {};
struct Gemm { const bf16_t* A; const bf16_t* Bt; int lda, K; };
struct GridOrder {
    int nM, nN, nwg, G, c, pn0;
    __host__ __device__ void init(int nM_, int nN_, int G_, int c_, int pn0_ = 0) { nM = nM_; nN = nN_; nwg = nM * nN; G = G_; c = c_; pn0 = pn0_; }
    __host__ __device__ bool tile(long L, int& pm, int& pn) const {
        if (L >= nwg) return false;
        int wgid = (int)L; { const int q = nwg / NXCD, r = nwg % NXCD, xcd = wgid % NXCD, off = wgid / NXCD; wgid = (xcd < r ? xcd * (q + 1) : r * (q + 1) + (xcd - r) * q) + off; }
        const int nig = WGM * nN, gid = wgid / nig, fm = gid * WGM, gsz = (nM - fm) < WGM ? (nM - fm) : WGM;
        pm = fm + ((wgid % nig) % gsz); pn = (wgid % nig) / gsz; return true;
    }
    __host__ __device__ bool next(int i, Unit& u) const { int pm, pn; if (!tile((long)i * G + c, pm, pn)) return false; u.pm = pm; u.pn = pn0 + pn; u.ka = 0; u.aux = pn; return true; }
    __device__ __forceinline__ void a_ready(const Unit&) const {}
    __device__ __forceinline__ void done(const Unit&) const {}
};
struct MergeOrder : GridOrder {
    __host__ __device__ bool next(int i, Unit& u) const { int pm, pc; if (!tile((long)(i >> 2) * G + c, pm, pc)) return false; const int n = i & 3; u.pm = pm; u.pn = 8 * n + pc; u.ka = 256 * n; u.aux = (n << 8) | pc; return true; }
};
#ifndef CPU_EMU
#define PG8_LAS __attribute__((address_space(3)))
template <class Epi, class Sched, bool ALIGN_EPI = false, bool SP2 = false, bool HALFN = false>
__device__ __forceinline__ void gemm_phase(PG8_LAS unsigned char* lds, const Gemm g, const Sched& S, const Epi& E) {
    int tid = threadIdx.x; asm volatile("" : "+v"(tid));
    const int wid = __builtin_amdgcn_readfirstlane(tid >> 6), lane = tid & 63, wr = wid >> 2, wc = wid & 3, fr = lane & 15, fq = lane >> 4;
    int K = g.K; asm volatile("" : "+s"(K));
    const int nt = K / BK, lda = g.lda;
    unsigned voffA[2], voffB[2];
#pragma unroll
    for (int i = 0; i < 2; ++i) { int R, C; stage_rc(tid * 16 + i * 8192, R, C); const int Rb = Epi::PERM ? ((R & ~31) + perm32(R & 31)) : R;
        voffA[i] = (unsigned)(R * lda + C) * 2u; voffB[i] = (unsigned)(Rb * K + C) * 2u; }
    const size_t kstep = (size_t)(BK * 2);
    const size_t hstepA = (size_t)HALF * lda * 2, hstepB = HALFN ? (size_t)0 : (size_t)HALF * K * 2;
    const size_t tstepA = 2 * hstepA, tstepB = HALFN ? (size_t)HALF * K * 2 : 2 * hstepB;
    const unsigned ldsw = (unsigned)wid * 1024u;
    const int aoff = lds_byte(wr * 64 + fr, fq * 8), boff = lds_byte(wc * 32 + fr, fq * 8);
#define PG8_SA(b, h) (((b) * 2 + (h)) * HTB)
#define PG8_SB(b, h) ((4 + (b) * 2 + (h)) * HTB)
#define PG8_STAGE(bufoff, gbase, voff) do { _Pragma("unroll") for (int _i = 0; _i < 2; ++_i) \
        __builtin_amdgcn_global_load_lds((const unsigned*)((const char*)(gbase) + (voff)[_i]), (PG8_LAS unsigned*)(lds + (bufoff) + ldsw + _i * 8192), 16, 0, 0); } while (0)
#define PG8_LDA(dst, b, h) do { _Pragma("unroll") for (int m = 0; m < 4; ++m) _Pragma("unroll") for (int k = 0; k < 2; ++k) dst[m][k] = *(const PG8_LAS bf16x8*)(lds + PG8_SA(b, h) + aoff + m * 2048 + k * 1024); } while (0)
#define PG8_LDB(dst, b, h) do { _Pragma("unroll") for (int n = 0; n < 2; ++n) _Pragma("unroll") for (int k = 0; k < 2; ++k) dst[n][k] = *(const PG8_LAS bf16x8*)(lds + PG8_SB(b, h) + boff + n * 2048 + k * 1024); } while (0)
#define PG8_MMA(ai, bj, At, Bt) do { __builtin_amdgcn_s_setprio(1); _Pragma("unroll") for (int m = 0; m < 4; ++m) _Pragma("unroll") for (int n = 0; n < 2; ++n) _Pragma("unroll") for (int k = 0; k < 2; ++k) \
        acc[ai][bj][m][n] = __builtin_amdgcn_mfma_f32_16x16x32_bf16(Bt[n][k], At[m][k], acc[ai][bj][m][n], 0, 0, 0); __builtin_amdgcn_s_setprio(0); } while (0)
#define PG8_WAIT_V(n) asm volatile("s_waitcnt vmcnt(" #n ")" ::: "memory")
#define PG8_WAIT_L(n) asm volatile("s_waitcnt lgkmcnt(" #n ")" ::: "memory")
#define PG8_BAR __builtin_amdgcn_s_barrier()
#define PG8_SCHED __builtin_amdgcn_sched_barrier(0)
    Unit cur, nxt; int ui = 0;
    if (!S.next(0, cur)) return;
    f32x4 acc[2][2][4][2];
    typename Epi::State est;
#pragma unroll
    for (int a = 0; a < 2; ++a)
#pragma unroll
        for (int b = 0; b < 2; ++b)
#pragma unroll
            for (int m = 0; m < 4; ++m)
#pragma unroll
                for (int n = 0; n < 2; ++n) acc[a][b][m][n] = (f32x4){0.f, 0.f, 0.f, 0.f};
    static_assert(!HALFN || SP2, "HALFN is written for the SP2 loop");
    bf16x8 At[4][2], B0[2][2], B1[2][2];
    const char* cA = (const char*)g.A + (size_t)cur.pm * tstepA + (size_t)cur.ka * 2; const char* cB = (const char*)g.Bt + (size_t)cur.pn * tstepB;
    S.a_ready(cur);
    if constexpr (SP2) {
        PG8_STAGE(PG8_SB(0, 0), cB, voffB); PG8_STAGE(PG8_SB(0, 1), cB + hstepB, voffB); PG8_STAGE(PG8_SA(0, 0), cA, voffA); PG8_STAGE(PG8_SA(0, 1), cA + hstepA, voffA);
        if (wr == 1) PG8_BAR;
        PG8_WAIT_V(2); PG8_BAR;
        PG8_STAGE(PG8_SB(1, 0), cB + kstep, voffB); PG8_STAGE(PG8_SA(1, 0), cA + kstep, voffA); PG8_STAGE(PG8_SB(1, 1), cB + hstepB + kstep, voffB);
        PG8_WAIT_V(6); PG8_BAR;
    } else {
        PG8_STAGE(PG8_SB(0, 0), cB, voffB); PG8_STAGE(PG8_SA(0, 0), cA, voffA); PG8_STAGE(PG8_SB(0, 1), cB + hstepB, voffB); PG8_STAGE(PG8_SA(0, 1), cA + hstepA, voffA);
        if (wr == 1) PG8_BAR;
        PG8_WAIT_V(4); PG8_BAR;
        PG8_STAGE(PG8_SB(1, 0), cB + kstep, voffB); PG8_STAGE(PG8_SA(1, 0), cA + kstep, voffA); PG8_STAGE(PG8_SB(1, 1), cB + hstepB + kstep, voffB);
        PG8_WAIT_V(6); PG8_BAR;
    }
    for (;;) {
        const bool has_next = S.next(ui + 1, nxt);
        const char* nA = has_next ? (const char*)g.A + (size_t)nxt.pm * tstepA + (size_t)nxt.ka * 2 : cA; const char* nB = has_next ? (const char*)g.Bt + (size_t)nxt.pn * tstepB : cB;
        for (int t = 0; t < nt; t += 2) {
            const bool last = (t == nt - 2);
            const char* a1 = cA + (size_t)(t + 1) * kstep;
            const char* a2 = last ? nA : cA + (size_t)(t + 2) * kstep; const char* b2 = last ? nB : cB + (size_t)(t + 2) * kstep;
            const char* a3 = a2 + kstep; const char* b3 = b2 + kstep;
            if (last && has_next) S.a_ready(nxt);
            if constexpr (SP2) {
            PG8_LDB(B0, 0, 0); if constexpr (!HALFN) PG8_LDB(B1, 0, 1); PG8_SCHED; PG8_LDA(At, 0, 0); PG8_STAGE(PG8_SA(1, 1), a1 + hstepA, voffA);
            PG8_WAIT_V(8); PG8_WAIT_L(0); PG8_BAR; PG8_MMA(0, 0, At, B0); if constexpr (!HALFN) PG8_MMA(0, 1, At, B1); PG8_BAR; PG8_SCHED;
            PG8_LDA(At, 0, 1); PG8_STAGE(PG8_SB(0, 0), b2, voffB); PG8_STAGE(PG8_SB(0, 1), b2 + hstepB, voffB); PG8_STAGE(PG8_SA(0, 0), a2, voffA);
            PG8_WAIT_V(8); PG8_WAIT_L(0); PG8_BAR; PG8_MMA(1, 0, At, B0); if constexpr (!HALFN) PG8_MMA(1, 1, At, B1); PG8_BAR; PG8_SCHED;
            PG8_LDB(B0, 1, 0); if constexpr (!HALFN) PG8_LDB(B1, 1, 1); PG8_SCHED; PG8_LDA(At, 1, 0); PG8_STAGE(PG8_SA(0, 1), a2 + hstepA, voffA);
            PG8_WAIT_V(8); PG8_WAIT_L(0); PG8_BAR; PG8_MMA(0, 0, At, B0); if constexpr (!HALFN) PG8_MMA(0, 1, At, B1); PG8_BAR; PG8_SCHED;
            PG8_LDA(At, 1, 1); PG8_STAGE(PG8_SB(1, 0), b3, voffB); PG8_STAGE(PG8_SB(1, 1), b3 + hstepB, voffB); PG8_STAGE(PG8_SA(1, 0), a3, voffA);
            PG8_WAIT_V(8); PG8_WAIT_L(0); PG8_BAR; PG8_MMA(1, 0, At, B0); if constexpr (!HALFN) PG8_MMA(1, 1, At, B1); PG8_BAR; PG8_SCHED;
            } else {
            PG8_LDB(B0, 0, 0); PG8_SCHED; PG8_LDA(At, 0, 0); PG8_STAGE(PG8_SA(1, 1), a1 + hstepA, voffA);
            PG8_WAIT_L(8); PG8_BAR; PG8_WAIT_L(0); PG8_MMA(0, 0, At, B0); PG8_BAR; PG8_SCHED;
            PG8_LDB(B1, 0, 1); PG8_STAGE(PG8_SB(0, 0), b2, voffB);
            PG8_BAR; PG8_WAIT_L(0); PG8_MMA(0, 1, At, B1); PG8_BAR;
            PG8_LDA(At, 0, 1); PG8_STAGE(PG8_SA(0, 0), a2, voffA);
            PG8_BAR; PG8_WAIT_L(0); PG8_MMA(1, 0, At, B0); PG8_BAR; PG8_SCHED;
            PG8_STAGE(PG8_SB(0, 1), b2 + hstepB, voffB);
            PG8_WAIT_V(6); PG8_BAR; PG8_MMA(1, 1, At, B1); PG8_BAR;
            PG8_LDB(B0, 1, 0); PG8_SCHED; PG8_LDA(At, 1, 0); PG8_STAGE(PG8_SA(0, 1), a2 + hstepA, voffA);
            PG8_WAIT_L(8); PG8_BAR; PG8_WAIT_L(0); PG8_MMA(0, 0, At, B0); PG8_BAR; PG8_SCHED;
            PG8_LDB(B1, 1, 1); PG8_STAGE(PG8_SB(1, 0), b3, voffB);
            PG8_BAR; PG8_WAIT_L(0); PG8_MMA(0, 1, At, B1); PG8_BAR;
            PG8_LDA(At, 1, 1); PG8_STAGE(PG8_SA(1, 0), a3, voffA);
            PG8_BAR; PG8_WAIT_L(0); PG8_MMA(1, 0, At, B0); PG8_BAR; PG8_SCHED;
            PG8_STAGE(PG8_SB(1, 1), b3 + hstepB, voffB);
            PG8_WAIT_V(6); PG8_BAR; PG8_MMA(1, 1, At, B1); PG8_BAR;
            }
        }
        if constexpr (ALIGN_EPI) { if (wr == 0) PG8_BAR; }
        E(acc, est, cur, wr, wc, fr, fq); S.done(cur);
        if (!has_next) break;
#pragma unroll
        for (int a = 0; a < 2; ++a)
#pragma unroll
            for (int b = 0; b < 2; ++b)
#pragma unroll
                for (int m = 0; m < 4; ++m)
#pragma unroll
                    for (int n = 0; n < 2; ++n) acc[a][b][m][n] = (f32x4){0.f, 0.f, 0.f, 0.f};
        cur = nxt; cA = nA; cB = nB; ++ui;
        if constexpr (ALIGN_EPI) { if (wr == 1) PG8_BAR; }
    }
    PG8_WAIT_V(0);
    if constexpr (!ALIGN_EPI) { if (wr == 0) PG8_BAR; }
    PG8_BAR;
#undef PG8_SA
#undef PG8_SB
#undef PG8_STAGE
#undef PG8_LDA
#undef PG8_LDB
#undef PG8_MMA
#undef PG8_WAIT_V
#undef PG8_WAIT_L
#undef PG8_BAR
#undef PG8_SCHED
}
#else
template <class Epi, class Sched, bool ALIGN_EPI = false, bool SP2 = false, bool HALFN = false>
void gemm_phase(unsigned char* lds, const Gemm g, const Sched& S, const Epi& E) {
    const int tid = threadIdx.x, wid = tid >> 6, lane = tid & 63, wr = wid >> 2, wc = wid & 3, fr = lane & 15, fq = lane >> 4;
    static thread_local float* Ct = nullptr; static thread_local float* Af = nullptr; static thread_local float* Bf = nullptr;
    Unit u; typename Epi::State est;
    for (int i = 0; S.next(i, u); ++i) {
        S.a_ready(u);
        __syncthreads();
        if (tid == 0) {
            if (!Ct) { Ct = new float[256 * 256]; Af = new float[256 * 4096]; Bf = new float[256 * 4096]; }
            const int K = g.K;
            for (int r = 0; r < 256; ++r) for (int k = 0; k < K; ++k) { Af[r * K + k] = bf2f(g.A[(size_t)(u.pm * 256 + r) * g.lda + u.ka + k]); Bf[r * K + k] = HALFN ? (r < 128 ? bf2f(g.Bt[(size_t)(u.pn * 128 + r) * K + k]) : 0.f) : bf2f(g.Bt[(size_t)(u.pn * 256 + r) * K + k]); }
            for (int r = 0; r < 256; ++r) for (int c = 0; c < 256; ++c) { float s = 0.f; const float* a = Af + r * K; const float* b = Bf + c * K; for (int k = 0; k < K; ++k) s += a[k] * b[k]; Ct[r * 256 + c] = s; }
        }
        __syncthreads();
        f32x4 acc[2][2][4][2];
        for (int ai = 0; ai < 2; ++ai) for (int bj = 0; bj < 2; ++bj) for (int m = 0; m < 4; ++m) for (int n = 0; n < 2; ++n) for (int e = 0; e < 4; ++e) {
            const int r = 128 * ai + 64 * wr + 16 * m + fr; const int c = Epi::PERM ? (128 * bj + 32 * wc + 8 * fq + 4 * n + e) : (128 * bj + 32 * wc + 16 * n + 4 * fq + e);
            acc[ai][bj][m][n][e] = Ct[r * 256 + c]; }
        E(acc, est, u, wr, wc, fr, fq); S.done(u);
    }
    __syncthreads();
}
#endif
}
namespace pg8 {
struct EpiMod {
    static constexpr bool PERM = false; typedef NoState State;
    float* C; const float* bias;
    __device__ __forceinline__ void operator()(const f32x4 (&acc)[2][2][4][2], State& st, const Unit& u, int wr, int wc, int fr_in, int fq_in) const {
        int fr = fr_in, fq = fq_in; OPAQUE_V(fr); OPAQUE_V(fq);
        const int row0 = wr * 64 + fr, col0 = u.aux * BM + wc * 32 + 4 * fq;
#pragma unroll
        for (int ai = 0; ai < 2; ++ai)
#pragma unroll
            for (int m = 0; m < 4; ++m) { float* rowp = C + (size_t)(row0 + ai * HALF + m * 16) * NMOD + col0;
#pragma unroll
                for (int bj = 0; bj < 2; ++bj)
#pragma unroll
                    for (int n = 0; n < 2; ++n) *(f32x4*)(rowp + bj * HALF + n * 16) = acc[ai][bj][m][n] + *(const f32x4*)(bias + col0 + bj * HALF + n * 16); }
    }
};
struct EpiProj {
    static constexpr bool PERM = true; typedef NoState State;
    bf16* proj; bf16* gate; float* outk_p; float* outv_p; float* outk_s; float* outv_s; bf16* vt;
    __device__ __forceinline__ void operator()(const f32x4 (&acc)[2][2][4][2], State& st, const Unit& u, int wr, int wc, int fr_in, int fq_in) const {
        int fr = fr_in, fq = fq_in; OPAQUE_V(fr); OPAQUE_V(fq);
        const int t = u.aux; const bool isg = t >= 11;
        const int row0 = u.pm * BM + wr * 64 + fr, colt = wc * 32 + 8 * fq;
        bf16* base = isg ? gate + (size_t)(t - 11) * 256 : proj + (size_t)t * 256; const int ldc = isg ? NGATE : NPROJ;
#pragma unroll
        for (int ai = 0; ai < 2; ++ai)
#pragma unroll
            for (int m = 0; m < 4; ++m) { const int row = row0 + ai * HALF + m * 16; bf16* rowp = base + (size_t)row * ldc + colt;
#pragma unroll
                for (int bj = 0; bj < 2; ++bj) { f32x4 v0 = acc[ai][bj][m][0], v1 = acc[ai][bj][m][1];
                    if (isg) {
#pragma unroll
                        for (int e = 0; e < 4; ++e) { v0[e] = sigmoidf_(v0[e]); v1[e] = sigmoidf_(v1[e]); } }
                    else if (t >= 9) { if (t == 10 && row < MP) { const int cv = colt + bj * HALF, bb = row / SEQ, tt = row % SEQ; bf16* vp = vt + ((size_t)(bb * SBH + (cv >> 6)) * 64 + (cv & 63)) * SEQ + tt;
#pragma unroll
                            for (int e = 0; e < 4; ++e) { vp[(size_t)e * SEQ] = (bf16)f2bf(v0[e]); vp[(size_t)(4 + e) * SEQ] = (bf16)f2bf(v1[e]); } }
                        float* o = (row < MP) ? ((t == 9 ? outk_p : outv_p) + (size_t)row * 256) : ((t == 9 ? outk_s : outv_s) + (size_t)(row - MP) * 256);
                        *(f32x4*)(o + colt + bj * HALF) = v0; *(f32x4*)(o + colt + bj * HALF + 4) = v1; }
                    v4u w; w.x = pk2(v0[0], v0[1]); w.y = pk2(v0[2], v0[3]); w.z = pk2(v1[0], v1[1]); w.w = pk2(v1[2], v1[3]);
                    *(v4u*)(rowp + bj * HALF) = w; } }
    }
};
struct EpiGlu {
    static constexpr bool PERM = true; typedef NoState State;
    const bf16* ys; bf16* y;
    __device__ __forceinline__ void operator()(const f32x4 (&acc)[2][2][4][2], State& st, const Unit& u, int wr, int wc, int fr_in, int fq_in) const {
        int fr = fr_in, fq = fq_in; OPAQUE_V(fr); OPAQUE_V(fq);
        const int row0 = u.pm * BM + wr * 64 + fr, colt = wc * 32 + 8 * fq;
#pragma unroll
        for (int ai = 0; ai < 2; ++ai)
#pragma unroll
            for (int m = 0; m < 4; ++m) { const int row = row0 + ai * HALF + m * 16;
#pragma unroll
                for (int bj = 0; bj < 2; ++bj) { const f32x4 v0 = acc[ai][bj][m][0], v1 = acc[ai][bj][m][1];
                    const v4u s = *(const v4u*)(ys + (size_t)row * 256 + colt + bj * HALF);
                    v4u w; w.x = pk2(bflo(s.x) * sigmoidf_(v0[0]), bfhi(s.x) * sigmoidf_(v0[1])); w.y = pk2(bflo(s.y) * sigmoidf_(v0[2]), bfhi(s.y) * sigmoidf_(v0[3]));
                    w.z = pk2(bflo(s.z) * sigmoidf_(v1[0]), bfhi(s.z) * sigmoidf_(v1[1])); w.w = pk2(bflo(s.w) * sigmoidf_(v1[2]), bfhi(s.w) * sigmoidf_(v1[3]));
                    *(v4u*)(y + (size_t)row * D + colt + bj * HALF) = w; } CFENCE(); }
    }
};
struct EpiMerge {
    static constexpr bool PERM = false; struct State { f32x4 macc[2][4][2]; };
    const bf16* gate; bf16* mgb;
    __device__ __forceinline__ void operator()(const f32x4 (&acc)[2][2][4][2], State& st, const Unit& u, int wr, int wc, int fr_in, int fq_in) const {
        int fr = fr_in, fq = fq_in; OPAQUE_V(fr); OPAQUE_V(fq);
        const int n_ = u.aux >> 8, pc = u.aux & 255;
        const int row0 = u.pm * BM + wr * 64 + fr, col0 = pc * HALF + wc * 32 + 4 * fq;
        v2u gw[2][4][2];
#pragma unroll
        for (int ai = 0; ai < 2; ++ai)
#pragma unroll
            for (int m = 0; m < 4; ++m)
#pragma unroll
                for (int n = 0; n < 2; ++n) gw[ai][m][n] = *(const v2u*)(gate + (size_t)(row0 + ai * HALF + m * 16) * NGATE + n_ * D + col0 + n * 16);
        CFENCE();
#pragma unroll
        for (int ai = 0; ai < 2; ++ai)
#pragma unroll
            for (int m = 0; m < 4; ++m) { const int row = row0 + ai * HALF + m * 16;
#pragma unroll
                for (int n = 0; n < 2; ++n) { const int col = col0 + n * 16; const v2u g2 = gw[ai][m][n];
                    f32x4 v = acc[ai][0][m][n]; v[0] *= bflo(g2.x); v[1] *= bfhi(g2.x); v[2] *= bflo(g2.y); v[3] *= bfhi(g2.y);
                    if (n_ > 0) v += st.macc[ai][m][n];
                    st.macc[ai][m][n] = v;
                    if (n_ == 3) { v2u o; o.x = pk2(v[0], v[1]); o.y = pk2(v[2], v[3]); *(v2u*)(mgb + (size_t)row * D + col) = o; } } }
    }
};
struct EpiRes {
    static constexpr bool PERM = false; typedef NoState State;
    const float* xP; const float* xS; const float* gmod; float* out;
    __device__ __forceinline__ void operator()(const f32x4 (&acc)[2][2][4][2], State& st, const Unit& u, int wr, int wc, int fr_in, int fq_in) const {
        int fr = fr_in, fq = fq_in; OPAQUE_V(fr); OPAQUE_V(fq);
        const int row0 = u.pm * BM + wr * 64 + fr, col0 = u.aux * BM + wc * 32 + 4 * fq;
#pragma unroll
        for (int ai = 0; ai < 2; ++ai)
#pragma unroll
            for (int m = 0; m < 4; ++m) { const int row = row0 + ai * HALF + m * 16; const float* xr = row < MP ? xP + (size_t)row * D : xS + (size_t)(row - MP) * D;
                const float* gr = gmod + (size_t)seq_of(row) * NMOD;
#pragma unroll
                for (int bj = 0; bj < 2; ++bj)
#pragma unroll
                    for (int n = 0; n < 2; ++n) { const int col = col0 + bj * HALF + n * 16;
                        const f32x4 xv = *(const f32x4*)(xr + col), gv = *(const f32x4*)(gr + col);
                        *(f32x4*)(out + (size_t)row * D + col) = xv * ALPHA + (gv + 1.0f) * acc[ai][bj][m][n]; } CFENCE(); }
    }
};
struct EpiUp {
    static constexpr bool PERM = true; typedef NoState State;
    bf16* act;
    __device__ __forceinline__ void operator()(const f32x4 (&acc)[2][2][4][2], State& st, const Unit& u, int wr, int wc, int fr_in, int fq_in) const {
        int fr = fr_in, fq = fq_in; OPAQUE_V(fr); OPAQUE_V(fq);
        const int row0 = u.pm * BM + wr * 64 + fr, col0 = u.aux * HALF + wc * 32 + 8 * fq;
#pragma unroll
        for (int ai = 0; ai < 2; ++ai)
#pragma unroll
            for (int m = 0; m < 4; ++m) { const int row = row0 + ai * HALF + m * 16;
                const f32x4 a0 = acc[ai][0][m][0], a1 = acc[ai][0][m][1], b0 = acc[ai][1][m][0], b1 = acc[ai][1][m][1];
                v4u w; w.x = pk2(siluf_(a0[0]) * b0[0], siluf_(a0[1]) * b0[1]); w.y = pk2(siluf_(a0[2]) * b0[2], siluf_(a0[3]) * b0[3]);
                w.z = pk2(siluf_(a1[0]) * b1[0], siluf_(a1[1]) * b1[1]); w.w = pk2(siluf_(a1[2]) * b1[2], siluf_(a1[3]) * b1[3]);
                *(v4u*)(act + (size_t)row * DFF + col0) = w; }
    }
};
}
struct Args { const float* in[38]; float* out; unsigned char* ws; int ph_lo, ph_hi, li, pad; };
enum { I_XP = 0, I_XS, I_CK, I_CV, I_SRE, I_SIM, I_SCB, I_SD, I_SCD, I_PT, I_CP, I_CS, I_WADA, I_BADA, I_WIN, I_ARE, I_AIM, I_LDT, I_BRE, I_BIM, I_CRE, I_CIM, I_SSD, I_WGLU,
       I_CBW, I_DCW, I_DAL, I_DDT, I_DNW, I_WBR, I_WGATE, I_WO, I_L1G, I_L1B, I_WUP, I_WDN, I_L2G, I_L2B };
constexpr int NWAVES = 8, RING_BYTES = 131072, MISC_OFF = RING_BYTES, LDS_BYTES = 147456;
#ifndef CPU_EMU
#define XB_TMO      128
#define XB_XCNT(j)  (256  + 64 * (j))
#define XB_XSUB(j)  (1280 + 64 * (j))
#define XB_XGEN(j)  (2304 + 64 * (j))
#define XB_TOP      3328
#define XB_TOPGEN   3392
#define XCD_BAR_WORDS 3456
#define XB_SPIN_CAP (1u << 18)
__device__ __forceinline__ unsigned xb_ld(unsigned* p)              { return __hip_atomic_load(p, __ATOMIC_RELAXED, __HIP_MEMORY_SCOPE_AGENT); }
__device__ __forceinline__ unsigned xb_add(unsigned* p, unsigned v) { return __hip_atomic_fetch_add(p, v, __ATOMIC_RELAXED, __HIP_MEMORY_SCOPE_AGENT); }
__device__ __forceinline__ unsigned xb_xcc_id() { return (unsigned)__builtin_amdgcn_s_getreg((3 << 11) | 20) & 0xFu; }
#define XB_SPIN(cond, bar) do { unsigned _sp = 0; while (cond) { __builtin_amdgcn_s_sleep(1); \
    if ((++_sp & 255u) == 0u) { if (xb_ld(&(bar)[XB_TMO])) break; if (_sp > XB_SPIN_CAP) { atomicAdd(&(bar)[XB_TMO], 1u); break; } } } } while (0)
struct XcdBarrier { unsigned* bar; unsigned x; volatile LAS_HW unsigned* st; };
__device__ __forceinline__ XcdBarrier xcd_barrier_post(unsigned* bar, volatile LAS_HW unsigned* st) {
    XcdBarrier b; b.bar = bar; b.x = xb_xcc_id(); b.st = st;
    if (threadIdx.x == 0) (void)xb_add(&bar[XB_XCNT(b.x)], 1u);
    return b;
}
__device__ __forceinline__ void xcd_barrier_complete(unsigned* bar, unsigned x, unsigned& nloc, unsigned& nx) {
    const unsigned G = gridDim.x * gridDim.y * gridDim.z;
    unsigned sum, cnt, mine, sp = 0u;
    for (;;) {
        sum = 0u; cnt = 0u; mine = 0u;
#pragma unroll
        for (unsigned j = 0; j < 16; ++j) { const unsigned c = xb_ld(&bar[XB_XCNT(j)]); sum += c; cnt += (c > 0u) ? 1u : 0u; mine = (j == x) ? c : mine; }
        if (sum == G) break;
        __builtin_amdgcn_s_sleep(1);
        if ((++sp & 255u) == 0u) { if (xb_ld(&bar[XB_TMO])) break; if (sp > XB_SPIN_CAP) { atomicAdd(&bar[XB_TMO], 1u); break; } }
    }
    nloc = mine > 0u ? mine : 1u; nx = cnt > 0u ? cnt : 1u;
}
__device__ __forceinline__ void xcd_barrier(const XcdBarrier& b) {
    asm volatile("s_waitcnt vmcnt(0)" ::: "memory");
    __syncthreads();
    if (threadIdx.x == 0) {
        unsigned* bar = b.bar;
        __builtin_amdgcn_s_waitcnt(0);
        unsigned nloc = b.st[0], nx = b.st[1];
        if (nloc == 0u) { xcd_barrier_complete(bar, b.x, nloc, nx); b.st[0] = nloc; b.st[1] = nx; }
        const unsigned old = xb_add(&bar[XB_XSUB(b.x)], 1u);
        const unsigned gen = old / nloc;
        if (old + 1u == (gen + 1u) * nloc) {
            __builtin_amdgcn_fence(__ATOMIC_RELEASE, "agent");
            asm volatile("s_waitcnt vmcnt(0)" ::: "memory");
            const unsigned og = xb_add(&bar[XB_TOP], 1u);
            const unsigned tg = og / nx;
            if (og + 1u == (tg + 1u) * nx) xb_add(&bar[XB_TOPGEN], 1u);
            else XB_SPIN(xb_ld(&bar[XB_TOPGEN]) == tg, bar);
            __builtin_amdgcn_fence(__ATOMIC_ACQUIRE, "agent");
            xb_add(&bar[XB_XGEN(b.x)], 1u);
            asm volatile("s_waitcnt vmcnt(0)" ::: "memory");
        } else {
            XB_SPIN(xb_ld(&bar[XB_XGEN(b.x)]) == gen, bar);
            __builtin_amdgcn_fence(__ATOMIC_ACQUIRE, "agent");
            asm volatile("s_waitcnt vmcnt(0)" ::: "memory");
        }
    }
    __syncthreads();
}
#else
#define XCD_BAR_WORDS 3456
struct XcdBarrier { int dummy; };
inline void xcd_barrier(const XcdBarrier&) { emu::grid_sync(); }
#endif

#define TIDS int tid_ = threadIdx.x; OPAQUE_V(tid_); const int tid = tid_, lane = tid & 63, wave = __builtin_amdgcn_readfirstlane(tid >> 6), G = gridDim.x, bid = blockIdx.x, gw = bid * NWAVES + wave, NGW = G * NWAVES; (void)lane; (void)wave; (void)gw; (void)NGW; (void)G; (void)bid
__device__ __forceinline__ bf16* wsb(const Args& A, size_t off) { return (bf16*)(A.ws + off); }
__device__ __forceinline__ float* wsf(const Args& A, size_t off) { return (float*)(A.ws + off); }
__device__ __forceinline__ float softplusf_(float x) { return fmaxf(x, 0.f) + log1pf(__expf(-fabsf(x))); }
__device__ __forceinline__ void tr_item(const float* W, int N, int K, int k0, int c0, bf16* WT, int drow0, LAS float* scr, int lane) {
#pragma unroll 8
    for (int i = 0; i < 32; ++i) { const int kk = 2 * i + (lane >> 5); scr[kk * 33 + (lane & 31)] = W[(size_t)(k0 + kk) * N + c0 + (lane & 31)]; }
    WAVE_SYNC();
    const int c = lane & 7;
#pragma unroll
    for (int j = 0; j < 4; ++j) { const int n = (lane >> 3) + 8 * j; const LAS float* s = scr + (8 * c) * 33 + n;
        v4u o; o.x = pk2(s[0 * 33], s[1 * 33]); o.y = pk2(s[2 * 33], s[3 * 33]); o.z = pk2(s[4 * 33], s[5 * 33]); o.w = pk2(s[6 * 33], s[7 * 33]);
        *(v4u*)(WT + (size_t)(drow0 + n) * K + k0 + 8 * c) = o; }
    WAVE_SYNC();
}
__device__ __forceinline__ void ph_prologue(const Args& A, LAS unsigned char* lds) {
    TIDS;
    LAS float* scr = (LAS float*)(lds + wave * 16384);
    constexpr int I_ADA = 16 * 192, I_IN1 = 16 * 64, I_IN2 = 16 * 24, I_GT = 16 * 128, I_GLU = 4 * 8, I_BR = 4 * 4 * 32, I_WO_ = 16 * 32, I_UP = 16 * 176, I_DN = 44 * 32;
    constexpr int PER_L = I_ADA + I_IN1 + I_IN2 + I_GT + I_GLU + I_BR + I_WO_ + I_UP + I_DN;
    for (int it = gw; it < DEPTH * PER_L; it += NGW) {
        const int l = it / PER_L; int r = it % PER_L; unsigned char* wl = A.ws + WS_W + (size_t)l * WL_SIZE;
        if (r < I_ADA) { const int kb = r / 192, nb = r % 192; tr_item(A.in[I_WADA] + (size_t)l * D * NMOD, NMOD, D, kb * 64, nb * 32, (bf16*)(wl + WL_ADA), nb * 32, scr, lane); continue; } r -= I_ADA;
        if (r < I_IN1) { const int kb = r / 64, nb = r % 64; tr_item(A.in[I_WIN] + (size_t)l * D * NIN, NIN, D, kb * 64, nb * 32, (bf16*)(wl + WL_W1), nb * 32, scr, lane); continue; } r -= I_IN1;
        if (r < I_IN2) { const int kb = r / 24, nb = r % 24; tr_item(A.in[I_WIN] + (size_t)l * D * NIN, NIN, D, kb * 64, 2056 + nb * 32, (bf16*)(wl + WL_W1), 2048 + nb * 32, scr, lane); continue; } r -= I_IN2;
        if (r < I_GT) { const int kb = r / 128, nb = r % 128; tr_item(A.in[I_WGATE] + (size_t)l * D * NGATE, NGATE, D, kb * 64, nb * 32, (bf16*)(wl + WL_W1), NPROJ + nb * 32, scr, lane); continue; } r -= I_GT;
        if (r < I_GLU) { const int kb = r / 8, nb = r % 8; tr_item(A.in[I_WGLU] + (size_t)l * 256 * 256, 256, 256, kb * 64, nb * 32, (bf16*)(wl + WL_GLU), nb * 32, scr, lane); continue; } r -= I_GLU;
        if (r < I_BR) { const int n = r / 128, r2 = r % 128, kb = r2 / 32, nb = r2 % 32; tr_item(A.in[I_WBR] + (size_t)(l * 4 + n) * 256 * D, D, 256, kb * 64, nb * 32, (bf16*)(wl + WL_BR), n * D + nb * 32, scr, lane); continue; } r -= I_BR;
        if (r < I_WO_) { const int kb = r / 32, nb = r % 32; tr_item(A.in[I_WO] + (size_t)l * D * D, D, D, kb * 64, nb * 32, (bf16*)(wl + WL_WO), nb * 32, scr, lane); continue; } r -= I_WO_;
        if (r < I_UP) { const int kb = r / 176, nb = r % 176; const int c0 = nb * 32, j = c0 < DFF ? c0 : c0 - DFF; const int drow = (j / 128) * 256 + (c0 < DFF ? 0 : 128) + (j % 128);
            tr_item(A.in[I_WUP] + (size_t)l * D * NUP, NUP, D, kb * 64, c0, (bf16*)(wl + WL_UP), drow, scr, lane); continue; } r -= I_UP;
        { const int kb = r / 32, nb = r % 32; tr_item(A.in[I_WDN] + (size_t)l * DFF * D, D, DFF, kb * 64, nb * 32, (bf16*)(wl + WL_DN), nb * 32, scr, lane); }
    }
    const int gt = bid * (NWAVES * 64) + tid, NGT = G * NWAVES * 64;
    for (int i = gt; i < DEPTH * 8 * D; i += NGT) { const int l = i / (8 * D), j = (i / D) % 8, k = i % D; ((float*)(A.ws + WS_W + (size_t)l * WL_SIZE + WL_LOG))[j * D + k] = A.in[I_WIN][((size_t)l * D + k) * NIN + 2048 + j]; }
    for (int i = gt; i < 256 * D; i += NGT) { const int r = i / D, k = i % D; float v = 0.f;
        if (r < NB) v = siluf_(A.in[I_CP][r * D + k]); else if (r < NSEQ) v = siluf_(A.in[I_CS][(r - NB) * D + k]);
        wsb(A, WS_CSILU)[i] = (bf16)f2bf(v); }
}
struct ModOrder {
    int G, c;
    __host__ __device__ bool next(int i, pg8::Unit& u) const { const int L = i * G + c; if (L >= 24 * DEPTH) return false; const int l = L / 24, pn = L % 24;
        u.pm = 0; u.pn = l * (int)(WL_SIZE / (512 * 1024)) + pn; u.ka = 0; u.aux = pn | (l << 8); return true; }
    __device__ __forceinline__ void a_ready(const pg8::Unit&) const {}
    __device__ __forceinline__ void done(const pg8::Unit&) const {}
};
struct EpiMod2 { static constexpr bool PERM = false; typedef pg8::NoState State; float* C; const float* bias;
    __device__ __forceinline__ void operator()(const f32x4 (&acc)[2][2][4][2], State& st, const pg8::Unit& u, int wr, int wc, int fr, int fq) const {
        const int l = u.aux >> 8; pg8::Unit u2 = u; u2.aux = u.aux & 255; pg8::EpiMod e{C + (size_t)l * 256 * NMOD, bias + (size_t)l * NMOD}; e(acc, st, u2, wr, wc, fr, fq); } };
template <int MODE> __device__ __forceinline__ void ph_rows(const Args& A, int l) {
    TIDS;
    const float* MOD = wsf(A, WS_MOD);
    for (int m = gw; m < M; m += NGW) {
        const float* src; float* dstx = nullptr;
        if (MODE == 0) src = m < MP ? A.in[I_XP] + (size_t)m * D : A.in[I_XS] + (size_t)(m - MP) * D;
        else if (MODE == 1) { src = wsf(A, WS_X1) + (size_t)m * D; dstx = wsf(A, WS_X1) + (size_t)m * D; }
        else { src = wsf(A, WS_X2) + (size_t)m * D; dstx = (l == DEPTH - 1) ? A.out + O_Y + (size_t)m * D : wsf(A, WS_X2) + (size_t)m * D; }
        f32x4 v[4];
#pragma unroll
        for (int j = 0; j < 4; ++j) v[j] = ((const f32x4*)src)[lane + 64 * j];
        if (MODE != 0) {
            float s = 0.f;
#pragma unroll
            for (int j = 0; j < 4; ++j) s += (v[j][0] + v[j][1]) + (v[j][2] + v[j][3]);
            const float mean = wave_sum(s) * (1.f / D); float s2 = 0.f;
#pragma unroll
            for (int j = 0; j < 4; ++j) { v[j] = v[j] - mean; s2 += (v[j][0] * v[j][0] + v[j][1] * v[j][1]) + (v[j][2] * v[j][2] + v[j][3] * v[j][3]); }
            const float rstd = 1.f / sqrtf(wave_sum(s2) * (1.f / D) + LN_EPS);
            const float* gp = A.in[MODE == 1 ? I_L1G : I_L2G] + (size_t)l * D; const float* bp = A.in[MODE == 1 ? I_L1B : I_L2B] + (size_t)l * D;
#pragma unroll
            for (int j = 0; j < 4; ++j) { const f32x4 g = ((const f32x4*)gp)[lane + 64 * j], b = ((const f32x4*)bp)[lane + 64 * j]; v[j] = v[j] * rstd * g + b; ((f32x4*)dstx)[lane + 64 * j] = v[j]; }
            if (MODE == 2 && l == DEPTH - 1) continue;
        }
        const int ln = (MODE == 2) ? l + 1 : l;
        const float* mr = MOD + ((size_t)ln * 256 + seq_of(m)) * NMOD + (MODE == 1 ? 3 * D : 0);
        float s = 0.f;
#pragma unroll
        for (int j = 0; j < 4; ++j) s += (v[j][0] + v[j][1]) + (v[j][2] + v[j][3]);
        const float mean = wave_sum(s) * (1.f / D); float s2 = 0.f;
#pragma unroll
        for (int j = 0; j < 4; ++j) { v[j] = v[j] - mean; s2 += (v[j][0] * v[j][0] + v[j][1] * v[j][1]) + (v[j][2] * v[j][2] + v[j][3] * v[j][3]); }
        const float rstd = 1.f / sqrtf(wave_sum(s2) * (1.f / D) + LN_EPS);
        v2u* hrow = (v2u*)(wsb(A, WS_H) + (size_t)m * D);
#pragma unroll
        for (int j = 0; j < 4; ++j) { const f32x4 sh = ((const f32x4*)mr)[lane + 64 * j], sc = ((const f32x4*)(mr + D))[lane + 64 * j]; v[j] = v[j] * rstd * (sc + 1.0f) + sh;
            v2u o; o.x = pk2(v[j][0], v[j][1]); o.y = pk2(v[j][2], v[j][3]); hrow[lane + 64 * j] = o; }
        if (MODE != 1) {
            const float* wl = (const float*)(A.ws + WS_W + (size_t)ln * WL_SIZE + WL_LOG);
            float lg[8];
#pragma unroll
            for (int jj = 0; jj < 8; ++jj) { float t = 0.f;
#pragma unroll
                for (int j = 0; j < 4; ++j) { const f32x4 w = ((const f32x4*)(wl + jj * D))[lane + 64 * j]; t += (v[j][0] * w[0] + v[j][1] * w[1]) + (v[j][2] * w[2] + v[j][3] * w[3]); }
                lg[jj] = wave_sum(t); }
            if (lane == 0) { float* o = wsf(A, WS_LOG8) + (size_t)m * 8; *(f32x4*)o = (f32x4){lg[0], lg[1], lg[2], lg[3]}; *(f32x4*)(o + 4) = (f32x4){lg[4], lg[5], lg[6], lg[7]}; }
        }
    }
}
struct SsmC { float abr, abi, bbr[16], bbi[16]; };
__device__ __forceinline__ void ssm_consts(const Args& A, int l, int g, int p, SsmC& c) {
    const int gi = l * 16 + g;
    const float dt = expf(A.in[I_LDT][gi]), ar = A.in[I_ARE][gi * 64 + p], ai = A.in[I_AIM][gi * 64 + p];
    const float mag = expf(dt * ar); c.abr = mag * cosf(dt * ai); c.abi = mag * sinf(dt * ai);
    const float den = ar * ar + ai * ai, fre = ((c.abr - 1.0f) * ar + c.abi * ai) / den, fim = (c.abi * ar - (c.abr - 1.0f) * ai) / den;
    const f32x4* br = (const f32x4*)(A.in[I_BRE] + (size_t)(gi * 64 + p) * 16); const f32x4* bi = (const f32x4*)(A.in[I_BIM] + (size_t)(gi * 64 + p) * 16);
#pragma unroll
    for (int q = 0; q < 4; ++q) { const f32x4 r = br[q], i = bi[q];
#pragma unroll
        for (int e = 0; e < 4; ++e) { c.bbr[4 * q + e] = fre * r[e] - fim * i[e]; c.bbi[4 * q + e] = fre * i[e] + fim * r[e]; } }
}
__device__ __forceinline__ void ssm_step(const SsmC& c, const bf16* urow, float& hr, float& hi) {
    const v4u u0 = *(const v4u*)urow, u1 = *(const v4u*)(urow + 8);
    float u[16] = {bflo(u0.x), bfhi(u0.x), bflo(u0.y), bfhi(u0.y), bflo(u0.z), bfhi(u0.z), bflo(u0.w), bfhi(u0.w), bflo(u1.x), bfhi(u1.x), bflo(u1.y), bfhi(u1.y), bflo(u1.z), bfhi(u1.z), bflo(u1.w), bfhi(u1.w)};
    float br = 0.f, bi = 0.f;
#pragma unroll
    for (int h = 0; h < 16; ++h) { br += c.bbr[h] * u[h]; bi += c.bbi[h] * u[h]; }
    const float nr = c.abr * hr - c.abi * hi + br, ni = c.abr * hi + c.abi * hr + bi; hr = nr; hi = ni;
}
constexpr int SSM_NCT = (NB * SSM_NCH + 15) / 16;
__device__ __forceinline__ void ph_ssm1(const Args& A, int l) {
    TIDS;
    const bf16* proj = wsb(A, WS_PROJ); const int gg = lane >> 4, i16 = lane & 15;
    for (int un = gw; un < 16 * 8 * SSM_NCT; un += NGW) {
        const int ctile = un % SSM_NCT, rt = (un / SSM_NCT) % 8, g = un / (SSM_NCT * 8);
        const int cidx = ctile * 16 + i16; const bool valid = cidx < NB * SSM_NCH; const int b = valid ? cidx / SSM_NCH : 0, c = valid ? cidx % SSM_NCH : 0;
        const bf16* up = proj + (size_t)(b * SEQ + c * SSM_CH + (gg >> 1)) * NPROJ + PC_U + g * 16 + 8 * (gg & 1);
        const bf16x8* wf = (const bf16x8*)(A.ws + WS_SSMW + (size_t)l * SSMW_L) + (size_t)((g * 8 + rt) * (SSM_CH / 2)) * 64 + lane;
        f32x4 acc = {0.f, 0.f, 0.f, 0.f};
#pragma unroll 8
        for (int ks = 0; ks < SSM_CH / 2; ++ks) { bf16x8 bv = *(const bf16x8*)(up + (size_t)(2 * ks) * NPROJ); if (!valid) bv = (bf16x8){0, 0, 0, 0, 0, 0, 0, 0};
            acc = __builtin_amdgcn_mfma_f32_16x16x32_bf16(wf[(size_t)ks * 64], bv, acc, 0, 0, 0); }
        if (valid) *(f32x4*)(wsf(A, WS_SEND) + ((size_t)(b * 16 + g) * SSM_NCH + c) * 128 + 16 * rt + 4 * gg) = acc;
    }
}
__device__ __forceinline__ void ph_ssm_weights(const Args& A) {
    TIDS;
    const int gt = bid * (NWAVES * 64) + tid, NGT = G * NWAVES * 64;
    for (int it = gt; it < DEPTH * 16 * 8 * (SSM_CH / 2) * 64; it += NGT) {
        const int ln = it & 63, ks = (it >> 6) % (SSM_CH / 2), rt = (it / (64 * (SSM_CH / 2))) % 8, g = (it / (64 * (SSM_CH / 2) * 8)) % 16, l = it / (64 * (SSM_CH / 2) * 8 * 16);
        const int gg = ln >> 4, rs = 16 * rt + (ln & 15), p = rs & 63, t = 2 * ks + (gg >> 1), h0 = 8 * (gg & 1), gi = l * 16 + g;
        const float dt = expf(A.in[I_LDT][gi]), ar = A.in[I_ARE][gi * 64 + p], ai = A.in[I_AIM][gi * 64 + p];
        const float mag = expf(dt * ar), abr = mag * cosf(dt * ai), abi = mag * sinf(dt * ai);
        const float den = ar * ar + ai * ai, fre = ((abr - 1.0f) * ar + abi * ai) / den, fim = (abi * ar - (abr - 1.0f) * ai) / den;
        const float n = (float)(SSM_CH - 1 - t), pm = expf(n * dt * ar), pr = pm * cosf(n * dt * ai), pi = pm * sinf(n * dt * ai);
        const float cr = pr * fre - pi * fim, ci = pr * fim + pi * fre;
        const float* br = A.in[I_BRE] + (size_t)(gi * 64 + p) * 16 + h0; const float* bi = A.in[I_BIM] + (size_t)(gi * 64 + p) * 16 + h0;
        float v[8];
#pragma unroll
        for (int j = 0; j < 8; ++j) v[j] = rs < 64 ? cr * br[j] - ci * bi[j] : cr * bi[j] + ci * br[j];
        v4u o; o.x = pk2(v[0], v[1]); o.y = pk2(v[2], v[3]); o.z = pk2(v[4], v[5]); o.w = pk2(v[6], v[7]);
        ((v4u*)(A.ws + WS_SSMW + (size_t)l * SSMW_L))[(size_t)((g * 8 + rt) * (SSM_CH / 2) + ks) * 64 + ln] = o;
    }
}
__device__ __forceinline__ void ph_ssm_carry(const Args& A, int l) {
    TIDS;
    const int gt = (G - 1 - bid) * (NWAVES * 64) + tid;
    if (gt < NB * 16 * 64) {
        const int p = gt & 63, g = (gt >> 6) & 15, b = gt >> 10; const int gi = l * 16 + g;
        const float dt = expf(A.in[I_LDT][gi]), ar = A.in[I_ARE][gi * 64 + p], ai = A.in[I_AIM][gi * 64 + p];
        const float mag = expf(dt * ar); float pr = mag * cosf(dt * ai), pi = mag * sinf(dt * ai);
        for (int s = 1; s < SSM_CH; s <<= 1) { const float nr = pr * pr - pi * pi, ni = 2.f * pr * pi; pr = nr; pi = ni; }
        float cr = 0.f, ci = 0.f;
        for (int c = 0; c < SSM_NCH; ++c) { const size_t un = ((size_t)(b * 16 + g) * SSM_NCH + c) * 128;
            wsf(A, WS_HIN)[un + p] = cr; wsf(A, WS_HIN)[un + 64 + p] = ci;
            const float sr = wsf(A, WS_SEND)[un + p], si = wsf(A, WS_SEND)[un + 64 + p];
            const float nr = pr * cr - pi * ci + sr, ni = pr * ci + pi * cr + si; cr = nr; ci = ni; }
    }
}
__device__ __forceinline__ float gelu_tanh(float x) { const float e = __expf(2.0f * 0.7978845608028654f * (x + 0.044715f * x * x * x)); return 0.5f * x * (2.0f - 2.0f / (1.0f + e)); }
__device__ __forceinline__ void ph_ssm2(const Args& A, LAS unsigned char* lds, int l) {
    TIDS;
    LAS float* uf = (LAS float*)(lds + wave * 16384);
    LAS bf16* ht = (LAS bf16*)(uf + 256);
    const bf16* proj = wsb(A, WS_PROJ);
    const int gg = lane >> 4, i16 = lane & 15;
    constexpr int NPU = NB * 16 * SSM_NCH, NSU = DB * 16;
    for (int un = gw; un < NPU + NSU; un += NGW) {
        int g, m0, ntok; float hr, hi; float* fre = nullptr; float* fim = nullptr;
        if (un < NPU) { const int c = un % SSM_NCH; g = (un / SSM_NCH) % 16; const int b = un / (SSM_NCH * 16); m0 = b * SEQ + c * SSM_CH; ntok = SSM_CH;
            hr = wsf(A, WS_HIN)[(size_t)un * 128 + lane]; hi = wsf(A, WS_HIN)[(size_t)un * 128 + 64 + lane];
            if (c == SSM_NCH - 1) { fre = A.out + O_REP + ((size_t)(l * NB + b) * 16 + g) * 64; fim = A.out + O_IMP + ((size_t)(l * NB + b) * 16 + g) * 64; } }
        else { const int su = un - NPU; g = su & 15; const int s = su >> 4; m0 = MP + s * DEC_SEQ; ntok = DEC_SEQ;
            hr = A.in[I_SRE][((size_t)(l * DB + s) * 16 + g) * 64 + lane]; hi = A.in[I_SIM][((size_t)(l * DB + s) * 16 + g) * 64 + lane];
            fre = A.out + O_RES + ((size_t)(l * DB + s) * 16 + g) * 64; fim = A.out + O_IMS + ((size_t)(l * DB + s) * 16 + g) * 64; }
        SsmC k; ssm_consts(A, l, g, lane, k);
        const int gi = l * 16 + g;
        bf16x8 Cb[4];
#pragma unroll
        for (int ks = 0; ks < 4; ++ks) { const float* cp = A.in[ks < 2 ? I_CRE : I_CIM] + ((size_t)gi * 16 + i16) * 64 + 32 * (ks & 1) + 8 * gg; const float sg = ks < 2 ? 1.0f : -1.0f;
            const f32x4 c0 = *(const f32x4*)cp * sg, c1 = *(const f32x4*)(cp + 4) * sg; Cb[ks] = acc2b(c0, c1); }
        const float dd = A.in[I_SSD][l * 256 + g * 16 + i16];
        for (int t0 = 0; t0 < ntok; t0 += 16) {
            const int nt = (ntok - t0) < 16 ? (ntok - t0) : 16;
            { const int tt = lane >> 2, c4 = (lane & 3) * 4;
              if (tt < nt) { const v2u w = *(const v2u*)(proj + (size_t)(m0 + t0 + tt) * NPROJ + PC_U + g * 16 + c4); *(LAS f32x4*)(uf + tt * 16 + c4) = (f32x4){bflo(w.x), bfhi(w.x), bflo(w.y), bfhi(w.y)}; } }
            WAVE_SYNC();
            for (int t = 0; t < nt; ++t) {
                float br = 0.f, bi = 0.f;
#pragma unroll
                for (int q = 0; q < 4; ++q) { const f32x4 u = *(const LAS f32x4*)(uf + t * 16 + 4 * q);
#pragma unroll
                    for (int e = 0; e < 4; ++e) { br += k.bbr[4 * q + e] * u[e]; bi += k.bbi[4 * q + e] * u[e]; } }
                const float nr = k.abr * hr - k.abi * hi + br, ni = k.abr * hi + k.abi * hr + bi; hr = nr; hi = ni;
                ht[t * 136 + lane] = (bf16)f2bf(hr); ht[t * 136 + 64 + lane] = (bf16)f2bf(hi);
            }
            WAVE_SYNC();
            f32x4 acc = {0.f, 0.f, 0.f, 0.f};
#pragma unroll
            for (int ks = 0; ks < 4; ++ks) acc = __builtin_amdgcn_mfma_f32_16x16x32_bf16(*(const LAS bf16x8*)(ht + i16 * 136 + 32 * ks + 8 * gg), Cb[ks], acc, 0, 0, 0);
#pragma unroll
            for (int r = 0; r < 4; ++r) { const int tt = 4 * gg + r;
                if (tt < nt) { const float y = acc[r] + dd * uf[tt * 16 + i16]; wsb(A, WS_YS)[(size_t)(m0 + t0 + tt) * 256 + g * 16 + i16] = (bf16)f2bf(gelu_tanh(y)); } }
            WAVE_SYNC();
        }
        if (fre) { fre[lane] = hr; fim[lane] = hi; }
    }
}
__device__ __forceinline__ void ph_conv(const Args& A, int l) {
    TIDS;
    const int gt = bid * (NWAVES * 64) + tid, NGT = G * NWAVES * 64;
    const bf16* proj = wsb(A, WS_PROJ);
    for (int i = gt; i < M * 128; i += NGT) {
        const int m = i >> 7, c = (i & 127) * 2;
        int t, L; const float* hist = nullptr; float* so;
        if (m < MP) { t = m % SEQ; L = SEQ; so = A.out + O_CBP + (size_t)(l * NB + m / SEQ) * 512; }
        else { const int s = (m - MP) / DEC_SEQ; t = (m - MP) % DEC_SEQ; L = DEC_SEQ; hist = A.in[I_SCB] + (size_t)(l * DB + s) * 512; so = A.out + O_CBS + (size_t)(l * DB + s) * 512; }
        float cx0[3], cx1[3];
#pragma unroll
        for (int j = 0; j < 3; ++j) { const int tt = t - 2 + j;
            if (tt >= 0) { const bf16* r = proj + (size_t)(m - 2 + j) * NPROJ; const unsigned cg = *(const unsigned*)(r + PC_CG + c), xc = *(const unsigned*)(r + PC_XC + c); cx0[j] = bflo(cg) * bflo(xc); cx1[j] = bfhi(cg) * bfhi(xc); }
            else if (hist) { cx0[j] = hist[(2 + tt) * 256 + c]; cx1[j] = hist[(2 + tt) * 256 + c + 1]; }
            else { cx0[j] = 0.f; cx1[j] = 0.f; } }
        const float* w = A.in[I_CBW] + (size_t)l * 3 * 256;
        const float o0 = w[c] * cx0[0] + w[256 + c] * cx0[1] + w[512 + c] * cx0[2], o1 = w[c + 1] * cx1[0] + w[256 + c + 1] * cx1[1] + w[512 + c + 1] * cx1[2];
        const unsigned bg = *(const unsigned*)(proj + (size_t)m * NPROJ + PC_BG + c);
        *(unsigned*)(wsb(A, WS_Y) + (size_t)m * D + 256 + c) = pk2(bflo(bg) * o0, bfhi(bg) * o1);
        if (t >= L - 2) { so[(t - (L - 2)) * 256 + c] = cx0[2]; so[(t - (L - 2)) * 256 + c + 1] = cx1[2]; }
    }
}
__device__ __forceinline__ void ph_gdn_c1(const Args& A, LAS unsigned char* lds, int l) {
    TIDS;
    constexpr int XS = 72, GS = 68, RS = 132;
    LAS bf16* Qs = (LAS bf16*)lds; LAS bf16* Ks = Qs + 64 * XS; LAS bf16* Vs = Ks + 64 * XS;
    LAS float* GKK = (LAS float*)(lds + 27648); LAS float* GQK = GKK + 64 * GS; LAS float* rhs = GQK + 64 * GS;
    LAS float* Linv = rhs + 64 * RS; LAS float* sc = Linv + 1024;
    LAS float* DQ = sc, *DK = sc + 64, *RQ = sc + 128, *RK = sc + 192, *BET = sc + 256, *GC = sc + 320, *EGC = sc + 384, *EK = sc + 448;
    LAS float* Wst = GQK;
    const bf16* proj = wsb(A, WS_PROJ); const float* cw = A.in[I_DCW] + (size_t)l * 4 * GQKV; const float* lg8 = wsf(A, WS_LOG8);
    const int g = lane >> 4, i16 = lane & 15;
    for (int un = bid; un < NB * GH * GNCH; un += G) {
        const int c = un % GNCH, h = (un / GNCH) % GH, b = un / (GNCH * GH); const int m0 = b * SEQ + c * GCH;
        unsigned char* gd = A.ws + WS_GD + (size_t)un * GD_UNIT;
        if (wave < 6) { const int sec = wave >> 1, th = wave & 1, src = sec * 256 + h * 64 + lane, t0 = c * GCH + th * 32;
            const float w0 = cw[src], w1 = cw[GQKV + src], w2 = cw[2 * GQKV + src], w3 = cw[3 * GQKV + src];
            float x[35];
#pragma unroll
            for (int k = 0; k < 35; ++k) { const int tt = t0 - 3 + k; x[k] = tt >= 0 ? bf2f(proj[(size_t)(b * SEQ + tt) * NPROJ + PC_QKV + src]) : 0.f; }
            LAS bf16* X = sec == 0 ? Qs : (sec == 1 ? Ks : Vs);
#pragma unroll
            for (int k = 0; k < 32; ++k) X[(th * 32 + k) * XS + lane] = (bf16)f2bf(siluf_(w0 * x[k] + w1 * x[k + 1] + w2 * x[k + 2] + w3 * x[k + 3]));
            if (c == GNCH - 1 && th == 1) {
#pragma unroll
                for (int k = 0; k < 3; ++k) A.out[O_CDP + ((size_t)(l * NB + b) * 3 + k) * GQKV + src] = x[32 + k]; } }
        __syncthreads();
#pragma unroll
        for (int q2 = 0; q2 < 2; ++q2) { const int tt = 2 * wave + q2, rt = tt >> 2, ct = tt & 3;
            f32x4 akk = {0.f, 0.f, 0.f, 0.f}, aqk = {0.f, 0.f, 0.f, 0.f};
#pragma unroll
            for (int s = 0; s < 2; ++s) { const bf16x8 kc = *(const LAS bf16x8*)(Ks + (16 * ct + i16) * XS + 32 * s + 8 * g), kr = *(const LAS bf16x8*)(Ks + (16 * rt + i16) * XS + 32 * s + 8 * g),
                                                         qr = *(const LAS bf16x8*)(Qs + (16 * rt + i16) * XS + 32 * s + 8 * g);
                akk = __builtin_amdgcn_mfma_f32_16x16x32_bf16(kr, kc, akk, 0, 0, 0); aqk = __builtin_amdgcn_mfma_f32_16x16x32_bf16(qr, kc, aqk, 0, 0, 0); }
#pragma unroll
            for (int r = 0; r < 4; ++r) { GKK[(16 * rt + 4 * g + r) * GS + 16 * ct + i16] = akk[r]; GQK[(16 * rt + 4 * g + r) * GS + 16 * ct + i16] = aqk[r]; }
            if (rt == ct && g == (i16 >> 2)) { const int r = i16 & 3; DK[16 * rt + i16] = r == 0 ? akk[0] : r == 1 ? akk[1] : r == 2 ? akk[2] : akk[3]; } }
        if (wave < 4) { f32x4 aqq = {0.f, 0.f, 0.f, 0.f};
#pragma unroll
            for (int s = 0; s < 2; ++s) { const bf16x8 qr = *(const LAS bf16x8*)(Qs + (16 * wave + i16) * XS + 32 * s + 8 * g); aqq = __builtin_amdgcn_mfma_f32_16x16x32_bf16(qr, qr, aqq, 0, 0, 0); }
            if (g == (i16 >> 2)) { const int r = i16 & 3; DQ[16 * wave + i16] = r == 0 ? aqq[0] : r == 1 ? aqq[1] : r == 2 ? aqq[2] : aqq[3]; } }
        __syncthreads();
        if (wave == 0) { const float* lr = lg8 + (size_t)(m0 + lane) * 8;
            const float gv = -expf(A.in[I_DAL][l * 4 + h]) * softplusf_(lr[4 + h] + A.in[I_DDT][l * 4 + h]);
            float gc = gv;
#pragma unroll
            for (int o = 1; o < 64; o <<= 1) { const float t = __shfl_up(gc, o); if (lane >= o) gc += t; }
            const float gl = __shfl(gc, 63);
            RK[lane] = 1.0f / sqrtf(DK[lane] + RMS_EPS); RQ[lane] = 0.125f / sqrtf(DQ[lane] + RMS_EPS); BET[lane] = sigmoidf_(lr[h]); GC[lane] = gc; EGC[lane] = expf(gc); EK[lane] = expf(gl - gc);
            if (lane == 0) wsf(A, WS_EGL)[un] = expf(gl); }
        __syncthreads();
        for (int idx = tid; idx < 4096; idx += 512) { const int i = idx >> 6, j = idx & 63; GKK[i * GS + j] = i > j ? BET[i] * RK[i] * RK[j] * GKK[i * GS + j] * expf(GC[i] - GC[j]) : 0.f; }
        for (int idx = tid; idx < 64 * 128; idx += 512) { const int i = idx >> 7, cc = idx & 127; rhs[i * RS + cc] = cc < 64 ? BET[i] * bf2f(Vs[i * XS + cc]) : BET[i] * EGC[i] * RK[i] * bf2f(Ks[i * XS + cc - 64]); }
        for (int idx = tid; idx < 4096; idx += 512) { const int f = idx >> 9, ln = (idx >> 3) & 63, j = idx & 7, row = 16 * (f >> 1) + (ln & 15), kx = 32 * (f & 1) + 16 * (j >> 2) + 4 * (ln >> 4) + (j & 3);
            ((bf16*)gd)[8192 + idx] = (bf16)f2bf(row >= kx ? RQ[row] * RK[kx] * GQK[row * GS + kx] * expf(GC[row] - GC[kx]) : 0.f);
            ((bf16*)gd)[4096 + idx] = (bf16)f2bf(bf2f(Qs[row * XS + kx]) * RQ[row] * EGC[row]);
            ((bf16*)gd)[12288 + idx] = (bf16)f2bf(bf2f(Ks[kx * XS + row]) * RK[kx] * EK[kx]); }
        __syncthreads();
        if (wave == 0) { const int blk = lane >> 4, cI = lane & 15; float x[16];
            x[0] = cI == 0 ? 1.f : 0.f;
#pragma unroll
            for (int i = 1; i < 16; ++i) { float sacc = cI == i ? 1.f : 0.f;
#pragma unroll
                for (int j = 0; j < i; ++j) sacc -= GKK[(16 * blk + i) * GS + 16 * blk + j] * x[j];
                x[i] = sacc; }
#pragma unroll
            for (int i = 0; i < 16; ++i) Linv[blk * 256 + i * 16 + cI] = x[i]; }
        __syncthreads();
        { const f32x4 Z = {0.f, 0.f, 0.f, 0.f}; f32x4 X[4];
#define C1_LD4(p) ((f32x4)(*(const LAS f32x4*)(p)) * 1.0f)
#define C1_LF(I) acc2b(C1_LD4(Linv + (I) * 256 + i16 * 16 + 4 * g), Z)
#define C1_MF2(I, J) acc2b(-*(const LAS f32x4*)(GKK + (16 * (I) + i16) * GS + 16 * (J) + 4 * g), -*(const LAS f32x4*)(GKK + (16 * (I) + i16) * GS + 16 * ((J) + 1) + 4 * g))
#define C1_MF1(I, J) acc2b(-*(const LAS f32x4*)(GKK + (16 * (I) + i16) * GS + 16 * (J) + 4 * g), Z)
#define C1_R(I) (f32x4){rhs[(16 * (I) + 4 * g) * RS + 16 * wave + i16], rhs[(16 * (I) + 4 * g + 1) * RS + 16 * wave + i16], rhs[(16 * (I) + 4 * g + 2) * RS + 16 * wave + i16], rhs[(16 * (I) + 4 * g + 3) * RS + 16 * wave + i16]}
            f32x4 R = C1_R(0);
            X[0] = __builtin_amdgcn_mfma_f32_16x16x32_bf16(C1_LF(0), acc2b(R, Z), Z, 0, 0, 0);
            R = C1_R(1); R = __builtin_amdgcn_mfma_f32_16x16x32_bf16(C1_MF1(1, 0), acc2b(X[0], Z), R, 0, 0, 0);
            X[1] = __builtin_amdgcn_mfma_f32_16x16x32_bf16(C1_LF(1), acc2b(R, Z), Z, 0, 0, 0);
            const bf16x8 X01 = acc2b(X[0], X[1]);
            R = C1_R(2); R = __builtin_amdgcn_mfma_f32_16x16x32_bf16(C1_MF2(2, 0), X01, R, 0, 0, 0);
            X[2] = __builtin_amdgcn_mfma_f32_16x16x32_bf16(C1_LF(2), acc2b(R, Z), Z, 0, 0, 0);
            R = C1_R(3); R = __builtin_amdgcn_mfma_f32_16x16x32_bf16(C1_MF2(3, 0), X01, R, 0, 0, 0); R = __builtin_amdgcn_mfma_f32_16x16x32_bf16(C1_MF1(3, 2), acc2b(X[2], Z), R, 0, 0, 0);
            X[3] = __builtin_amdgcn_mfma_f32_16x16x32_bf16(C1_LF(3), acc2b(R, Z), Z, 0, 0, 0);
#undef C1_LF
#undef C1_LD4
#undef C1_MF2
#undef C1_MF1
#undef C1_R
            if (wave < 4) {
#pragma unroll
                for (int I = 0; I < 4; ++I) ((f32x4*)(gd + 32768))[(wave * 4 + I) * 64 + lane] = X[I]; }
            else {
#pragma unroll
                for (int I = 0; I < 4; ++I)
#pragma unroll
                    for (int r = 0; r < 4; ++r) Wst[(16 * I + 4 * g + r) * GS + 16 * (wave - 4) + i16] = -X[I][r]; } }
        __syncthreads();
        for (int idx = tid; idx < 4096; idx += 512) { const int f = idx >> 9, ln = (idx >> 3) & 63, j = idx & 7, row = 16 * (f >> 1) + (ln & 15), kx = 32 * (f & 1) + 16 * (j >> 2) + 4 * (ln >> 4) + (j & 3);
            ((bf16*)gd)[idx] = (bf16)f2bf(Wst[row * GS + kx]); }
        __syncthreads();
    }
}
__device__ __forceinline__ void ph_gdn_scan(const Args& A, LAS unsigned char* lds, int l) {
    TIDS;
    for (int grp = bid; grp < NB * GH; grp += G) {
        const int h = grp % GH, b = grp / GH;
        const unsigned char* gbase = A.ws + WS_GD + (size_t)(b * GH + h) * GNCH * GD_UNIT;
        if (wave >= 4) {
            const int lw = wave - 4; v4u ra[12], rb[12];
            const v4u* src = (const v4u*)gbase + lw * 12 * 64 + lane;
            LAS v4u* dst0 = (LAS v4u*)lds + lw * 12 * 64 + lane;
#define SC_LOAD(R, c) do { if ((c) < GNCH) { _Pragma("unroll") for (int k = 0; k < 12; ++k) R[k] = src[(size_t)(c) * (GD_UNIT / 16) + k * 64]; } } while (0)
#define SC_STORE(R, c) do { if ((c) < GNCH) { LAS v4u* d_ = dst0 + ((c) & 1) * (GD_UNIT / 16); _Pragma("unroll") for (int k = 0; k < 12; ++k) d_[k * 64] = R[k]; } } while (0)
            SC_LOAD(ra, 0); SC_STORE(ra, 0); SC_LOAD(ra, 1); SC_LOAD(rb, 2);
            RAW_BAR();
            for (int c = 0; c < GNCH; c += 2) {
                SC_STORE(ra, c + 1); SC_LOAD(ra, c + 3);
                RAW_BAR();
                if (c + 1 < GNCH) { SC_STORE(rb, c + 2); SC_LOAD(rb, c + 4); RAW_BAR(); }
            }
#undef SC_LOAD
#undef SC_STORE
        } else {
            const int vs = wave, g = lane >> 4, cc = lane & 15;
            f32x4 S[4];
#pragma unroll
            for (int T = 0; T < 4; ++T) S[T] = (f32x4){0.f, 0.f, 0.f, 0.f};
            const float* eglp = wsf(A, WS_EGL) + (size_t)(b * GH + h) * GNCH;
            float egl_n = eglp[0];
            RAW_BAR();
            for (int c = 0; c < GNCH; ++c) {
                const float egl = egl_n; if (c + 1 < GNCH) egl_n = eglp[c + 1];
                const LAS unsigned char* slot = lds + (c & 1) * GD_UNIT;
                const LAS bf16x8* fr = (const LAS bf16x8*)slot + lane;
                const LAS f32x4* uvp = (const LAS f32x4*)(slot + 32768) + (vs * 4) * 64 + lane;
                bf16x8 Sb[2] = {acc2b(S[0], S[1]), acc2b(S[2], S[3])};
                f32x4 u[4], o[4];
#pragma unroll
                for (int T = 0; T < 4; ++T) { u[T] = uvp[T * 64]; o[T] = (f32x4){0.f, 0.f, 0.f, 0.f};
#pragma unroll
                    for (int s = 0; s < 2; ++s) { u[T] = __builtin_amdgcn_mfma_f32_16x16x32_bf16(fr[(0 * 8 + 2 * T + s) * 64], Sb[s], u[T], 0, 0, 0); o[T] = __builtin_amdgcn_mfma_f32_16x16x32_bf16(fr[(1 * 8 + 2 * T + s) * 64], Sb[s], o[T], 0, 0, 0); } }
                bf16x8 ub[2] = {acc2b(u[0], u[1]), acc2b(u[2], u[3])};
#pragma unroll
                for (int T = 0; T < 4; ++T) { S[T] = S[T] * egl;
#pragma unroll
                    for (int s = 0; s < 2; ++s) { S[T] = __builtin_amdgcn_mfma_f32_16x16x32_bf16(fr[(3 * 8 + 2 * T + s) * 64], ub[s], S[T], 0, 0, 0); o[T] = __builtin_amdgcn_mfma_f32_16x16x32_bf16(fr[(2 * 8 + 2 * T + s) * 64], ub[s], o[T], 0, 0, 0); } }
                float* od = wsf(A, WS_ODRAW) + (size_t)(b * SEQ + c * GCH + 4 * g) * 256 + h * 64 + vs * 16 + cc;
#pragma unroll
                for (int T = 0; T < 4; ++T)
#pragma unroll
                    for (int r = 0; r < 4; ++r) od[(size_t)(16 * T + r) * 256] = o[T][r];
                RAW_BAR();
            }
            float* so = A.out + O_DP + (((size_t)(l * NB + b) * GH + h) * 64 + 4 * g) * 64 + vs * 16 + cc;
#pragma unroll
            for (int T = 0; T < 4; ++T)
#pragma unroll
                for (int r = 0; r < 4; ++r) so[(16 * T + r) * 64] = S[T][r];
        }
        __syncthreads();
    }
}
__device__ __forceinline__ void ph_gdn_sample(const Args& A, LAS unsigned char* lds, int l) {
    TIDS;
    LAS float* S = (LAS float*)(lds + wave * 16384);
    LAS float* kq = (LAS float*)(lds + MISC_OFF + 1024 + wave * 512);
    const bf16* proj = wsb(A, WS_PROJ); const float* cw = A.in[I_DCW] + (size_t)l * 4 * GQKV; const float* lg8 = wsf(A, WS_LOG8);
    if (wave < 4 || wave >= 6) return;
    for (int un = (wave - 4) * G + bid; un < DB * GH; un += 2 * G) {
        const int h = un % GH, s = un / GH;
        const float* s0 = A.in[I_SD] + ((size_t)(l * DB + s) * GH + h) * 4096;
#pragma unroll 8
        for (int kk = 0; kk < 64; ++kk) S[kk * 64 + lane] = s0[kk * 64 + lane];
        const float* hist = A.in[I_SCD] + (size_t)(l * DB + s) * 3 * GQKV;
        for (int t = 0; t < DEC_SEQ; ++t) {
            const size_t m = (size_t)MP + s * DEC_SEQ + t;
            float val[3];
#pragma unroll
            for (int sec = 0; sec < 3; ++sec) { const int src = sec * 256 + h * 64 + lane; float acc = 0.f, cur = 0.f;
#pragma unroll
                for (int j = 0; j < 4; ++j) { const int tt = t - 3 + j; const float x = tt >= 0 ? bf2f(proj[(size_t)(MP + s * DEC_SEQ + tt) * NPROJ + PC_QKV + src]) : hist[(3 + tt) * GQKV + src]; acc += cw[j * GQKV + src] * x; cur = x; }
                val[sec] = siluf_(acc);
                if (t >= 1) A.out[O_CDS + ((size_t)(l * DB + s) * 3 + (t - 1)) * GQKV + src] = cur; }
            const float sq = wave_sum(val[0] * val[0]), sk = wave_sum(val[1] * val[1]);
            const float qv = val[0] * (1.0f / sqrtf(sq + RMS_EPS)) * 0.125f, kv = val[1] * (1.0f / sqrtf(sk + RMS_EPS)), vv = val[2];
            const float* lr = lg8 + m * 8; const float beta = sigmoidf_(lr[h]); const float a = expf(-expf(A.in[I_DAL][l * 4 + h]) * softplusf_(lr[4 + h] + A.in[I_DDT][l * 4 + h]));
            kq[lane] = kv; kq[64 + lane] = qv;
            WAVE_SYNC();
            float kS = 0.f;
#pragma unroll 8
            for (int kk = 0; kk < 64; ++kk) kS += kq[kk] * S[kk * 64 + lane];
            float o = 0.f;
#pragma unroll 8
            for (int kk = 0; kk < 64; ++kk) { const float bk = beta * kq[kk]; const float sn = a * (S[kk * 64 + lane] - bk * kS) + bk * vv; S[kk * 64 + lane] = sn; o += kq[64 + kk] * sn; }
            wsf(A, WS_ODRAW)[m * 256 + h * 64 + lane] = o;
            WAVE_SYNC();
        }
        float* so = A.out + O_DS + ((size_t)(l * DB + s) * GH + h) * 4096;
#pragma unroll 8
        for (int kk = 0; kk < 64; ++kk) so[kk * 64 + lane] = S[kk * 64 + lane];
    }
}
__device__ __forceinline__ void ph_gdn_out(const Args& A, int l) {
    TIDS;
    for (int idx = gw; idx < M * GH; idx += NGW) { const size_t m = idx >> 2; const int h = idx & 3;
        const float o = wsf(A, WS_ODRAW)[m * 256 + h * 64 + lane];
        const float ms = wave_sum(o * o) * (1.0f / 64.0f);
        const float z = bf2f(wsb(A, WS_PROJ)[m * NPROJ + PC_Z + h * 64 + lane]);
        wsb(A, WS_Y)[m * D + 512 + h * 64 + lane] = (bf16)f2bf(o * (1.0f / sqrtf(ms + RMS_EPS)) * A.in[I_DNW][l * 64 + lane] * siluf_(z)); }
}
__device__ __forceinline__ void sb_terms(float z, float& ls, float& ln) { const float L = log1pf(__expf(-fabsf(z))); ls = fminf(z, 0.f) - L; ln = -fmaxf(z, 0.f) - L; }
constexpr float SB_CUT = -105.0f;
__device__ __forceinline__ void ph_sb_prompt(const Args& A, int l) {
    TIDS; (void)l;
    const bf16* proj = wsb(A, WS_PROJ); const bf16* vtg = wsb(A, WS_VT);
    constexpr int NQB = SEQ / 32;
    const int g = lane >> 4, i16 = lane & 15;
    for (int un0 = gw; un0 < NB * SBH * NQB; un0 += NGW) {
        const int un = NB * SBH * NQB - 1 - un0;
        const int qb = un / (NB * SBH), h = un % SBH, b = (un / SBH) % NB;
        const int q0 = qb * 32;
        bf16x8 Qb[2][2];
#pragma unroll
        for (int ct = 0; ct < 2; ++ct)
#pragma unroll
            for (int s = 0; s < 2; ++s) Qb[ct][s] = *(const bf16x8*)(proj + ((size_t)b * SEQ + q0 + 16 * ct + i16) * NPROJ + PC_Q + h * 64 + 32 * s + 8 * g);
        f32x4 O[4][2];
#pragma unroll
        for (int rt = 0; rt < 4; ++rt) { O[rt][0] = (f32x4){0.f, 0.f, 0.f, 0.f}; O[rt][1] = (f32x4){0.f, 0.f, 0.f, 0.f}; }
        float R[2] = {0.f, 0.f};
        const bf16* vth = vtg + ((size_t)(b * SBH + h) * 64) * SEQ;
        for (int kb = q0 >> 6; kb >= 0; --kb) {
            const int k0 = kb * 64;
            bf16x8 Ka[4][2], Va[4][2];
#pragma unroll
            for (int T = 0; T < 4; ++T)
#pragma unroll
                for (int s = 0; s < 2; ++s) { Ka[T][s] = *(const bf16x8*)(proj + ((size_t)b * SEQ + k0 + 16 * (i16 >> 2) + 4 * T + (i16 & 3)) * NPROJ + PC_K + h * 64 + 32 * s + 8 * g);
                                              Va[T][s] = *(const bf16x8*)(vth + (size_t)(16 * T + i16) * SEQ + k0 + 16 * g + 8 * s); }
            const bool diag = (k0 + 63 >= q0);
#pragma unroll
            for (int ct = 0; ct < 2; ++ct) {
                f32x4 z[4];
#pragma unroll
                for (int T = 0; T < 4; ++T) { z[T] = (f32x4){0.f, 0.f, 0.f, 0.f};
#pragma unroll
                    for (int s = 0; s < 2; ++s) z[T] = __builtin_amdgcn_mfma_f32_16x16x32_bf16(Ka[T][s], Qb[ct][s], z[T], 0, 0, 0); }
                const int qi = q0 + 16 * ct + i16;
                float run = 0.f; f32x4 lsv[4], sfx[4];
#pragma unroll
                for (int T = 3; T >= 0; --T)
#pragma unroll
                    for (int r = 3; r >= 0; --r) { const float zz = z[T][r] * 0.125f; const float L = __logf(1.0f + __expf(-fabsf(zz))); const float ls = fminf(zz, 0.f) - L;
                        const bool valid = !diag || (k0 + 16 * g + 4 * T + r) < qi;
                        lsv[T][r] = valid ? ls : -1e30f; sfx[T][r] = run; run += valid ? (ls - zz) : 0.f; }
                const float p1 = __shfl_down(run, 16), p2 = __shfl_down(run, 32), p3 = __shfl_down(run, 48);
                const float gs = (g < 3 ? p1 : 0.f) + (g < 2 ? p2 : 0.f) + (g < 1 ? p3 : 0.f);
                float tot = run + __shfl_xor(run, 16); tot += __shfl_xor(tot, 32);
                const float base = R[ct] + gs;
#pragma unroll
                for (int T = 0; T < 4; ++T)
#pragma unroll
                    for (int r = 0; r < 4; ++r) z[T][r] = __expf(lsv[T][r] + base + sfx[T][r]);
                R[ct] += tot;
                const bf16x8 Wb0 = acc2b(z[0], z[1]), Wb1 = acc2b(z[2], z[3]);
#pragma unroll
                for (int rt = 0; rt < 4; ++rt) { O[rt][ct] = __builtin_amdgcn_mfma_f32_16x16x32_bf16(Va[rt][0], Wb0, O[rt][ct], 0, 0, 0); O[rt][ct] = __builtin_amdgcn_mfma_f32_16x16x32_bf16(Va[rt][1], Wb1, O[rt][ct], 0, 0, 0); }
            }
            if (!diag && __all(R[0] < SB_CUT && R[1] < SB_CUT)) break;
        }
#pragma unroll
        for (int ct = 0; ct < 2; ++ct)
#pragma unroll
            for (int rt = 0; rt < 4; ++rt) { v2u o; o.x = pk2(O[rt][ct][0], O[rt][ct][1]); o.y = pk2(O[rt][ct][2], O[rt][ct][3]);
                *(v2u*)(wsb(A, WS_Y) + ((size_t)b * SEQ + q0 + 16 * ct + i16) * D + 768 + h * 64 + 16 * rt + 4 * g) = o; }
    }
}
__device__ __forceinline__ void ph_sb_sample(const Args& A, LAS unsigned char* lds, int l) {
    TIDS;
    if (wave >= 2) return;
    LAS float* vt = (LAS float*)(lds + wave * 32768);
    LAS float* qs = vt + 64 * 68;
    LAS float* wq = qs + 256;
    const bf16* proj = wsb(A, WS_PROJ); const int* pt = (const int*)A.in[I_PT];
    for (int un = wave * G + bid; un < DB * SBH; un += 2 * G) {
        const int h = un % SBH, s = un / SBH;
#pragma unroll
        for (int qi = 0; qi < 4; ++qi) qs[qi * 64 + lane] = bf2f(proj[((size_t)MP + s * DEC_SEQ + qi) * NPROJ + PC_Q + h * 64 + lane]) * 0.125f;
        WAVE_SYNC();
        float R[4] = {0.f, 0.f, 0.f, 0.f}; f32x4 acc = {0.f, 0.f, 0.f, 0.f};
        const int qi_b = lane & 3, ds = lane >> 2;
        for (int tile = 0; tile * 64 < PAST + DEC_SEQ; ++tile) {
            const int p = PAST + DEC_SEQ - 1 - (tile * 64 + lane);
            f32x4 kr[16], vr[16];
            if (p >= PAST) { const bf16* rp = proj + ((size_t)MP + s * DEC_SEQ + (p - PAST)) * NPROJ + h * 64;
#pragma unroll
                for (int x = 0; x < 8; ++x) { const v4u kw = ((const v4u*)(rp + PC_K))[x], vw = ((const v4u*)(rp + PC_V))[x];
                    kr[2 * x] = (f32x4){bflo(kw.x), bfhi(kw.x), bflo(kw.y), bfhi(kw.y)}; kr[2 * x + 1] = (f32x4){bflo(kw.z), bfhi(kw.z), bflo(kw.w), bfhi(kw.w)};
                    vr[2 * x] = (f32x4){bflo(vw.x), bfhi(vw.x), bflo(vw.y), bfhi(vw.y)}; vr[2 * x + 1] = (f32x4){bflo(vw.z), bfhi(vw.z), bflo(vw.w), bfhi(vw.w)}; } }
            else if (p >= 0) { const int page = pt[s * NPAGES + p / PAGE]; const size_t off = ((((size_t)l * NPOOL + page) * PAGE + p % PAGE) * SBH + h) * 64;
#pragma unroll
                for (int x = 0; x < 16; ++x) { kr[x] = ((const f32x4*)(A.in[I_CK] + off))[x]; vr[x] = ((const f32x4*)(A.in[I_CV] + off))[x]; } }
            else {
#pragma unroll
                for (int x = 0; x < 16; ++x) { kr[x] = (f32x4){0.f, 0.f, 0.f, 0.f}; vr[x] = (f32x4){0.f, 0.f, 0.f, 0.f}; } }
#pragma unroll
            for (int x = 0; x < 16; ++x) *(LAS f32x4*)(vt + lane * 68 + 4 * x) = vr[x];
#pragma unroll
            for (int qi = 0; qi < 4; ++qi) { float z = 0.f;
#pragma unroll
                for (int x = 0; x < 16; ++x) { const f32x4 qv = *(const LAS f32x4*)(qs + qi * 64 + 4 * x); z += (kr[x][0] * qv[0] + kr[x][1] * qv[1]) + (kr[x][2] * qv[2] + kr[x][3] * qv[3]); }
                float ls, ln; sb_terms(z, ls, ln);
                const bool valid = p >= 0 && p < PAST + qi; const float lnv = valid ? ln : 0.f;
                float incl = lnv;
#pragma unroll
                for (int o = 1; o < 64; o <<= 1) { const float t = __shfl_up(incl, o); if (lane >= o) incl += t; }
                wq[qi * 64 + lane] = valid ? __expf(ls + R[qi] + (incl - lnv)) : 0.f;
                R[qi] += __shfl(incl, 63); }
            WAVE_SYNC();
#pragma unroll 8
            for (int key = 0; key < 64; ++key) acc += *(const LAS f32x4*)(vt + key * 68 + 4 * ds) * wq[qi_b * 64 + key];
            WAVE_SYNC();
            if (R[0] < SB_CUT && R[1] < SB_CUT && R[2] < SB_CUT && R[3] < SB_CUT) break;
        }
        v2u o; o.x = pk2(acc[0], acc[1]); o.y = pk2(acc[2], acc[3]);
        *(v2u*)(wsb(A, WS_Y) + ((size_t)MP + s * DEC_SEQ + qi_b) * D + 768 + h * 64 + ds * 4) = o;
    }
}
constexpr int PH_PER_LAYER = 12, NPHASE = 2 + PH_PER_LAYER * DEPTH;
#ifndef DUP_MASK
#define DUP_MASK 0
#endif
#if DUP_MASK
__device__ __forceinline__ int rep_n(int k) { int n = ((DUP_MASK >> k) & 1) ? 2 : 1; asm volatile("" : "+s"(n)); return n; }
#define REP(k) _Pragma("nounroll") for (int rep_ = 0, repn_ = rep_n(k); rep_ < repn_; ++rep_)
#else
#define REP(k)
#endif
#ifndef TIME_SUB
#define TIME_SUB 0
#endif
#ifndef TIME_MASK
#define TIME_MASK 0
#endif
#ifndef MK_N_LAUNCHES
#define MK_N_LAUNCHES 1
#endif
__global__ void __launch_bounds__(NWAVES * 64, 2) fwd_kernel(Args A) {
#ifndef CPU_EMU
    extern __shared__ __attribute__((aligned(16))) unsigned char lds_raw[];
    LAS unsigned char* lds = (LAS unsigned char*)lds_raw;
    volatile LAS unsigned* MISC = (volatile LAS unsigned*)(lds + MISC_OFF);
    for (int u = threadIdx.x; u < (LDS_BYTES - MISC_OFF) / 4; u += NWAVES * 64) ((LAS unsigned*)(lds + MISC_OFF))[u] = 0u;
    __syncthreads();
    XcdBarrier bar; bar.bar = (unsigned*)(A.ws + WS_CTL) + CW_BAR + A.li * XCD_BAR_WORDS; bar.x = 0; bar.st = nullptr;
    if (A.ph_hi - A.ph_lo > 1) bar = xcd_barrier_post((unsigned*)(A.ws + WS_CTL) + CW_BAR + A.li * XCD_BAR_WORDS, MISC + 8);
#else
    unsigned char* lds = emu::B->lds; XcdBarrier bar{0};
#endif
    const int lo = A.ph_lo, hi = A.ph_hi, G = gridDim.x, bid = blockIdx.x;
#define IN(k) (lo <= (k) && (k) < hi)
#if TIME_MASK || TIME_SUB
    unsigned long long tp_ = __builtin_amdgcn_s_memrealtime(), tacc_ = 0;
#define SEAM(k) do { if (IN((k) + 1)) xcd_barrier(bar); { const unsigned long long tn_ = __builtin_amdgcn_s_memrealtime(); if ((TIME_MASK >> (k)) & 1) tacc_ += tn_ - tp_; tp_ = tn_; } } while (0)
#else
#define SEAM(k) do { if (IN((k) + 1)) xcd_barrier(bar); } while (0)
#endif
    if (IN(0)) { REP(9) ph_prologue(A, lds); ph_ssm_weights(A); SEAM(0); }
    if (IN(1)) {
        pg8::Gemm g{wsb(A, WS_CSILU), (const bf16*)(A.ws + WS_W + WL_ADA), D, D}; ModOrder S{G, bid}; EpiMod2 E{wsf(A, WS_MOD), A.in[I_BADA]};
        pg8::gemm_phase<EpiMod2, ModOrder, true, true>(lds, g, S, E); SEAM(1);
    }
    for (int l = 0; l < DEPTH; ++l) {
        const int pb = 2 + PH_PER_LAYER * l;
        unsigned char* wl = A.ws + WS_W + (size_t)l * WL_SIZE;
        if (IN(pb + 0)) { if (l == 0) ph_rows<0>(A, 0); SEAM(pb + 0); }
        if (IN(pb + 1)) {
            pg8::Gemm g{wsb(A, WS_H), (const bf16*)(wl + WL_W1), D, D}; pg8::GridOrder S; S.init(M / 256, N1 / 256, G, bid);
            pg8::EpiProj E{wsb(A, WS_PROJ), wsb(A, WS_GATE), A.out + O_KP + (size_t)l * MP * 256, A.out + O_VP + (size_t)l * MP * 256, A.out + O_KS + (size_t)l * MS * 256, A.out + O_VS + (size_t)l * MS * 256, wsb(A, WS_VT)};
            REP(5) pg8::gemm_phase<pg8::EpiProj, pg8::GridOrder, true, true>(lds, g, S, E); SEAM(pb + 1);
        }
        if (IN(pb + 2)) {
#if TIME_SUB
#define SUBT(k, call) do { const unsigned long long ts_ = __builtin_amdgcn_s_memrealtime(); call; if ((TIME_SUB >> (k)) & 1) tacc_ += __builtin_amdgcn_s_memrealtime() - ts_; } while (0)
#else
#define SUBT(k, call) do { call; } while (0)
#endif
            SUBT(0, REP(3) ph_gdn_c1(A, lds, l)); SUBT(1, REP(2) ph_sb_prompt(A, l)); __syncthreads(); SUBT(2, REP(10) ph_gdn_sample(A, lds, l)); SUBT(3, REP(1) ph_sb_sample(A, lds, l));
            SUBT(4, REP(4) ph_ssm1(A, l)); SUBT(5, REP(10) ph_conv(A, l)); SUBT(6, SEAM(pb + 2)); }
        if (IN(pb + 3)) { REP(0) ph_gdn_scan(A, lds, l); REP(10) ph_ssm_carry(A, l); SEAM(pb + 3); }
        if (IN(pb + 4)) { REP(4) ph_ssm2(A, lds, l); REP(10) ph_gdn_out(A, l); SEAM(pb + 4); }
        if (IN(pb + 5)) {
            pg8::Gemm g{wsb(A, WS_YS), (const bf16*)(wl + WL_GLU), 256, 256}; pg8::GridOrder S; S.init(M / 256, 1, G, bid);
            pg8::EpiGlu E{wsb(A, WS_YS), wsb(A, WS_Y)};
            REP(8) pg8::gemm_phase<pg8::EpiGlu, pg8::GridOrder, true, true>(lds, g, S, E); SEAM(pb + 5);
        }
        if (IN(pb + 6)) {
            pg8::Gemm g{wsb(A, WS_Y), (const bf16*)(wl + WL_BR), D, 256}; pg8::MergeOrder S; S.init(M / 256, 8, G, bid);
            pg8::EpiMerge E; E.gate = wsb(A, WS_GATE); E.mgb = wsb(A, WS_MERGEB);
            REP(6) pg8::gemm_phase<pg8::EpiMerge, pg8::MergeOrder, true, true, true>(lds, g, S, E); SEAM(pb + 6);
        }
        if (IN(pb + 7)) {
            pg8::Gemm g{wsb(A, WS_MERGEB), (const bf16*)(wl + WL_WO), D, D}; pg8::GridOrder S; S.init(M / 256, 4, G, bid);
            pg8::EpiRes E{l == 0 ? A.in[I_XP] : wsf(A, WS_X2), l == 0 ? A.in[I_XS] : wsf(A, WS_X2) + (size_t)MP * D, wsf(A, WS_MOD) + (size_t)l * 256 * NMOD + 2 * D, wsf(A, WS_X1)};
            REP(8) pg8::gemm_phase<pg8::EpiRes, pg8::GridOrder, true, true>(lds, g, S, E); SEAM(pb + 7);
        }
        if (IN(pb + 8)) { ph_rows<1>(A, l); SEAM(pb + 8); }
        if (IN(pb + 9)) {
            pg8::Gemm g{wsb(A, WS_H), (const bf16*)(wl + WL_UP), D, D}; pg8::GridOrder S; S.init(M / 256, NUP / 256, G, bid);
            pg8::EpiUp E{wsb(A, WS_ACT)};
            REP(7) pg8::gemm_phase<pg8::EpiUp, pg8::GridOrder, true, true>(lds, g, S, E); SEAM(pb + 9);
        }
        if (IN(pb + 10)) {
            pg8::Gemm g{wsb(A, WS_ACT), (const bf16*)(wl + WL_DN), DFF, DFF}; pg8::GridOrder S; S.init(M / 256, 4, G, bid);
            pg8::EpiRes E{wsf(A, WS_X1), wsf(A, WS_X1) + (size_t)MP * D, wsf(A, WS_MOD) + (size_t)l * 256 * NMOD + 5 * D, wsf(A, WS_X2)};
            REP(7) pg8::gemm_phase<pg8::EpiRes, pg8::GridOrder, true, true>(lds, g, S, E); SEAM(pb + 10);
        }
        if (IN(pb + 11)) { ph_rows<2>(A, l); SEAM(pb + 11); }
    }
#if TIME_MASK || TIME_SUB
    if (blockIdx.x == 0 && threadIdx.x == 0) { const unsigned long long t0_ = __builtin_amdgcn_s_memrealtime(); while (__builtin_amdgcn_s_memrealtime() - t0_ < 4 * tacc_) __builtin_amdgcn_s_sleep(8); }
#endif
#undef IN
#undef SEAM
}
#ifndef CPU_EMU
extern "C" void kernel_launch(void* const* d_in, const int* in_sizes, int n_in, void* d_out, int out_size, void* d_ws, size_t ws_size, hipStream_t stream) {
    static int grid = 0;
    if (grid == 0) {
        if (n_in != 38 || (size_t)out_size != O_END || ws_size < WS_END) { fprintf(stderr, "kernel_launch: unexpected shapes (n_in %d out %d ws %zu; want 38, %zu, >= %zu)\n", n_in, out_size, ws_size, (size_t)O_END, (size_t)WS_END); grid = -1; return; }
        int dev = 0, cus = 0, per_cu = 0;
        if (hipGetDevice(&dev) != hipSuccess || hipDeviceGetAttribute(&cus, hipDeviceAttributeMultiprocessorCount, dev) != hipSuccess) { grid = -1; return; }
        if (hipFuncSetAttribute((const void*)fwd_kernel, hipFuncAttributeMaxDynamicSharedMemorySize, LDS_BYTES) != hipSuccess) { fprintf(stderr, "kernel_launch: hipFuncSetAttribute failed\n"); grid = -1; return; }
        if (hipOccupancyMaxActiveBlocksPerMultiprocessor(&per_cu, (const void*)fwd_kernel, NWAVES * 64, LDS_BYTES) != hipSuccess || per_cu < 1) { fprintf(stderr, "kernel_launch: occupancy query says %d\n", per_cu); }
        (void)hipGetLastError();
        grid = cus;
    }
    if (grid < 0) return;
    if (hipMemsetAsync((char*)d_ws + WS_CTL, 0, CTL_ZERO_BYTES, stream) != hipSuccess) return;
    Args a{};
    for (int i = 0; i < 38; ++i) a.in[i] = (const float*)d_in[i];
    a.out = (float*)d_out; a.ws = (unsigned char*)d_ws;
    if (MK_N_LAUNCHES == 1) { a.ph_lo = 0; a.ph_hi = NPHASE; a.li = 0; hipLaunchKernelGGL(fwd_kernel, dim3(grid), dim3(NWAVES * 64), LDS_BYTES, stream, a); }
    else for (int p = 0; p < NPHASE; ++p) { if (p == 2 + PH_PER_LAYER) continue; a.ph_lo = p; a.ph_hi = p + 1; a.li = 0; hipLaunchKernelGGL(fwd_kernel, dim3(grid), dim3(NWAVES * 64), LDS_BYTES, stream, a); }
}
#endif
```

```cpp
#ifndef CPU_EMU
#include <hip/hip_runtime.h>
#endif
#include <cstdio>
#include <cstdint>
#include <cmath>

constexpr int D = 1024, NB = 2, DEPTH = 2, DEC_SEQ = 4, PAGE = 128;
#ifdef CPU_EMU
#ifndef EMU_SEQ
#define EMU_SEQ 512
#endif
#ifndef EMU_DB
#define EMU_DB 64
#endif
#ifndef EMU_PAST
#define EMU_PAST 512
#endif
constexpr int SEQ = EMU_SEQ, DB = EMU_DB, PAST = EMU_PAST;
#else
constexpr int SEQ = 8192, DB = 128, PAST = 2048;
#endif
constexpr int NPAGES = PAST / PAGE, NUSED = DB * NPAGES, NPOOL = NUSED + (NUSED / 4 > 1 ? NUSED / 4 : 1);
constexpr int MP = NB * SEQ, MS = DB * DEC_SEQ, M = MP + MS, NSEQ = NB + DB;
constexpr int WMIX = 256, NPROJ = 2816, NIN = 2824, NGATE = 4096, N1 = NPROJ + NGATE, DFF = 2816, NUP = 2 * DFF, NMOD = 6 * D;
constexpr int SSM_G = 16, SSM_P = 64, SSM_CH = 128, SSM_NCH = SEQ / SSM_CH;
constexpr int GH = 4, GDK = 64, GCH = 64, GNCH = SEQ / GCH, GQKV = 768;
constexpr int SBH = 4;
constexpr int PC_U = 0, PC_BG = 256, PC_CG = 512, PC_XC = 768, PC_QKV = 1024, PC_Z = 1792, PC_Q = 2048, PC_K = 2304, PC_V = 2560;
constexpr float LN_EPS = 1e-5f, RMS_EPS = 1e-6f, ALPHA = 1.41421356237309515f  ;
static_assert(M % 256 == 0 && MP % 256 == 0 && SEQ % 256 == 0 && NSEQ <= 256, "tile shapes");
constexpr size_t O_Y = 0, O_KP = (size_t)M * D, O_VP = O_KP + (size_t)DEPTH * MP * 256, O_KS = O_VP + (size_t)DEPTH * MP * 256, O_VS = O_KS + (size_t)DEPTH * MS * 256,
    O_REP = O_VS + (size_t)DEPTH * MS * 256, O_IMP = O_REP + DEPTH * NB * 1024, O_RES = O_IMP + DEPTH * NB * 1024, O_IMS = O_RES + (size_t)DEPTH * DB * 1024,
    O_CBP = O_IMS + (size_t)DEPTH * DB * 1024, O_CBS = O_CBP + DEPTH * NB * 512, O_DP = O_CBS + (size_t)DEPTH * DB * 512, O_DS = O_DP + (size_t)DEPTH * NB * 16384,
    O_CDP = O_DS + (size_t)DEPTH * DB * 16384, O_CDS = O_CDP + DEPTH * NB * 2304, O_END = O_CDS + (size_t)DEPTH * DB * 2304;

constexpr size_t MiB = 1u << 20;
constexpr size_t al(size_t x) { return (x + 4095) & ~(size_t)4095; }
constexpr size_t WS_CTL = 0, CTL_ZERO_BYTES = 1 * MiB;
constexpr size_t WL_ADA = 0, WL_W1 = WL_ADA + (size_t)NMOD * D * 2, WL_GLU = WL_W1 + (size_t)N1 * D * 2, WL_BR = WL_GLU + 256 * 256 * 2, WL_WO = WL_BR + (size_t)4 * D * 256 * 2,
    WL_UP = WL_WO + (size_t)D * D * 2, WL_DN = WL_UP + (size_t)NUP * D * 2, WL_LOG = WL_DN + (size_t)D * DFF * 2, WL_SIZE = (WL_LOG + 8 * D * 4 + 524287) & ~(size_t)524287;
constexpr size_t WS_W = 1 * MiB, WS_CSILU = WS_W + DEPTH * WL_SIZE, WS_MOD = WS_CSILU + 256 * D * 2, WS_H = WS_MOD + (size_t)DEPTH * 256 * NMOD * 4,
    WS_PROJ = WS_H + (size_t)M * D * 2, WS_GATE = al(WS_PROJ + (size_t)M * NPROJ * 2), WS_LOG8 = WS_GATE + (size_t)M * NGATE * 2, WS_Y = WS_LOG8 + (size_t)M * 8 * 4,
    WS_YS = WS_Y + (size_t)M * D * 2, WS_MERGE = WS_YS + (size_t)M * 256 * 2, WS_MERGEB = WS_MERGE + (size_t)M * D * 4, WS_X1 = WS_MERGEB + (size_t)M * D * 2,
    WS_ACT = WS_X1 + (size_t)M * D * 4, WS_X2 = al(WS_ACT + (size_t)M * DFF * 2), WS_SEND = WS_X2 + (size_t)M * D * 4, WS_HIN = WS_SEND + (size_t)NB * 16 * SSM_NCH * 128 * 4,
    WS_GD = WS_HIN + (size_t)NB * 16 * SSM_NCH * 128 * 4, WS_EGL = WS_GD + (size_t)NB * GH * GNCH * 49152, WS_ODRAW = al(WS_EGL + (size_t)NB * GH * GNCH * 4),
    WS_VT = al(WS_ODRAW + (size_t)M * 256 * 4), WS_SSMW = al(WS_VT + (size_t)NB * SBH * 64 * SEQ * 2), WS_PART = al(WS_SSMW + (size_t)DEPTH * 16 * 8 * (SSM_CH / 2) * 64 * 16), WS_END = WS_PART + (size_t)(DFF / 256) * MS * D * 4;
constexpr size_t SSMW_L = (size_t)16 * 8 * (SSM_CH / 2) * 64 * 16;
constexpr int CW_TMO = 0, CW_BAR = 4096;
constexpr size_t GD_UNIT = 49152;

#define LAS_HW __attribute__((address_space(3)))
#ifdef CPU_EMU
#define LAS
#else
#define LAS LAS_HW
#endif
typedef unsigned short bf16;
typedef unsigned v4u __attribute__((ext_vector_type(4)));
typedef unsigned v2u __attribute__((ext_vector_type(2)));
typedef float f32x4 __attribute__((ext_vector_type(4)));
typedef float f32x2 __attribute__((ext_vector_type(2)));
typedef short bf16x8 __attribute__((ext_vector_type(8)));
#ifdef CPU_EMU
#define LDS_WAIT() do {} while (0)
#define VM_WAIT() do {} while (0)
#define WAVE_SYNC() emu::wave_sync()
#define CFENCE() do {} while (0)
#define RAW_BAR() emu::block_sync()
#else
#define LDS_WAIT() asm volatile("s_waitcnt lgkmcnt(0)" ::: "memory")
#define VM_WAIT() asm volatile("s_waitcnt vmcnt(0)" ::: "memory")
#define WAVE_SYNC() do { asm volatile("s_waitcnt lgkmcnt(0)" ::: "memory"); __builtin_amdgcn_wave_barrier(); } while (0)
#define CFENCE() asm volatile("" ::: "memory")
#define RAW_BAR() do { asm volatile("s_waitcnt lgkmcnt(0)" ::: "memory"); __builtin_amdgcn_s_barrier(); asm volatile("" ::: "memory"); } while (0)
#endif
#ifdef CPU_EMU
#define OPAQUE_V(x) do {} while (0)
#else
#define OPAQUE_V(x) asm volatile("" : "+v"(x))
#endif
__device__ __forceinline__ unsigned f2bf(float f) { unsigned u = __builtin_bit_cast(unsigned, f); return (u + 0x7fffu + ((u >> 16) & 1u)) >> 16; }
__device__ __forceinline__ unsigned pk2(float lo, float hi) { return f2bf(lo) | (f2bf(hi) << 16); }
__device__ __forceinline__ float bf2f(unsigned b) { return __builtin_bit_cast(float, b << 16); }
__device__ __forceinline__ float bflo(unsigned w) { return __builtin_bit_cast(float, w << 16); }
__device__ __forceinline__ float bfhi(unsigned w) { return __builtin_bit_cast(float, w & 0xffff0000u); }
__device__ __forceinline__ float sigmoidf_(float x) { return 1.0f / (1.0f + __expf(-x)); }
__device__ __forceinline__ float siluf_(float x) { return x / (1.0f + __expf(-x)); }
__device__ __forceinline__ bf16x8 acc2b(const f32x4& lo, const f32x4& hi) { v4u w; w.x = pk2(lo[0], lo[1]); w.y = pk2(lo[2], lo[3]); w.z = pk2(hi[0], hi[1]); w.w = pk2(hi[2], hi[3]); return __builtin_bit_cast(bf16x8, w); }
__device__ __forceinline__ float wave_sum(float v) {
#pragma unroll
    for (int o = 1; o < 64; o <<= 1) v += __shfl_xor(v, o);
    return v;
}
__device__ __forceinline__ int seq_of(int m) { return m < MP ? m / SEQ : NB + (m - MP) / DEC_SEQ; }
namespace pg8 {
typedef unsigned short bf16_t;
constexpr int BM = 256, BK = 64, HALF = 128, HTB = HALF * BK * 2, STAGE_BYTES = 8 * HTB, NXCD = 8, WGM = 8;
__host__ __device__ __forceinline__ int lds_byte(int r, int c) { const int st = (r >> 4) * 2 + (c >> 5), rr = r & 15, cc = c & 31, ob = rr * 64 + cc * 2; return st * 1024 + (ob ^ (((ob >> 9) & 1) << 5)); }
__host__ __device__ __forceinline__ void stage_rc(int b, int& R, int& C) { const int st = b / 1024, sb = b % 1024, swz = sb ^ (((sb >> 9) & 1) << 5); R = (st >> 1) * 16 + swz / 64; C = (st & 1) * 32 + (swz % 64) / 2; }
__host__ __device__ __forceinline__ int perm32(int rho) { const int n = rho >> 4, i = rho & 15; return 8 * (i >> 2) + 4 * n + (i & 3); }
struct Unit { int pm, pn, ka, kb, aux; };
struct NoState {};
struct Gemm { const bf16_t* A; const bf16_t* Bt; int lda, ldb, K; };
struct GridOrder {
    int nM, nN, nwg, G, c, pn0;
    __host__ __device__ void init(int nM_, int nN_, int G_, int c_, int pn0_ = 0) { nM = nM_; nN = nN_; nwg = nM * nN; G = G_; c = c_; pn0 = pn0_; }
    __host__ __device__ bool tile(long L, int& pm, int& pn) const {
        if (L >= nwg) return false;
        int wgid = (int)L; { const int q = nwg / NXCD, r = nwg % NXCD, xcd = wgid % NXCD, off = wgid / NXCD; wgid = (xcd < r ? xcd * (q + 1) : r * (q + 1) + (xcd - r) * q) + off; }
        const int nig = WGM * nN, gid = wgid / nig, fm = gid * WGM, gsz = (nM - fm) < WGM ? (nM - fm) : WGM;
        pm = fm + ((wgid % nig) % gsz); pn = (wgid % nig) / gsz; return true;
    }
    __host__ __device__ bool next(int i, Unit& u) const { int pm, pn; if (!tile((long)i * G + c, pm, pn)) return false; u.pm = pm; u.pn = pn0 + pn; u.ka = 0; u.kb = 0; u.aux = pn; return true; }
    __device__ __forceinline__ void a_ready(const Unit&) const {}
    __device__ __forceinline__ void done(const Unit&) const {}
};
struct MergeOrder : GridOrder {
    __host__ __device__ bool next(int i, Unit& u) const { int pm, pc; if (!tile((long)(i >> 2) * G + c, pm, pc)) return false; const int n = i & 3; u.pm = pm; u.pn = 8 * n + pc; u.ka = 256 * n; u.kb = 0; u.aux = (n << 8) | pc; return true; }
};
struct SplitOrder {
    int G, c, pm0, nrow, ncol, nks;
    __host__ __device__ bool next(int i, Unit& u) const { const int L = i * G + c; if (L >= nrow * ncol * nks) return false; const int ks = L % nks, pn = (L / nks) % ncol, pr = L / (nks * ncol);
        u.pm = pm0 + pr; u.pn = pn; u.ka = 256 * ks; u.kb = 256 * ks; u.aux = pn | (ks << 8); return true; }
    __device__ __forceinline__ void a_ready(const Unit&) const {}
    __device__ __forceinline__ void done(const Unit&) const {}
};
#ifndef CPU_EMU
#define PG8_LAS __attribute__((address_space(3)))
template <class Epi, class Sched, bool ALIGN_EPI = false, bool SP2 = false, bool HALFN = false>
__device__ __forceinline__ void gemm_phase(PG8_LAS unsigned char* lds, const Gemm g, const Sched& S, const Epi& E) {
    int tid = threadIdx.x; asm volatile("" : "+v"(tid));
    const int wid = __builtin_amdgcn_readfirstlane(tid >> 6), lane = tid & 63, wr = wid >> 2, wc = wid & 3, fr = lane & 15, fq = lane >> 4;
    int K = g.K; asm volatile("" : "+s"(K));
    const int nt = K / BK, lda = g.lda, ldb = g.ldb;
    unsigned voffA[2], voffB[2];
#pragma unroll
    for (int i = 0; i < 2; ++i) { int R, C; stage_rc(tid * 16 + i * 8192, R, C); const int Rb = Epi::PERM ? ((R & ~31) + perm32(R & 31)) : R;
        voffA[i] = (unsigned)(R * lda + C) * 2u; voffB[i] = (unsigned)(Rb * ldb + C) * 2u; }
    const size_t kstep = (size_t)(BK * 2);
    const size_t hstepA = (size_t)HALF * lda * 2, hstepB = HALFN ? (size_t)0 : (size_t)HALF * ldb * 2;
    const size_t tstepA = 2 * hstepA, tstepB = HALFN ? (size_t)HALF * ldb * 2 : 2 * hstepB;
    const unsigned ldsw = (unsigned)wid * 1024u;
    const int aoff = lds_byte(wr * 64 + fr, fq * 8), boff = lds_byte(wc * 32 + fr, fq * 8);
#define PG8_SA(b, h) (((b) * 2 + (h)) * HTB)
#define PG8_SB(b, h) ((4 + (b) * 2 + (h)) * HTB)
#define PG8_STAGE(bufoff, gbase, voff) do { _Pragma("unroll") for (int _i = 0; _i < 2; ++_i) \
        __builtin_amdgcn_global_load_lds((const unsigned*)((const char*)(gbase) + (voff)[_i]), (PG8_LAS unsigned*)(lds + (bufoff) + ldsw + _i * 8192), 16, 0, 0); } while (0)
#define PG8_LDA(dst, b, h) do { _Pragma("unroll") for (int m = 0; m < 4; ++m) _Pragma("unroll") for (int k = 0; k < 2; ++k) dst[m][k] = *(const PG8_LAS bf16x8*)(lds + PG8_SA(b, h) + aoff + m * 2048 + k * 1024); } while (0)
#define PG8_LDB(dst, b, h) do { _Pragma("unroll") for (int n = 0; n < 2; ++n) _Pragma("unroll") for (int k = 0; k < 2; ++k) dst[n][k] = *(const PG8_LAS bf16x8*)(lds + PG8_SB(b, h) + boff + n * 2048 + k * 1024); } while (0)
#define PG8_MMA(ai, bj, At, Bt) do { __builtin_amdgcn_s_setprio(1); _Pragma("unroll") for (int m = 0; m < 4; ++m) _Pragma("unroll") for (int n = 0; n < 2; ++n) _Pragma("unroll") for (int k = 0; k < 2; ++k) \
        acc[ai][bj][m][n] = __builtin_amdgcn_mfma_f32_16x16x32_bf16(Bt[n][k], At[m][k], acc[ai][bj][m][n], 0, 0, 0); __builtin_amdgcn_s_setprio(0); } while (0)
#define PG8_WAIT_V(n) asm volatile("s_waitcnt vmcnt(" #n ")" ::: "memory")
#define PG8_WAIT_L(n) asm volatile("s_waitcnt lgkmcnt(" #n ")" ::: "memory")
#define PG8_BAR __builtin_amdgcn_s_barrier()
#define PG8_SCHED __builtin_amdgcn_sched_barrier(0)
    Unit cur, nxt; int ui = 0;
    if (!S.next(0, cur)) return;
    f32x4 acc[2][2][4][2];
    typename Epi::State est;
#pragma unroll
    for (int a = 0; a < 2; ++a)
#pragma unroll
        for (int b = 0; b < 2; ++b)
#pragma unroll
            for (int m = 0; m < 4; ++m)
#pragma unroll
                for (int n = 0; n < 2; ++n) acc[a][b][m][n] = (f32x4){0.f, 0.f, 0.f, 0.f};
    static_assert(!HALFN || SP2, "HALFN is written for the SP2 loop");
    bf16x8 At[4][2], B0[2][2], B1[2][2];
    const char* cA = (const char*)g.A + (size_t)cur.pm * tstepA + (size_t)cur.ka * 2; const char* cB = (const char*)g.Bt + (size_t)cur.pn * tstepB + (size_t)cur.kb * 2;
    S.a_ready(cur);
    if constexpr (SP2) {
        PG8_STAGE(PG8_SB(0, 0), cB, voffB); PG8_STAGE(PG8_SB(0, 1), cB + hstepB, voffB); PG8_STAGE(PG8_SA(0, 0), cA, voffA); PG8_STAGE(PG8_SA(0, 1), cA + hstepA, voffA);
        if (wr == 1) PG8_BAR;
        PG8_WAIT_V(2); PG8_BAR;
        PG8_STAGE(PG8_SB(1, 0), cB + kstep, voffB); PG8_STAGE(PG8_SA(1, 0), cA + kstep, voffA); PG8_STAGE(PG8_SB(1, 1), cB + hstepB + kstep, voffB);
        PG8_WAIT_V(6); PG8_BAR;
    } else {
        PG8_STAGE(PG8_SB(0, 0), cB, voffB); PG8_STAGE(PG8_SA(0, 0), cA, voffA); PG8_STAGE(PG8_SB(0, 1), cB + hstepB, voffB); PG8_STAGE(PG8_SA(0, 1), cA + hstepA, voffA);
        if (wr == 1) PG8_BAR;
        PG8_WAIT_V(4); PG8_BAR;
        PG8_STAGE(PG8_SB(1, 0), cB + kstep, voffB); PG8_STAGE(PG8_SA(1, 0), cA + kstep, voffA); PG8_STAGE(PG8_SB(1, 1), cB + hstepB + kstep, voffB);
        PG8_WAIT_V(6); PG8_BAR;
    }
    for (;;) {
        const bool has_next = S.next(ui + 1, nxt);
        const char* nA = has_next ? (const char*)g.A + (size_t)nxt.pm * tstepA + (size_t)nxt.ka * 2 : cA; const char* nB = has_next ? (const char*)g.Bt + (size_t)nxt.pn * tstepB + (size_t)nxt.kb * 2 : cB;
        for (int t = 0; t < nt; t += 2) {
            const bool last = (t == nt - 2);
            const char* a1 = cA + (size_t)(t + 1) * kstep;
            const char* a2 = last ? nA : cA + (size_t)(t + 2) * kstep; const char* b2 = last ? nB : cB + (size_t)(t + 2) * kstep;
            const char* a3 = a2 + kstep; const char* b3 = b2 + kstep;
            if (last && has_next) S.a_ready(nxt);
            if constexpr (SP2) {
            PG8_LDB(B0, 0, 0); if constexpr (!HALFN) PG8_LDB(B1, 0, 1); PG8_SCHED; PG8_LDA(At, 0, 0); PG8_STAGE(PG8_SA(1, 1), a1 + hstepA, voffA);
            PG8_WAIT_V(8); PG8_WAIT_L(0); PG8_BAR; PG8_MMA(0, 0, At, B0); if constexpr (!HALFN) PG8_MMA(0, 1, At, B1); PG8_BAR; PG8_SCHED;
            PG8_LDA(At, 0, 1); PG8_STAGE(PG8_SB(0, 0), b2, voffB); PG8_STAGE(PG8_SB(0, 1), b2 + hstepB, voffB); PG8_STAGE(PG8_SA(0, 0), a2, voffA);
            PG8_WAIT_V(8); PG8_WAIT_L(0); PG8_BAR; PG8_MMA(1, 0, At, B0); if constexpr (!HALFN) PG8_MMA(1, 1, At, B1); PG8_BAR; PG8_SCHED;
            PG8_LDB(B0, 1, 0); if constexpr (!HALFN) PG8_LDB(B1, 1, 1); PG8_SCHED; PG8_LDA(At, 1, 0); PG8_STAGE(PG8_SA(0, 1), a2 + hstepA, voffA);
            PG8_WAIT_V(8); PG8_WAIT_L(0); PG8_BAR; PG8_MMA(0, 0, At, B0); if constexpr (!HALFN) PG8_MMA(0, 1, At, B1); PG8_BAR; PG8_SCHED;
            PG8_LDA(At, 1, 1); PG8_STAGE(PG8_SB(1, 0), b3, voffB); PG8_STAGE(PG8_SB(1, 1), b3 + hstepB, voffB); PG8_STAGE(PG8_SA(1, 0), a3, voffA);
            PG8_WAIT_V(8); PG8_WAIT_L(0); PG8_BAR; PG8_MMA(1, 0, At, B0); if constexpr (!HALFN) PG8_MMA(1, 1, At, B1); PG8_BAR; PG8_SCHED;
            } else {
            PG8_LDB(B0, 0, 0); PG8_SCHED; PG8_LDA(At, 0, 0); PG8_STAGE(PG8_SA(1, 1), a1 + hstepA, voffA);
            PG8_WAIT_L(8); PG8_BAR; PG8_WAIT_L(0); PG8_MMA(0, 0, At, B0); PG8_BAR; PG8_SCHED;
            PG8_LDB(B1, 0, 1); PG8_STAGE(PG8_SB(0, 0), b2, voffB);
            PG8_BAR; PG8_WAIT_L(0); PG8_MMA(0, 1, At, B1); PG8_BAR;
            PG8_LDA(At, 0, 1); PG8_STAGE(PG8_SA(0, 0), a2, voffA);
            PG8_BAR; PG8_WAIT_L(0); PG8_MMA(1, 0, At, B0); PG8_BAR; PG8_SCHED;
            PG8_STAGE(PG8_SB(0, 1), b2 + hstepB, voffB);
            PG8_WAIT_V(6); PG8_BAR; PG8_MMA(1, 1, At, B1); PG8_BAR;
            PG8_LDB(B0, 1, 0); PG8_SCHED; PG8_LDA(At, 1, 0); PG8_STAGE(PG8_SA(0, 1), a2 + hstepA, voffA);
            PG8_WAIT_L(8); PG8_BAR; PG8_WAIT_L(0); PG8_MMA(0, 0, At, B0); PG8_BAR; PG8_SCHED;
            PG8_LDB(B1, 1, 1); PG8_STAGE(PG8_SB(1, 0), b3, voffB);
            PG8_BAR; PG8_WAIT_L(0); PG8_MMA(0, 1, At, B1); PG8_BAR;
            PG8_LDA(At, 1, 1); PG8_STAGE(PG8_SA(1, 0), a3, voffA);
            PG8_BAR; PG8_WAIT_L(0); PG8_MMA(1, 0, At, B0); PG8_BAR; PG8_SCHED;
            PG8_STAGE(PG8_SB(1, 1), b3 + hstepB, voffB);
            PG8_WAIT_V(6); PG8_BAR; PG8_MMA(1, 1, At, B1); PG8_BAR;
            }
        }
        if constexpr (ALIGN_EPI) { if (wr == 0) PG8_BAR; }
        E(acc, est, cur, wr, wc, fr, fq); S.done(cur);
        if (!has_next) break;
#pragma unroll
        for (int a = 0; a < 2; ++a)
#pragma unroll
            for (int b = 0; b < 2; ++b)
#pragma unroll
                for (int m = 0; m < 4; ++m)
#pragma unroll
                    for (int n = 0; n < 2; ++n) acc[a][b][m][n] = (f32x4){0.f, 0.f, 0.f, 0.f};
        cur = nxt; cA = nA; cB = nB; ++ui;
        if constexpr (ALIGN_EPI) { if (wr == 1) PG8_BAR; }
    }
    PG8_WAIT_V(0);
    if constexpr (!ALIGN_EPI) { if (wr == 0) PG8_BAR; }
    PG8_BAR;
#undef PG8_SA
#undef PG8_SB
#undef PG8_STAGE
#undef PG8_LDA
#undef PG8_LDB
#undef PG8_MMA
#undef PG8_WAIT_V
#undef PG8_WAIT_L
#undef PG8_BAR
#undef PG8_SCHED
}
#else
template <class Epi, class Sched, bool ALIGN_EPI = false, bool SP2 = false, bool HALFN = false>
void gemm_phase(unsigned char* lds, const Gemm g, const Sched& S, const Epi& E) {
    const int tid = threadIdx.x, wid = tid >> 6, lane = tid & 63, wr = wid >> 2, wc = wid & 3, fr = lane & 15, fq = lane >> 4;
    static thread_local float* Ct = nullptr; static thread_local float* Af = nullptr; static thread_local float* Bf = nullptr;
    Unit u; typename Epi::State est;
    for (int i = 0; S.next(i, u); ++i) {
        S.a_ready(u);
        __syncthreads();
        if (tid == 0) {
            if (!Ct) { Ct = new float[256 * 256]; Af = new float[256 * 4096]; Bf = new float[256 * 4096]; }
            const int K = g.K;
            for (int r = 0; r < 256; ++r) for (int k = 0; k < K; ++k) { Af[r * K + k] = bf2f(g.A[(size_t)(u.pm * 256 + r) * g.lda + u.ka + k]); Bf[r * K + k] = HALFN ? (r < 128 ? bf2f(g.Bt[(size_t)(u.pn * 128 + r) * g.ldb + u.kb + k]) : 0.f) : bf2f(g.Bt[(size_t)(u.pn * 256 + r) * g.ldb + u.kb + k]); }
            for (int r = 0; r < 256; ++r) for (int c = 0; c < 256; ++c) { float s = 0.f; const float* a = Af + r * K; const float* b = Bf + c * K; for (int k = 0; k < K; ++k) s += a[k] * b[k]; Ct[r * 256 + c] = s; }
        }
        __syncthreads();
        f32x4 acc[2][2][4][2];
        for (int ai = 0; ai < 2; ++ai) for (int bj = 0; bj < 2; ++bj) for (int m = 0; m < 4; ++m) for (int n = 0; n < 2; ++n) for (int e = 0; e < 4; ++e) {
            const int r = 128 * ai + 64 * wr + 16 * m + fr; const int c = Epi::PERM ? (128 * bj + 32 * wc + 8 * fq + 4 * n + e) : (128 * bj + 32 * wc + 16 * n + 4 * fq + e);
            acc[ai][bj][m][n][e] = Ct[r * 256 + c]; }
        E(acc, est, u, wr, wc, fr, fq); S.done(u);
    }
    __syncthreads();
}
#endif
}
namespace pg8 {
struct EpiMod {
    static constexpr bool PERM = false; typedef NoState State;
    float* C; const float* bias;
    __device__ __forceinline__ void operator()(const f32x4 (&acc)[2][2][4][2], State& st, const Unit& u, int wr, int wc, int fr_in, int fq_in) const {
        int fr = fr_in, fq = fq_in; OPAQUE_V(fr); OPAQUE_V(fq);
        const int row0 = wr * 64 + fr, col0 = u.aux * BM + wc * 32 + 4 * fq;
#pragma unroll
        for (int ai = 0; ai < 2; ++ai)
#pragma unroll
            for (int m = 0; m < 4; ++m) { float* rowp = C + (size_t)(row0 + ai * HALF + m * 16) * NMOD + col0;
#pragma unroll
                for (int bj = 0; bj < 2; ++bj)
#pragma unroll
                    for (int n = 0; n < 2; ++n) *(f32x4*)(rowp + bj * HALF + n * 16) = acc[ai][bj][m][n] + *(const f32x4*)(bias + col0 + bj * HALF + n * 16); }
    }
};
struct EpiProj {
    static constexpr bool PERM = true; typedef NoState State;
    bf16* proj; bf16* gate; float* outk_p; float* outv_p; float* outk_s; float* outv_s; bf16* vt;
    __device__ __forceinline__ void operator()(const f32x4 (&acc)[2][2][4][2], State& st, const Unit& u, int wr, int wc, int fr_in, int fq_in) const {
        int fr = fr_in, fq = fq_in; OPAQUE_V(fr); OPAQUE_V(fq);
        const int t = u.aux; const bool isg = t >= 11;
        const int row0 = u.pm * BM + wr * 64 + fr, colt = wc * 32 + 8 * fq;
        bf16* base = isg ? gate + (size_t)(t - 11) * 256 : proj + (size_t)t * 256; const int ldc = isg ? NGATE : NPROJ;
#pragma unroll
        for (int ai = 0; ai < 2; ++ai)
#pragma unroll
            for (int m = 0; m < 4; ++m) { const int row = row0 + ai * HALF + m * 16; bf16* rowp = base + (size_t)row * ldc + colt;
#pragma unroll
                for (int bj = 0; bj < 2; ++bj) { f32x4 v0 = acc[ai][bj][m][0], v1 = acc[ai][bj][m][1];
                    if (isg) {
#pragma unroll
                        for (int e = 0; e < 4; ++e) { v0[e] = sigmoidf_(v0[e]); v1[e] = sigmoidf_(v1[e]); } }
                    else if (t >= 9) { if (t == 10 && row < MP) { const int cv = colt + bj * HALF, bb = row / SEQ, tt = row % SEQ; bf16* vp = vt + ((size_t)(bb * SBH + (cv >> 6)) * 64 + (cv & 63)) * SEQ + tt;
#pragma unroll
                            for (int e = 0; e < 4; ++e) { vp[(size_t)e * SEQ] = (bf16)f2bf(v0[e]); vp[(size_t)(4 + e) * SEQ] = (bf16)f2bf(v1[e]); } }
                        float* o = (row < MP) ? ((t == 9 ? outk_p : outv_p) + (size_t)row * 256) : ((t == 9 ? outk_s : outv_s) + (size_t)(row - MP) * 256);
                        *(f32x4*)(o + colt + bj * HALF) = v0; *(f32x4*)(o + colt + bj * HALF + 4) = v1; }
                    v4u w; w.x = pk2(v0[0], v0[1]); w.y = pk2(v0[2], v0[3]); w.z = pk2(v1[0], v1[1]); w.w = pk2(v1[2], v1[3]);
                    *(v4u*)(rowp + bj * HALF) = w; } }
    }
};
struct EpiGlu {
    static constexpr bool PERM = true; typedef NoState State;
    const bf16* ys; bf16* y;
    __device__ __forceinline__ void operator()(const f32x4 (&acc)[2][2][4][2], State& st, const Unit& u, int wr, int wc, int fr_in, int fq_in) const {
        int fr = fr_in, fq = fq_in; OPAQUE_V(fr); OPAQUE_V(fq);
        const int row0 = u.pm * BM + wr * 64 + fr, colt = wc * 32 + 8 * fq;
#pragma unroll
        for (int ai = 0; ai < 2; ++ai)
#pragma unroll
            for (int m = 0; m < 4; ++m) { const int row = row0 + ai * HALF + m * 16;
#pragma unroll
                for (int bj = 0; bj < 2; ++bj) { const f32x4 v0 = acc[ai][bj][m][0], v1 = acc[ai][bj][m][1];
                    const v4u s = *(const v4u*)(ys + (size_t)row * 256 + colt + bj * HALF);
                    v4u w; w.x = pk2(bflo(s.x) * sigmoidf_(v0[0]), bfhi(s.x) * sigmoidf_(v0[1])); w.y = pk2(bflo(s.y) * sigmoidf_(v0[2]), bfhi(s.y) * sigmoidf_(v0[3]));
                    w.z = pk2(bflo(s.z) * sigmoidf_(v1[0]), bfhi(s.z) * sigmoidf_(v1[1])); w.w = pk2(bflo(s.w) * sigmoidf_(v1[2]), bfhi(s.w) * sigmoidf_(v1[3]));
                    *(v4u*)(y + (size_t)row * D + colt + bj * HALF) = w; } CFENCE(); }
    }
};
struct EpiMerge {
    static constexpr bool PERM = false; struct State { f32x4 macc[2][4][2]; };
    const bf16* gate; bf16* mgb;
    __device__ __forceinline__ void operator()(const f32x4 (&acc)[2][2][4][2], State& st, const Unit& u, int wr, int wc, int fr_in, int fq_in) const {
        int fr = fr_in, fq = fq_in; OPAQUE_V(fr); OPAQUE_V(fq);
        const int n_ = u.aux >> 8, pc = u.aux & 255;
        const int row0 = u.pm * BM + wr * 64 + fr, col0 = pc * HALF + wc * 32 + 4 * fq;
        v2u gw[2][4][2];
#pragma unroll
        for (int ai = 0; ai < 2; ++ai)
#pragma unroll
            for (int m = 0; m < 4; ++m)
#pragma unroll
                for (int n = 0; n < 2; ++n) gw[ai][m][n] = *(const v2u*)(gate + (size_t)(row0 + ai * HALF + m * 16) * NGATE + n_ * D + col0 + n * 16);
        CFENCE();
#pragma unroll
        for (int ai = 0; ai < 2; ++ai)
#pragma unroll
            for (int m = 0; m < 4; ++m) { const int row = row0 + ai * HALF + m * 16;
#pragma unroll
                for (int n = 0; n < 2; ++n) { const int col = col0 + n * 16; const v2u g2 = gw[ai][m][n];
                    f32x4 v = acc[ai][0][m][n]; v[0] *= bflo(g2.x); v[1] *= bfhi(g2.x); v[2] *= bflo(g2.y); v[3] *= bfhi(g2.y);
                    if (n_ > 0) v += st.macc[ai][m][n];
                    st.macc[ai][m][n] = v;
                    if (n_ == 3) { v2u o; o.x = pk2(v[0], v[1]); o.y = pk2(v[2], v[3]); *(v2u*)(mgb + (size_t)row * D + col) = o; } } }
    }
};
struct EpiRes {
    static constexpr bool PERM = false; typedef NoState State;
    const float* xP; const float* xS; const float* gmod; float* out;
    __device__ __forceinline__ void operator()(const f32x4 (&acc)[2][2][4][2], State& st, const Unit& u, int wr, int wc, int fr_in, int fq_in) const {
        int fr = fr_in, fq = fq_in; OPAQUE_V(fr); OPAQUE_V(fq);
        const int row0 = u.pm * BM + wr * 64 + fr, col0 = u.aux * BM + wc * 32 + 4 * fq;
#pragma unroll
        for (int ai = 0; ai < 2; ++ai)
#pragma unroll
            for (int m = 0; m < 4; ++m) { const int row = row0 + ai * HALF + m * 16; const float* xr = row < MP ? xP + (size_t)row * D : xS + (size_t)(row - MP) * D;
                const float* gr = gmod + (size_t)seq_of(row) * NMOD;
#pragma unroll
                for (int bj = 0; bj < 2; ++bj)
#pragma unroll
                    for (int n = 0; n < 2; ++n) { const int col = col0 + bj * HALF + n * 16;
                        const f32x4 xv = *(const f32x4*)(xr + col), gv = *(const f32x4*)(gr + col);
                        *(f32x4*)(out + (size_t)row * D + col) = xv * ALPHA + (gv + 1.0f) * acc[ai][bj][m][n]; } CFENCE(); }
    }
};
struct EpiPart {
    static constexpr bool PERM = false; typedef NoState State;
    float* part;
    __device__ __forceinline__ void operator()(const f32x4 (&acc)[2][2][4][2], State& st, const Unit& u, int wr, int wc, int fr_in, int fq_in) const {
        int fr = fr_in, fq = fq_in; OPAQUE_V(fr); OPAQUE_V(fq);
        const int ks = u.aux >> 8, pn = u.aux & 255; const int row0 = u.pm * BM - MP + wr * 64 + fr, col0 = pn * BM + wc * 32 + 4 * fq;
        float* base = part + (size_t)ks * MS * D;
#pragma unroll
        for (int ai = 0; ai < 2; ++ai)
#pragma unroll
            for (int m = 0; m < 4; ++m) { float* rowp = base + (size_t)(row0 + ai * HALF + m * 16) * D + col0;
#pragma unroll
                for (int bj = 0; bj < 2; ++bj)
#pragma unroll
                    for (int n = 0; n < 2; ++n) *(f32x4*)(rowp + bj * HALF + n * 16) = acc[ai][bj][m][n]; }
    }
};
struct EpiUp {
    static constexpr bool PERM = true; typedef NoState State;
    bf16* act;
    __device__ __forceinline__ void operator()(const f32x4 (&acc)[2][2][4][2], State& st, const Unit& u, int wr, int wc, int fr_in, int fq_in) const {
        int fr = fr_in, fq = fq_in; OPAQUE_V(fr); OPAQUE_V(fq);
        const int row0 = u.pm * BM + wr * 64 + fr, col0 = u.aux * HALF + wc * 32 + 8 * fq;
#pragma unroll
        for (int ai = 0; ai < 2; ++ai)
#pragma unroll
            for (int m = 0; m < 4; ++m) { const int row = row0 + ai * HALF + m * 16;
                const f32x4 a0 = acc[ai][0][m][0], a1 = acc[ai][0][m][1], b0 = acc[ai][1][m][0], b1 = acc[ai][1][m][1];
                v4u w; w.x = pk2(siluf_(a0[0]) * b0[0], siluf_(a0[1]) * b0[1]); w.y = pk2(siluf_(a0[2]) * b0[2], siluf_(a0[3]) * b0[3]);
                w.z = pk2(siluf_(a1[0]) * b1[0], siluf_(a1[1]) * b1[1]); w.w = pk2(siluf_(a1[2]) * b1[2], siluf_(a1[3]) * b1[3]);
                *(v4u*)(act + (size_t)row * DFF + col0) = w; }
    }
};
}
struct Args { const float* in[38]; float* out; unsigned char* ws; int ph_lo, ph_hi, li, pad; };
enum { I_XP = 0, I_XS, I_CK, I_CV, I_SRE, I_SIM, I_SCB, I_SD, I_SCD, I_PT, I_CP, I_CS, I_WADA, I_BADA, I_WIN, I_ARE, I_AIM, I_LDT, I_BRE, I_BIM, I_CRE, I_CIM, I_SSD, I_WGLU,
       I_CBW, I_DCW, I_DAL, I_DDT, I_DNW, I_WBR, I_WGATE, I_WO, I_L1G, I_L1B, I_WUP, I_WDN, I_L2G, I_L2B };
constexpr int NWAVES = 8, RING_BYTES = 131072, MISC_OFF = RING_BYTES, LDS_BYTES = 147456;
#ifndef CPU_EMU
#define XB_TMO      128
#define XB_XCNT(j)  (256  + 64 * (j))
#define XB_XSUB(j)  (1280 + 64 * (j))
#define XB_XGEN(j)  (2304 + 64 * (j))
#define XB_TOP      3328
#define XB_TOPGEN   3392
#define XCD_BAR_WORDS 3456
#define XB_SPIN_CAP (1u << 18)
__device__ __forceinline__ unsigned xb_ld(unsigned* p)              { return __hip_atomic_load(p, __ATOMIC_RELAXED, __HIP_MEMORY_SCOPE_AGENT); }
__device__ __forceinline__ unsigned xb_add(unsigned* p, unsigned v) { return __hip_atomic_fetch_add(p, v, __ATOMIC_RELAXED, __HIP_MEMORY_SCOPE_AGENT); }
__device__ __forceinline__ unsigned xb_xcc_id() { return (unsigned)__builtin_amdgcn_s_getreg((3 << 11) | 20) & 0xFu; }
#define XB_SPIN(cond, bar) do { unsigned _sp = 0; while (cond) { __builtin_amdgcn_s_sleep(1); \
    if ((++_sp & 255u) == 0u) { if (xb_ld(&(bar)[XB_TMO])) break; if (_sp > XB_SPIN_CAP) { atomicAdd(&(bar)[XB_TMO], 1u); break; } } } } while (0)
struct XcdBarrier { unsigned* bar; unsigned x; volatile LAS_HW unsigned* st; };
__device__ __forceinline__ XcdBarrier xcd_barrier_post(unsigned* bar, volatile LAS_HW unsigned* st) {
    XcdBarrier b; b.bar = bar; b.x = xb_xcc_id(); b.st = st;
    if (threadIdx.x == 0) (void)xb_add(&bar[XB_XCNT(b.x)], 1u);
    return b;
}
__device__ __forceinline__ void xcd_barrier_complete(unsigned* bar, unsigned x, unsigned& nloc, unsigned& nx) {
    const unsigned G = gridDim.x * gridDim.y * gridDim.z;
    unsigned sum, cnt, mine, sp = 0u;
    for (;;) {
        sum = 0u; cnt = 0u; mine = 0u;
#pragma unroll
        for (unsigned j = 0; j < 16; ++j) { const unsigned c = xb_ld(&bar[XB_XCNT(j)]); sum += c; cnt += (c > 0u) ? 1u : 0u; mine = (j == x) ? c : mine; }
        if (sum == G) break;
        __builtin_amdgcn_s_sleep(1);
        if ((++sp & 255u) == 0u) { if (xb_ld(&bar[XB_TMO])) break; if (sp > XB_SPIN_CAP) { atomicAdd(&bar[XB_TMO], 1u); break; } }
    }
    nloc = mine > 0u ? mine : 1u; nx = cnt > 0u ? cnt : 1u;
}
__device__ __forceinline__ void xcd_barrier(const XcdBarrier& b) {
    asm volatile("s_waitcnt vmcnt(0)" ::: "memory");
    __syncthreads();
    if (threadIdx.x == 0) {
        unsigned* bar = b.bar;
        __builtin_amdgcn_s_waitcnt(0);
        unsigned nloc = b.st[0], nx = b.st[1];
        if (nloc == 0u) { xcd_barrier_complete(bar, b.x, nloc, nx); b.st[0] = nloc; b.st[1] = nx; }
        const unsigned old = xb_add(&bar[XB_XSUB(b.x)], 1u);
        const unsigned gen = old / nloc;
        if (old + 1u == (gen + 1u) * nloc) {
            __builtin_amdgcn_fence(__ATOMIC_RELEASE, "agent");
            asm volatile("s_waitcnt vmcnt(0)" ::: "memory");
            const unsigned og = xb_add(&bar[XB_TOP], 1u);
            const unsigned tg = og / nx;
            if (og + 1u == (tg + 1u) * nx) xb_add(&bar[XB_TOPGEN], 1u);
            else XB_SPIN(xb_ld(&bar[XB_TOPGEN]) == tg, bar);
            __builtin_amdgcn_fence(__ATOMIC_ACQUIRE, "agent");
            xb_add(&bar[XB_XGEN(b.x)], 1u);
            asm volatile("s_waitcnt vmcnt(0)" ::: "memory");
        } else {
            XB_SPIN(xb_ld(&bar[XB_XGEN(b.x)]) == gen, bar);
            __builtin_amdgcn_fence(__ATOMIC_ACQUIRE, "agent");
            asm volatile("s_waitcnt vmcnt(0)" ::: "memory");
        }
    }
    __syncthreads();
}
#else
#define XCD_BAR_WORDS 3456
struct XcdBarrier { int dummy; };
inline void xcd_barrier(const XcdBarrier&) { emu::grid_sync(); }
#endif

#define TIDSV(vb_, vg_) int tid_ = threadIdx.x; OPAQUE_V(tid_); const int tid = tid_, lane = tid & 63, wave = __builtin_amdgcn_readfirstlane(tid >> 6), G = (vg_), bid = (vb_), gw = bid * NWAVES + wave, NGW = G * NWAVES; (void)lane; (void)wave; (void)gw; (void)NGW; (void)G; (void)bid
#define TIDS int tid_ = threadIdx.x; OPAQUE_V(tid_); const int tid = tid_, lane = tid & 63, wave = __builtin_amdgcn_readfirstlane(tid >> 6), G = gridDim.x, bid = blockIdx.x, gw = bid * NWAVES + wave, NGW = G * NWAVES; (void)lane; (void)wave; (void)gw; (void)NGW; (void)G; (void)bid
__device__ __forceinline__ bf16* wsb(const Args& A, size_t off) { return (bf16*)(A.ws + off); }
__device__ __forceinline__ float* wsf(const Args& A, size_t off) { return (float*)(A.ws + off); }
__device__ __forceinline__ float softplusf_(float x) { return fmaxf(x, 0.f) + log1pf(__expf(-fabsf(x))); }
__device__ __forceinline__ void tr_item(const float* W, int N, int K, int k0, int c0, bf16* WT, int drow0, LAS float* scr, int lane) {
#pragma unroll 8
    for (int i = 0; i < 32; ++i) { const int kk = 2 * i + (lane >> 5); scr[kk * 33 + (lane & 31)] = W[(size_t)(k0 + kk) * N + c0 + (lane & 31)]; }
    WAVE_SYNC();
    const int c = lane & 7;
#pragma unroll
    for (int j = 0; j < 4; ++j) { const int n = (lane >> 3) + 8 * j; const LAS float* s = scr + (8 * c) * 33 + n;
        v4u o; o.x = pk2(s[0 * 33], s[1 * 33]); o.y = pk2(s[2 * 33], s[3 * 33]); o.z = pk2(s[4 * 33], s[5 * 33]); o.w = pk2(s[6 * 33], s[7 * 33]);
        *(v4u*)(WT + (size_t)(drow0 + n) * K + k0 + 8 * c) = o; }
    WAVE_SYNC();
}
__device__ __forceinline__ void ph_prologue(const Args& A, LAS unsigned char* lds) {
    TIDS;
    LAS float* scr = (LAS float*)(lds + wave * 16384);
    constexpr int I_ADA = 16 * 192, I_IN1 = 16 * 64, I_IN2 = 16 * 24, I_GT = 16 * 128, I_GLU = 4 * 8, I_BR = 4 * 4 * 32, I_WO_ = 16 * 32, I_UP = 16 * 176, I_DN = 44 * 32;
    constexpr int PER_L = I_ADA + I_IN1 + I_IN2 + I_GT + I_GLU + I_BR + I_WO_ + I_UP + I_DN;
    for (int it = gw; it < DEPTH * PER_L; it += NGW) {
        const int l = it / PER_L; int r = it % PER_L; unsigned char* wl = A.ws + WS_W + (size_t)l * WL_SIZE;
        if (r < I_ADA) { const int kb = r / 192, nb = r % 192; tr_item(A.in[I_WADA] + (size_t)l * D * NMOD, NMOD, D, kb * 64, nb * 32, (bf16*)(wl + WL_ADA), nb * 32, scr, lane); continue; } r -= I_ADA;
        if (r < I_IN1) { const int kb = r / 64, nb = r % 64; tr_item(A.in[I_WIN] + (size_t)l * D * NIN, NIN, D, kb * 64, nb * 32, (bf16*)(wl + WL_W1), nb * 32, scr, lane); continue; } r -= I_IN1;
        if (r < I_IN2) { const int kb = r / 24, nb = r % 24; tr_item(A.in[I_WIN] + (size_t)l * D * NIN, NIN, D, kb * 64, 2056 + nb * 32, (bf16*)(wl + WL_W1), 2048 + nb * 32, scr, lane); continue; } r -= I_IN2;
        if (r < I_GT) { const int kb = r / 128, nb = r % 128; tr_item(A.in[I_WGATE] + (size_t)l * D * NGATE, NGATE, D, kb * 64, nb * 32, (bf16*)(wl + WL_W1), NPROJ + nb * 32, scr, lane); continue; } r -= I_GT;
        if (r < I_GLU) { const int kb = r / 8, nb = r % 8; tr_item(A.in[I_WGLU] + (size_t)l * 256 * 256, 256, 256, kb * 64, nb * 32, (bf16*)(wl + WL_GLU), nb * 32, scr, lane); continue; } r -= I_GLU;
        if (r < I_BR) { const int n = r / 128, r2 = r % 128, kb = r2 / 32, nb = r2 % 32; tr_item(A.in[I_WBR] + (size_t)(l * 4 + n) * 256 * D, D, 256, kb * 64, nb * 32, (bf16*)(wl + WL_BR), n * D + nb * 32, scr, lane); continue; } r -= I_BR;
        if (r < I_WO_) { const int kb = r / 32, nb = r % 32; tr_item(A.in[I_WO] + (size_t)l * D * D, D, D, kb * 64, nb * 32, (bf16*)(wl + WL_WO), nb * 32, scr, lane); continue; } r -= I_WO_;
        if (r < I_UP) { const int kb = r / 176, nb = r % 176; const int c0 = nb * 32, j = c0 < DFF ? c0 : c0 - DFF; const int drow = (j / 128) * 256 + (c0 < DFF ? 0 : 128) + (j % 128);
            tr_item(A.in[I_WUP] + (size_t)l * D * NUP, NUP, D, kb * 64, c0, (bf16*)(wl + WL_UP), drow, scr, lane); continue; } r -= I_UP;
        { const int kb = r / 32, nb = r % 32; tr_item(A.in[I_WDN] + (size_t)l * DFF * D, D, DFF, kb * 64, nb * 32, (bf16*)(wl + WL_DN), nb * 32, scr, lane); }
    }
    const int gt = bid * (NWAVES * 64) + tid, NGT = G * NWAVES * 64;
    for (int i = gt; i < DEPTH * 8 * D; i += NGT) { const int l = i / (8 * D), j = (i / D) % 8, k = i % D; ((float*)(A.ws + WS_W + (size_t)l * WL_SIZE + WL_LOG))[j * D + k] = A.in[I_WIN][((size_t)l * D + k) * NIN + 2048 + j]; }
    for (int i = gt; i < 256 * D; i += NGT) { const int r = i / D, k = i % D; float v = 0.f;
        if (r < NB) v = siluf_(A.in[I_CP][r * D + k]); else if (r < NSEQ) v = siluf_(A.in[I_CS][(r - NB) * D + k]);
        wsb(A, WS_CSILU)[i] = (bf16)f2bf(v); }
}
struct ModOrder {
    int G, c;
    __host__ __device__ bool next(int i, pg8::Unit& u) const { const int L = i * G + c; if (L >= 24 * DEPTH) return false; const int l = L / 24, pn = L % 24;
        u.pm = 0; u.pn = l * (int)(WL_SIZE / (512 * 1024)) + pn; u.ka = 0; u.kb = 0; u.aux = pn | (l << 8); return true; }
    __device__ __forceinline__ void a_ready(const pg8::Unit&) const {}
    __device__ __forceinline__ void done(const pg8::Unit&) const {}
};
struct EpiMod2 { static constexpr bool PERM = false; typedef pg8::NoState State; float* C; const float* bias;
    __device__ __forceinline__ void operator()(const f32x4 (&acc)[2][2][4][2], State& st, const pg8::Unit& u, int wr, int wc, int fr, int fq) const {
        const int l = u.aux >> 8; pg8::Unit u2 = u; u2.aux = u.aux & 255; pg8::EpiMod e{C + (size_t)l * 256 * NMOD, bias + (size_t)l * NMOD}; e(acc, st, u2, wr, wc, fr, fq); } };
template <int MODE> __device__ __forceinline__ void ph_rows(const Args& A, int l) {
    TIDS;
    const float* MOD = wsf(A, WS_MOD);
    for (int m = gw; m < M; m += NGW) {
        const float* src; float* dstx = nullptr;
        if (MODE == 0) src = m < MP ? A.in[I_XP] + (size_t)m * D : A.in[I_XS] + (size_t)(m - MP) * D;
        else if (MODE == 1) { src = wsf(A, WS_X1) + (size_t)m * D; dstx = wsf(A, WS_X1) + (size_t)m * D; }
        else { src = wsf(A, WS_X2) + (size_t)m * D; dstx = (l == DEPTH - 1) ? A.out + O_Y + (size_t)m * D : wsf(A, WS_X2) + (size_t)m * D; }
        f32x4 v[4];
#pragma unroll
        for (int j = 0; j < 4; ++j) v[j] = ((const f32x4*)src)[lane + 64 * j];
        if (MODE != 0 && m >= MP) {
            constexpr int NKS = MODE == 1 ? 4 : DFF / 256;
            const float* xin = MODE == 1 ? (l == 0 ? A.in[I_XS] + (size_t)(m - MP) * D : wsf(A, WS_X2) + (size_t)m * D) : wsf(A, WS_X1) + (size_t)m * D;
            const float* gr = MOD + ((size_t)l * 256 + seq_of(m)) * NMOD + (MODE == 1 ? 2 * D : 5 * D);
#pragma unroll
            for (int j = 0; j < 4; ++j) { f32x4 sacc = {0.f, 0.f, 0.f, 0.f};
#pragma unroll
                for (int ks = 0; ks < NKS; ++ks) sacc += ((const f32x4*)(wsf(A, WS_PART) + ((size_t)ks * MS + (m - MP)) * D))[lane + 64 * j];
                v[j] = ((const f32x4*)xin)[lane + 64 * j] * ALPHA + (((const f32x4*)gr)[lane + 64 * j] + 1.0f) * sacc; } }
        if (MODE != 0) {
            float s = 0.f;
#pragma unroll
            for (int j = 0; j < 4; ++j) s += (v[j][0] + v[j][1]) + (v[j][2] + v[j][3]);
            const float mean = wave_sum(s) * (1.f / D); float s2 = 0.f;
#pragma unroll
            for (int j = 0; j < 4; ++j) { v[j] = v[j] - mean; s2 += (v[j][0] * v[j][0] + v[j][1] * v[j][1]) + (v[j][2] * v[j][2] + v[j][3] * v[j][3]); }
            const float rstd = 1.f / sqrtf(wave_sum(s2) * (1.f / D) + LN_EPS);
            const float* gp = A.in[MODE == 1 ? I_L1G : I_L2G] + (size_t)l * D; const float* bp = A.in[MODE == 1 ? I_L1B : I_L2B] + (size_t)l * D;
#pragma unroll
            for (int j = 0; j < 4; ++j) { const f32x4 g = ((const f32x4*)gp)[lane + 64 * j], b = ((const f32x4*)bp)[lane + 64 * j]; v[j] = v[j] * rstd * g + b; ((f32x4*)dstx)[lane + 64 * j] = v[j]; }
            if (MODE == 2 && l == DEPTH - 1) continue;
        }
        const int ln = (MODE == 2) ? l + 1 : l;
        const float* mr = MOD + ((size_t)ln * 256 + seq_of(m)) * NMOD + (MODE == 1 ? 3 * D : 0);
        float s = 0.f;
#pragma unroll
        for (int j = 0; j < 4; ++j) s += (v[j][0] + v[j][1]) + (v[j][2] + v[j][3]);
        const float mean = wave_sum(s) * (1.f / D); float s2 = 0.f;
#pragma unroll
        for (int j = 0; j < 4; ++j) { v[j] = v[j] - mean; s2 += (v[j][0] * v[j][0] + v[j][1] * v[j][1]) + (v[j][2] * v[j][2] + v[j][3] * v[j][3]); }
        const float rstd = 1.f / sqrtf(wave_sum(s2) * (1.f / D) + LN_EPS);
        v2u* hrow = (v2u*)(wsb(A, WS_H) + (size_t)m * D);
#pragma unroll
        for (int j = 0; j < 4; ++j) { const f32x4 sh = ((const f32x4*)mr)[lane + 64 * j], sc = ((const f32x4*)(mr + D))[lane + 64 * j]; v[j] = v[j] * rstd * (sc + 1.0f) + sh;
            v2u o; o.x = pk2(v[j][0], v[j][1]); o.y = pk2(v[j][2], v[j][3]); hrow[lane + 64 * j] = o; }
        if (MODE != 1) {
            const float* wl = (const float*)(A.ws + WS_W + (size_t)ln * WL_SIZE + WL_LOG);
            float lg[8];
#pragma unroll
            for (int jj = 0; jj < 8; ++jj) { float t = 0.f;
#pragma unroll
                for (int j = 0; j < 4; ++j) { const f32x4 w = ((const f32x4*)(wl + jj * D))[lane + 64 * j]; t += (v[j][0] * w[0] + v[j][1] * w[1]) + (v[j][2] * w[2] + v[j][3] * w[3]); }
                lg[jj] = wave_sum(t); }
            if (lane == 0) { float* o = wsf(A, WS_LOG8) + (size_t)m * 8; *(f32x4*)o = (f32x4){lg[0], lg[1], lg[2], lg[3]}; *(f32x4*)(o + 4) = (f32x4){lg[4], lg[5], lg[6], lg[7]}; }
        }
    }
}
struct SsmC { float abr, abi, bbr[16], bbi[16]; };
__device__ __forceinline__ void ssm_consts(const Args& A, int l, int g, int p, SsmC& c) {
    const int gi = l * 16 + g;
    const float dt = expf(A.in[I_LDT][gi]), ar = A.in[I_ARE][gi * 64 + p], ai = A.in[I_AIM][gi * 64 + p];
    const float mag = expf(dt * ar); c.abr = mag * cosf(dt * ai); c.abi = mag * sinf(dt * ai);
    const float den = ar * ar + ai * ai, fre = ((c.abr - 1.0f) * ar + c.abi * ai) / den, fim = (c.abi * ar - (c.abr - 1.0f) * ai) / den;
    const f32x4* br = (const f32x4*)(A.in[I_BRE] + (size_t)(gi * 64 + p) * 16); const f32x4* bi = (const f32x4*)(A.in[I_BIM] + (size_t)(gi * 64 + p) * 16);
#pragma unroll
    for (int q = 0; q < 4; ++q) { const f32x4 r = br[q], i = bi[q];
#pragma unroll
        for (int e = 0; e < 4; ++e) { c.bbr[4 * q + e] = fre * r[e] - fim * i[e]; c.bbi[4 * q + e] = fre * i[e] + fim * r[e]; } }
}
__device__ __forceinline__ void ssm_step(const SsmC& c, const bf16* urow, float& hr, float& hi) {
    const v4u u0 = *(const v4u*)urow, u1 = *(const v4u*)(urow + 8);
    float u[16] = {bflo(u0.x), bfhi(u0.x), bflo(u0.y), bfhi(u0.y), bflo(u0.z), bfhi(u0.z), bflo(u0.w), bfhi(u0.w), bflo(u1.x), bfhi(u1.x), bflo(u1.y), bfhi(u1.y), bflo(u1.z), bfhi(u1.z), bflo(u1.w), bfhi(u1.w)};
    float br = 0.f, bi = 0.f;
#pragma unroll
    for (int h = 0; h < 16; ++h) { br += c.bbr[h] * u[h]; bi += c.bbi[h] * u[h]; }
    const float nr = c.abr * hr - c.abi * hi + br, ni = c.abr * hi + c.abi * hr + bi; hr = nr; hi = ni;
}
constexpr int SSM_NCT = (NB * SSM_NCH + 15) / 16;
__device__ __forceinline__ void ph_ssm1(const Args& A, int l) {
    TIDS;
    const bf16* proj = wsb(A, WS_PROJ); const int gg = lane >> 4, i16 = lane & 15;
    for (int un = gw; un < 16 * 8 * SSM_NCT; un += NGW) {
        const int ctile = un % SSM_NCT, rt = (un / SSM_NCT) % 8, g = un / (SSM_NCT * 8);
        const int cidx = ctile * 16 + i16; const bool valid = cidx < NB * SSM_NCH; const int b = valid ? cidx / SSM_NCH : 0, c = valid ? cidx % SSM_NCH : 0;
        const bf16* up = proj + (size_t)(b * SEQ + c * SSM_CH + (gg >> 1)) * NPROJ + PC_U + g * 16 + 8 * (gg & 1);
        const bf16x8* wf = (const bf16x8*)(A.ws + WS_SSMW + (size_t)l * SSMW_L) + (size_t)((g * 8 + rt) * (SSM_CH / 2)) * 64 + lane;
        f32x4 acc = {0.f, 0.f, 0.f, 0.f};
#pragma unroll 8
        for (int ks = 0; ks < SSM_CH / 2; ++ks) { bf16x8 bv = *(const bf16x8*)(up + (size_t)(2 * ks) * NPROJ); if (!valid) bv = (bf16x8){0, 0, 0, 0, 0, 0, 0, 0};
            acc = __builtin_amdgcn_mfma_f32_16x16x32_bf16(wf[(size_t)ks * 64], bv, acc, 0, 0, 0); }
        if (valid) *(f32x4*)(wsf(A, WS_SEND) + ((size_t)(b * 16 + g) * SSM_NCH + c) * 128 + 16 * rt + 4 * gg) = acc;
    }
}
__device__ __forceinline__ void ph_ssm_weights(const Args& A) {
    TIDS;
    const int gt = bid * (NWAVES * 64) + tid, NGT = G * NWAVES * 64;
    for (int it = gt; it < DEPTH * 16 * 8 * (SSM_CH / 2) * 64; it += NGT) {
        const int ln = it & 63, ks = (it >> 6) % (SSM_CH / 2), rt = (it / (64 * (SSM_CH / 2))) % 8, g = (it / (64 * (SSM_CH / 2) * 8)) % 16, l = it / (64 * (SSM_CH / 2) * 8 * 16);
        const int gg = ln >> 4, rs = 16 * rt + (ln & 15), p = rs & 63, t = 2 * ks + (gg >> 1), h0 = 8 * (gg & 1), gi = l * 16 + g;
        const float dt = expf(A.in[I_LDT][gi]), ar = A.in[I_ARE][gi * 64 + p], ai = A.in[I_AIM][gi * 64 + p];
        const float mag = expf(dt * ar), abr = mag * cosf(dt * ai), abi = mag * sinf(dt * ai);
        const float den = ar * ar + ai * ai, fre = ((abr - 1.0f) * ar + abi * ai) / den, fim = (abi * ar - (abr - 1.0f) * ai) / den;
        const float n = (float)(SSM_CH - 1 - t), pm = expf(n * dt * ar), pr = pm * cosf(n * dt * ai), pi = pm * sinf(n * dt * ai);
        const float cr = pr * fre - pi * fim, ci = pr * fim + pi * fre;
        const float* br = A.in[I_BRE] + (size_t)(gi * 64 + p) * 16 + h0; const float* bi = A.in[I_BIM] + (size_t)(gi * 64 + p) * 16 + h0;
        float v[8];
#pragma unroll
        for (int j = 0; j < 8; ++j) v[j] = rs < 64 ? cr * br[j] - ci * bi[j] : cr * bi[j] + ci * br[j];
        v4u o; o.x = pk2(v[0], v[1]); o.y = pk2(v[2], v[3]); o.z = pk2(v[4], v[5]); o.w = pk2(v[6], v[7]);
        ((v4u*)(A.ws + WS_SSMW + (size_t)l * SSMW_L))[(size_t)((g * 8 + rt) * (SSM_CH / 2) + ks) * 64 + ln] = o;
    }
}
__device__ __forceinline__ float gelu_tanh(float x) { const float e = __expf(2.0f * 0.7978845608028654f * (x + 0.044715f * x * x * x)); return 0.5f * x * (2.0f - 2.0f / (1.0f + e)); }
__device__ __forceinline__ void ph_ssm2(const Args& A, LAS unsigned char* lds, int l, int vb, int vg) {
    TIDSV(vb, vg);
    LAS float* uf = (LAS float*)(lds + wave * 16384);
    LAS bf16* ht = (LAS bf16*)(uf + 256);
    const bf16* proj = wsb(A, WS_PROJ);
    const int gg = lane >> 4, i16 = lane & 15;
    constexpr int NPU = NB * 16 * SSM_NCH, NSU = DB * 16;
    for (int un = gw; un < NPU + NSU; un += NGW) {
        int g, m0, ntok; float hr, hi; float* fre = nullptr; float* fim = nullptr;
        if (un < NPU) { const int c = un % SSM_NCH; g = (un / SSM_NCH) % 16; const int b = un / (SSM_NCH * 16); m0 = b * SEQ + c * SSM_CH; ntok = SSM_CH;
            {
              const int gi0 = l * 16 + g; const float dt0 = expf(A.in[I_LDT][gi0]), ar0 = A.in[I_ARE][gi0 * 64 + lane], ai0 = A.in[I_AIM][gi0 * 64 + lane];
              const float mg0 = expf(dt0 * ar0); float pr = mg0 * cosf(dt0 * ai0), pi = mg0 * sinf(dt0 * ai0);
              for (int sq = 1; sq < SSM_CH; sq <<= 1) { const float nr = pr * pr - pi * pi, ni = 2.f * pr * pi; pr = nr; pi = ni; }
              hr = 0.f; hi = 0.f; const float* sp = wsf(A, WS_SEND) + (size_t)(un - c) * 128 + lane;
#pragma unroll 4
              for (int c2 = 0; c2 < c; ++c2) { const float sr = sp[(size_t)c2 * 128], si = sp[(size_t)c2 * 128 + 64]; const float nr = pr * hr - pi * hi + sr, ni = pr * hi + pi * hr + si; hr = nr; hi = ni; } }
            if (c == SSM_NCH - 1) { fre = A.out + O_REP + ((size_t)(l * NB + b) * 16 + g) * 64; fim = A.out + O_IMP + ((size_t)(l * NB + b) * 16 + g) * 64; } }
        else { const int su = un - NPU; g = su & 15; const int s = su >> 4; m0 = MP + s * DEC_SEQ; ntok = DEC_SEQ;
            hr = A.in[I_SRE][((size_t)(l * DB + s) * 16 + g) * 64 + lane]; hi = A.in[I_SIM][((size_t)(l * DB + s) * 16 + g) * 64 + lane];
            fre = A.out + O_RES + ((size_t)(l * DB + s) * 16 + g) * 64; fim = A.out + O_IMS + ((size_t)(l * DB + s) * 16 + g) * 64; }
        SsmC k; ssm_consts(A, l, g, lane, k);
        const int gi = l * 16 + g;
        bf16x8 Cb[4];
#pragma unroll
        for (int ks = 0; ks < 4; ++ks) { const float* cp = A.in[ks < 2 ? I_CRE : I_CIM] + ((size_t)gi * 16 + i16) * 64 + 32 * (ks & 1) + 8 * gg; const float sg = ks < 2 ? 1.0f : -1.0f;
            const f32x4 c0 = *(const f32x4*)cp * sg, c1 = *(const f32x4*)(cp + 4) * sg; Cb[ks] = acc2b(c0, c1); }
        const float dd = A.in[I_SSD][l * 256 + g * 16 + i16];
        for (int t0 = 0; t0 < ntok; t0 += 16) {
            const int nt = (ntok - t0) < 16 ? (ntok - t0) : 16;
            { const int tt = lane >> 2, c4 = (lane & 3) * 4;
              if (tt < nt) { const v2u w = *(const v2u*)(proj + (size_t)(m0 + t0 + tt) * NPROJ + PC_U + g * 16 + c4); *(LAS f32x4*)(uf + tt * 16 + c4) = (f32x4){bflo(w.x), bfhi(w.x), bflo(w.y), bfhi(w.y)}; } }
            WAVE_SYNC();
            for (int t = 0; t < nt; ++t) {
                float br = 0.f, bi = 0.f;
#pragma unroll
                for (int q = 0; q < 4; ++q) { const f32x4 u = *(const LAS f32x4*)(uf + t * 16 + 4 * q);
#pragma unroll
                    for (int e = 0; e < 4; ++e) { br += k.bbr[4 * q + e] * u[e]; bi += k.bbi[4 * q + e] * u[e]; } }
                const float nr = k.abr * hr - k.abi * hi + br, ni = k.abr * hi + k.abi * hr + bi; hr = nr; hi = ni;
                ht[t * 136 + lane] = (bf16)f2bf(hr); ht[t * 136 + 64 + lane] = (bf16)f2bf(hi);
            }
            WAVE_SYNC();
            f32x4 acc = {0.f, 0.f, 0.f, 0.f};
#pragma unroll
            for (int ks = 0; ks < 4; ++ks) acc = __builtin_amdgcn_mfma_f32_16x16x32_bf16(*(const LAS bf16x8*)(ht + i16 * 136 + 32 * ks + 8 * gg), Cb[ks], acc, 0, 0, 0);
#pragma unroll
            for (int r = 0; r < 4; ++r) { const int tt = 4 * gg + r;
                if (tt < nt) { const float y = acc[r] + dd * uf[tt * 16 + i16]; wsb(A, WS_YS)[(size_t)(m0 + t0 + tt) * 256 + g * 16 + i16] = (bf16)f2bf(gelu_tanh(y)); } }
            WAVE_SYNC();
        }
        if (fre) { fre[lane] = hr; fim[lane] = hi; }
    }
}
__device__ __forceinline__ void ph_conv(const Args& A, int l, int vb, int vg) {
    TIDSV(vb, vg);
    const int gt = bid * (NWAVES * 64) + tid, NGT = G * NWAVES * 64;
    const bf16* proj = wsb(A, WS_PROJ);
    for (int i = gt; i < M * 128; i += NGT) {
        const int m = i >> 7, c = (i & 127) * 2;
        int t, L; const float* hist = nullptr; float* so;
        if (m < MP) { t = m % SEQ; L = SEQ; so = A.out + O_CBP + (size_t)(l * NB + m / SEQ) * 512; }
        else { const int s = (m - MP) / DEC_SEQ; t = (m - MP) % DEC_SEQ; L = DEC_SEQ; hist = A.in[I_SCB] + (size_t)(l * DB + s) * 512; so = A.out + O_CBS + (size_t)(l * DB + s) * 512; }
        float cx0[3], cx1[3];
#pragma unroll
        for (int j = 0; j < 3; ++j) { const int tt = t - 2 + j;
            if (tt >= 0) { const bf16* r = proj + (size_t)(m - 2 + j) * NPROJ; const unsigned cg = *(const unsigned*)(r + PC_CG + c), xc = *(const unsigned*)(r + PC_XC + c); cx0[j] = bflo(cg) * bflo(xc); cx1[j] = bfhi(cg) * bfhi(xc); }
            else if (hist) { cx0[j] = hist[(2 + tt) * 256 + c]; cx1[j] = hist[(2 + tt) * 256 + c + 1]; }
            else { cx0[j] = 0.f; cx1[j] = 0.f; } }
        const float* w = A.in[I_CBW] + (size_t)l * 3 * 256;
        const float o0 = w[c] * cx0[0] + w[256 + c] * cx0[1] + w[512 + c] * cx0[2], o1 = w[c + 1] * cx1[0] + w[256 + c + 1] * cx1[1] + w[512 + c + 1] * cx1[2];
        const unsigned bg = *(const unsigned*)(proj + (size_t)m * NPROJ + PC_BG + c);
        *(unsigned*)(wsb(A, WS_Y) + (size_t)m * D + 256 + c) = pk2(bflo(bg) * o0, bfhi(bg) * o1);
        if (t >= L - 2) { so[(t - (L - 2)) * 256 + c] = cx0[2]; so[(t - (L - 2)) * 256 + c + 1] = cx1[2]; }
    }
}
__device__ __forceinline__ void ph_gdn_c1(const Args& A, LAS unsigned char* lds, int l) {
    TIDS;
    constexpr int XS = 72, GS = 68, RS = 132;
    LAS bf16* Qs = (LAS bf16*)lds; LAS bf16* Ks = Qs + 64 * XS; LAS bf16* Vs = Ks + 64 * XS;
    LAS float* GKK = (LAS float*)(lds + 27648); LAS float* GQK = GKK + 64 * GS; LAS float* rhs = GQK + 64 * GS;
    LAS float* Linv = rhs + 64 * RS; LAS float* sc = Linv + 1024;
    LAS float* DQ = sc, *DK = sc + 64, *RQ = sc + 128, *RK = sc + 192, *BET = sc + 256, *GC = sc + 320, *EGC = sc + 384, *EK = sc + 448;
    LAS float* Wst = GQK;
    const bf16* proj = wsb(A, WS_PROJ); const float* cw = A.in[I_DCW] + (size_t)l * 4 * GQKV; const float* lg8 = wsf(A, WS_LOG8);
    const int g = lane >> 4, i16 = lane & 15;
    for (int un = bid; un < NB * GH * GNCH; un += G) {
        const int c = un % GNCH, h = (un / GNCH) % GH, b = un / (GNCH * GH); const int m0 = b * SEQ + c * GCH;
        unsigned char* gd = A.ws + WS_GD + (size_t)un * GD_UNIT;
        if (wave < 6) { const int sec = wave >> 1, th = wave & 1, src = sec * 256 + h * 64 + lane, t0 = c * GCH + th * 32;
            const float w0 = cw[src], w1 = cw[GQKV + src], w2 = cw[2 * GQKV + src], w3 = cw[3 * GQKV + src];
            float x[35];
#pragma unroll
            for (int k = 0; k < 35; ++k) { const int tt = t0 - 3 + k; x[k] = tt >= 0 ? bf2f(proj[(size_t)(b * SEQ + tt) * NPROJ + PC_QKV + src]) : 0.f; }
            LAS bf16* X = sec == 0 ? Qs : (sec == 1 ? Ks : Vs);
#pragma unroll
            for (int k = 0; k < 32; ++k) X[(th * 32 + k) * XS + lane] = (bf16)f2bf(siluf_(w0 * x[k] + w1 * x[k + 1] + w2 * x[k + 2] + w3 * x[k + 3]));
            if (c == GNCH - 1 && th == 1) {
#pragma unroll
                for (int k = 0; k < 3; ++k) A.out[O_CDP + ((size_t)(l * NB + b) * 3 + k) * GQKV + src] = x[32 + k]; } }
        __syncthreads();
#pragma unroll
        for (int q2 = 0; q2 < 2; ++q2) { const int tt = 2 * wave + q2, rt = tt >> 2, ct = tt & 3;
            f32x4 akk = {0.f, 0.f, 0.f, 0.f}, aqk = {0.f, 0.f, 0.f, 0.f};
#pragma unroll
            for (int s = 0; s < 2; ++s) { const bf16x8 kc = *(const LAS bf16x8*)(Ks + (16 * ct + i16) * XS + 32 * s + 8 * g), kr = *(const LAS bf16x8*)(Ks + (16 * rt + i16) * XS + 32 * s + 8 * g),
                                                         qr = *(const LAS bf16x8*)(Qs + (16 * rt + i16) * XS + 32 * s + 8 * g);
                akk = __builtin_amdgcn_mfma_f32_16x16x32_bf16(kr, kc, akk, 0, 0, 0); aqk = __builtin_amdgcn_mfma_f32_16x16x32_bf16(qr, kc, aqk, 0, 0, 0); }
#pragma unroll
            for (int r = 0; r < 4; ++r) { GKK[(16 * rt + 4 * g + r) * GS + 16 * ct + i16] = akk[r]; GQK[(16 * rt + 4 * g + r) * GS + 16 * ct + i16] = aqk[r]; }
            if (rt == ct && g == (i16 >> 2)) { const int r = i16 & 3; DK[16 * rt + i16] = r == 0 ? akk[0] : r == 1 ? akk[1] : r == 2 ? akk[2] : akk[3]; } }
        if (wave < 4) { f32x4 aqq = {0.f, 0.f, 0.f, 0.f};
#pragma unroll
            for (int s = 0; s < 2; ++s) { const bf16x8 qr = *(const LAS bf16x8*)(Qs + (16 * wave + i16) * XS + 32 * s + 8 * g); aqq = __builtin_amdgcn_mfma_f32_16x16x32_bf16(qr, qr, aqq, 0, 0, 0); }
            if (g == (i16 >> 2)) { const int r = i16 & 3; DQ[16 * wave + i16] = r == 0 ? aqq[0] : r == 1 ? aqq[1] : r == 2 ? aqq[2] : aqq[3]; } }
        __syncthreads();
        if (wave == 0) { const float* lr = lg8 + (size_t)(m0 + lane) * 8;
            const float gv = -expf(A.in[I_DAL][l * 4 + h]) * softplusf_(lr[4 + h] + A.in[I_DDT][l * 4 + h]);
            float gc = gv;
#pragma unroll
            for (int o = 1; o < 64; o <<= 1) { const float t = __shfl_up(gc, o); if (lane >= o) gc += t; }
            const float gl = __shfl(gc, 63);
            RK[lane] = 1.0f / sqrtf(DK[lane] + RMS_EPS); RQ[lane] = 0.125f / sqrtf(DQ[lane] + RMS_EPS); BET[lane] = sigmoidf_(lr[h]); GC[lane] = gc; EGC[lane] = expf(gc); EK[lane] = expf(gl - gc);
            if (lane == 0) wsf(A, WS_EGL)[un] = expf(gl); }
        __syncthreads();
        for (int idx = tid; idx < 4096; idx += 512) { const int i = idx >> 6, j = idx & 63; GKK[i * GS + j] = i > j ? BET[i] * RK[i] * RK[j] * GKK[i * GS + j] * expf(GC[i] - GC[j]) : 0.f; }
        for (int idx = tid; idx < 64 * 128; idx += 512) { const int i = idx >> 7, cc = idx & 127; rhs[i * RS + cc] = cc < 64 ? BET[i] * bf2f(Vs[i * XS + cc]) : BET[i] * EGC[i] * RK[i] * bf2f(Ks[i * XS + cc - 64]); }
        for (int idx = tid; idx < 4096; idx += 512) { const int f = idx >> 9, ln = (idx >> 3) & 63, j = idx & 7, row = 16 * (f >> 1) + (ln & 15), kx = 32 * (f & 1) + 16 * (j >> 2) + 4 * (ln >> 4) + (j & 3);
            ((bf16*)gd)[8192 + idx] = (bf16)f2bf(row >= kx ? RQ[row] * RK[kx] * GQK[row * GS + kx] * expf(GC[row] - GC[kx]) : 0.f);
            ((bf16*)gd)[4096 + idx] = (bf16)f2bf(bf2f(Qs[row * XS + kx]) * RQ[row] * EGC[row]);
            ((bf16*)gd)[12288 + idx] = (bf16)f2bf(bf2f(Ks[kx * XS + row]) * RK[kx] * EK[kx]); }
        __syncthreads();
        if (wave == 0) { const int blk = lane >> 4, cI = lane & 15; float x[16];
            x[0] = cI == 0 ? 1.f : 0.f;
#pragma unroll
            for (int i = 1; i < 16; ++i) { float sacc = cI == i ? 1.f : 0.f;
#pragma unroll
                for (int j = 0; j < i; ++j) sacc -= GKK[(16 * blk + i) * GS + 16 * blk + j] * x[j];
                x[i] = sacc; }
#pragma unroll
            for (int i = 0; i < 16; ++i) Linv[blk * 256 + i * 16 + cI] = x[i]; }
        __syncthreads();
        { const f32x4 Z = {0.f, 0.f, 0.f, 0.f}; f32x4 X[4];
#define C1_LD4(p) ((f32x4)(*(const LAS f32x4*)(p)) * 1.0f)
#define C1_LF(I) acc2b(C1_LD4(Linv + (I) * 256 + i16 * 16 + 4 * g), Z)
#define C1_MF2(I, J) acc2b(-*(const LAS f32x4*)(GKK + (16 * (I) + i16) * GS + 16 * (J) + 4 * g), -*(const LAS f32x4*)(GKK + (16 * (I) + i16) * GS + 16 * ((J) + 1) + 4 * g))
#define C1_MF1(I, J) acc2b(-*(const LAS f32x4*)(GKK + (16 * (I) + i16) * GS + 16 * (J) + 4 * g), Z)
#define C1_R(I) (f32x4){rhs[(16 * (I) + 4 * g) * RS + 16 * wave + i16], rhs[(16 * (I) + 4 * g + 1) * RS + 16 * wave + i16], rhs[(16 * (I) + 4 * g + 2) * RS + 16 * wave + i16], rhs[(16 * (I) + 4 * g + 3) * RS + 16 * wave + i16]}
            f32x4 R = C1_R(0);
            X[0] = __builtin_amdgcn_mfma_f32_16x16x32_bf16(C1_LF(0), acc2b(R, Z), Z, 0, 0, 0);
            R = C1_R(1); R = __builtin_amdgcn_mfma_f32_16x16x32_bf16(C1_MF1(1, 0), acc2b(X[0], Z), R, 0, 0, 0);
            X[1] = __builtin_amdgcn_mfma_f32_16x16x32_bf16(C1_LF(1), acc2b(R, Z), Z, 0, 0, 0);
            const bf16x8 X01 = acc2b(X[0], X[1]);
            R = C1_R(2); R = __builtin_amdgcn_mfma_f32_16x16x32_bf16(C1_MF2(2, 0), X01, R, 0, 0, 0);
            X[2] = __builtin_amdgcn_mfma_f32_16x16x32_bf16(C1_LF(2), acc2b(R, Z), Z, 0, 0, 0);
            R = C1_R(3); R = __builtin_amdgcn_mfma_f32_16x16x32_bf16(C1_MF2(3, 0), X01, R, 0, 0, 0); R = __builtin_amdgcn_mfma_f32_16x16x32_bf16(C1_MF1(3, 2), acc2b(X[2], Z), R, 0, 0, 0);
            X[3] = __builtin_amdgcn_mfma_f32_16x16x32_bf16(C1_LF(3), acc2b(R, Z), Z, 0, 0, 0);
#undef C1_LF
#undef C1_LD4
#undef C1_MF2
#undef C1_MF1
#undef C1_R
            if (wave < 4) {
#pragma unroll
                for (int I = 0; I < 4; ++I) ((f32x4*)(gd + 32768))[(wave * 4 + I) * 64 + lane] = X[I]; }
            else {
#pragma unroll
                for (int I = 0; I < 4; ++I)
#pragma unroll
                    for (int r = 0; r < 4; ++r) Wst[(16 * I + 4 * g + r) * GS + 16 * (wave - 4) + i16] = -X[I][r]; } }
        __syncthreads();
        for (int idx = tid; idx < 4096; idx += 512) { const int f = idx >> 9, ln = (idx >> 3) & 63, j = idx & 7, row = 16 * (f >> 1) + (ln & 15), kx = 32 * (f & 1) + 16 * (j >> 2) + 4 * (ln >> 4) + (j & 3);
            ((bf16*)gd)[idx] = (bf16)f2bf(Wst[row * GS + kx]); }
        __syncthreads();
    }
}
__device__ __forceinline__ void ph_gdn_scan(const Args& A, LAS unsigned char* lds, int l) {
    TIDS;
    for (int grp = bid; grp < NB * GH; grp += G) {
        const int h = grp % GH, b = grp / GH;
        const unsigned char* gbase = A.ws + WS_GD + (size_t)(b * GH + h) * GNCH * GD_UNIT;
        if (wave >= 4) {
            const int lw = wave - 4; v4u ra[12], rb[12];
            const v4u* src = (const v4u*)gbase + lw * 12 * 64 + lane;
            LAS v4u* dst0 = (LAS v4u*)lds + lw * 12 * 64 + lane;
#define SC_LOAD(R, c) do { if ((c) < GNCH) { _Pragma("unroll") for (int k = 0; k < 12; ++k) R[k] = src[(size_t)(c) * (GD_UNIT / 16) + k * 64]; } } while (0)
#define SC_STORE(R, c) do { if ((c) < GNCH) { LAS v4u* d_ = dst0 + ((c) & 1) * (GD_UNIT / 16); _Pragma("unroll") for (int k = 0; k < 12; ++k) d_[k * 64] = R[k]; } } while (0)
            SC_LOAD(ra, 0); SC_STORE(ra, 0); SC_LOAD(ra, 1); SC_LOAD(rb, 2);
            RAW_BAR();
            for (int c = 0; c < GNCH; c += 2) {
                SC_STORE(ra, c + 1); SC_LOAD(ra, c + 3);
                RAW_BAR();
                if (c + 1 < GNCH) { SC_STORE(rb, c + 2); SC_LOAD(rb, c + 4); RAW_BAR(); }
            }
#undef SC_LOAD
#undef SC_STORE
        } else {
            const int vs = wave, g = lane >> 4, cc = lane & 15;
            f32x4 S[4];
#pragma unroll
            for (int T = 0; T < 4; ++T) S[T] = (f32x4){0.f, 0.f, 0.f, 0.f};
            const float* eglp = wsf(A, WS_EGL) + (size_t)(b * GH + h) * GNCH;
            float egl_n = eglp[0];
            RAW_BAR();
            for (int c = 0; c < GNCH; ++c) {
                const float egl = egl_n; if (c + 1 < GNCH) egl_n = eglp[c + 1];
                const LAS unsigned char* slot = lds + (c & 1) * GD_UNIT;
                const LAS bf16x8* fr = (const LAS bf16x8*)slot + lane;
                const LAS f32x4* uvp = (const LAS f32x4*)(slot + 32768) + (vs * 4) * 64 + lane;
                bf16x8 Sb[2] = {acc2b(S[0], S[1]), acc2b(S[2], S[3])};
                f32x4 u[4], o[4];
#pragma unroll
                for (int T = 0; T < 4; ++T) { u[T] = uvp[T * 64]; o[T] = (f32x4){0.f, 0.f, 0.f, 0.f};
#pragma unroll
                    for (int s = 0; s < 2; ++s) { u[T] = __builtin_amdgcn_mfma_f32_16x16x32_bf16(fr[(0 * 8 + 2 * T + s) * 64], Sb[s], u[T], 0, 0, 0); o[T] = __builtin_amdgcn_mfma_f32_16x16x32_bf16(fr[(1 * 8 + 2 * T + s) * 64], Sb[s], o[T], 0, 0, 0); } }
                bf16x8 ub[2] = {acc2b(u[0], u[1]), acc2b(u[2], u[3])};
#pragma unroll
                for (int T = 0; T < 4; ++T) { S[T] = S[T] * egl;
#pragma unroll
                    for (int s = 0; s < 2; ++s) { S[T] = __builtin_amdgcn_mfma_f32_16x16x32_bf16(fr[(3 * 8 + 2 * T + s) * 64], ub[s], S[T], 0, 0, 0); o[T] = __builtin_amdgcn_mfma_f32_16x16x32_bf16(fr[(2 * 8 + 2 * T + s) * 64], ub[s], o[T], 0, 0, 0); } }
                float* od = wsf(A, WS_ODRAW) + (size_t)(b * SEQ + c * GCH + 4 * g) * 256 + h * 64 + vs * 16 + cc;
#pragma unroll
                for (int T = 0; T < 4; ++T)
#pragma unroll
                    for (int r = 0; r < 4; ++r) od[(size_t)(16 * T + r) * 256] = o[T][r];
                RAW_BAR();
            }
            float* so = A.out + O_DP + (((size_t)(l * NB + b) * GH + h) * 64 + 4 * g) * 64 + vs * 16 + cc;
#pragma unroll
            for (int T = 0; T < 4; ++T)
#pragma unroll
                for (int r = 0; r < 4; ++r) so[(16 * T + r) * 64] = S[T][r];
        }
        __syncthreads();
    }
}
__device__ __forceinline__ void ph_gdn_sample(const Args& A, LAS unsigned char* lds, int l, int vb, int vg) {
    TIDSV(vb, vg);
    LAS float* S = (LAS float*)(lds + wave * 16384);
    LAS float* kq = (LAS float*)(lds + MISC_OFF + 1024 + wave * 512);
    const bf16* proj = wsb(A, WS_PROJ); const float* cw = A.in[I_DCW] + (size_t)l * 4 * GQKV; const float* lg8 = wsf(A, WS_LOG8);
    if (wave < 4 || wave >= 6) return;
    for (int un = (wave - 4) * G + bid; un < DB * GH; un += 2 * G) {
        const int h = un % GH, s = un / GH;
        const float* s0 = A.in[I_SD] + ((size_t)(l * DB + s) * GH + h) * 4096;
#pragma unroll 8
        for (int kk = 0; kk < 64; ++kk) S[kk * 64 + lane] = s0[kk * 64 + lane];
        const float* hist = A.in[I_SCD] + (size_t)(l * DB + s) * 3 * GQKV;
        for (int t = 0; t < DEC_SEQ; ++t) {
            const size_t m = (size_t)MP + s * DEC_SEQ + t;
            float val[3];
#pragma unroll
            for (int sec = 0; sec < 3; ++sec) { const int src = sec * 256 + h * 64 + lane; float acc = 0.f, cur = 0.f;
#pragma unroll
                for (int j = 0; j < 4; ++j) { const int tt = t - 3 + j; const float x = tt >= 0 ? bf2f(proj[(size_t)(MP + s * DEC_SEQ + tt) * NPROJ + PC_QKV + src]) : hist[(3 + tt) * GQKV + src]; acc += cw[j * GQKV + src] * x; cur = x; }
                val[sec] = siluf_(acc);
                if (t >= 1) A.out[O_CDS + ((size_t)(l * DB + s) * 3 + (t - 1)) * GQKV + src] = cur; }
            const float sq = wave_sum(val[0] * val[0]), sk = wave_sum(val[1] * val[1]);
            const float qv = val[0] * (1.0f / sqrtf(sq + RMS_EPS)) * 0.125f, kv = val[1] * (1.0f / sqrtf(sk + RMS_EPS)), vv = val[2];
            const float* lr = lg8 + m * 8; const float beta = sigmoidf_(lr[h]); const float a = expf(-expf(A.in[I_DAL][l * 4 + h]) * softplusf_(lr[4 + h] + A.in[I_DDT][l * 4 + h]));
            kq[lane] = kv; kq[64 + lane] = qv;
            WAVE_SYNC();
            float kS = 0.f;
#pragma unroll 8
            for (int kk = 0; kk < 64; ++kk) kS += kq[kk] * S[kk * 64 + lane];
            float o = 0.f;
#pragma unroll 8
            for (int kk = 0; kk < 64; ++kk) { const float bk = beta * kq[kk]; const float sn = a * (S[kk * 64 + lane] - bk * kS) + bk * vv; S[kk * 64 + lane] = sn; o += kq[64 + kk] * sn; }
            wsf(A, WS_ODRAW)[m * 256 + h * 64 + lane] = o;
            WAVE_SYNC();
        }
        float* so = A.out + O_DS + ((size_t)(l * DB + s) * GH + h) * 4096;
#pragma unroll 8
        for (int kk = 0; kk < 64; ++kk) so[kk * 64 + lane] = S[kk * 64 + lane];
    }
}
__device__ __forceinline__ void ph_gdn_out(const Args& A, int l) {
    TIDS;
    for (int idx = gw; idx < M * GH; idx += NGW) { const size_t m = idx >> 2; const int h = idx & 3;
        const float o = wsf(A, WS_ODRAW)[m * 256 + h * 64 + lane];
        const float ms = wave_sum(o * o) * (1.0f / 64.0f);
        const float z = bf2f(wsb(A, WS_PROJ)[m * NPROJ + PC_Z + h * 64 + lane]);
        wsb(A, WS_Y)[m * D + 512 + h * 64 + lane] = (bf16)f2bf(o * (1.0f / sqrtf(ms + RMS_EPS)) * A.in[I_DNW][l * 64 + lane] * siluf_(z)); }
}
__device__ __forceinline__ void sb_terms(float z, float& ls, float& ln) { const float L = log1pf(__expf(-fabsf(z))); ls = fminf(z, 0.f) - L; ln = -fmaxf(z, 0.f) - L; }
constexpr float SB_CUT = -105.0f;
__device__ __forceinline__ void ph_sb_prompt(const Args& A, int l, int vb, int vg) {
    TIDSV(vb, vg); (void)l;
    const bf16* proj = wsb(A, WS_PROJ); const bf16* vtg = wsb(A, WS_VT);
    constexpr int NQB = SEQ / 32;
    const int g = lane >> 4, i16 = lane & 15;
    for (int un0 = gw; un0 < NB * SBH * NQB; un0 += NGW) {
        const int un = NB * SBH * NQB - 1 - un0;
        const int qb = un / (NB * SBH), h = un % SBH, b = (un / SBH) % NB;
        const int q0 = qb * 32;
        bf16x8 Qb[2][2];
#pragma unroll
        for (int ct = 0; ct < 2; ++ct)
#pragma unroll
            for (int s = 0; s < 2; ++s) Qb[ct][s] = *(const bf16x8*)(proj + ((size_t)b * SEQ + q0 + 16 * ct + i16) * NPROJ + PC_Q + h * 64 + 32 * s + 8 * g);
        f32x4 O[4][2];
#pragma unroll
        for (int rt = 0; rt < 4; ++rt) { O[rt][0] = (f32x4){0.f, 0.f, 0.f, 0.f}; O[rt][1] = (f32x4){0.f, 0.f, 0.f, 0.f}; }
        float R[2] = {0.f, 0.f};
        const bf16* vth = vtg + ((size_t)(b * SBH + h) * 64) * SEQ;
        for (int kb = q0 >> 6; kb >= 0; --kb) {
            const int k0 = kb * 64;
            bf16x8 Ka[4][2], Va[4][2];
#pragma unroll
            for (int T = 0; T < 4; ++T)
#pragma unroll
                for (int s = 0; s < 2; ++s) { Ka[T][s] = *(const bf16x8*)(proj + ((size_t)b * SEQ + k0 + 16 * (i16 >> 2) + 4 * T + (i16 & 3)) * NPROJ + PC_K + h * 64 + 32 * s + 8 * g);
                                              Va[T][s] = *(const bf16x8*)(vth + (size_t)(16 * T + i16) * SEQ + k0 + 16 * g + 8 * s); }
            const bool diag = (k0 + 63 >= q0);
#pragma unroll
            for (int ct = 0; ct < 2; ++ct) {
                f32x4 z[4];
#pragma unroll
                for (int T = 0; T < 4; ++T) { z[T] = (f32x4){0.f, 0.f, 0.f, 0.f};
#pragma unroll
                    for (int s = 0; s < 2; ++s) z[T] = __builtin_amdgcn_mfma_f32_16x16x32_bf16(Ka[T][s], Qb[ct][s], z[T], 0, 0, 0); }
                const int qi = q0 + 16 * ct + i16;
                float run = 0.f; f32x4 lsv[4], sfx[4];
#pragma unroll
                for (int T = 3; T >= 0; --T)
#pragma unroll
                    for (int r = 3; r >= 0; --r) { const float zz = z[T][r] * 0.125f; const float L = __logf(1.0f + __expf(-fabsf(zz))); const float ls = fminf(zz, 0.f) - L;
                        const bool valid = !diag || (k0 + 16 * g + 4 * T + r) < qi;
                        lsv[T][r] = valid ? ls : -1e30f; sfx[T][r] = run; run += valid ? (ls - zz) : 0.f; }
                const float p1 = __shfl_down(run, 16), p2 = __shfl_down(run, 32), p3 = __shfl_down(run, 48);
                const float gs = (g < 3 ? p1 : 0.f) + (g < 2 ? p2 : 0.f) + (g < 1 ? p3 : 0.f);
                float tot = run + __shfl_xor(run, 16); tot += __shfl_xor(tot, 32);
                const float base = R[ct] + gs;
#pragma unroll
                for (int T = 0; T < 4; ++T)
#pragma unroll
                    for (int r = 0; r < 4; ++r) z[T][r] = __expf(lsv[T][r] + base + sfx[T][r]);
                R[ct] += tot;
                const bf16x8 Wb0 = acc2b(z[0], z[1]), Wb1 = acc2b(z[2], z[3]);
#pragma unroll
                for (int rt = 0; rt < 4; ++rt) { O[rt][ct] = __builtin_amdgcn_mfma_f32_16x16x32_bf16(Va[rt][0], Wb0, O[rt][ct], 0, 0, 0); O[rt][ct] = __builtin_amdgcn_mfma_f32_16x16x32_bf16(Va[rt][1], Wb1, O[rt][ct], 0, 0, 0); }
            }
            if (!diag && __all(R[0] < SB_CUT && R[1] < SB_CUT)) break;
        }
#pragma unroll
        for (int ct = 0; ct < 2; ++ct)
#pragma unroll
            for (int rt = 0; rt < 4; ++rt) { v2u o; o.x = pk2(O[rt][ct][0], O[rt][ct][1]); o.y = pk2(O[rt][ct][2], O[rt][ct][3]);
                *(v2u*)(wsb(A, WS_Y) + ((size_t)b * SEQ + q0 + 16 * ct + i16) * D + 768 + h * 64 + 16 * rt + 4 * g) = o; }
    }
}
__device__ __forceinline__ void ph_sb_sample(const Args& A, LAS unsigned char* lds, int l, int vb, int vg) {
    TIDSV(vb, vg);
    if (wave >= 2) return;
    LAS float* vt = (LAS float*)(lds + wave * 32768);
    LAS float* qs = vt + 64 * 68;
    LAS float* wq = qs + 256;
    const bf16* proj = wsb(A, WS_PROJ); const int* pt = (const int*)A.in[I_PT];
    for (int un = wave * G + bid; un < DB * SBH; un += 2 * G) {
        const int h = un % SBH, s = un / SBH;
#pragma unroll
        for (int qi = 0; qi < 4; ++qi) qs[qi * 64 + lane] = bf2f(proj[((size_t)MP + s * DEC_SEQ + qi) * NPROJ + PC_Q + h * 64 + lane]) * 0.125f;
        WAVE_SYNC();
        float R[4] = {0.f, 0.f, 0.f, 0.f}; f32x4 acc = {0.f, 0.f, 0.f, 0.f};
        const int qi_b = lane & 3, ds = lane >> 2;
        for (int tile = 0; tile * 64 < PAST + DEC_SEQ; ++tile) {
            const int p = PAST + DEC_SEQ - 1 - (tile * 64 + lane);
            f32x4 kr[16], vr[16];
            if (p >= PAST) { const bf16* rp = proj + ((size_t)MP + s * DEC_SEQ + (p - PAST)) * NPROJ + h * 64;
#pragma unroll
                for (int x = 0; x < 8; ++x) { const v4u kw = ((const v4u*)(rp + PC_K))[x], vw = ((const v4u*)(rp + PC_V))[x];
                    kr[2 * x] = (f32x4){bflo(kw.x), bfhi(kw.x), bflo(kw.y), bfhi(kw.y)}; kr[2 * x + 1] = (f32x4){bflo(kw.z), bfhi(kw.z), bflo(kw.w), bfhi(kw.w)};
                    vr[2 * x] = (f32x4){bflo(vw.x), bfhi(vw.x), bflo(vw.y), bfhi(vw.y)}; vr[2 * x + 1] = (f32x4){bflo(vw.z), bfhi(vw.z), bflo(vw.w), bfhi(vw.w)}; } }
            else if (p >= 0) { const int page = pt[s * NPAGES + p / PAGE]; const size_t off = ((((size_t)l * NPOOL + page) * PAGE + p % PAGE) * SBH + h) * 64;
#pragma unroll
                for (int x = 0; x < 16; ++x) { kr[x] = ((const f32x4*)(A.in[I_CK] + off))[x]; vr[x] = ((const f32x4*)(A.in[I_CV] + off))[x]; } }
            else {
#pragma unroll
                for (int x = 0; x < 16; ++x) { kr[x] = (f32x4){0.f, 0.f, 0.f, 0.f}; vr[x] = (f32x4){0.f, 0.f, 0.f, 0.f}; } }
#pragma unroll
            for (int x = 0; x < 16; ++x) *(LAS f32x4*)(vt + lane * 68 + 4 * x) = vr[x];
#pragma unroll
            for (int qi = 0; qi < 4; ++qi) { float z = 0.f;
#pragma unroll
                for (int x = 0; x < 16; ++x) { const f32x4 qv = *(const LAS f32x4*)(qs + qi * 64 + 4 * x); z += (kr[x][0] * qv[0] + kr[x][1] * qv[1]) + (kr[x][2] * qv[2] + kr[x][3] * qv[3]); }
                float ls, ln; sb_terms(z, ls, ln);
                const bool valid = p >= 0 && p < PAST + qi; const float lnv = valid ? ln : 0.f;
                float incl = lnv;
#pragma unroll
                for (int o = 1; o < 64; o <<= 1) { const float t = __shfl_up(incl, o); if (lane >= o) incl += t; }
                wq[qi * 64 + lane] = valid ? __expf(ls + R[qi] + (incl - lnv)) : 0.f;
                R[qi] += __shfl(incl, 63); }
            WAVE_SYNC();
#pragma unroll 8
            for (int key = 0; key < 64; ++key) acc += *(const LAS f32x4*)(vt + key * 68 + 4 * ds) * wq[qi_b * 64 + key];
            WAVE_SYNC();
            if (R[0] < SB_CUT && R[1] < SB_CUT && R[2] < SB_CUT && R[3] < SB_CUT) break;
        }
        v2u o; o.x = pk2(acc[0], acc[1]); o.y = pk2(acc[2], acc[3]);
        *(v2u*)(wsb(A, WS_Y) + ((size_t)MP + s * DEC_SEQ + qi_b) * D + 768 + h * 64 + ds * 4) = o;
    }
}
constexpr int PH_PER_LAYER = 12, NPHASE = 2 + PH_PER_LAYER * DEPTH;
#ifndef DUP_MASK
#define DUP_MASK 0
#endif
#if DUP_MASK
__device__ __forceinline__ int rep_n(int k) { int n = ((DUP_MASK >> k) & 1) ? 2 : 1; asm volatile("" : "+s"(n)); return n; }
#define REP(k) _Pragma("nounroll") for (int rep_ = 0, repn_ = rep_n(k); rep_ < repn_; ++rep_)
#else
#define REP(k)
#endif
#ifndef TIME_SUB
#define TIME_SUB 0
#endif
#ifndef TIME_MASK
#define TIME_MASK 0
#endif
#ifndef MK_N_LAUNCHES
#define MK_N_LAUNCHES 1
#endif
__global__ void __launch_bounds__(NWAVES * 64, 2) fwd_kernel(Args A) {
#ifndef CPU_EMU
    extern __shared__ __attribute__((aligned(16))) unsigned char lds_raw[];
    LAS unsigned char* lds = (LAS unsigned char*)lds_raw;
    volatile LAS unsigned* MISC = (volatile LAS unsigned*)(lds + MISC_OFF);
    for (int u = threadIdx.x; u < (LDS_BYTES - MISC_OFF) / 4; u += NWAVES * 64) ((LAS unsigned*)(lds + MISC_OFF))[u] = 0u;
    __syncthreads();
    XcdBarrier bar; bar.bar = (unsigned*)(A.ws + WS_CTL) + CW_BAR + A.li * XCD_BAR_WORDS; bar.x = 0; bar.st = nullptr;
    if (A.ph_hi - A.ph_lo > 1) bar = xcd_barrier_post((unsigned*)(A.ws + WS_CTL) + CW_BAR + A.li * XCD_BAR_WORDS, MISC + 8);
#else
    unsigned char* lds = emu::B->lds; XcdBarrier bar{0};
#endif
    const int lo = A.ph_lo, hi = A.ph_hi, G = gridDim.x, bid = blockIdx.x;
#define IN(k) (lo <= (k) && (k) < hi)
#if TIME_MASK || TIME_SUB
    unsigned long long tp_ = __builtin_amdgcn_s_memrealtime(), tacc_ = 0;
#define SEAM(k) do { if (IN((k) + 1)) xcd_barrier(bar); { const unsigned long long tn_ = __builtin_amdgcn_s_memrealtime(); if ((TIME_MASK >> (k)) & 1) tacc_ += tn_ - tp_; tp_ = tn_; } } while (0)
#else
#define SEAM(k) do { if (IN((k) + 1)) xcd_barrier(bar); } while (0)
#endif
    if (IN(0)) { REP(9) ph_prologue(A, lds); ph_ssm_weights(A); SEAM(0); }
    if (IN(1)) {
        pg8::Gemm g{wsb(A, WS_CSILU), (const bf16*)(A.ws + WS_W + WL_ADA), D, D, D}; ModOrder S{G, bid}; EpiMod2 E{wsf(A, WS_MOD), A.in[I_BADA]};
        pg8::gemm_phase<EpiMod2, ModOrder, true, true>(lds, g, S, E); SEAM(1);
    }
    for (int l = 0; l < DEPTH; ++l) {
        const int pb = 2 + PH_PER_LAYER * l;
        unsigned char* wl = A.ws + WS_W + (size_t)l * WL_SIZE;
        if (IN(pb + 0)) { if (l == 0) ph_rows<0>(A, 0); SEAM(pb + 0); }
        if (IN(pb + 1)) {
            pg8::Gemm g{wsb(A, WS_H), (const bf16*)(wl + WL_W1), D, D, D}; pg8::GridOrder S; S.init(M / 256, N1 / 256, G, bid);
            pg8::EpiProj E{wsb(A, WS_PROJ), wsb(A, WS_GATE), A.out + O_KP + (size_t)l * MP * 256, A.out + O_VP + (size_t)l * MP * 256, A.out + O_KS + (size_t)l * MS * 256, A.out + O_VS + (size_t)l * MS * 256, wsb(A, WS_VT)};
            REP(5) pg8::gemm_phase<pg8::EpiProj, pg8::GridOrder, true, true>(lds, g, S, E); SEAM(pb + 1);
        }
#if TIME_SUB
#define SUBT(k, call) do { const unsigned long long ts_ = __builtin_amdgcn_s_memrealtime(); call; if ((TIME_SUB >> (k)) & 1) tacc_ += __builtin_amdgcn_s_memrealtime() - ts_; } while (0)
#else
#define SUBT(k, call) do { call; } while (0)
#endif
        if (IN(pb + 2)) { SUBT(0, REP(3) ph_gdn_c1(A, lds, l)); SUBT(4, REP(4) ph_ssm1(A, l)); SUBT(6, SEAM(pb + 2)); }
        if (IN(pb + 3)) {
            const bool split = G > NB * GH + 8; const int vb = split ? bid - NB * GH : bid, vg = split ? G - NB * GH : G;
            if (!split || bid < NB * GH) { SUBT(7, REP(0) ph_gdn_scan(A, lds, l)); }
            if (!split || bid >= NB * GH) { __syncthreads();
                SUBT(1, REP(2) ph_sb_prompt(A, l, vb, vg)); SUBT(8, REP(4) ph_ssm2(A, lds, l, vb, vg)); __syncthreads();
                SUBT(2, REP(10) ph_gdn_sample(A, lds, l, vb, vg)); SUBT(3, REP(1) ph_sb_sample(A, lds, l, vb, vg)); SUBT(5, REP(10) ph_conv(A, l, vb, vg)); }
            SUBT(9, SEAM(pb + 3)); }
        if (IN(pb + 4)) { REP(10) ph_gdn_out(A, l); SEAM(pb + 4); }
        if (IN(pb + 5)) {
            pg8::Gemm g{wsb(A, WS_YS), (const bf16*)(wl + WL_GLU), 256, 256, 256}; pg8::GridOrder S; S.init(M / 256, 1, G, bid);
            pg8::EpiGlu E{wsb(A, WS_YS), wsb(A, WS_Y)};
            REP(8) pg8::gemm_phase<pg8::EpiGlu, pg8::GridOrder, true, true>(lds, g, S, E); SEAM(pb + 5);
        }
        if (IN(pb + 6)) {
            pg8::Gemm g{wsb(A, WS_Y), (const bf16*)(wl + WL_BR), D, 256, 256}; pg8::MergeOrder S; S.init(M / 256, 8, G, bid);
            pg8::EpiMerge E; E.gate = wsb(A, WS_GATE); E.mgb = wsb(A, WS_MERGEB);
            REP(6) pg8::gemm_phase<pg8::EpiMerge, pg8::MergeOrder, true, true, true>(lds, g, S, E); SEAM(pb + 6);
        }
        if (IN(pb + 7)) {
            { pg8::Gemm g{wsb(A, WS_MERGEB), (const bf16*)(wl + WL_WO), D, D, D}; pg8::GridOrder S; S.init(MP / 256, 4, G, bid);
              pg8::EpiRes E{l == 0 ? A.in[I_XP] : wsf(A, WS_X2), l == 0 ? A.in[I_XS] : wsf(A, WS_X2) + (size_t)MP * D, wsf(A, WS_MOD) + (size_t)l * 256 * NMOD + 2 * D, wsf(A, WS_X1)};
              REP(8) pg8::gemm_phase<pg8::EpiRes, pg8::GridOrder, true, true>(lds, g, S, E); }
            { pg8::Gemm g{wsb(A, WS_MERGEB), (const bf16*)(wl + WL_WO), D, D, 256}; pg8::SplitOrder S{G, (bid + 128) % G, MP / 256, MS / 256, 4, 4};
              pg8::EpiPart E{wsf(A, WS_PART)};
              REP(8) pg8::gemm_phase<pg8::EpiPart, pg8::SplitOrder, true, true>(lds, g, S, E); }
            SEAM(pb + 7);
        }
        if (IN(pb + 8)) { ph_rows<1>(A, l); SEAM(pb + 8); }
        if (IN(pb + 9)) {
            pg8::Gemm g{wsb(A, WS_H), (const bf16*)(wl + WL_UP), D, D, D}; pg8::GridOrder S; S.init(M / 256, NUP / 256, G, bid);
            pg8::EpiUp E{wsb(A, WS_ACT)};
            REP(7) pg8::gemm_phase<pg8::EpiUp, pg8::GridOrder, true, true>(lds, g, S, E); SEAM(pb + 9);
        }
        if (IN(pb + 10)) {
            { pg8::Gemm g{wsb(A, WS_ACT), (const bf16*)(wl + WL_DN), DFF, DFF, DFF}; pg8::GridOrder S; S.init(MP / 256, 4, G, bid);
              pg8::EpiRes E{wsf(A, WS_X1), wsf(A, WS_X1) + (size_t)MP * D, wsf(A, WS_MOD) + (size_t)l * 256 * NMOD + 5 * D, wsf(A, WS_X2)};
              REP(7) pg8::gemm_phase<pg8::EpiRes, pg8::GridOrder, true, true>(lds, g, S, E); }
            { pg8::Gemm g{wsb(A, WS_ACT), (const bf16*)(wl + WL_DN), DFF, DFF, 256}; pg8::SplitOrder S{G, (bid + 128) % G, MP / 256, MS / 256, 4, DFF / 256};
              pg8::EpiPart E{wsf(A, WS_PART)};
              REP(7) pg8::gemm_phase<pg8::EpiPart, pg8::SplitOrder, true, true>(lds, g, S, E); }
            SEAM(pb + 10);
        }
        if (IN(pb + 11)) { ph_rows<2>(A, l); SEAM(pb + 11); }
    }
#if TIME_MASK || TIME_SUB
    if (blockIdx.x == 0 && threadIdx.x == 0) { const unsigned long long t0_ = __builtin_amdgcn_s_memrealtime(); while (__builtin_amdgcn_s_memrealtime() - t0_ < 4 * tacc_) __builtin_amdgcn_s_sleep(8); }
#endif
#undef IN
#undef SEAM
}
#ifndef CPU_EMU
extern "C" void kernel_launch(void* const* d_in, const int* in_sizes, int n_in, void* d_out, int out_size, void* d_ws, size_t ws_size, hipStream_t stream) {
    static int grid = 0;
    if (grid == 0) {
        if (n_in != 38 || (size_t)out_size != O_END || ws_size < WS_END) { fprintf(stderr, "kernel_launch: unexpected shapes (n_in %d out %d ws %zu; want 38, %zu, >= %zu)\n", n_in, out_size, ws_size, (size_t)O_END, (size_t)WS_END); grid = -1; return; }
        int dev = 0, cus = 0, per_cu = 0;
        if (hipGetDevice(&dev) != hipSuccess || hipDeviceGetAttribute(&cus, hipDeviceAttributeMultiprocessorCount, dev) != hipSuccess) { grid = -1; return; }
        if (hipFuncSetAttribute((const void*)fwd_kernel, hipFuncAttributeMaxDynamicSharedMemorySize, LDS_BYTES) != hipSuccess) { fprintf(stderr, "kernel_launch: hipFuncSetAttribute failed\n"); grid = -1; return; }
        if (hipOccupancyMaxActiveBlocksPerMultiprocessor(&per_cu, (const void*)fwd_kernel, NWAVES * 64, LDS_BYTES) != hipSuccess || per_cu < 1) { fprintf(stderr, "kernel_launch: occupancy query says %d\n", per_cu); }
        (void)hipGetLastError();
        grid = cus;
    }
    if (grid < 0) return;
    if (hipMemsetAsync((char*)d_ws + WS_CTL, 0, CTL_ZERO_BYTES, stream) != hipSuccess) return;
    Args a{};
    for (int i = 0; i < 38; ++i) a.in[i] = (const float*)d_in[i];
    a.out = (float*)d_out; a.ws = (unsigned char*)d_ws;
    if (MK_N_LAUNCHES == 1) { a.ph_lo = 0; a.ph_hi = NPHASE; a.li = 0; hipLaunchKernelGGL(fwd_kernel, dim3(grid), dim3(NWAVES * 64), LDS_BYTES, stream, a); }
    else for (int p = 0; p < NPHASE; ++p) { if (p == 2 + PH_PER_LAYER) continue; a.ph_lo = p; a.ph_hi = p + 1; a.li = 0; hipLaunchKernelGGL(fwd_kernel, dim3(grid), dim3(NWAVES * 64), LDS_BYTES, stream, a); }
}
#endif
```

```cpp
#ifndef CPU_EMU
#include <hip/hip_runtime.h>
#endif
#include <cstdio>
#include <cstdint>
#include <cmath>

constexpr int D = 1024, NB = 2, DEPTH = 2, DEC_SEQ = 4, PAGE = 128;
#ifdef CPU_EMU
#ifndef EMU_SEQ
#define EMU_SEQ 512
#endif
#ifndef EMU_DB
#define EMU_DB 64
#endif
#ifndef EMU_PAST
#define EMU_PAST 512
#endif
constexpr int SEQ = EMU_SEQ, DB = EMU_DB, PAST = EMU_PAST;
#else
constexpr int SEQ = 8192, DB = 128, PAST = 2048;
#endif
constexpr int NPAGES = PAST / PAGE, NUSED = DB * NPAGES, NPOOL = NUSED + (NUSED / 4 > 1 ? NUSED / 4 : 1);
constexpr int MP = NB * SEQ, MS = DB * DEC_SEQ, M = MP + MS, NSEQ = NB + DB;
constexpr int WMIX = 256, NPROJ = 2816, NIN = 2824, NGATE = 4096, N1 = NPROJ + NGATE, DFF = 2816, NUP = 2 * DFF, NMOD = 6 * D;
constexpr int SSM_G = 16, SSM_P = 64, SSM_CH = 128, SSM_NCH = SEQ / SSM_CH;
constexpr int GH = 4, GDK = 64, GCH = 64, GNCH = SEQ / GCH, GQKV = 768;
constexpr int SBH = 4;
constexpr int PC_U = 0, PC_BG = 256, PC_CG = 512, PC_XC = 768, PC_QKV = 1024, PC_Z = 1792, PC_Q = 2048, PC_K = 2304, PC_V = 2560;
constexpr float LN_EPS = 1e-5f, RMS_EPS = 1e-6f, ALPHA = 1.41421356237309515f  ;
static_assert(M % 256 == 0 && MP % 256 == 0 && SEQ % 256 == 0 && NSEQ <= 256, "tile shapes");
constexpr size_t O_Y = 0, O_KP = (size_t)M * D, O_VP = O_KP + (size_t)DEPTH * MP * 256, O_KS = O_VP + (size_t)DEPTH * MP * 256, O_VS = O_KS + (size_t)DEPTH * MS * 256,
    O_REP = O_VS + (size_t)DEPTH * MS * 256, O_IMP = O_REP + DEPTH * NB * 1024, O_RES = O_IMP + DEPTH * NB * 1024, O_IMS = O_RES + (size_t)DEPTH * DB * 1024,
    O_CBP = O_IMS + (size_t)DEPTH * DB * 1024, O_CBS = O_CBP + DEPTH * NB * 512, O_DP = O_CBS + (size_t)DEPTH * DB * 512, O_DS = O_DP + (size_t)DEPTH * NB * 16384,
    O_CDP = O_DS + (size_t)DEPTH * DB * 16384, O_CDS = O_CDP + DEPTH * NB * 2304, O_END = O_CDS + (size_t)DEPTH * DB * 2304;

constexpr size_t MiB = 1u << 20;
constexpr size_t al(size_t x) { return (x + 4095) & ~(size_t)4095; }
constexpr size_t WS_CTL = 0, CTL_ZERO_BYTES = 1 * MiB;
constexpr size_t WL_ADA = 0, WL_W1 = WL_ADA + (size_t)NMOD * D * 2, WL_GLU = WL_W1 + (size_t)N1 * D * 2, WL_BR = WL_GLU + 256 * 256 * 2, WL_WO = WL_BR + (size_t)4 * D * 256 * 2,
    WL_UP = WL_WO + (size_t)D * D * 2, WL_DN = WL_UP + (size_t)NUP * D * 2, WL_LOG = WL_DN + (size_t)D * DFF * 2, WL_SIZE = (WL_LOG + 8 * D * 4 + 524287) & ~(size_t)524287;
constexpr size_t WS_W = 1 * MiB, WS_CSILU = WS_W + DEPTH * WL_SIZE, WS_MOD = WS_CSILU + 256 * D * 2, WS_H = WS_MOD + (size_t)DEPTH * 256 * NMOD * 4,
    WS_PROJ = WS_H + (size_t)M * D * 2, WS_GATE = al(WS_PROJ + (size_t)M * NPROJ * 2), WS_LOG8 = WS_GATE + (size_t)M * NGATE * 2, WS_Y = WS_LOG8 + (size_t)M * 8 * 4,
    WS_YS = WS_Y + (size_t)M * D * 2, WS_MERGE = WS_YS + (size_t)M * 256 * 2, WS_MERGEB = WS_MERGE + (size_t)M * D * 4, WS_X1 = WS_MERGEB + (size_t)M * D * 2,
    WS_ACT = WS_X1 + (size_t)M * D * 4, WS_X2 = al(WS_ACT + (size_t)M * DFF * 2), WS_SEND = WS_X2 + (size_t)M * D * 4, WS_HIN = WS_SEND + (size_t)NB * 16 * SSM_NCH * 128 * 4,
    WS_GD = WS_HIN + (size_t)NB * 16 * SSM_NCH * 128 * 4, WS_EGL = WS_GD + (size_t)NB * GH * GNCH * 49152, WS_ODRAW = al(WS_EGL + (size_t)NB * GH * GNCH * 4),
    WS_VT = al(WS_ODRAW + (size_t)M * 256 * 4), WS_SSMW = al(WS_VT + (size_t)NB * SBH * 64 * SEQ * 2), WS_PART = al(WS_SSMW + (size_t)DEPTH * 16 * 8 * (SSM_CH / 2) * 64 * 16), WS_END = WS_PART + (size_t)(DFF / 256) * MS * D * 4;
constexpr size_t SSMW_L = (size_t)16 * 8 * (SSM_CH / 2) * 64 * 16;
constexpr int CW_TMO = 0, CW_BAR = 4096;
constexpr size_t GD_UNIT = 49152;

#define LAS_HW __attribute__((address_space(3)))
#ifdef CPU_EMU
#define LAS
#else
#define LAS LAS_HW
#endif
typedef unsigned short bf16;
typedef unsigned v4u __attribute__((ext_vector_type(4)));
typedef unsigned v2u __attribute__((ext_vector_type(2)));
typedef float f32x4 __attribute__((ext_vector_type(4)));
typedef float f32x2 __attribute__((ext_vector_type(2)));
typedef short bf16x8 __attribute__((ext_vector_type(8)));
#ifdef CPU_EMU
#define LDS_WAIT() do {} while (0)
#define VM_WAIT() do {} while (0)
#define WAVE_SYNC() emu::wave_sync()
#define CFENCE() do {} while (0)
#define RAW_BAR() emu::block_sync()
#else
#define LDS_WAIT() asm volatile("s_waitcnt lgkmcnt(0)" ::: "memory")
#define VM_WAIT() asm volatile("s_waitcnt vmcnt(0)" ::: "memory")
#define WAVE_SYNC() do { asm volatile("s_waitcnt lgkmcnt(0)" ::: "memory"); __builtin_amdgcn_wave_barrier(); } while (0)
#define CFENCE() asm volatile("" ::: "memory")
#define RAW_BAR() do { asm volatile("s_waitcnt lgkmcnt(0)" ::: "memory"); __builtin_amdgcn_s_barrier(); asm volatile("" ::: "memory"); } while (0)
#endif
#ifdef CPU_EMU
#define OPAQUE_V(x) do {} while (0)
#else
#define OPAQUE_V(x) asm volatile("" : "+v"(x))
#endif
__device__ __forceinline__ unsigned f2bf(float f) { unsigned u = __builtin_bit_cast(unsigned, f); return (u + 0x7fffu + ((u >> 16) & 1u)) >> 16; }
__device__ __forceinline__ unsigned pk2(float lo, float hi) { return f2bf(lo) | (f2bf(hi) << 16); }
__device__ __forceinline__ float bf2f(unsigned b) { return __builtin_bit_cast(float, b << 16); }
__device__ __forceinline__ float bflo(unsigned w) { return __builtin_bit_cast(float, w << 16); }
__device__ __forceinline__ float bfhi(unsigned w) { return __builtin_bit_cast(float, w & 0xffff0000u); }
__device__ __forceinline__ float sigmoidf_(float x) { return 1.0f / (1.0f + __expf(-x)); }
__device__ __forceinline__ float siluf_(float x) { return x / (1.0f + __expf(-x)); }
__device__ __forceinline__ bf16x8 acc2b(const f32x4& lo, const f32x4& hi) { v4u w; w.x = pk2(lo[0], lo[1]); w.y = pk2(lo[2], lo[3]); w.z = pk2(hi[0], hi[1]); w.w = pk2(hi[2], hi[3]); return __builtin_bit_cast(bf16x8, w); }
__device__ __forceinline__ float wave_sum(float v) {
#pragma unroll
    for (int o = 1; o < 64; o <<= 1) v += __shfl_xor(v, o);
    return v;
}
__device__ __forceinline__ int seq_of(int m) { return m < MP ? m / SEQ : NB + (m - MP) / DEC_SEQ; }
namespace pg8 {
typedef unsigned short bf16_t;
constexpr int BM = 256, BK = 64, HALF = 128, HTB = HALF * BK * 2, STAGE_BYTES = 8 * HTB, NXCD = 8, WGM = 8;
__host__ __device__ __forceinline__ int lds_byte(int r, int c) { const int st = (r >> 4) * 2 + (c >> 5), rr = r & 15, cc = c & 31, ob = rr * 64 + cc * 2; return st * 1024 + (ob ^ (((ob >> 9) & 1) << 5)); }
__host__ __device__ __forceinline__ void stage_rc(int b, int& R, int& C) { const int st = b / 1024, sb = b % 1024, swz = sb ^ (((sb >> 9) & 1) << 5); R = (st >> 1) * 16 + swz / 64; C = (st & 1) * 32 + (swz % 64) / 2; }
__host__ __device__ __forceinline__ int perm32(int rho) { const int n = rho >> 4, i = rho & 15; return 8 * (i >> 2) + 4 * n + (i & 3); }
struct Unit { int pm, pn, ka, kb, aux; };
struct NoState {};
struct Gemm { const bf16_t* A; const bf16_t* Bt; int lda, ldb, K; };
struct GridOrder {
    int nM, nN, nwg, G, c, pn0;
    __host__ __device__ void init(int nM_, int nN_, int G_, int c_, int pn0_ = 0) { nM = nM_; nN = nN_; nwg = nM * nN; G = G_; c = c_; pn0 = pn0_; }
    __host__ __device__ bool tile(long L, int& pm, int& pn) const {
        if (L >= nwg) return false;
        int wgid = (int)L; { const int q = nwg / NXCD, r = nwg % NXCD, xcd = wgid % NXCD, off = wgid / NXCD; wgid = (xcd < r ? xcd * (q + 1) : r * (q + 1) + (xcd - r) * q) + off; }
        const int nig = WGM * nN, gid = wgid / nig, fm = gid * WGM, gsz = (nM - fm) < WGM ? (nM - fm) : WGM;
        pm = fm + ((wgid % nig) % gsz); pn = (wgid % nig) / gsz; return true;
    }
    __host__ __device__ bool next(int i, Unit& u) const { int pm, pn; if (!tile((long)i * G + c, pm, pn)) return false; u.pm = pm; u.pn = pn0 + pn; u.ka = 0; u.kb = 0; u.aux = pn; return true; }
    __device__ __forceinline__ void a_ready(const Unit&) const {}
    __device__ __forceinline__ void done(const Unit&) const {}
};
struct MergeOrder : GridOrder {
    __host__ __device__ bool next(int i, Unit& u) const { int pm, pc; if (!tile((long)(i >> 2) * G + c, pm, pc)) return false; const int n = i & 3; u.pm = pm; u.pn = 8 * n + pc; u.ka = 256 * n; u.kb = 0; u.aux = (n << 8) | pc; return true; }
};
struct SplitOrder {
    int G, c, pm0, nrow, ncol, nks;
    __host__ __device__ bool next(int i, Unit& u) const { const int L = i * G + c; if (L >= nrow * ncol * nks) return false; const int ks = L % nks, pn = (L / nks) % ncol, pr = L / (nks * ncol);
        u.pm = pm0 + pr; u.pn = pn; u.ka = 256 * ks; u.kb = 256 * ks; u.aux = pn | (ks << 8); return true; }
    __device__ __forceinline__ void a_ready(const Unit&) const {}
    __device__ __forceinline__ void done(const Unit&) const {}
};
#ifndef CPU_EMU
#define PG8_LAS __attribute__((address_space(3)))
template <class Epi, class Sched, bool ALIGN_EPI = false, bool SP2 = false, bool HALFN = false>
__device__ __forceinline__ void gemm_phase(PG8_LAS unsigned char* lds, const Gemm g, const Sched& S, const Epi& E) {
    int tid = threadIdx.x; asm volatile("" : "+v"(tid));
    const int wid = __builtin_amdgcn_readfirstlane(tid >> 6), lane = tid & 63, wr = wid >> 2, wc = wid & 3, fr = lane & 15, fq = lane >> 4;
    int K = g.K; asm volatile("" : "+s"(K));
    const int nt = K / BK, lda = g.lda, ldb = g.ldb;
    unsigned voffA[2], voffB[2];
#pragma unroll
    for (int i = 0; i < 2; ++i) { int R, C; stage_rc(tid * 16 + i * 8192, R, C); const int Rb = Epi::PERM ? ((R & ~31) + perm32(R & 31)) : R;
        voffA[i] = (unsigned)(R * lda + C) * 2u; voffB[i] = (unsigned)(Rb * ldb + C) * 2u; }
    const size_t kstep = (size_t)(BK * 2);
    const size_t hstepA = (size_t)HALF * lda * 2, hstepB = HALFN ? (size_t)0 : (size_t)HALF * ldb * 2;
    const size_t tstepA = 2 * hstepA, tstepB = HALFN ? (size_t)HALF * ldb * 2 : 2 * hstepB;
    const unsigned ldsw = (unsigned)wid * 1024u;
    const int aoff = lds_byte(wr * 64 + fr, fq * 8), boff = lds_byte(wc * 32 + fr, fq * 8);
#define PG8_SA(b, h) (((b) * 2 + (h)) * HTB)
#define PG8_SB(b, h) ((4 + (b) * 2 + (h)) * HTB)
#define PG8_STAGE(bufoff, gbase, voff) do { _Pragma("unroll") for (int _i = 0; _i < 2; ++_i) \
        __builtin_amdgcn_global_load_lds((const unsigned*)((const char*)(gbase) + (voff)[_i]), (PG8_LAS unsigned*)(lds + (bufoff) + ldsw + _i * 8192), 16, 0, 0); } while (0)
#define PG8_LDA(dst, b, h) do { _Pragma("unroll") for (int m = 0; m < 4; ++m) _Pragma("unroll") for (int k = 0; k < 2; ++k) dst[m][k] = *(const PG8_LAS bf16x8*)(lds + PG8_SA(b, h) + aoff + m * 2048 + k * 1024); } while (0)
#define PG8_LDB(dst, b, h) do { _Pragma("unroll") for (int n = 0; n < 2; ++n) _Pragma("unroll") for (int k = 0; k < 2; ++k) dst[n][k] = *(const PG8_LAS bf16x8*)(lds + PG8_SB(b, h) + boff + n * 2048 + k * 1024); } while (0)
#define PG8_MMA(ai, bj, At, Bt) do { __builtin_amdgcn_s_setprio(1); _Pragma("unroll") for (int m = 0; m < 4; ++m) _Pragma("unroll") for (int n = 0; n < 2; ++n) _Pragma("unroll") for (int k = 0; k < 2; ++k) \
        acc[ai][bj][m][n] = __builtin_amdgcn_mfma_f32_16x16x32_bf16(Bt[n][k], At[m][k], acc[ai][bj][m][n], 0, 0, 0); __builtin_amdgcn_s_setprio(0); } while (0)
#define PG8_WAIT_V(n) asm volatile("s_waitcnt vmcnt(" #n ")" ::: "memory")
#define PG8_WAIT_L(n) asm volatile("s_waitcnt lgkmcnt(" #n ")" ::: "memory")
#define PG8_BAR __builtin_amdgcn_s_barrier()
#define PG8_SCHED __builtin_amdgcn_sched_barrier(0)
    Unit cur, nxt; int ui = 0;
    if (!S.next(0, cur)) return;
    f32x4 acc[2][2][4][2];
    typename Epi::State est;
#pragma unroll
    for (int a = 0; a < 2; ++a)
#pragma unroll
        for (int b = 0; b < 2; ++b)
#pragma unroll
            for (int m = 0; m < 4; ++m)
#pragma unroll
                for (int n = 0; n < 2; ++n) acc[a][b][m][n] = (f32x4){0.f, 0.f, 0.f, 0.f};
    static_assert(!HALFN || SP2, "HALFN is written for the SP2 loop");
    bf16x8 At[4][2], B0[2][2], B1[2][2];
    const char* cA = (const char*)g.A + (size_t)cur.pm * tstepA + (size_t)cur.ka * 2; const char* cB = (const char*)g.Bt + (size_t)cur.pn * tstepB + (size_t)cur.kb * 2;
    S.a_ready(cur);
    if constexpr (SP2) {
        PG8_STAGE(PG8_SB(0, 0), cB, voffB); PG8_STAGE(PG8_SB(0, 1), cB + hstepB, voffB); PG8_STAGE(PG8_SA(0, 0), cA, voffA); PG8_STAGE(PG8_SA(0, 1), cA + hstepA, voffA);
        if (wr == 1) PG8_BAR;
        PG8_WAIT_V(2); PG8_BAR;
        PG8_STAGE(PG8_SB(1, 0), cB + kstep, voffB); PG8_STAGE(PG8_SA(1, 0), cA + kstep, voffA); PG8_STAGE(PG8_SB(1, 1), cB + hstepB + kstep, voffB);
        PG8_WAIT_V(6); PG8_BAR;
    } else {
        PG8_STAGE(PG8_SB(0, 0), cB, voffB); PG8_STAGE(PG8_SA(0, 0), cA, voffA); PG8_STAGE(PG8_SB(0, 1), cB + hstepB, voffB); PG8_STAGE(PG8_SA(0, 1), cA + hstepA, voffA);
        if (wr == 1) PG8_BAR;
        PG8_WAIT_V(4); PG8_BAR;
        PG8_STAGE(PG8_SB(1, 0), cB + kstep, voffB); PG8_STAGE(PG8_SA(1, 0), cA + kstep, voffA); PG8_STAGE(PG8_SB(1, 1), cB + hstepB + kstep, voffB);
        PG8_WAIT_V(6); PG8_BAR;
    }
    for (;;) {
        const bool has_next = S.next(ui + 1, nxt);
        const char* nA = has_next ? (const char*)g.A + (size_t)nxt.pm * tstepA + (size_t)nxt.ka * 2 : cA; const char* nB = has_next ? (const char*)g.Bt + (size_t)nxt.pn * tstepB + (size_t)nxt.kb * 2 : cB;
        for (int t = 0; t < nt; t += 2) {
            const bool last = (t == nt - 2);
            const char* a1 = cA + (size_t)(t + 1) * kstep;
            const char* a2 = last ? nA : cA + (size_t)(t + 2) * kstep; const char* b2 = last ? nB : cB + (size_t)(t + 2) * kstep;
            const char* a3 = a2 + kstep; const char* b3 = b2 + kstep;
            if (last && has_next) S.a_ready(nxt);
            if constexpr (SP2) {
            PG8_LDB(B0, 0, 0); if constexpr (!HALFN) PG8_LDB(B1, 0, 1); PG8_SCHED; PG8_LDA(At, 0, 0); PG8_STAGE(PG8_SA(1, 1), a1 + hstepA, voffA);
            PG8_WAIT_V(8); PG8_WAIT_L(0); PG8_BAR; PG8_MMA(0, 0, At, B0); if constexpr (!HALFN) PG8_MMA(0, 1, At, B1); PG8_BAR; PG8_SCHED;
            PG8_LDA(At, 0, 1); PG8_STAGE(PG8_SB(0, 0), b2, voffB); PG8_STAGE(PG8_SB(0, 1), b2 + hstepB, voffB); PG8_STAGE(PG8_SA(0, 0), a2, voffA);
            PG8_WAIT_V(8); PG8_WAIT_L(0); PG8_BAR; PG8_MMA(1, 0, At, B0); if constexpr (!HALFN) PG8_MMA(1, 1, At, B1); PG8_BAR; PG8_SCHED;
            PG8_LDB(B0, 1, 0); if constexpr (!HALFN) PG8_LDB(B1, 1, 1); PG8_SCHED; PG8_LDA(At, 1, 0); PG8_STAGE(PG8_SA(0, 1), a2 + hstepA, voffA);
            PG8_WAIT_V(8); PG8_WAIT_L(0); PG8_BAR; PG8_MMA(0, 0, At, B0); if constexpr (!HALFN) PG8_MMA(0, 1, At, B1); PG8_BAR; PG8_SCHED;
            PG8_LDA(At, 1, 1); PG8_STAGE(PG8_SB(1, 0), b3, voffB); PG8_STAGE(PG8_SB(1, 1), b3 + hstepB, voffB); PG8_STAGE(PG8_SA(1, 0), a3, voffA);
            PG8_WAIT_V(8); PG8_WAIT_L(0); PG8_BAR; PG8_MMA(1, 0, At, B0); if constexpr (!HALFN) PG8_MMA(1, 1, At, B1); PG8_BAR; PG8_SCHED;
            } else {
            PG8_LDB(B0, 0, 0); PG8_SCHED; PG8_LDA(At, 0, 0); PG8_STAGE(PG8_SA(1, 1), a1 + hstepA, voffA);
            PG8_WAIT_L(8); PG8_BAR; PG8_WAIT_L(0); PG8_MMA(0, 0, At, B0); PG8_BAR; PG8_SCHED;
            PG8_LDB(B1, 0, 1); PG8_STAGE(PG8_SB(0, 0), b2, voffB);
            PG8_BAR; PG8_WAIT_L(0); PG8_MMA(0, 1, At, B1); PG8_BAR;
            PG8_LDA(At, 0, 1); PG8_STAGE(PG8_SA(0, 0), a2, voffA);
            PG8_BAR; PG8_WAIT_L(0); PG8_MMA(1, 0, At, B0); PG8_BAR; PG8_SCHED;
            PG8_STAGE(PG8_SB(0, 1), b2 + hstepB, voffB);
            PG8_WAIT_V(6); PG8_BAR; PG8_MMA(1, 1, At, B1); PG8_BAR;
            PG8_LDB(B0, 1, 0); PG8_SCHED; PG8_LDA(At, 1, 0); PG8_STAGE(PG8_SA(0, 1), a2 + hstepA, voffA);
            PG8_WAIT_L(8); PG8_BAR; PG8_WAIT_L(0); PG8_MMA(0, 0, At, B0); PG8_BAR; PG8_SCHED;
            PG8_LDB(B1, 1, 1); PG8_STAGE(PG8_SB(1, 0), b3, voffB);
            PG8_BAR; PG8_WAIT_L(0); PG8_MMA(0, 1, At, B1); PG8_BAR;
            PG8_LDA(At, 1, 1); PG8_STAGE(PG8_SA(1, 0), a3, voffA);
            PG8_BAR; PG8_WAIT_L(0); PG8_MMA(1, 0, At, B0); PG8_BAR; PG8_SCHED;
            PG8_STAGE(PG8_SB(1, 1), b3 + hstepB, voffB);
            PG8_WAIT_V(6); PG8_BAR; PG8_MMA(1, 1, At, B1); PG8_BAR;
            }
        }
        if constexpr (ALIGN_EPI) { if (wr == 0) PG8_BAR; }
        E(acc, est, cur, wr, wc, fr, fq); S.done(cur);
        if (!has_next) break;
#pragma unroll
        for (int a = 0; a < 2; ++a)
#pragma unroll
            for (int b = 0; b < 2; ++b)
#pragma unroll
                for (int m = 0; m < 4; ++m)
#pragma unroll
                    for (int n = 0; n < 2; ++n) acc[a][b][m][n] = (f32x4){0.f, 0.f, 0.f, 0.f};
        cur = nxt; cA = nA; cB = nB; ++ui;
        if constexpr (ALIGN_EPI) { if (wr == 1) PG8_BAR; }
    }
    PG8_WAIT_V(0);
    if constexpr (!ALIGN_EPI) { if (wr == 0) PG8_BAR; }
    PG8_BAR;
#undef PG8_SA
#undef PG8_SB
#undef PG8_STAGE
#undef PG8_LDA
#undef PG8_LDB
#undef PG8_MMA
#undef PG8_WAIT_V
#undef PG8_WAIT_L
#undef PG8_BAR
#undef PG8_SCHED
}
#else
template <class Epi, class Sched, bool ALIGN_EPI = false, bool SP2 = false, bool HALFN = false>
void gemm_phase(unsigned char* lds, const Gemm g, const Sched& S, const Epi& E) {
    const int tid = threadIdx.x, wid = tid >> 6, lane = tid & 63, wr = wid >> 2, wc = wid & 3, fr = lane & 15, fq = lane >> 4;
    static thread_local float* Ct = nullptr; static thread_local float* Af = nullptr; static thread_local float* Bf = nullptr;
    Unit u; typename Epi::State est;
    for (int i = 0; S.next(i, u); ++i) {
        S.a_ready(u);
        __syncthreads();
        if (tid == 0) {
            if (!Ct) { Ct = new float[256 * 256]; Af = new float[256 * 4096]; Bf = new float[256 * 4096]; }
            const int K = g.K;
            for (int r = 0; r < 256; ++r) for (int k = 0; k < K; ++k) { Af[r * K + k] = bf2f(g.A[(size_t)(u.pm * 256 + r) * g.lda + u.ka + k]); Bf[r * K + k] = HALFN ? (r < 128 ? bf2f(g.Bt[(size_t)(u.pn * 128 + r) * g.ldb + u.kb + k]) : 0.f) : bf2f(g.Bt[(size_t)(u.pn * 256 + r) * g.ldb + u.kb + k]); }
            for (int r = 0; r < 256; ++r) for (int c = 0; c < 256; ++c) { float s = 0.f; const float* a = Af + r * K; const float* b = Bf + c * K; for (int k = 0; k < K; ++k) s += a[k] * b[k]; Ct[r * 256 + c] = s; }
        }
        __syncthreads();
        f32x4 acc[2][2][4][2];
        for (int ai = 0; ai < 2; ++ai) for (int bj = 0; bj < 2; ++bj) for (int m = 0; m < 4; ++m) for (int n = 0; n < 2; ++n) for (int e = 0; e < 4; ++e) {
            const int r = 128 * ai + 64 * wr + 16 * m + fr; const int c = Epi::PERM ? (128 * bj + 32 * wc + 8 * fq + 4 * n + e) : (128 * bj + 32 * wc + 16 * n + 4 * fq + e);
            acc[ai][bj][m][n][e] = Ct[r * 256 + c]; }
        E(acc, est, u, wr, wc, fr, fq); S.done(u);
    }
    __syncthreads();
}
#endif
}
namespace pg8 {
struct EpiMod {
    static constexpr bool PERM = false; typedef NoState State;
    float* C; const float* bias;
    __device__ __forceinline__ void operator()(const f32x4 (&acc)[2][2][4][2], State& st, const Unit& u, int wr, int wc, int fr_in, int fq_in) const {
        int fr = fr_in, fq = fq_in; OPAQUE_V(fr); OPAQUE_V(fq);
        const int row0 = wr * 64 + fr, col0 = u.aux * BM + wc * 32 + 4 * fq;
#pragma unroll
        for (int ai = 0; ai < 2; ++ai)
#pragma unroll
            for (int m = 0; m < 4; ++m) { float* rowp = C + (size_t)(row0 + ai * HALF + m * 16) * NMOD + col0;
#pragma unroll
                for (int bj = 0; bj < 2; ++bj)
#pragma unroll
                    for (int n = 0; n < 2; ++n) *(f32x4*)(rowp + bj * HALF + n * 16) = acc[ai][bj][m][n] + *(const f32x4*)(bias + col0 + bj * HALF + n * 16); }
    }
};
struct EpiProj {
    static constexpr bool PERM = true; typedef NoState State;
    bf16* proj; bf16* gate; float* outk_p; float* outv_p; float* outk_s; float* outv_s; bf16* vt;
    __device__ __forceinline__ void operator()(const f32x4 (&acc)[2][2][4][2], State& st, const Unit& u, int wr, int wc, int fr_in, int fq_in) const {
        int fr = fr_in, fq = fq_in; OPAQUE_V(fr); OPAQUE_V(fq);
        const int t = u.aux; const bool isg = t >= 11;
        const int row0 = u.pm * BM + wr * 64 + fr, colt = wc * 32 + 8 * fq;
        bf16* base = isg ? gate + (size_t)(t - 11) * 256 : proj + (size_t)t * 256; const int ldc = isg ? NGATE : NPROJ;
#pragma unroll
        for (int ai = 0; ai < 2; ++ai)
#pragma unroll
            for (int m = 0; m < 4; ++m) { const int row = row0 + ai * HALF + m * 16; bf16* rowp = base + (size_t)row * ldc + colt;
#pragma unroll
                for (int bj = 0; bj < 2; ++bj) { f32x4 v0 = acc[ai][bj][m][0], v1 = acc[ai][bj][m][1];
                    if (isg) {
#pragma unroll
                        for (int e = 0; e < 4; ++e) { v0[e] = sigmoidf_(v0[e]); v1[e] = sigmoidf_(v1[e]); } }
                    else if (t >= 9) { if (t == 10 && row < MP) { const int cv = colt + bj * HALF, bb = row / SEQ, tt = row % SEQ; bf16* vp = vt + ((size_t)(bb * SBH + (cv >> 6)) * 64 + (cv & 63)) * SEQ + tt;
#pragma unroll
                            for (int e = 0; e < 4; ++e) { vp[(size_t)e * SEQ] = (bf16)f2bf(v0[e]); vp[(size_t)(4 + e) * SEQ] = (bf16)f2bf(v1[e]); } }
                        float* o = (row < MP) ? ((t == 9 ? outk_p : outv_p) + (size_t)row * 256) : ((t == 9 ? outk_s : outv_s) + (size_t)(row - MP) * 256);
                        *(f32x4*)(o + colt + bj * HALF) = v0; *(f32x4*)(o + colt + bj * HALF + 4) = v1; }
                    v4u w; w.x = pk2(v0[0], v0[1]); w.y = pk2(v0[2], v0[3]); w.z = pk2(v1[0], v1[1]); w.w = pk2(v1[2], v1[3]);
                    *(v4u*)(rowp + bj * HALF) = w; } }
    }
};
struct EpiGlu {
    static constexpr bool PERM = true; typedef NoState State;
    const bf16* ys; bf16* y;
    __device__ __forceinline__ void operator()(const f32x4 (&acc)[2][2][4][2], State& st, const Unit& u, int wr, int wc, int fr_in, int fq_in) const {
        int fr = fr_in, fq = fq_in; OPAQUE_V(fr); OPAQUE_V(fq);
        const int row0 = u.pm * BM + wr * 64 + fr, colt = wc * 32 + 8 * fq;
#pragma unroll
        for (int ai = 0; ai < 2; ++ai)
#pragma unroll
            for (int m = 0; m < 4; ++m) { const int row = row0 + ai * HALF + m * 16;
#pragma unroll
                for (int bj = 0; bj < 2; ++bj) { const f32x4 v0 = acc[ai][bj][m][0], v1 = acc[ai][bj][m][1];
                    const v4u s = *(const v4u*)(ys + (size_t)row * 256 + colt + bj * HALF);
                    v4u w; w.x = pk2(bflo(s.x) * sigmoidf_(v0[0]), bfhi(s.x) * sigmoidf_(v0[1])); w.y = pk2(bflo(s.y) * sigmoidf_(v0[2]), bfhi(s.y) * sigmoidf_(v0[3]));
                    w.z = pk2(bflo(s.z) * sigmoidf_(v1[0]), bfhi(s.z) * sigmoidf_(v1[1])); w.w = pk2(bflo(s.w) * sigmoidf_(v1[2]), bfhi(s.w) * sigmoidf_(v1[3]));
                    *(v4u*)(y + (size_t)row * D + colt + bj * HALF) = w; } CFENCE(); }
    }
};
struct EpiMerge {
    static constexpr bool PERM = false; struct State { f32x4 macc[2][4][2]; };
    const bf16* gate; bf16* mgb;
    __device__ __forceinline__ void operator()(const f32x4 (&acc)[2][2][4][2], State& st, const Unit& u, int wr, int wc, int fr_in, int fq_in) const {
        int fr = fr_in, fq = fq_in; OPAQUE_V(fr); OPAQUE_V(fq);
        const int n_ = u.aux >> 8, pc = u.aux & 255;
        const int row0 = u.pm * BM + wr * 64 + fr, col0 = pc * HALF + wc * 32 + 4 * fq;
        v2u gw[2][4][2];
#pragma unroll
        for (int ai = 0; ai < 2; ++ai)
#pragma unroll
            for (int m = 0; m < 4; ++m)
#pragma unroll
                for (int n = 0; n < 2; ++n) gw[ai][m][n] = *(const v2u*)(gate + (size_t)(row0 + ai * HALF + m * 16) * NGATE + n_ * D + col0 + n * 16);
        CFENCE();
#pragma unroll
        for (int ai = 0; ai < 2; ++ai)
#pragma unroll
            for (int m = 0; m < 4; ++m) { const int row = row0 + ai * HALF + m * 16;
#pragma unroll
                for (int n = 0; n < 2; ++n) { const int col = col0 + n * 16; const v2u g2 = gw[ai][m][n];
                    f32x4 v = acc[ai][0][m][n]; v[0] *= bflo(g2.x); v[1] *= bfhi(g2.x); v[2] *= bflo(g2.y); v[3] *= bfhi(g2.y);
                    if (n_ > 0) v += st.macc[ai][m][n];
                    st.macc[ai][m][n] = v;
                    if (n_ == 3) { v2u o; o.x = pk2(v[0], v[1]); o.y = pk2(v[2], v[3]); *(v2u*)(mgb + (size_t)row * D + col) = o; } } }
    }
};
struct EpiRes {
    static constexpr bool PERM = false; typedef NoState State;
    const float* xP; const float* xS; const float* gmod; float* out;
    __device__ __forceinline__ void operator()(const f32x4 (&acc)[2][2][4][2], State& st, const Unit& u, int wr, int wc, int fr_in, int fq_in) const {
        int fr = fr_in, fq = fq_in; OPAQUE_V(fr); OPAQUE_V(fq);
        const int row0 = u.pm * BM + wr * 64 + fr, col0 = u.aux * BM + wc * 32 + 4 * fq;
#pragma unroll
        for (int ai = 0; ai < 2; ++ai)
#pragma unroll
            for (int m = 0; m < 4; ++m) { const int row = row0 + ai * HALF + m * 16; const float* xr = row < MP ? xP + (size_t)row * D : xS + (size_t)(row - MP) * D;
                const float* gr = gmod + (size_t)seq_of(row) * NMOD;
#pragma unroll
                for (int bj = 0; bj < 2; ++bj)
#pragma unroll
                    for (int n = 0; n < 2; ++n) { const int col = col0 + bj * HALF + n * 16;
                        const f32x4 xv = *(const f32x4*)(xr + col), gv = *(const f32x4*)(gr + col);
                        *(f32x4*)(out + (size_t)row * D + col) = xv * ALPHA + (gv + 1.0f) * acc[ai][bj][m][n]; } CFENCE(); }
    }
};
struct EpiPart {
    static constexpr bool PERM = false; typedef NoState State;
    float* part;
    __device__ __forceinline__ void operator()(const f32x4 (&acc)[2][2][4][2], State& st, const Unit& u, int wr, int wc, int fr_in, int fq_in) const {
        int fr = fr_in, fq = fq_in; OPAQUE_V(fr); OPAQUE_V(fq);
        const int ks = u.aux >> 8, pn = u.aux & 255; const int row0 = u.pm * BM - MP + wr * 64 + fr, col0 = pn * BM + wc * 32 + 4 * fq;
        float* base = part + (size_t)ks * MS * D;
#pragma unroll
        for (int ai = 0; ai < 2; ++ai)
#pragma unroll
            for (int m = 0; m < 4; ++m) { float* rowp = base + (size_t)(row0 + ai * HALF + m * 16) * D + col0;
#pragma unroll
                for (int bj = 0; bj < 2; ++bj)
#pragma unroll
                    for (int n = 0; n < 2; ++n) *(f32x4*)(rowp + bj * HALF + n * 16) = acc[ai][bj][m][n]; }
    }
};
struct EpiUp {
    static constexpr bool PERM = true; typedef NoState State;
    bf16* act;
    __device__ __forceinline__ void operator()(const f32x4 (&acc)[2][2][4][2], State& st, const Unit& u, int wr, int wc, int fr_in, int fq_in) const {
        int fr = fr_in, fq = fq_in; OPAQUE_V(fr); OPAQUE_V(fq);
        const int row0 = u.pm * BM + wr * 64 + fr, col0 = u.aux * HALF + wc * 32 + 8 * fq;
#pragma unroll
        for (int ai = 0; ai < 2; ++ai)
#pragma unroll
            for (int m = 0; m < 4; ++m) { const int row = row0 + ai * HALF + m * 16;
                const f32x4 a0 = acc[ai][0][m][0], a1 = acc[ai][0][m][1], b0 = acc[ai][1][m][0], b1 = acc[ai][1][m][1];
                v4u w; w.x = pk2(siluf_(a0[0]) * b0[0], siluf_(a0[1]) * b0[1]); w.y = pk2(siluf_(a0[2]) * b0[2], siluf_(a0[3]) * b0[3]);
                w.z = pk2(siluf_(a1[0]) * b1[0], siluf_(a1[1]) * b1[1]); w.w = pk2(siluf_(a1[2]) * b1[2], siluf_(a1[3]) * b1[3]);
                *(v4u*)(act + (size_t)row * DFF + col0) = w; }
    }
};
}
struct Args { const float* in[38]; float* out; unsigned char* ws; int ph_lo, ph_hi, li, pad; };
enum { I_XP = 0, I_XS, I_CK, I_CV, I_SRE, I_SIM, I_SCB, I_SD, I_SCD, I_PT, I_CP, I_CS, I_WADA, I_BADA, I_WIN, I_ARE, I_AIM, I_LDT, I_BRE, I_BIM, I_CRE, I_CIM, I_SSD, I_WGLU,
       I_CBW, I_DCW, I_DAL, I_DDT, I_DNW, I_WBR, I_WGATE, I_WO, I_L1G, I_L1B, I_WUP, I_WDN, I_L2G, I_L2B };
constexpr int NWAVES = 8, RING_BYTES = 131072, MISC_OFF = RING_BYTES, LDS_BYTES = 147456;
#ifndef CPU_EMU
#define XB_TMO      128
#define XB_XCNT(j)  (256  + 64 * (j))
#define XB_XSUB(j)  (1280 + 64 * (j))
#define XB_XGEN(j)  (2304 + 64 * (j))
#define XB_TOP      3328
#define XB_TOPGEN   3392
#define XCD_BAR_WORDS 3456
#define XB_SPIN_CAP (1u << 18)
__device__ __forceinline__ unsigned xb_ld(unsigned* p)              { return __hip_atomic_load(p, __ATOMIC_RELAXED, __HIP_MEMORY_SCOPE_AGENT); }
__device__ __forceinline__ unsigned xb_add(unsigned* p, unsigned v) { return __hip_atomic_fetch_add(p, v, __ATOMIC_RELAXED, __HIP_MEMORY_SCOPE_AGENT); }
__device__ __forceinline__ unsigned xb_xcc_id() { return (unsigned)__builtin_amdgcn_s_getreg((3 << 11) | 20) & 0xFu; }
#define XB_SPIN(cond, bar) do { unsigned _sp = 0; while (cond) { __builtin_amdgcn_s_sleep(1); \
    if ((++_sp & 255u) == 0u) { if (xb_ld(&(bar)[XB_TMO])) break; if (_sp > XB_SPIN_CAP) { atomicAdd(&(bar)[XB_TMO], 1u); break; } } } } while (0)
struct XcdBarrier { unsigned* bar; unsigned x; volatile LAS_HW unsigned* st; };
__device__ __forceinline__ XcdBarrier xcd_barrier_post(unsigned* bar, volatile LAS_HW unsigned* st) {
    XcdBarrier b; b.bar = bar; b.x = xb_xcc_id(); b.st = st;
    if (threadIdx.x == 0) (void)xb_add(&bar[XB_XCNT(b.x)], 1u);
    return b;
}
__device__ __forceinline__ void xcd_barrier_complete(unsigned* bar, unsigned x, unsigned& nloc, unsigned& nx) {
    const unsigned G = gridDim.x * gridDim.y * gridDim.z;
    unsigned sum, cnt, mine, sp = 0u;
    for (;;) {
        sum = 0u; cnt = 0u; mine = 0u;
#pragma unroll
        for (unsigned j = 0; j < 16; ++j) { const unsigned c = xb_ld(&bar[XB_XCNT(j)]); sum += c; cnt += (c > 0u) ? 1u : 0u; mine = (j == x) ? c : mine; }
        if (sum == G) break;
        __builtin_amdgcn_s_sleep(1);
        if ((++sp & 255u) == 0u) { if (xb_ld(&bar[XB_TMO])) break; if (sp > XB_SPIN_CAP) { atomicAdd(&bar[XB_TMO], 1u); break; } }
    }
    nloc = mine > 0u ? mine : 1u; nx = cnt > 0u ? cnt : 1u;
}
__device__ __forceinline__ void xcd_barrier(const XcdBarrier& b) {
    asm volatile("s_waitcnt vmcnt(0)" ::: "memory");
    __syncthreads();
    if (threadIdx.x == 0) {
        unsigned* bar = b.bar;
        __builtin_amdgcn_s_waitcnt(0);
        unsigned nloc = b.st[0], nx = b.st[1];
        if (nloc == 0u) { xcd_barrier_complete(bar, b.x, nloc, nx); b.st[0] = nloc; b.st[1] = nx; }
        const unsigned old = xb_add(&bar[XB_XSUB(b.x)], 1u);
        const unsigned gen = old / nloc;
        if (old + 1u == (gen + 1u) * nloc) {
            __builtin_amdgcn_fence(__ATOMIC_RELEASE, "agent");
            asm volatile("s_waitcnt vmcnt(0)" ::: "memory");
            const unsigned og = xb_add(&bar[XB_TOP], 1u);
            const unsigned tg = og / nx;
            if (og + 1u == (tg + 1u) * nx) xb_add(&bar[XB_TOPGEN], 1u);
            else XB_SPIN(xb_ld(&bar[XB_TOPGEN]) == tg, bar);
            __builtin_amdgcn_fence(__ATOMIC_ACQUIRE, "agent");
            xb_add(&bar[XB_XGEN(b.x)], 1u);
            asm volatile("s_waitcnt vmcnt(0)" ::: "memory");
        } else {
            XB_SPIN(xb_ld(&bar[XB_XGEN(b.x)]) == gen, bar);
            __builtin_amdgcn_fence(__ATOMIC_ACQUIRE, "agent");
            asm volatile("s_waitcnt vmcnt(0)" ::: "memory");
        }
    }
    __syncthreads();
}
#else
#define XCD_BAR_WORDS 3456
struct XcdBarrier { int dummy; };
inline void xcd_barrier(const XcdBarrier&) { emu::grid_sync(); }
#endif

#define TIDSV(vb_, vg_) int tid_ = threadIdx.x; OPAQUE_V(tid_); const int tid = tid_, lane = tid & 63, wave = __builtin_amdgcn_readfirstlane(tid >> 6), G = (vg_), bid = (vb_), gw = bid * NWAVES + wave, NGW = G * NWAVES; (void)lane; (void)wave; (void)gw; (void)NGW; (void)G; (void)bid
#define TIDS int tid_ = threadIdx.x; OPAQUE_V(tid_); const int tid = tid_, lane = tid & 63, wave = __builtin_amdgcn_readfirstlane(tid >> 6), G = gridDim.x, bid = blockIdx.x, gw = bid * NWAVES + wave, NGW = G * NWAVES; (void)lane; (void)wave; (void)gw; (void)NGW; (void)G; (void)bid
__device__ __forceinline__ bf16* wsb(const Args& A, size_t off) { return (bf16*)(A.ws + off); }
__device__ __forceinline__ float* wsf(const Args& A, size_t off) { return (float*)(A.ws + off); }
__device__ __forceinline__ float softplusf_(float x) { return fmaxf(x, 0.f) + log1pf(__expf(-fabsf(x))); }
__device__ __forceinline__ void tr_item(const float* W, int N, int K, int k0, int c0, bf16* WT, int drow0, LAS float* scr, int lane) {
#pragma unroll 8
    for (int i = 0; i < 32; ++i) { const int kk = 2 * i + (lane >> 5); scr[kk * 33 + (lane & 31)] = W[(size_t)(k0 + kk) * N + c0 + (lane & 31)]; }
    WAVE_SYNC();
    const int c = lane & 7;
#pragma unroll
    for (int j = 0; j < 4; ++j) { const int n = (lane >> 3) + 8 * j; const LAS float* s = scr + (8 * c) * 33 + n;
        v4u o; o.x = pk2(s[0 * 33], s[1 * 33]); o.y = pk2(s[2 * 33], s[3 * 33]); o.z = pk2(s[4 * 33], s[5 * 33]); o.w = pk2(s[6 * 33], s[7 * 33]);
        *(v4u*)(WT + (size_t)(drow0 + n) * K + k0 + 8 * c) = o; }
    WAVE_SYNC();
}
__device__ __forceinline__ void ph_prologue(const Args& A, LAS unsigned char* lds) {
    TIDS;
    LAS float* scr = (LAS float*)(lds + wave * 16384);
    constexpr int I_ADA = 16 * 192, I_IN1 = 16 * 64, I_IN2 = 16 * 24, I_GT = 16 * 128, I_GLU = 4 * 8, I_BR = 4 * 4 * 32, I_WO_ = 16 * 32, I_UP = 16 * 176, I_DN = 44 * 32;
    constexpr int PER_L = I_ADA + I_IN1 + I_IN2 + I_GT + I_GLU + I_BR + I_WO_ + I_UP + I_DN;
    for (int it = gw; it < DEPTH * PER_L; it += NGW) {
        const int l = it / PER_L; int r = it % PER_L; unsigned char* wl = A.ws + WS_W + (size_t)l * WL_SIZE;
        if (r < I_ADA) { const int kb = r / 192, nb = r % 192; tr_item(A.in[I_WADA] + (size_t)l * D * NMOD, NMOD, D, kb * 64, nb * 32, (bf16*)(wl + WL_ADA), nb * 32, scr, lane); continue; } r -= I_ADA;
        if (r < I_IN1) { const int kb = r / 64, nb = r % 64; tr_item(A.in[I_WIN] + (size_t)l * D * NIN, NIN, D, kb * 64, nb * 32, (bf16*)(wl + WL_W1), nb * 32, scr, lane); continue; } r -= I_IN1;
        if (r < I_IN2) { const int kb = r / 24, nb = r % 24; tr_item(A.in[I_WIN] + (size_t)l * D * NIN, NIN, D, kb * 64, 2056 + nb * 32, (bf16*)(wl + WL_W1), 2048 + nb * 32, scr, lane); continue; } r -= I_IN2;
        if (r < I_GT) { const int kb = r / 128, nb = r % 128; tr_item(A.in[I_WGATE] + (size_t)l * D * NGATE, NGATE, D, kb * 64, nb * 32, (bf16*)(wl + WL_W1), NPROJ + nb * 32, scr, lane); continue; } r -= I_GT;
        if (r < I_GLU) { const int kb = r / 8, nb = r % 8; tr_item(A.in[I_WGLU] + (size_t)l * 256 * 256, 256, 256, kb * 64, nb * 32, (bf16*)(wl + WL_GLU), nb * 32, scr, lane); continue; } r -= I_GLU;
        if (r < I_BR) { const int n = r / 128, r2 = r % 128, kb = r2 / 32, nb = r2 % 32; tr_item(A.in[I_WBR] + (size_t)(l * 4 + n) * 256 * D, D, 256, kb * 64, nb * 32, (bf16*)(wl + WL_BR), n * D + nb * 32, scr, lane); continue; } r -= I_BR;
        if (r < I_WO_) { const int kb = r / 32, nb = r % 32; tr_item(A.in[I_WO] + (size_t)l * D * D, D, D, kb * 64, nb * 32, (bf16*)(wl + WL_WO), nb * 32, scr, lane); continue; } r -= I_WO_;
        if (r < I_UP) { const int kb = r / 176, nb = r % 176; const int c0 = nb * 32, j = c0 < DFF ? c0 : c0 - DFF; const int drow = (j / 128) * 256 + (c0 < DFF ? 0 : 128) + (j % 128);
            tr_item(A.in[I_WUP] + (size_t)l * D * NUP, NUP, D, kb * 64, c0, (bf16*)(wl + WL_UP), drow, scr, lane); continue; } r -= I_UP;
        { const int kb = r / 32, nb = r % 32; tr_item(A.in[I_WDN] + (size_t)l * DFF * D, D, DFF, kb * 64, nb * 32, (bf16*)(wl + WL_DN), nb * 32, scr, lane); }
    }
    const int gt = bid * (NWAVES * 64) + tid, NGT = G * NWAVES * 64;
    for (int i = gt; i < DEPTH * 8 * D; i += NGT) { const int l = i / (8 * D), j = (i / D) % 8, k = i % D; ((float*)(A.ws + WS_W + (size_t)l * WL_SIZE + WL_LOG))[j * D + k] = A.in[I_WIN][((size_t)l * D + k) * NIN + 2048 + j]; }
    for (int i = gt; i < 256 * D; i += NGT) { const int r = i / D, k = i % D; float v = 0.f;
        if (r < NB) v = siluf_(A.in[I_CP][r * D + k]); else if (r < NSEQ) v = siluf_(A.in[I_CS][(r - NB) * D + k]);
        wsb(A, WS_CSILU)[i] = (bf16)f2bf(v); }
}
struct ModOrder {
    int G, c;
    __host__ __device__ bool next(int i, pg8::Unit& u) const { const int L = i * G + c; if (L >= 24 * DEPTH) return false; const int l = L / 24, pn = L % 24;
        u.pm = 0; u.pn = l * (int)(WL_SIZE / (512 * 1024)) + pn; u.ka = 0; u.kb = 0; u.aux = pn | (l << 8); return true; }
    __device__ __forceinline__ void a_ready(const pg8::Unit&) const {}
    __device__ __forceinline__ void done(const pg8::Unit&) const {}
};
struct EpiMod2 { static constexpr bool PERM = false; typedef pg8::NoState State; float* C; const float* bias;
    __device__ __forceinline__ void operator()(const f32x4 (&acc)[2][2][4][2], State& st, const pg8::Unit& u, int wr, int wc, int fr, int fq) const {
        const int l = u.aux >> 8; pg8::Unit u2 = u; u2.aux = u.aux & 255; pg8::EpiMod e{C + (size_t)l * 256 * NMOD, bias + (size_t)l * NMOD}; e(acc, st, u2, wr, wc, fr, fq); } };
template <int MODE> __device__ __forceinline__ void ph_rows(const Args& A, int l) {
    TIDS;
    const float* MOD = wsf(A, WS_MOD);
    for (int m = gw; m < M; m += NGW) {
        const float* src; float* dstx = nullptr;
        if (MODE == 0) src = m < MP ? A.in[I_XP] + (size_t)m * D : A.in[I_XS] + (size_t)(m - MP) * D;
        else if (MODE == 1) { src = wsf(A, WS_X1) + (size_t)m * D; dstx = wsf(A, WS_X1) + (size_t)m * D; }
        else { src = wsf(A, WS_X2) + (size_t)m * D; dstx = (l == DEPTH - 1) ? A.out + O_Y + (size_t)m * D : wsf(A, WS_X2) + (size_t)m * D; }
        f32x4 v[4];
#pragma unroll
        for (int j = 0; j < 4; ++j) v[j] = ((const f32x4*)src)[lane + 64 * j];
        if (MODE != 0 && m >= MP) {
            constexpr int NKS = MODE == 1 ? 4 : DFF / 256;
            const float* xin = MODE == 1 ? (l == 0 ? A.in[I_XS] + (size_t)(m - MP) * D : wsf(A, WS_X2) + (size_t)m * D) : wsf(A, WS_X1) + (size_t)m * D;
            const float* gr = MOD + ((size_t)l * 256 + seq_of(m)) * NMOD + (MODE == 1 ? 2 * D : 5 * D);
#pragma unroll
            for (int j = 0; j < 4; ++j) { f32x4 sacc = {0.f, 0.f, 0.f, 0.f};
#pragma unroll
                for (int ks = 0; ks < NKS; ++ks) sacc += ((const f32x4*)(wsf(A, WS_PART) + ((size_t)ks * MS + (m - MP)) * D))[lane + 64 * j];
                v[j] = ((const f32x4*)xin)[lane + 64 * j] * ALPHA + (((const f32x4*)gr)[lane + 64 * j] + 1.0f) * sacc; } }
        if (MODE != 0) {
            float s = 0.f;
#pragma unroll
            for (int j = 0; j < 4; ++j) s += (v[j][0] + v[j][1]) + (v[j][2] + v[j][3]);
            const float mean = wave_sum(s) * (1.f / D); float s2 = 0.f;
#pragma unroll
            for (int j = 0; j < 4; ++j) { v[j] = v[j] - mean; s2 += (v[j][0] * v[j][0] + v[j][1] * v[j][1]) + (v[j][2] * v[j][2] + v[j][3] * v[j][3]); }
            const float rstd = 1.f / sqrtf(wave_sum(s2) * (1.f / D) + LN_EPS);
            const float* gp = A.in[MODE == 1 ? I_L1G : I_L2G] + (size_t)l * D; const float* bp = A.in[MODE == 1 ? I_L1B : I_L2B] + (size_t)l * D;
#pragma unroll
            for (int j = 0; j < 4; ++j) { const f32x4 g = ((const f32x4*)gp)[lane + 64 * j], b = ((const f32x4*)bp)[lane + 64 * j]; v[j] = v[j] * rstd * g + b; ((f32x4*)dstx)[lane + 64 * j] = v[j]; }
            if (MODE == 2 && l == DEPTH - 1) continue;
        }
        const int ln = (MODE == 2) ? l + 1 : l;
        const float* mr = MOD + ((size_t)ln * 256 + seq_of(m)) * NMOD + (MODE == 1 ? 3 * D : 0);
        float s = 0.f;
#pragma unroll
        for (int j = 0; j < 4; ++j) s += (v[j][0] + v[j][1]) + (v[j][2] + v[j][3]);
        const float mean = wave_sum(s) * (1.f / D); float s2 = 0.f;
#pragma unroll
        for (int j = 0; j < 4; ++j) { v[j] = v[j] - mean; s2 += (v[j][0] * v[j][0] + v[j][1] * v[j][1]) + (v[j][2] * v[j][2] + v[j][3] * v[j][3]); }
        const float rstd = 1.f / sqrtf(wave_sum(s2) * (1.f / D) + LN_EPS);
        v2u* hrow = (v2u*)(wsb(A, WS_H) + (size_t)m * D);
#pragma unroll
        for (int j = 0; j < 4; ++j) { const f32x4 sh = ((const f32x4*)mr)[lane + 64 * j], sc = ((const f32x4*)(mr + D))[lane + 64 * j]; v[j] = v[j] * rstd * (sc + 1.0f) + sh;
            v2u o; o.x = pk2(v[j][0], v[j][1]); o.y = pk2(v[j][2], v[j][3]); hrow[lane + 64 * j] = o; }
        if (MODE != 1) {
            const float* wl = (const float*)(A.ws + WS_W + (size_t)ln * WL_SIZE + WL_LOG);
            float lg[8];
#pragma unroll
            for (int jj = 0; jj < 8; ++jj) { float t = 0.f;
#pragma unroll
                for (int j = 0; j < 4; ++j) { const f32x4 w = ((const f32x4*)(wl + jj * D))[lane + 64 * j]; t += (v[j][0] * w[0] + v[j][1] * w[1]) + (v[j][2] * w[2] + v[j][3] * w[3]); }
                lg[jj] = wave_sum(t); }
            if (lane == 0) { float* o = wsf(A, WS_LOG8) + (size_t)m * 8; *(f32x4*)o = (f32x4){lg[0], lg[1], lg[2], lg[3]}; *(f32x4*)(o + 4) = (f32x4){lg[4], lg[5], lg[6], lg[7]}; }
        }
    }
}
struct SsmC { float abr, abi, bbr[16], bbi[16]; };
__device__ __forceinline__ void ssm_consts(const Args& A, int l, int g, int p, SsmC& c) {
    const int gi = l * 16 + g;
    const float dt = expf(A.in[I_LDT][gi]), ar = A.in[I_ARE][gi * 64 + p], ai = A.in[I_AIM][gi * 64 + p];
    const float mag = expf(dt * ar); c.abr = mag * cosf(dt * ai); c.abi = mag * sinf(dt * ai);
    const float den = ar * ar + ai * ai, fre = ((c.abr - 1.0f) * ar + c.abi * ai) / den, fim = (c.abi * ar - (c.abr - 1.0f) * ai) / den;
    const f32x4* br = (const f32x4*)(A.in[I_BRE] + (size_t)(gi * 64 + p) * 16); const f32x4* bi = (const f32x4*)(A.in[I_BIM] + (size_t)(gi * 64 + p) * 16);
#pragma unroll
    for (int q = 0; q < 4; ++q) { const f32x4 r = br[q], i = bi[q];
#pragma unroll
        for (int e = 0; e < 4; ++e) { c.bbr[4 * q + e] = fre * r[e] - fim * i[e]; c.bbi[4 * q + e] = fre * i[e] + fim * r[e]; } }
}
__device__ __forceinline__ void ssm_step(const SsmC& c, const bf16* urow, float& hr, float& hi) {
    const v4u u0 = *(const v4u*)urow, u1 = *(const v4u*)(urow + 8);
    float u[16] = {bflo(u0.x), bfhi(u0.x), bflo(u0.y), bfhi(u0.y), bflo(u0.z), bfhi(u0.z), bflo(u0.w), bfhi(u0.w), bflo(u1.x), bfhi(u1.x), bflo(u1.y), bfhi(u1.y), bflo(u1.z), bfhi(u1.z), bflo(u1.w), bfhi(u1.w)};
    float br = 0.f, bi = 0.f;
#pragma unroll
    for (int h = 0; h < 16; ++h) { br += c.bbr[h] * u[h]; bi += c.bbi[h] * u[h]; }
    const float nr = c.abr * hr - c.abi * hi + br, ni = c.abr * hi + c.abi * hr + bi; hr = nr; hi = ni;
}
constexpr int SSM_NCT = (NB * SSM_NCH + 15) / 16;
__device__ __forceinline__ void ph_ssm1(const Args& A, int l) {
    TIDS;
    const bf16* proj = wsb(A, WS_PROJ); const int gg = lane >> 4, i16 = lane & 15;
    for (int un = gw; un < 16 * 8 * SSM_NCT; un += NGW) {
        const int ctile = un % SSM_NCT, rt = (un / SSM_NCT) % 8, g = un / (SSM_NCT * 8);
        const int cidx = ctile * 16 + i16; const bool valid = cidx < NB * SSM_NCH; const int b = valid ? cidx / SSM_NCH : 0, c = valid ? cidx % SSM_NCH : 0;
        const bf16* up = proj + (size_t)(b * SEQ + c * SSM_CH + (gg >> 1)) * NPROJ + PC_U + g * 16 + 8 * (gg & 1);
        const bf16x8* wf = (const bf16x8*)(A.ws + WS_SSMW + (size_t)l * SSMW_L) + (size_t)((g * 8 + rt) * (SSM_CH / 2)) * 64 + lane;
        f32x4 acc = {0.f, 0.f, 0.f, 0.f};
#pragma unroll 8
        for (int ks = 0; ks < SSM_CH / 2; ++ks) { bf16x8 bv = *(const bf16x8*)(up + (size_t)(2 * ks) * NPROJ); if (!valid) bv = (bf16x8){0, 0, 0, 0, 0, 0, 0, 0};
            acc = __builtin_amdgcn_mfma_f32_16x16x32_bf16(wf[(size_t)ks * 64], bv, acc, 0, 0, 0); }
        if (valid) { float* sp = wsf(A, WS_SEND) + ((size_t)(b * 16 + g) * 128 + 16 * rt + 4 * gg) * SSM_NCH + c;
#pragma unroll
            for (int r = 0; r < 4; ++r) sp[(size_t)r * SSM_NCH] = acc[r]; }
    }
}
__device__ __forceinline__ void ph_ssm_weights(const Args& A) {
    TIDS;
    const int gt = bid * (NWAVES * 64) + tid, NGT = G * NWAVES * 64;
    for (int it = gt; it < DEPTH * 16 * 8 * (SSM_CH / 2) * 64; it += NGT) {
        const int ln = it & 63, ks = (it >> 6) % (SSM_CH / 2), rt = (it / (64 * (SSM_CH / 2))) % 8, g = (it / (64 * (SSM_CH / 2) * 8)) % 16, l = it / (64 * (SSM_CH / 2) * 8 * 16);
        const int gg = ln >> 4, rs = 16 * rt + (ln & 15), p = rs & 63, t = 2 * ks + (gg >> 1), h0 = 8 * (gg & 1), gi = l * 16 + g;
        const float dt = expf(A.in[I_LDT][gi]), ar = A.in[I_ARE][gi * 64 + p], ai = A.in[I_AIM][gi * 64 + p];
        const float mag = expf(dt * ar), abr = mag * cosf(dt * ai), abi = mag * sinf(dt * ai);
        const float den = ar * ar + ai * ai, fre = ((abr - 1.0f) * ar + abi * ai) / den, fim = (abi * ar - (abr - 1.0f) * ai) / den;
        const float n = (float)(SSM_CH - 1 - t), pm = expf(n * dt * ar), pr = pm * cosf(n * dt * ai), pi = pm * sinf(n * dt * ai);
        const float cr = pr * fre - pi * fim, ci = pr * fim + pi * fre;
        const float* br = A.in[I_BRE] + (size_t)(gi * 64 + p) * 16 + h0; const float* bi = A.in[I_BIM] + (size_t)(gi * 64 + p) * 16 + h0;
        float v[8];
#pragma unroll
        for (int j = 0; j < 8; ++j) v[j] = rs < 64 ? cr * br[j] - ci * bi[j] : cr * bi[j] + ci * br[j];
        v4u o; o.x = pk2(v[0], v[1]); o.y = pk2(v[2], v[3]); o.z = pk2(v[4], v[5]); o.w = pk2(v[6], v[7]);
        ((v4u*)(A.ws + WS_SSMW + (size_t)l * SSMW_L))[(size_t)((g * 8 + rt) * (SSM_CH / 2) + ks) * 64 + ln] = o;
    }
}
__device__ __forceinline__ float gelu_tanh(float x) { const float e = __expf(2.0f * 0.7978845608028654f * (x + 0.044715f * x * x * x)); return 0.5f * x * (2.0f - 2.0f / (1.0f + e)); }
__device__ __forceinline__ void ph_ssm2(const Args& A, LAS unsigned char* lds, int l, int vb, int vg) {
    TIDSV(vb, vg);
    LAS float* uf = (LAS float*)(lds + wave * 16384);
    LAS bf16* ht = (LAS bf16*)(uf + 256);
    const bf16* proj = wsb(A, WS_PROJ);
    const int gg = lane >> 4, i16 = lane & 15;
    constexpr int NPU = NB * 16 * SSM_NCH, NSU = DB * 16;
    for (int un = gw; un < NPU + NSU; un += NGW) {
        int g, m0, ntok; float hr, hi; float* fre = nullptr; float* fim = nullptr;
        if (un < NPU) { const int c = un % SSM_NCH; g = (un / SSM_NCH) % 16; const int b = un / (SSM_NCH * 16); m0 = b * SEQ + c * SSM_CH; ntok = SSM_CH;
            {
              const int gi0 = l * 16 + g; const float dt0 = expf(A.in[I_LDT][gi0]), ar0 = A.in[I_ARE][gi0 * 64 + lane], ai0 = A.in[I_AIM][gi0 * 64 + lane];
              const float mg0 = expf(dt0 * ar0); float pr = mg0 * cosf(dt0 * ai0), pi = mg0 * sinf(dt0 * ai0);
              for (int sq = 1; sq < SSM_CH; sq <<= 1) { const float nr = pr * pr - pi * pi, ni = 2.f * pr * pi; pr = nr; pi = ni; }
              hr = 0.f; hi = 0.f; const float* spr = wsf(A, WS_SEND) + ((size_t)(b * 16 + g) * 128 + lane) * SSM_NCH; const float* spi = spr + (size_t)64 * SSM_NCH;
              for (int c4 = 0; c4 < c; c4 += 4) { const f32x4 sr = *(const f32x4*)(spr + c4), si = *(const f32x4*)(spi + c4);
#pragma unroll
                  for (int e = 0; e < 4; ++e) if (c4 + e < c) { const float nr = pr * hr - pi * hi + sr[e], ni = pr * hi + pi * hr + si[e]; hr = nr; hi = ni; } } }
            if (c == SSM_NCH - 1) { fre = A.out + O_REP + ((size_t)(l * NB + b) * 16 + g) * 64; fim = A.out + O_IMP + ((size_t)(l * NB + b) * 16 + g) * 64; } }
        else { const int su = un - NPU; g = su & 15; const int s = su >> 4; m0 = MP + s * DEC_SEQ; ntok = DEC_SEQ;
            hr = A.in[I_SRE][((size_t)(l * DB + s) * 16 + g) * 64 + lane]; hi = A.in[I_SIM][((size_t)(l * DB + s) * 16 + g) * 64 + lane];
            fre = A.out + O_RES + ((size_t)(l * DB + s) * 16 + g) * 64; fim = A.out + O_IMS + ((size_t)(l * DB + s) * 16 + g) * 64; }
        SsmC k; ssm_consts(A, l, g, lane, k);
        const int gi = l * 16 + g;
        bf16x8 Cb[4];
#pragma unroll
        for (int ks = 0; ks < 4; ++ks) { const float* cp = A.in[ks < 2 ? I_CRE : I_CIM] + ((size_t)gi * 16 + i16) * 64 + 32 * (ks & 1) + 8 * gg; const float sg = ks < 2 ? 1.0f : -1.0f;
            const f32x4 c0 = *(const f32x4*)cp * sg, c1 = *(const f32x4*)(cp + 4) * sg; Cb[ks] = acc2b(c0, c1); }
        const float dd = A.in[I_SSD][l * 256 + g * 16 + i16];
        for (int t0 = 0; t0 < ntok; t0 += 16) {
            const int nt = (ntok - t0) < 16 ? (ntok - t0) : 16;
            { const int tt = lane >> 2, c4 = (lane & 3) * 4;
              if (tt < nt) { const v2u w = *(const v2u*)(proj + (size_t)(m0 + t0 + tt) * NPROJ + PC_U + g * 16 + c4); *(LAS f32x4*)(uf + tt * 16 + c4) = (f32x4){bflo(w.x), bfhi(w.x), bflo(w.y), bfhi(w.y)}; } }
            WAVE_SYNC();
            for (int t = 0; t < nt; ++t) {
                float br = 0.f, bi = 0.f;
#pragma unroll
                for (int q = 0; q < 4; ++q) { const f32x4 u = *(const LAS f32x4*)(uf + t * 16 + 4 * q);
#pragma unroll
                    for (int e = 0; e < 4; ++e) { br += k.bbr[4 * q + e] * u[e]; bi += k.bbi[4 * q + e] * u[e]; } }
                const float nr = k.abr * hr - k.abi * hi + br, ni = k.abr * hi + k.abi * hr + bi; hr = nr; hi = ni;
                ht[t * 136 + lane] = (bf16)f2bf(hr); ht[t * 136 + 64 + lane] = (bf16)f2bf(hi);
            }
            WAVE_SYNC();
            f32x4 acc = {0.f, 0.f, 0.f, 0.f};
#pragma unroll
            for (int ks = 0; ks < 4; ++ks) acc = __builtin_amdgcn_mfma_f32_16x16x32_bf16(*(const LAS bf16x8*)(ht + i16 * 136 + 32 * ks + 8 * gg), Cb[ks], acc, 0, 0, 0);
#pragma unroll
            for (int r = 0; r < 4; ++r) { const int tt = 4 * gg + r;
                if (tt < nt) { const float y = acc[r] + dd * uf[tt * 16 + i16]; wsb(A, WS_YS)[(size_t)(m0 + t0 + tt) * 256 + g * 16 + i16] = (bf16)f2bf(gelu_tanh(y)); } }
            WAVE_SYNC();
        }
        if (fre) { fre[lane] = hr; fim[lane] = hi; }
    }
}
__device__ __forceinline__ void ph_conv(const Args& A, int l, int vb, int vg) {
    TIDSV(vb, vg);
    const int gt = bid * (NWAVES * 64) + tid, NGT = G * NWAVES * 64;
    const bf16* proj = wsb(A, WS_PROJ);
    for (int i = gt; i < M * 128; i += NGT) {
        const int m = i >> 7, c = (i & 127) * 2;
        int t, L; const float* hist = nullptr; float* so;
        if (m < MP) { t = m % SEQ; L = SEQ; so = A.out + O_CBP + (size_t)(l * NB + m / SEQ) * 512; }
        else { const int s = (m - MP) / DEC_SEQ; t = (m - MP) % DEC_SEQ; L = DEC_SEQ; hist = A.in[I_SCB] + (size_t)(l * DB + s) * 512; so = A.out + O_CBS + (size_t)(l * DB + s) * 512; }
        float cx0[3], cx1[3];
#pragma unroll
        for (int j = 0; j < 3; ++j) { const int tt = t - 2 + j;
            if (tt >= 0) { const bf16* r = proj + (size_t)(m - 2 + j) * NPROJ; const unsigned cg = *(const unsigned*)(r + PC_CG + c), xc = *(const unsigned*)(r + PC_XC + c); cx0[j] = bflo(cg) * bflo(xc); cx1[j] = bfhi(cg) * bfhi(xc); }
            else if (hist) { cx0[j] = hist[(2 + tt) * 256 + c]; cx1[j] = hist[(2 + tt) * 256 + c + 1]; }
            else { cx0[j] = 0.f; cx1[j] = 0.f; } }
        const float* w = A.in[I_CBW] + (size_t)l * 3 * 256;
        const float o0 = w[c] * cx0[0] + w[256 + c] * cx0[1] + w[512 + c] * cx0[2], o1 = w[c + 1] * cx1[0] + w[256 + c + 1] * cx1[1] + w[512 + c + 1] * cx1[2];
        const unsigned bg = *(const unsigned*)(proj + (size_t)m * NPROJ + PC_BG + c);
        *(unsigned*)(wsb(A, WS_Y) + (size_t)m * D + 256 + c) = pk2(bflo(bg) * o0, bfhi(bg) * o1);
        if (t >= L - 2) { so[(t - (L - 2)) * 256 + c] = cx0[2]; so[(t - (L - 2)) * 256 + c + 1] = cx1[2]; }
    }
}
__device__ __forceinline__ void ph_gdn_c1(const Args& A, LAS unsigned char* lds, int l) {
    TIDS;
    constexpr int XS = 72, GS = 68, RS = 132;
    LAS bf16* Qs = (LAS bf16*)lds; LAS bf16* Ks = Qs + 64 * XS; LAS bf16* Vs = Ks + 64 * XS;
    LAS float* GKK = (LAS float*)(lds + 27648); LAS float* GQK = GKK + 64 * GS; LAS float* rhs = GQK + 64 * GS;
    LAS float* Linv = rhs + 64 * RS; LAS float* sc = Linv + 1024;
    LAS float* DQ = sc, *DK = sc + 64, *RQ = sc + 128, *RK = sc + 192, *BET = sc + 256, *GC = sc + 320, *EGC = sc + 384, *EK = sc + 448;
    LAS float* Wst = GQK;
    const bf16* proj = wsb(A, WS_PROJ); const float* cw = A.in[I_DCW] + (size_t)l * 4 * GQKV; const float* lg8 = wsf(A, WS_LOG8);
    const int g = lane >> 4, i16 = lane & 15;
    for (int un = bid; un < NB * GH * GNCH; un += G) {
        const int c = un % GNCH, h = (un / GNCH) % GH, b = un / (GNCH * GH); const int m0 = b * SEQ + c * GCH;
        unsigned char* gd = A.ws + WS_GD + (size_t)un * GD_UNIT;
        if (wave < 6) { const int sec = wave >> 1, th = wave & 1, src = sec * 256 + h * 64 + lane, t0 = c * GCH + th * 32;
            const float w0 = cw[src], w1 = cw[GQKV + src], w2 = cw[2 * GQKV + src], w3 = cw[3 * GQKV + src];
            float x[35];
#pragma unroll
            for (int k = 0; k < 35; ++k) { const int tt = t0 - 3 + k; x[k] = tt >= 0 ? bf2f(proj[(size_t)(b * SEQ + tt) * NPROJ + PC_QKV + src]) : 0.f; }
            LAS bf16* X = sec == 0 ? Qs : (sec == 1 ? Ks : Vs);
#pragma unroll
            for (int k = 0; k < 32; ++k) X[(th * 32 + k) * XS + lane] = (bf16)f2bf(siluf_(w0 * x[k] + w1 * x[k + 1] + w2 * x[k + 2] + w3 * x[k + 3]));
            if (c == GNCH - 1 && th == 1) {
#pragma unroll
                for (int k = 0; k < 3; ++k) A.out[O_CDP + ((size_t)(l * NB + b) * 3 + k) * GQKV + src] = x[32 + k]; } }
        __syncthreads();
#pragma unroll
        for (int q2 = 0; q2 < 2; ++q2) { const int tt = 2 * wave + q2, rt = tt >> 2, ct = tt & 3;
            f32x4 akk = {0.f, 0.f, 0.f, 0.f}, aqk = {0.f, 0.f, 0.f, 0.f};
#pragma unroll
            for (int s = 0; s < 2; ++s) { const bf16x8 kc = *(const LAS bf16x8*)(Ks + (16 * ct + i16) * XS + 32 * s + 8 * g), kr = *(const LAS bf16x8*)(Ks + (16 * rt + i16) * XS + 32 * s + 8 * g),
                                                         qr = *(const LAS bf16x8*)(Qs + (16 * rt + i16) * XS + 32 * s + 8 * g);
                akk = __builtin_amdgcn_mfma_f32_16x16x32_bf16(kr, kc, akk, 0, 0, 0); aqk = __builtin_amdgcn_mfma_f32_16x16x32_bf16(qr, kc, aqk, 0, 0, 0); }
#pragma unroll
            for (int r = 0; r < 4; ++r) { GKK[(16 * rt + 4 * g + r) * GS + 16 * ct + i16] = akk[r]; GQK[(16 * rt + 4 * g + r) * GS + 16 * ct + i16] = aqk[r]; }
            if (rt == ct && g == (i16 >> 2)) { const int r = i16 & 3; DK[16 * rt + i16] = r == 0 ? akk[0] : r == 1 ? akk[1] : r == 2 ? akk[2] : akk[3]; } }
        if (wave < 4) { f32x4 aqq = {0.f, 0.f, 0.f, 0.f};
#pragma unroll
            for (int s = 0; s < 2; ++s) { const bf16x8 qr = *(const LAS bf16x8*)(Qs + (16 * wave + i16) * XS + 32 * s + 8 * g); aqq = __builtin_amdgcn_mfma_f32_16x16x32_bf16(qr, qr, aqq, 0, 0, 0); }
            if (g == (i16 >> 2)) { const int r = i16 & 3; DQ[16 * wave + i16] = r == 0 ? aqq[0] : r == 1 ? aqq[1] : r == 2 ? aqq[2] : aqq[3]; } }
        __syncthreads();
        if (wave == 0) { const float* lr = lg8 + (size_t)(m0 + lane) * 8;
            const float gv = -expf(A.in[I_DAL][l * 4 + h]) * softplusf_(lr[4 + h] + A.in[I_DDT][l * 4 + h]);
            float gc = gv;
#pragma unroll
            for (int o = 1; o < 64; o <<= 1) { const float t = __shfl_up(gc, o); if (lane >= o) gc += t; }
            const float gl = __shfl(gc, 63);
            RK[lane] = 1.0f / sqrtf(DK[lane] + RMS_EPS); RQ[lane] = 0.125f / sqrtf(DQ[lane] + RMS_EPS); BET[lane] = sigmoidf_(lr[h]); GC[lane] = gc; EGC[lane] = expf(gc); EK[lane] = expf(gl - gc);
            if (lane == 0) wsf(A, WS_EGL)[un] = expf(gl); }
        __syncthreads();
        for (int idx = tid; idx < 4096; idx += 512) { const int i = idx >> 6, j = idx & 63; GKK[i * GS + j] = i > j ? BET[i] * RK[i] * RK[j] * GKK[i * GS + j] * expf(GC[i] - GC[j]) : 0.f; }
        for (int idx = tid; idx < 64 * 128; idx += 512) { const int i = idx >> 7, cc = idx & 127; rhs[i * RS + cc] = cc < 64 ? BET[i] * bf2f(Vs[i * XS + cc]) : BET[i] * EGC[i] * RK[i] * bf2f(Ks[i * XS + cc - 64]); }
        for (int idx = tid; idx < 4096; idx += 512) { const int f = idx >> 9, ln = (idx >> 3) & 63, j = idx & 7, row = 16 * (f >> 1) + (ln & 15), kx = 32 * (f & 1) + 16 * (j >> 2) + 4 * (ln >> 4) + (j & 3);
            ((bf16*)gd)[8192 + idx] = (bf16)f2bf(row >= kx ? RQ[row] * RK[kx] * GQK[row * GS + kx] * expf(GC[row] - GC[kx]) : 0.f);
            ((bf16*)gd)[4096 + idx] = (bf16)f2bf(bf2f(Qs[row * XS + kx]) * RQ[row] * EGC[row]);
            ((bf16*)gd)[12288 + idx] = (bf16)f2bf(bf2f(Ks[kx * XS + row]) * RK[kx] * EK[kx]); }
        __syncthreads();
        if (wave == 0) { const int blk = lane >> 4, cI = lane & 15; float x[16];
            x[0] = cI == 0 ? 1.f : 0.f;
#pragma unroll
            for (int i = 1; i < 16; ++i) { float sacc = cI == i ? 1.f : 0.f;
#pragma unroll
                for (int j = 0; j < i; ++j) sacc -= GKK[(16 * blk + i) * GS + 16 * blk + j] * x[j];
                x[i] = sacc; }
#pragma unroll
            for (int i = 0; i < 16; ++i) Linv[blk * 256 + i * 16 + cI] = x[i]; }
        __syncthreads();
        { const f32x4 Z = {0.f, 0.f, 0.f, 0.f}; f32x4 X[4];
#define C1_LD4(p) ((f32x4)(*(const LAS f32x4*)(p)) * 1.0f)
#define C1_LF(I) acc2b(C1_LD4(Linv + (I) * 256 + i16 * 16 + 4 * g), Z)
#define C1_MF2(I, J) acc2b(-*(const LAS f32x4*)(GKK + (16 * (I) + i16) * GS + 16 * (J) + 4 * g), -*(const LAS f32x4*)(GKK + (16 * (I) + i16) * GS + 16 * ((J) + 1) + 4 * g))
#define C1_MF1(I, J) acc2b(-*(const LAS f32x4*)(GKK + (16 * (I) + i16) * GS + 16 * (J) + 4 * g), Z)
#define C1_R(I) (f32x4){rhs[(16 * (I) + 4 * g) * RS + 16 * wave + i16], rhs[(16 * (I) + 4 * g + 1) * RS + 16 * wave + i16], rhs[(16 * (I) + 4 * g + 2) * RS + 16 * wave + i16], rhs[(16 * (I) + 4 * g + 3) * RS + 16 * wave + i16]}
            f32x4 R = C1_R(0);
            X[0] = __builtin_amdgcn_mfma_f32_16x16x32_bf16(C1_LF(0), acc2b(R, Z), Z, 0, 0, 0);
            R = C1_R(1); R = __builtin_amdgcn_mfma_f32_16x16x32_bf16(C1_MF1(1, 0), acc2b(X[0], Z), R, 0, 0, 0);
            X[1] = __builtin_amdgcn_mfma_f32_16x16x32_bf16(C1_LF(1), acc2b(R, Z), Z, 0, 0, 0);
            const bf16x8 X01 = acc2b(X[0], X[1]);
            R = C1_R(2); R = __builtin_amdgcn_mfma_f32_16x16x32_bf16(C1_MF2(2, 0), X01, R, 0, 0, 0);
            X[2] = __builtin_amdgcn_mfma_f32_16x16x32_bf16(C1_LF(2), acc2b(R, Z), Z, 0, 0, 0);
            R = C1_R(3); R = __builtin_amdgcn_mfma_f32_16x16x32_bf16(C1_MF2(3, 0), X01, R, 0, 0, 0); R = __builtin_amdgcn_mfma_f32_16x16x32_bf16(C1_MF1(3, 2), acc2b(X[2], Z), R, 0, 0, 0);
            X[3] = __builtin_amdgcn_mfma_f32_16x16x32_bf16(C1_LF(3), acc2b(R, Z), Z, 0, 0, 0);
#undef C1_LF
#undef C1_LD4
#undef C1_MF2
#undef C1_MF1
#undef C1_R
            if (wave < 4) {
#pragma unroll
                for (int I = 0; I < 4; ++I) ((f32x4*)(gd + 32768))[(wave * 4 + I) * 64 + lane] = X[I]; }
            else {
#pragma unroll
                for (int I = 0; I < 4; ++I)
#pragma unroll
                    for (int r = 0; r < 4; ++r) Wst[(16 * I + 4 * g + r) * GS + 16 * (wave - 4) + i16] = -X[I][r]; } }
        __syncthreads();
        for (int idx = tid; idx < 4096; idx += 512) { const int f = idx >> 9, ln = (idx >> 3) & 63, j = idx & 7, row = 16 * (f >> 1) + (ln & 15), kx = 32 * (f & 1) + 16 * (j >> 2) + 4 * (ln >> 4) + (j & 3);
            ((bf16*)gd)[idx] = (bf16)f2bf(Wst[row * GS + kx]); }
        __syncthreads();
    }
}
__device__ __forceinline__ void ph_gdn_scan(const Args& A, LAS unsigned char* lds, int l) {
    TIDS;
    for (int grp2 = bid; grp2 < NB * GH * 2; grp2 += G) {
        const int grp = grp2 >> 1, half = grp2 & 1, h = grp % GH, b = grp / GH;
        const unsigned char* gbase = A.ws + WS_GD + (size_t)(b * GH + h) * GNCH * GD_UNIT;
        LAS float* egt = (LAS float*)(lds + 2 * GD_UNIT);
        if (wave >= 4) {
            const int lw = wave - 4; v4u r0[12], r1[12], r2[12], r3[12];
            const v4u* src = (const v4u*)gbase + lw * 12 * 64 + lane;
            LAS v4u* dst0 = (LAS v4u*)lds + lw * 12 * 64 + lane;
#define SC_LOAD(R, c) do { const int c_ = (c) < GNCH ? (c) : GNCH - 1; _Pragma("unroll") for (int k = 0; k < 12; ++k) R[k] = src[(size_t)c_ * (GD_UNIT / 16) + k * 64]; } while (0)
#define SC_STORE(R, c) do { LAS v4u* d_ = dst0 + ((c) & 1) * (GD_UNIT / 16); _Pragma("unroll") for (int k = 0; k < 12; ++k) d_[k * 64] = R[k]; } while (0)
            SC_LOAD(r0, 0); SC_STORE(r0, 0); SC_LOAD(r1, 1); SC_LOAD(r2, 2); SC_LOAD(r3, 3); SC_LOAD(r0, 4);
            if (lw == 0) { for (int k = lane; k < GNCH; k += 64) egt[k] = wsf(A, WS_EGL)[(size_t)(b * GH + h) * GNCH + k]; }
            RAW_BAR();
            for (int c = 0; c < GNCH; c += 4) {
                SC_STORE(r1, c + 1); SC_LOAD(r1, c + 5); RAW_BAR();
                SC_STORE(r2, c + 2); SC_LOAD(r2, c + 6); RAW_BAR();
                SC_STORE(r3, c + 3); SC_LOAD(r3, c + 7); RAW_BAR();
                SC_STORE(r0, c + 4); SC_LOAD(r0, c + 8); RAW_BAR();
            }
#undef SC_LOAD
#undef SC_STORE
        } else {
            const int vs = half * 2 + (wave & 1), g = lane >> 4, cc = lane & 15; const bool act = wave < 2;
            f32x4 S[4];
#pragma unroll
            for (int T = 0; T < 4; ++T) S[T] = (f32x4){0.f, 0.f, 0.f, 0.f};
            RAW_BAR();
            for (int c = 0; c < GNCH; ++c) {
                const float egl = egt[c];
                if (act) {
                const LAS unsigned char* slot = lds + (c & 1) * GD_UNIT;
                const LAS bf16x8* fr = (const LAS bf16x8*)slot + lane;
                const LAS f32x4* uvp = (const LAS f32x4*)(slot + 32768) + (vs * 4) * 64 + lane;
                bf16x8 F[4][8]; f32x4 u[4], o[4];
#pragma unroll
                for (int x = 0; x < 4; ++x)
#pragma unroll
                    for (int f = 0; f < 8; ++f) F[x][f] = fr[(x * 8 + f) * 64];
#pragma unroll
                for (int T = 0; T < 4; ++T) u[T] = uvp[T * 64];
                CFENCE();
                bf16x8 Sb[2] = {acc2b(S[0], S[1]), acc2b(S[2], S[3])};
#pragma unroll
                for (int T = 0; T < 4; ++T) { o[T] = (f32x4){0.f, 0.f, 0.f, 0.f};
#pragma unroll
                    for (int s = 0; s < 2; ++s) { u[T] = __builtin_amdgcn_mfma_f32_16x16x32_bf16(F[0][2 * T + s], Sb[s], u[T], 0, 0, 0); o[T] = __builtin_amdgcn_mfma_f32_16x16x32_bf16(F[1][2 * T + s], Sb[s], o[T], 0, 0, 0); } }
                bf16x8 ub[2] = {acc2b(u[0], u[1]), acc2b(u[2], u[3])};
#pragma unroll
                for (int T = 0; T < 4; ++T) { S[T] = S[T] * egl;
#pragma unroll
                    for (int s = 0; s < 2; ++s) { S[T] = __builtin_amdgcn_mfma_f32_16x16x32_bf16(F[3][2 * T + s], ub[s], S[T], 0, 0, 0); o[T] = __builtin_amdgcn_mfma_f32_16x16x32_bf16(F[2][2 * T + s], ub[s], o[T], 0, 0, 0); } }
                float* od = wsf(A, WS_ODRAW) + (size_t)(b * SEQ + c * GCH + 4 * g) * 256 + h * 64 + vs * 16 + cc;
#pragma unroll
                for (int T = 0; T < 4; ++T)
#pragma unroll
                    for (int r = 0; r < 4; ++r) od[(size_t)(16 * T + r) * 256] = o[T][r];
                }
                RAW_BAR();
            }
            if (act) {
            float* so = A.out + O_DP + (((size_t)(l * NB + b) * GH + h) * 64 + 4 * g) * 64 + vs * 16 + cc;
#pragma unroll
            for (int T = 0; T < 4; ++T)
#pragma unroll
                for (int r = 0; r < 4; ++r) so[(16 * T + r) * 64] = S[T][r];
            }
        }
        __syncthreads();
    }
}
__device__ __forceinline__ void ph_gdn_sample(const Args& A, LAS unsigned char* lds, int l, int vb, int vg) {
    TIDSV(vb, vg);
    if (wave < 2 || wave >= 7) return;
    LAS float* S = (LAS float*)(lds + 40960 + (wave - 2) * 16384);
    LAS float* kq = (LAS float*)(lds + MISC_OFF + 1024 + wave * 512);
    const bf16* proj = wsb(A, WS_PROJ); const float* cw = A.in[I_DCW] + (size_t)l * 4 * GQKV; const float* lg8 = wsf(A, WS_LOG8);
    for (int un = (wave - 2) * G + bid; un < DB * GH; un += 5 * G) {
        const int h = un % GH, s = un / GH;
        const float* s0 = A.in[I_SD] + ((size_t)(l * DB + s) * GH + h) * 4096;
        const float* hist = A.in[I_SCD] + (size_t)(l * DB + s) * 3 * GQKV;
        float xr[3][7];
#pragma unroll
        for (int sec = 0; sec < 3; ++sec) { const int src = sec * 256 + h * 64 + lane;
#pragma unroll
            for (int j = 0; j < 3; ++j) xr[sec][j] = hist[j * GQKV + src];
#pragma unroll
            for (int t = 0; t < 4; ++t) xr[sec][3 + t] = bf2f(proj[(size_t)(MP + s * DEC_SEQ + t) * NPROJ + PC_QKV + src]); }
        float lgb[4], lga[4];
#pragma unroll
        for (int t = 0; t < 4; ++t) { const float* lr = lg8 + ((size_t)MP + s * DEC_SEQ + t) * 8; lgb[t] = lr[h]; lga[t] = lr[4 + h]; }
#pragma unroll 16
        for (int kk = 0; kk < 64; ++kk) S[kk * 64 + lane] = s0[kk * 64 + lane];
        const float al = __expf(A.in[I_DAL][l * 4 + h]), dtb = A.in[I_DDT][l * 4 + h];
#pragma unroll
        for (int t = 0; t < DEC_SEQ; ++t) {
            const size_t m = (size_t)MP + s * DEC_SEQ + t;
            float val[3];
#pragma unroll
            for (int sec = 0; sec < 3; ++sec) { const int src = sec * 256 + h * 64 + lane;
                val[sec] = siluf_(cw[src] * xr[sec][t] + cw[GQKV + src] * xr[sec][t + 1] + cw[2 * GQKV + src] * xr[sec][t + 2] + cw[3 * GQKV + src] * xr[sec][t + 3]);
                if (t >= 1) A.out[O_CDS + ((size_t)(l * DB + s) * 3 + (t - 1)) * GQKV + src] = xr[sec][t + 3]; }
            const float sq = wave_sum(val[0] * val[0]), sk = wave_sum(val[1] * val[1]);
            const float qv = val[0] * (1.0f / sqrtf(sq + RMS_EPS)) * 0.125f, kv = val[1] * (1.0f / sqrtf(sk + RMS_EPS)), vv = val[2];
            const float beta = sigmoidf_(lgb[t]); const float xs = lga[t] + dtb; const float a = __expf(-al * (fmaxf(xs, 0.f) + __logf(1.0f + __expf(-fabsf(xs)))));
            kq[lane] = kv; kq[64 + lane] = qv;
            WAVE_SYNC();
            float kS = 0.f;
#pragma unroll 16
            for (int kk = 0; kk < 64; ++kk) kS += kq[kk] * S[kk * 64 + lane];
            float o = 0.f;
#pragma unroll 16
            for (int kk = 0; kk < 64; ++kk) { const float bk = beta * kq[kk]; const float sn = a * (S[kk * 64 + lane] - bk * kS) + bk * vv; S[kk * 64 + lane] = sn; o += kq[64 + kk] * sn; }
            wsf(A, WS_ODRAW)[m * 256 + h * 64 + lane] = o;
            WAVE_SYNC();
        }
        float* so = A.out + O_DS + ((size_t)(l * DB + s) * GH + h) * 4096;
#pragma unroll 16
        for (int kk = 0; kk < 64; ++kk) so[kk * 64 + lane] = S[kk * 64 + lane];
    }
}
__device__ __forceinline__ void ph_gdn_out(const Args& A, int l) {
    TIDS;
    const int sub = lane >> 4, c4 = (lane & 15) * 4;
    const f32x4 nw = *(const f32x4*)(A.in[I_DNW] + l * 64 + c4);
    for (int idx = gw * 4 + sub; idx < M * GH; idx += NGW * 4) { const size_t m = idx >> 2; const int h = idx & 3;
        const f32x4 o = *(const f32x4*)(wsf(A, WS_ODRAW) + m * 256 + h * 64 + c4);
        float ss = (o[0] * o[0] + o[1] * o[1]) + (o[2] * o[2] + o[3] * o[3]);
        ss += __shfl_xor(ss, 1); ss += __shfl_xor(ss, 2); ss += __shfl_xor(ss, 4); ss += __shfl_xor(ss, 8);
        const float rs = 1.0f / sqrtf(ss * (1.0f / 64.0f) + RMS_EPS);
        const v2u zw = *(const v2u*)(wsb(A, WS_PROJ) + m * NPROJ + PC_Z + h * 64 + c4);
        v2u ov; ov.x = pk2(o[0] * rs * nw[0] * siluf_(bflo(zw.x)), o[1] * rs * nw[1] * siluf_(bfhi(zw.x))); ov.y = pk2(o[2] * rs * nw[2] * siluf_(bflo(zw.y)), o[3] * rs * nw[3] * siluf_(bfhi(zw.y)));
        *(v2u*)(wsb(A, WS_Y) + m * D + 512 + h * 64 + c4) = ov; }
}
__device__ __forceinline__ void sb_terms(float z, float& ls, float& ln) { const float L = log1pf(__expf(-fabsf(z))); ls = fminf(z, 0.f) - L; ln = -fmaxf(z, 0.f) - L; }
constexpr float SB_CUT = -105.0f;
__device__ __forceinline__ void ph_sb_prompt(const Args& A, int l, int vb, int vg) {
    TIDSV(vb, vg); (void)l;
    const bf16* proj = wsb(A, WS_PROJ); const bf16* vtg = wsb(A, WS_VT);
    constexpr int NQB = SEQ / 32;
    const int g = lane >> 4, i16 = lane & 15;
    for (int un0 = gw; un0 < NB * SBH * NQB; un0 += NGW) {
        const int un = NB * SBH * NQB - 1 - un0;
        const int qb = un / (NB * SBH), h = un % SBH, b = (un / SBH) % NB;
        const int q0 = qb * 32;
        bf16x8 Qb[2][2];
#pragma unroll
        for (int ct = 0; ct < 2; ++ct)
#pragma unroll
            for (int s = 0; s < 2; ++s) Qb[ct][s] = *(const bf16x8*)(proj + ((size_t)b * SEQ + q0 + 16 * ct + i16) * NPROJ + PC_Q + h * 64 + 32 * s + 8 * g);
        f32x4 O[4][2];
#pragma unroll
        for (int rt = 0; rt < 4; ++rt) { O[rt][0] = (f32x4){0.f, 0.f, 0.f, 0.f}; O[rt][1] = (f32x4){0.f, 0.f, 0.f, 0.f}; }
        float R[2] = {0.f, 0.f};
        const bf16* vth = vtg + ((size_t)(b * SBH + h) * 64) * SEQ;
        for (int kb = q0 >> 6; kb >= 0; --kb) {
            const int k0 = kb * 64;
            bf16x8 Ka[4][2], Va[4][2];
#pragma unroll
            for (int T = 0; T < 4; ++T)
#pragma unroll
                for (int s = 0; s < 2; ++s) { Ka[T][s] = *(const bf16x8*)(proj + ((size_t)b * SEQ + k0 + 16 * (i16 >> 2) + 4 * T + (i16 & 3)) * NPROJ + PC_K + h * 64 + 32 * s + 8 * g);
                                              Va[T][s] = *(const bf16x8*)(vth + (size_t)(16 * T + i16) * SEQ + k0 + 16 * g + 8 * s); }
            const bool diag = (k0 + 63 >= q0);
#pragma unroll
            for (int ct = 0; ct < 2; ++ct) {
                f32x4 z[4];
#pragma unroll
                for (int T = 0; T < 4; ++T) { z[T] = (f32x4){0.f, 0.f, 0.f, 0.f};
#pragma unroll
                    for (int s = 0; s < 2; ++s) z[T] = __builtin_amdgcn_mfma_f32_16x16x32_bf16(Ka[T][s], Qb[ct][s], z[T], 0, 0, 0); }
                const int qi = q0 + 16 * ct + i16;
                float run = 0.f; f32x4 lsv[4], sfx[4];
#pragma unroll
                for (int T = 3; T >= 0; --T)
#pragma unroll
                    for (int r = 3; r >= 0; --r) { const float zz = z[T][r] * 0.125f; const float L = __logf(1.0f + __expf(-fabsf(zz))); const float ls = fminf(zz, 0.f) - L;
                        const bool valid = !diag || (k0 + 16 * g + 4 * T + r) < qi;
                        lsv[T][r] = valid ? ls : -1e30f; sfx[T][r] = run; run += valid ? (ls - zz) : 0.f; }
                const float p1 = __shfl_down(run, 16), p2 = __shfl_down(run, 32), p3 = __shfl_down(run, 48);
                const float gs = (g < 3 ? p1 : 0.f) + (g < 2 ? p2 : 0.f) + (g < 1 ? p3 : 0.f);
                float tot = run + __shfl_xor(run, 16); tot += __shfl_xor(tot, 32);
                const float base = R[ct] + gs;
#pragma unroll
                for (int T = 0; T < 4; ++T)
#pragma unroll
                    for (int r = 0; r < 4; ++r) z[T][r] = __expf(lsv[T][r] + base + sfx[T][r]);
                R[ct] += tot;
                const bf16x8 Wb0 = acc2b(z[0], z[1]), Wb1 = acc2b(z[2], z[3]);
#pragma unroll
                for (int rt = 0; rt < 4; ++rt) { O[rt][ct] = __builtin_amdgcn_mfma_f32_16x16x32_bf16(Va[rt][0], Wb0, O[rt][ct], 0, 0, 0); O[rt][ct] = __builtin_amdgcn_mfma_f32_16x16x32_bf16(Va[rt][1], Wb1, O[rt][ct], 0, 0, 0); }
            }
            if (!diag && __all(R[0] < SB_CUT && R[1] < SB_CUT)) break;
        }
#pragma unroll
        for (int ct = 0; ct < 2; ++ct)
#pragma unroll
            for (int rt = 0; rt < 4; ++rt) { v2u o; o.x = pk2(O[rt][ct][0], O[rt][ct][1]); o.y = pk2(O[rt][ct][2], O[rt][ct][3]);
                *(v2u*)(wsb(A, WS_Y) + ((size_t)b * SEQ + q0 + 16 * ct + i16) * D + 768 + h * 64 + 16 * rt + 4 * g) = o; }
    }
}
__device__ __forceinline__ void ph_sb_sample(const Args& A, LAS unsigned char* lds, int l, int vb, int vg) {
    TIDSV(vb, vg);
    if (wave >= 2) return;
    LAS float* vt = (LAS float*)(lds + wave * 20480);
    LAS float* qs = vt + 64 * 68;
    LAS float* wq = qs + 256;
    const bf16* proj = wsb(A, WS_PROJ); const int* pt = (const int*)A.in[I_PT];
    for (int un = wave * G + bid; un < DB * SBH; un += 2 * G) {
        const int h = un % SBH, s = un / SBH;
#pragma unroll
        for (int qi = 0; qi < 4; ++qi) qs[qi * 64 + lane] = bf2f(proj[((size_t)MP + s * DEC_SEQ + qi) * NPROJ + PC_Q + h * 64 + lane]) * 0.125f;
        WAVE_SYNC();
        float R[4] = {0.f, 0.f, 0.f, 0.f}; f32x4 acc = {0.f, 0.f, 0.f, 0.f};
        const int qi_b = lane & 3, ds = lane >> 2;
        for (int tile = 0; tile * 64 < PAST + DEC_SEQ; ++tile) {
            const int p = PAST + DEC_SEQ - 1 - (tile * 64 + lane);
            f32x4 kr[16], vr[16];
            if (p >= PAST) { const bf16* rp = proj + ((size_t)MP + s * DEC_SEQ + (p - PAST)) * NPROJ + h * 64;
#pragma unroll
                for (int x = 0; x < 8; ++x) { const v4u kw = ((const v4u*)(rp + PC_K))[x], vw = ((const v4u*)(rp + PC_V))[x];
                    kr[2 * x] = (f32x4){bflo(kw.x), bfhi(kw.x), bflo(kw.y), bfhi(kw.y)}; kr[2 * x + 1] = (f32x4){bflo(kw.z), bfhi(kw.z), bflo(kw.w), bfhi(kw.w)};
                    vr[2 * x] = (f32x4){bflo(vw.x), bfhi(vw.x), bflo(vw.y), bfhi(vw.y)}; vr[2 * x + 1] = (f32x4){bflo(vw.z), bfhi(vw.z), bflo(vw.w), bfhi(vw.w)}; } }
            else if (p >= 0) { const int page = pt[s * NPAGES + p / PAGE]; const size_t off = ((((size_t)l * NPOOL + page) * PAGE + p % PAGE) * SBH + h) * 64;
#pragma unroll
                for (int x = 0; x < 16; ++x) { kr[x] = ((const f32x4*)(A.in[I_CK] + off))[x]; vr[x] = ((const f32x4*)(A.in[I_CV] + off))[x]; } }
            else {
#pragma unroll
                for (int x = 0; x < 16; ++x) { kr[x] = (f32x4){0.f, 0.f, 0.f, 0.f}; vr[x] = (f32x4){0.f, 0.f, 0.f, 0.f}; } }
#pragma unroll
            for (int x = 0; x < 16; ++x) *(LAS f32x4*)(vt + lane * 68 + 4 * x) = vr[x];
#pragma unroll
            for (int qi = 0; qi < 4; ++qi) { float z = 0.f;
#pragma unroll
                for (int x = 0; x < 16; ++x) { const f32x4 qv = *(const LAS f32x4*)(qs + qi * 64 + 4 * x); z += (kr[x][0] * qv[0] + kr[x][1] * qv[1]) + (kr[x][2] * qv[2] + kr[x][3] * qv[3]); }
                float ls, ln; sb_terms(z, ls, ln);
                const bool valid = p >= 0 && p < PAST + qi; const float lnv = valid ? ln : 0.f;
                float incl = lnv;
#pragma unroll
                for (int o = 1; o < 64; o <<= 1) { const float t = __shfl_up(incl, o); if (lane >= o) incl += t; }
                wq[qi * 64 + lane] = valid ? __expf(ls + R[qi] + (incl - lnv)) : 0.f;
                R[qi] += __shfl(incl, 63); }
            WAVE_SYNC();
#pragma unroll 8
            for (int key = 0; key < 64; ++key) acc += *(const LAS f32x4*)(vt + key * 68 + 4 * ds) * wq[qi_b * 64 + key];
            WAVE_SYNC();
            if (R[0] < SB_CUT && R[1] < SB_CUT && R[2] < SB_CUT && R[3] < SB_CUT) break;
        }
        v2u o; o.x = pk2(acc[0], acc[1]); o.y = pk2(acc[2], acc[3]);
        *(v2u*)(wsb(A, WS_Y) + ((size_t)MP + s * DEC_SEQ + qi_b) * D + 768 + h * 64 + ds * 4) = o;
    }
}
constexpr int PH_PER_LAYER = 12, NPHASE = 2 + PH_PER_LAYER * DEPTH;
#ifndef DUP_MASK
#define DUP_MASK 0
#endif
#if DUP_MASK
__device__ __forceinline__ int rep_n(int k) { int n = ((DUP_MASK >> k) & 1) ? 2 : 1; asm volatile("" : "+s"(n)); return n; }
#define REP(k) _Pragma("nounroll") for (int rep_ = 0, repn_ = rep_n(k); rep_ < repn_; ++rep_)
#else
#define REP(k)
#endif
#ifndef PROBE_LAST
#define PROBE_LAST 0
#endif
#ifndef TIME_SUB
#define TIME_SUB 0
#endif
#ifndef TIME_MASK
#define TIME_MASK 0
#endif
#ifndef MK_N_LAUNCHES
#define MK_N_LAUNCHES 1
#endif
__global__ void __launch_bounds__(NWAVES * 64, 2) fwd_kernel(Args A) {
#ifndef CPU_EMU
    extern __shared__ __attribute__((aligned(16))) unsigned char lds_raw[];
    LAS unsigned char* lds = (LAS unsigned char*)lds_raw;
    volatile LAS unsigned* MISC = (volatile LAS unsigned*)(lds + MISC_OFF);
    for (int u = threadIdx.x; u < (LDS_BYTES - MISC_OFF) / 4; u += NWAVES * 64) ((LAS unsigned*)(lds + MISC_OFF))[u] = 0u;
    __syncthreads();
    XcdBarrier bar; bar.bar = (unsigned*)(A.ws + WS_CTL) + CW_BAR + A.li * XCD_BAR_WORDS; bar.x = 0; bar.st = nullptr;
    if (A.ph_hi - A.ph_lo > 1) bar = xcd_barrier_post((unsigned*)(A.ws + WS_CTL) + CW_BAR + A.li * XCD_BAR_WORDS, MISC + 8);
#else
    unsigned char* lds = emu::B->lds; XcdBarrier bar{0};
#endif
    const int lo = A.ph_lo, hi = A.ph_hi, G = gridDim.x, bid = blockIdx.x;
#define IN(k) (lo <= (k) && (k) < hi)
#if TIME_MASK || TIME_SUB
    unsigned long long tp_ = __builtin_amdgcn_s_memrealtime(), tacc_ = 0;
#define SEAM(k) do { if (IN((k) + 1)) xcd_barrier(bar); { const unsigned long long tn_ = __builtin_amdgcn_s_memrealtime(); if ((TIME_MASK >> (k)) & 1) tacc_ += tn_ - tp_; tp_ = tn_; } } while (0)
#else
#define SEAM(k) do { if (IN((k) + 1)) xcd_barrier(bar); } while (0)
#endif
    if (IN(0)) { REP(9) ph_prologue(A, lds); ph_ssm_weights(A); SEAM(0); }
    if (IN(1)) {
        pg8::Gemm g{wsb(A, WS_CSILU), (const bf16*)(A.ws + WS_W + WL_ADA), D, D, D}; ModOrder S{G, bid}; EpiMod2 E{wsf(A, WS_MOD), A.in[I_BADA]};
        pg8::gemm_phase<EpiMod2, ModOrder, true, true>(lds, g, S, E); SEAM(1);
    }
    for (int l = 0; l < DEPTH; ++l) {
        const int pb = 2 + PH_PER_LAYER * l;
        unsigned char* wl = A.ws + WS_W + (size_t)l * WL_SIZE;
        if (IN(pb + 0)) { if (l == 0) ph_rows<0>(A, 0); SEAM(pb + 0); }
        if (IN(pb + 1)) {
            pg8::Gemm g{wsb(A, WS_H), (const bf16*)(wl + WL_W1), D, D, D}; pg8::GridOrder S; S.init(M / 256, N1 / 256, G, bid);
            pg8::EpiProj E{wsb(A, WS_PROJ), wsb(A, WS_GATE), A.out + O_KP + (size_t)l * MP * 256, A.out + O_VP + (size_t)l * MP * 256, A.out + O_KS + (size_t)l * MS * 256, A.out + O_VS + (size_t)l * MS * 256, wsb(A, WS_VT)};
            REP(5) pg8::gemm_phase<pg8::EpiProj, pg8::GridOrder, true, true>(lds, g, S, E); SEAM(pb + 1);
        }
#if TIME_SUB
#define SUBT(k, call) do { const unsigned long long ts_ = __builtin_amdgcn_s_memrealtime(); call; if ((TIME_SUB >> (k)) & 1) tacc_ += __builtin_amdgcn_s_memrealtime() - ts_; } while (0)
#else
#define SUBT(k, call) do { call; } while (0)
#endif
        if (IN(pb + 2)) { SUBT(0, REP(3) ph_gdn_c1(A, lds, l)); SUBT(4, REP(4) ph_ssm1(A, l)); SUBT(6, SEAM(pb + 2)); }
        if (IN(pb + 3)) {
            constexpr int NSC = NB * GH * 2; const bool split = G > NSC + 8; const int vb = split ? bid - NSC : bid, vg = split ? G - NSC : G;
            if (!split || bid < NSC) { SUBT(7, REP(0) ph_gdn_scan(A, lds, l)); }
            if (!split || bid >= NSC) { __syncthreads();
                SUBT(1, REP(2) ph_sb_prompt(A, l, vb, vg)); SUBT(8, REP(4) ph_ssm2(A, lds, l, (vb + vg / 4) % vg, vg)); __syncthreads();
                SUBT(2, REP(10) ph_gdn_sample(A, lds, l, (vb + vg / 2) % vg, vg)); SUBT(3, REP(1) ph_sb_sample(A, lds, l, (vb + (3 * vg) / 4) % vg, vg)); SUBT(5, REP(10) ph_conv(A, l, vb, vg)); }
            SUBT(9, SEAM(pb + 3)); }
        if (IN(pb + 4)) { REP(10) ph_gdn_out(A, l); SEAM(pb + 4); }
        if (IN(pb + 5)) {
            pg8::Gemm g{wsb(A, WS_YS), (const bf16*)(wl + WL_GLU), 256, 256, 256}; pg8::GridOrder S; S.init(M / 256, 1, G, bid);
            pg8::EpiGlu E{wsb(A, WS_YS), wsb(A, WS_Y)};
            REP(8) pg8::gemm_phase<pg8::EpiGlu, pg8::GridOrder, true, true>(lds, g, S, E); SEAM(pb + 5);
        }
        if (IN(pb + 6)) {
            pg8::Gemm g{wsb(A, WS_Y), (const bf16*)(wl + WL_BR), D, 256, 256}; pg8::MergeOrder S; S.init(M / 256, 8, G, bid);
            pg8::EpiMerge E; E.gate = wsb(A, WS_GATE); E.mgb = wsb(A, WS_MERGEB);
            REP(6) pg8::gemm_phase<pg8::EpiMerge, pg8::MergeOrder, true, true, true>(lds, g, S, E); SEAM(pb + 6);
        }
        if (IN(pb + 7)) {
            { pg8::Gemm g{wsb(A, WS_MERGEB), (const bf16*)(wl + WL_WO), D, D, D}; pg8::GridOrder S; S.init(MP / 256, 4, G, bid);
              pg8::EpiRes E{l == 0 ? A.in[I_XP] : wsf(A, WS_X2), l == 0 ? A.in[I_XS] : wsf(A, WS_X2) + (size_t)MP * D, wsf(A, WS_MOD) + (size_t)l * 256 * NMOD + 2 * D, wsf(A, WS_X1)};
              REP(8) pg8::gemm_phase<pg8::EpiRes, pg8::GridOrder, true, true>(lds, g, S, E); }
            { pg8::Gemm g{wsb(A, WS_MERGEB), (const bf16*)(wl + WL_WO), D, D, 256}; pg8::SplitOrder S{G, (bid + 128) % G, MP / 256, MS / 256, 4, 4};
              pg8::EpiPart E{wsf(A, WS_PART)};
              REP(8) pg8::gemm_phase<pg8::EpiPart, pg8::SplitOrder, true, true>(lds, g, S, E); }
            SEAM(pb + 7);
        }
        if (IN(pb + 8)) { ph_rows<1>(A, l); SEAM(pb + 8); }
        if (IN(pb + 9)) {
            pg8::Gemm g{wsb(A, WS_H), (const bf16*)(wl + WL_UP), D, D, D}; pg8::GridOrder S; S.init(M / 256, NUP / 256, G, bid);
            pg8::EpiUp E{wsb(A, WS_ACT)};
            REP(7) pg8::gemm_phase<pg8::EpiUp, pg8::GridOrder, true, true>(lds, g, S, E); SEAM(pb + 9);
        }
        if (IN(pb + 10)) {
            { pg8::Gemm g{wsb(A, WS_ACT), (const bf16*)(wl + WL_DN), DFF, DFF, DFF}; pg8::GridOrder S; S.init(MP / 256, 4, G, bid);
              pg8::EpiRes E{wsf(A, WS_X1), wsf(A, WS_X1) + (size_t)MP * D, wsf(A, WS_MOD) + (size_t)l * 256 * NMOD + 5 * D, wsf(A, WS_X2)};
              REP(7) pg8::gemm_phase<pg8::EpiRes, pg8::GridOrder, true, true>(lds, g, S, E); }
            { pg8::Gemm g{wsb(A, WS_ACT), (const bf16*)(wl + WL_DN), DFF, DFF, 256}; pg8::SplitOrder S{G, (bid + 128) % G, MP / 256, MS / 256, 4, DFF / 256};
              pg8::EpiPart E{wsf(A, WS_PART)};
              REP(7) pg8::gemm_phase<pg8::EpiPart, pg8::SplitOrder, true, true>(lds, g, S, E); }
            SEAM(pb + 10);
        }
        if (IN(pb + 11)) { ph_rows<2>(A, l); SEAM(pb + 11); }
    }
#if TIME_MASK || TIME_SUB
    if (blockIdx.x == (PROBE_LAST == 1 ? gridDim.x - 1 : PROBE_LAST) && threadIdx.x == 0) { const unsigned long long t0_ = __builtin_amdgcn_s_memrealtime(); while (__builtin_amdgcn_s_memrealtime() - t0_ < 4 * tacc_) __builtin_amdgcn_s_sleep(8); }
#endif
#undef IN
#undef SEAM
}
#ifndef CPU_EMU
extern "C" void kernel_launch(void* const* d_in, const int* in_sizes, int n_in, void* d_out, int out_size, void* d_ws, size_t ws_size, hipStream_t stream) {
    static int grid = 0;
    if (grid == 0) {
        if (n_in != 38 || (size_t)out_size != O_END || ws_size < WS_END) { fprintf(stderr, "kernel_launch: unexpected shapes (n_in %d out %d ws %zu; want 38, %zu, >= %zu)\n", n_in, out_size, ws_size, (size_t)O_END, (size_t)WS_END); grid = -1; return; }
        int dev = 0, cus = 0, per_cu = 0;
        if (hipGetDevice(&dev) != hipSuccess || hipDeviceGetAttribute(&cus, hipDeviceAttributeMultiprocessorCount, dev) != hipSuccess) { grid = -1; return; }
        if (hipFuncSetAttribute((const void*)fwd_kernel, hipFuncAttributeMaxDynamicSharedMemorySize, LDS_BYTES) != hipSuccess) { fprintf(stderr, "kernel_launch: hipFuncSetAttribute failed\n"); grid = -1; return; }
        if (hipOccupancyMaxActiveBlocksPerMultiprocessor(&per_cu, (const void*)fwd_kernel, NWAVES * 64, LDS_BYTES) != hipSuccess || per_cu < 1) { fprintf(stderr, "kernel_launch: occupancy query says %d\n", per_cu); }
        (void)hipGetLastError();
        grid = cus;
    }
    if (grid < 0) return;
    if (hipMemsetAsync((char*)d_ws + WS_CTL, 0, CTL_ZERO_BYTES, stream) != hipSuccess) return;
    Args a{};
    for (int i = 0; i < 38; ++i) a.in[i] = (const float*)d_in[i];
    a.out = (float*)d_out; a.ws = (unsigned char*)d_ws;
    if (MK_N_LAUNCHES == 1) { a.ph_lo = 0; a.ph_hi = NPHASE; a.li = 0; hipLaunchKernelGGL(fwd_kernel, dim3(grid), dim3(NWAVES * 64), LDS_BYTES, stream, a); }
    else for (int p = 0; p < NPHASE; ++p) { if (p == 2 + PH_PER_LAYER) continue; a.ph_lo = p; a.ph_hi = p + 1; a.li = 0; hipLaunchKernelGGL(fwd_kernel, dim3(grid), dim3(NWAVES * 64), LDS_BYTES, stream, a); }
}
#endif
```

```cpp
#ifndef CPU_EMU
#include <hip/hip_runtime.h>
#endif
#include <cstdio>
#include <cstdint>
#include <cmath>

constexpr int D = 1024, NB = 2, DEPTH = 2, DEC_SEQ = 4, PAGE = 128;
#ifdef CPU_EMU
#ifndef EMU_SEQ
#define EMU_SEQ 512
#endif
#ifndef EMU_DB
#define EMU_DB 64
#endif
#ifndef EMU_PAST
#define EMU_PAST 512
#endif
constexpr int SEQ = EMU_SEQ, DB = EMU_DB, PAST = EMU_PAST;
#else
constexpr int SEQ = 8192, DB = 128, PAST = 2048;
#endif
constexpr int NPAGES = PAST / PAGE, NUSED = DB * NPAGES, NPOOL = NUSED + (NUSED / 4 > 1 ? NUSED / 4 : 1);
constexpr int MP = NB * SEQ, MS = DB * DEC_SEQ, M = MP + MS, NSEQ = NB + DB;
constexpr int WMIX = 256, NPROJ = 2816, NIN = 2824, NGATE = 4096, N1 = NPROJ + NGATE, DFF = 2816, NUP = 2 * DFF, NMOD = 6 * D;
constexpr int SSM_G = 16, SSM_P = 64, SSM_CH = 128, SSM_NCH = SEQ / SSM_CH;
constexpr int GH = 4, GDK = 64, GCH = 64, GNCH = SEQ / GCH, GQKV = 768;
constexpr int SBH = 4;
constexpr int PC_U = 0, PC_BG = 256, PC_CG = 512, PC_XC = 768, PC_QKV = 1024, PC_Z = 1792, PC_Q = 2048, PC_K = 2304, PC_V = 2560;
constexpr float LN_EPS = 1e-5f, RMS_EPS = 1e-6f, ALPHA = 1.41421356237309515f  ;
static_assert(M % 256 == 0 && MP % 256 == 0 && SEQ % 256 == 0 && NSEQ <= 256, "tile shapes");
constexpr size_t O_Y = 0, O_KP = (size_t)M * D, O_VP = O_KP + (size_t)DEPTH * MP * 256, O_KS = O_VP + (size_t)DEPTH * MP * 256, O_VS = O_KS + (size_t)DEPTH * MS * 256,
    O_REP = O_VS + (size_t)DEPTH * MS * 256, O_IMP = O_REP + DEPTH * NB * 1024, O_RES = O_IMP + DEPTH * NB * 1024, O_IMS = O_RES + (size_t)DEPTH * DB * 1024,
    O_CBP = O_IMS + (size_t)DEPTH * DB * 1024, O_CBS = O_CBP + DEPTH * NB * 512, O_DP = O_CBS + (size_t)DEPTH * DB * 512, O_DS = O_DP + (size_t)DEPTH * NB * 16384,
    O_CDP = O_DS + (size_t)DEPTH * DB * 16384, O_CDS = O_CDP + DEPTH * NB * 2304, O_END = O_CDS + (size_t)DEPTH * DB * 2304;

constexpr size_t MiB = 1u << 20;
constexpr size_t al(size_t x) { return (x + 4095) & ~(size_t)4095; }
constexpr size_t WS_CTL = 0, CTL_ZERO_BYTES = 1 * MiB;
constexpr size_t WL_ADA = 0, WL_W1 = WL_ADA + (size_t)NMOD * D * 2, WL_GLU = WL_W1 + (size_t)N1 * D * 2, WL_BR = WL_GLU + 256 * 256 * 2, WL_WO = WL_BR + (size_t)4 * D * 256 * 2,
    WL_UP = WL_WO + (size_t)D * D * 2, WL_DN = WL_UP + (size_t)NUP * D * 2, WL_LOG = WL_DN + (size_t)D * DFF * 2, WL_SIZE = (WL_LOG + 8 * D * 4 + 524287) & ~(size_t)524287;
constexpr size_t WS_W = 1 * MiB, WS_CSILU = WS_W + DEPTH * WL_SIZE, WS_MOD = WS_CSILU + 256 * D * 2, WS_H = WS_MOD + (size_t)DEPTH * 256 * NMOD * 4,
    WS_PROJ = WS_H + (size_t)M * D * 2, WS_GATE = al(WS_PROJ + (size_t)M * NPROJ * 2), WS_LOG8 = WS_GATE + (size_t)M * NGATE * 2, WS_Y = WS_LOG8 + (size_t)M * 8 * 4,
    WS_YS = WS_Y + (size_t)M * D * 2, WS_MERGE = WS_YS + (size_t)M * 256 * 2, WS_MERGEB = WS_MERGE + (size_t)M * D * 4, WS_X1 = WS_MERGEB + (size_t)M * D * 2,
    WS_ACT = WS_X1 + (size_t)M * D * 4, WS_X2 = al(WS_ACT + (size_t)M * DFF * 2), WS_SEND = WS_X2 + (size_t)M * D * 4, WS_HIN = WS_SEND + (size_t)NB * 16 * SSM_NCH * 128 * 4,
    WS_GD = WS_HIN + (size_t)NB * 16 * SSM_NCH * 128 * 4, WS_EGL = WS_GD + (size_t)NB * GH * GNCH * 49152, WS_ODRAW = al(WS_EGL + (size_t)NB * GH * GNCH * 4),
    WS_VT = al(WS_ODRAW + (size_t)M * 256 * 4), WS_SSMW = al(WS_VT + (size_t)NB * SBH * 64 * SEQ * 2), WS_PART = al(WS_SSMW + (size_t)DEPTH * 16 * 8 * (SSM_CH / 2) * 64 * 16), WS_END = WS_PART + (size_t)(DFF / 256) * MS * D * 4;
constexpr size_t SSMW_L = (size_t)16 * 8 * (SSM_CH / 2) * 64 * 16;
constexpr int CW_TMO = 0, CW_BAR = 4096;
constexpr size_t GD_UNIT = 49152;

#define LAS_HW __attribute__((address_space(3)))
#ifdef CPU_EMU
#define LAS
#else
#define LAS LAS_HW
#endif
typedef unsigned short bf16;
typedef unsigned v4u __attribute__((ext_vector_type(4)));
typedef unsigned v2u __attribute__((ext_vector_type(2)));
typedef float f32x4 __attribute__((ext_vector_type(4)));
typedef float f32x2 __attribute__((ext_vector_type(2)));
typedef short bf16x8 __attribute__((ext_vector_type(8)));
#ifdef CPU_EMU
#define LDS_WAIT() do {} while (0)
#define VM_WAIT() do {} while (0)
#define WAVE_SYNC() emu::wave_sync()
#define CFENCE() do {} while (0)
#define RAW_BAR() emu::block_sync()
#else
#define LDS_WAIT() asm volatile("s_waitcnt lgkmcnt(0)" ::: "memory")
#define VM_WAIT() asm volatile("s_waitcnt vmcnt(0)" ::: "memory")
#define WAVE_SYNC() do { asm volatile("s_waitcnt lgkmcnt(0)" ::: "memory"); __builtin_amdgcn_wave_barrier(); } while (0)
#define CFENCE() asm volatile("" ::: "memory")
#define RAW_BAR() do { asm volatile("s_waitcnt lgkmcnt(0)" ::: "memory"); __builtin_amdgcn_s_barrier(); asm volatile("" ::: "memory"); } while (0)
#endif
#ifdef CPU_EMU
#define OPAQUE_V(x) do {} while (0)
#else
#define OPAQUE_V(x) asm volatile("" : "+v"(x))
#endif
__device__ __forceinline__ unsigned f2bf(float f) { unsigned u = __builtin_bit_cast(unsigned, f); return (u + 0x7fffu + ((u >> 16) & 1u)) >> 16; }
#ifdef CPU_EMU
__device__ __forceinline__ unsigned pk2(float lo, float hi) { return f2bf(lo) | (f2bf(hi) << 16); }
#else
typedef __bf16 hwbf16x2 __attribute__((ext_vector_type(2)));
__device__ __forceinline__ unsigned pk2(float lo, float hi) { const f32x2 v = {lo, hi}; return __builtin_bit_cast(unsigned, __builtin_convertvector(v, hwbf16x2)); }
#endif
__device__ __forceinline__ float bf2f(unsigned b) { return __builtin_bit_cast(float, b << 16); }
__device__ __forceinline__ float bflo(unsigned w) { return __builtin_bit_cast(float, w << 16); }
__device__ __forceinline__ float bfhi(unsigned w) { return __builtin_bit_cast(float, w & 0xffff0000u); }
__device__ __forceinline__ float sigmoidf_(float x) { return __builtin_amdgcn_rcpf(1.0f + __expf(-x)); }
__device__ __forceinline__ float siluf_(float x) { return x * __builtin_amdgcn_rcpf(1.0f + __expf(-x)); }
__device__ __forceinline__ bf16x8 acc2b(const f32x4& lo, const f32x4& hi) { v4u w; w.x = pk2(lo[0], lo[1]); w.y = pk2(lo[2], lo[3]); w.z = pk2(hi[0], hi[1]); w.w = pk2(hi[2], hi[3]); return __builtin_bit_cast(bf16x8, w); }
#ifdef CPU_EMU
__device__ __forceinline__ float wave_sum(float v) {
#pragma unroll
    for (int o = 1; o < 64; o <<= 1) v += __shfl_xor(v, o);
    return v;
}
#else
#define WS_DPP(v, ctrl, rmask) __builtin_bit_cast(float, __builtin_amdgcn_update_dpp(0, __builtin_bit_cast(int, v), ctrl, rmask, 0xf, false))
__device__ __forceinline__ float wave_sum(float v) {
    v += WS_DPP(v, 0xB1, 0xf);
    v += WS_DPP(v, 0x4E, 0xf);
    v += WS_DPP(v, 0x114, 0xf);
    v += WS_DPP(v, 0x118, 0xf);
    v += WS_DPP(v, 0x142, 0xa);
    v += WS_DPP(v, 0x143, 0xc);
    return __builtin_bit_cast(float, __builtin_amdgcn_readlane(__builtin_bit_cast(int, v), 63));
}
#endif
__device__ __forceinline__ int seq_of(int m) { return m < MP ? m / SEQ : NB + (m - MP) / DEC_SEQ; }
namespace pg8 {
typedef unsigned short bf16_t;
constexpr int BM = 256, BK = 64, HALF = 128, HTB = HALF * BK * 2, STAGE_BYTES = 8 * HTB, NXCD = 8, WGM = 8;
__host__ __device__ __forceinline__ int lds_byte(int r, int c) { const int st = (r >> 4) * 2 + (c >> 5), rr = r & 15, cc = c & 31, ob = rr * 64 + cc * 2; return st * 1024 + (ob ^ (((ob >> 9) & 1) << 5)); }
__host__ __device__ __forceinline__ void stage_rc(int b, int& R, int& C) { const int st = b / 1024, sb = b % 1024, swz = sb ^ (((sb >> 9) & 1) << 5); R = (st >> 1) * 16 + swz / 64; C = (st & 1) * 32 + (swz % 64) / 2; }
__host__ __device__ __forceinline__ int perm32(int rho) { const int n = rho >> 4, i = rho & 15; return 8 * (i >> 2) + 4 * n + (i & 3); }
struct Unit { int pm, pn, ka, kb, aux; };
struct NoState {};
struct Gemm { const bf16_t* A; const bf16_t* Bt; int lda, ldb, K; };
struct GridOrder {
    int nM, nN, nwg, G, c, pn0;
    __host__ __device__ void init(int nM_, int nN_, int G_, int c_, int pn0_ = 0) { nM = nM_; nN = nN_; nwg = nM * nN; G = G_; c = c_; pn0 = pn0_; }
    __host__ __device__ bool tile(long L, int& pm, int& pn) const {
        if (L >= nwg) return false;
        int wgid = (int)L; { const int q = nwg / NXCD, r = nwg % NXCD, xcd = wgid % NXCD, off = wgid / NXCD; wgid = (xcd < r ? xcd * (q + 1) : r * (q + 1) + (xcd - r) * q) + off; }
        const int nig = WGM * nN, gid = wgid / nig, fm = gid * WGM, gsz = (nM - fm) < WGM ? (nM - fm) : WGM;
        pm = fm + ((wgid % nig) % gsz); pn = (wgid % nig) / gsz; return true;
    }
    __host__ __device__ bool next(int i, Unit& u) const { int pm, pn; if (!tile((long)i * G + c, pm, pn)) return false; u.pm = pm; u.pn = pn0 + pn; u.ka = 0; u.kb = 0; u.aux = pn; return true; }
    __device__ __forceinline__ void a_ready(const Unit&) const {}
    __device__ __forceinline__ void done(const Unit&) const {}
};
struct MergeOrder : GridOrder {
    __host__ __device__ bool next(int i, Unit& u) const { int pm, pc; if (!tile((long)(i >> 2) * G + c, pm, pc)) return false; const int n = i & 3; u.pm = pm; u.pn = 8 * n + pc; u.ka = 256 * n; u.kb = 0; u.aux = (n << 8) | pc; return true; }
};
struct SplitOrder {
    int G, c, pm0, nrow, ncol, nks;
    __host__ __device__ bool next(int i, Unit& u) const { const int L = i * G + c; if (L >= nrow * ncol * nks) return false; const int ks = L % nks, pn = (L / nks) % ncol, pr = L / (nks * ncol);
        u.pm = pm0 + pr; u.pn = pn; u.ka = 256 * ks; u.kb = 256 * ks; u.aux = pn | (ks << 8); return true; }
    __device__ __forceinline__ void a_ready(const Unit&) const {}
    __device__ __forceinline__ void done(const Unit&) const {}
};
#ifndef CPU_EMU
#define PG8_LAS __attribute__((address_space(3)))
template <class Epi, class Sched, bool ALIGN_EPI = false, bool SP2 = false, bool HALFN = false>
__device__ __forceinline__ void gemm_phase(PG8_LAS unsigned char* lds, const Gemm g, const Sched& S, const Epi& E) {
    int tid = threadIdx.x; asm volatile("" : "+v"(tid));
    const int wid = __builtin_amdgcn_readfirstlane(tid >> 6), lane = tid & 63, wr = wid >> 2, wc = wid & 3, fr = lane & 15, fq = lane >> 4;
    int K = g.K; asm volatile("" : "+s"(K));
    const int nt = K / BK, lda = g.lda, ldb = g.ldb;
    unsigned voffA[2], voffB[2];
#pragma unroll
    for (int i = 0; i < 2; ++i) { int R, C; stage_rc(tid * 16 + i * 8192, R, C); const int Rb = Epi::PERM ? ((R & ~31) + perm32(R & 31)) : R;
        voffA[i] = (unsigned)(R * lda + C) * 2u; voffB[i] = (unsigned)(Rb * ldb + C) * 2u; }
    const size_t kstep = (size_t)(BK * 2);
    const size_t hstepA = (size_t)HALF * lda * 2, hstepB = HALFN ? (size_t)0 : (size_t)HALF * ldb * 2;
    const size_t tstepA = 2 * hstepA, tstepB = HALFN ? (size_t)HALF * ldb * 2 : 2 * hstepB;
    const unsigned ldsw = (unsigned)wid * 1024u;
    const int aoff = lds_byte(wr * 64 + fr, fq * 8), boff = lds_byte(wc * 32 + fr, fq * 8);
#define PG8_SA(b, h) (((b) * 2 + (h)) * HTB)
#define PG8_SB(b, h) ((4 + (b) * 2 + (h)) * HTB)
#define PG8_STAGE(bufoff, gbase, voff) do { _Pragma("unroll") for (int _i = 0; _i < 2; ++_i) \
        __builtin_amdgcn_global_load_lds((const unsigned*)((const char*)(gbase) + (voff)[_i]), (PG8_LAS unsigned*)(lds + (bufoff) + ldsw + _i * 8192), 16, 0, 0); } while (0)
#define PG8_LDA(dst, b, h) do { _Pragma("unroll") for (int m = 0; m < 4; ++m) _Pragma("unroll") for (int k = 0; k < 2; ++k) dst[m][k] = *(const PG8_LAS bf16x8*)(lds + PG8_SA(b, h) + aoff + m * 2048 + k * 1024); } while (0)
#define PG8_LDB(dst, b, h) do { _Pragma("unroll") for (int n = 0; n < 2; ++n) _Pragma("unroll") for (int k = 0; k < 2; ++k) dst[n][k] = *(const PG8_LAS bf16x8*)(lds + PG8_SB(b, h) + boff + n * 2048 + k * 1024); } while (0)
#define PG8_MMA(ai, bj, At, Bt) do { __builtin_amdgcn_s_setprio(1); _Pragma("unroll") for (int m = 0; m < 4; ++m) _Pragma("unroll") for (int n = 0; n < 2; ++n) _Pragma("unroll") for (int k = 0; k < 2; ++k) \
        acc[ai][bj][m][n] = __builtin_amdgcn_mfma_f32_16x16x32_bf16(Bt[n][k], At[m][k], acc[ai][bj][m][n], 0, 0, 0); __builtin_amdgcn_s_setprio(0); } while (0)
#define PG8_WAIT_V(n) asm volatile("s_waitcnt vmcnt(" #n ")" ::: "memory")
#define PG8_WAIT_L(n) asm volatile("s_waitcnt lgkmcnt(" #n ")" ::: "memory")
#define PG8_BAR __builtin_amdgcn_s_barrier()
#define PG8_SCHED __builtin_amdgcn_sched_barrier(0)
    Unit cur, nxt; int ui = 0;
    if (!S.next(0, cur)) return;
    f32x4 acc[2][2][4][2];
    typename Epi::State est;
#pragma unroll
    for (int a = 0; a < 2; ++a)
#pragma unroll
        for (int b = 0; b < 2; ++b)
#pragma unroll
            for (int m = 0; m < 4; ++m)
#pragma unroll
                for (int n = 0; n < 2; ++n) acc[a][b][m][n] = (f32x4){0.f, 0.f, 0.f, 0.f};
    static_assert(!HALFN || SP2, "HALFN is written for the SP2 loop");
    bf16x8 At[4][2], B0[2][2], B1[2][2];
    const char* cA = (const char*)g.A + (size_t)cur.pm * tstepA + (size_t)cur.ka * 2; const char* cB = (const char*)g.Bt + (size_t)cur.pn * tstepB + (size_t)cur.kb * 2;
    S.a_ready(cur);
    if constexpr (SP2) {
        PG8_STAGE(PG8_SB(0, 0), cB, voffB); PG8_STAGE(PG8_SB(0, 1), cB + hstepB, voffB); PG8_STAGE(PG8_SA(0, 0), cA, voffA); PG8_STAGE(PG8_SA(0, 1), cA + hstepA, voffA);
        if (wr == 1) PG8_BAR;
        PG8_WAIT_V(2); PG8_BAR;
        PG8_STAGE(PG8_SB(1, 0), cB + kstep, voffB); PG8_STAGE(PG8_SA(1, 0), cA + kstep, voffA); PG8_STAGE(PG8_SB(1, 1), cB + hstepB + kstep, voffB);
        PG8_WAIT_V(6); PG8_BAR;
    } else {
        PG8_STAGE(PG8_SB(0, 0), cB, voffB); PG8_STAGE(PG8_SA(0, 0), cA, voffA); PG8_STAGE(PG8_SB(0, 1), cB + hstepB, voffB); PG8_STAGE(PG8_SA(0, 1), cA + hstepA, voffA);
        if (wr == 1) PG8_BAR;
        PG8_WAIT_V(4); PG8_BAR;
        PG8_STAGE(PG8_SB(1, 0), cB + kstep, voffB); PG8_STAGE(PG8_SA(1, 0), cA + kstep, voffA); PG8_STAGE(PG8_SB(1, 1), cB + hstepB + kstep, voffB);
        PG8_WAIT_V(6); PG8_BAR;
    }
    for (;;) {
        const bool has_next = S.next(ui + 1, nxt);
        const char* nA = has_next ? (const char*)g.A + (size_t)nxt.pm * tstepA + (size_t)nxt.ka * 2 : cA; const char* nB = has_next ? (const char*)g.Bt + (size_t)nxt.pn * tstepB + (size_t)nxt.kb * 2 : cB;
        for (int t = 0; t < nt; t += 2) {
            const bool last = (t == nt - 2);
            const char* a1 = cA + (size_t)(t + 1) * kstep;
            const char* a2 = last ? nA : cA + (size_t)(t + 2) * kstep; const char* b2 = last ? nB : cB + (size_t)(t + 2) * kstep;
            const char* a3 = a2 + kstep; const char* b3 = b2 + kstep;
            if (last && has_next) S.a_ready(nxt);
            if constexpr (SP2) {
            PG8_LDB(B0, 0, 0); if constexpr (!HALFN) PG8_LDB(B1, 0, 1); PG8_SCHED; PG8_LDA(At, 0, 0); PG8_STAGE(PG8_SA(1, 1), a1 + hstepA, voffA);
            PG8_WAIT_V(8); PG8_WAIT_L(0); PG8_BAR; PG8_MMA(0, 0, At, B0); if constexpr (!HALFN) PG8_MMA(0, 1, At, B1); PG8_BAR; PG8_SCHED;
            PG8_LDA(At, 0, 1); PG8_STAGE(PG8_SB(0, 0), b2, voffB); PG8_STAGE(PG8_SB(0, 1), b2 + hstepB, voffB); PG8_STAGE(PG8_SA(0, 0), a2, voffA);
            PG8_WAIT_V(8); PG8_WAIT_L(0); PG8_BAR; PG8_MMA(1, 0, At, B0); if constexpr (!HALFN) PG8_MMA(1, 1, At, B1); PG8_BAR; PG8_SCHED;
            PG8_LDB(B0, 1, 0); if constexpr (!HALFN) PG8_LDB(B1, 1, 1); PG8_SCHED; PG8_LDA(At, 1, 0); PG8_STAGE(PG8_SA(0, 1), a2 + hstepA, voffA);
            PG8_WAIT_V(8); PG8_WAIT_L(0); PG8_BAR; PG8_MMA(0, 0, At, B0); if constexpr (!HALFN) PG8_MMA(0, 1, At, B1); PG8_BAR; PG8_SCHED;
            PG8_LDA(At, 1, 1); PG8_STAGE(PG8_SB(1, 0), b3, voffB); PG8_STAGE(PG8_SB(1, 1), b3 + hstepB, voffB); PG8_STAGE(PG8_SA(1, 0), a3, voffA);
            PG8_WAIT_V(8); PG8_WAIT_L(0); PG8_BAR; PG8_MMA(1, 0, At, B0); if constexpr (!HALFN) PG8_MMA(1, 1, At, B1); PG8_BAR; PG8_SCHED;
            } else {
            PG8_LDB(B0, 0, 0); PG8_SCHED; PG8_LDA(At, 0, 0); PG8_STAGE(PG8_SA(1, 1), a1 + hstepA, voffA);
            PG8_WAIT_L(8); PG8_BAR; PG8_WAIT_L(0); PG8_MMA(0, 0, At, B0); PG8_BAR; PG8_SCHED;
            PG8_LDB(B1, 0, 1); PG8_STAGE(PG8_SB(0, 0), b2, voffB);
            PG8_BAR; PG8_WAIT_L(0); PG8_MMA(0, 1, At, B1); PG8_BAR;
            PG8_LDA(At, 0, 1); PG8_STAGE(PG8_SA(0, 0), a2, voffA);
            PG8_BAR; PG8_WAIT_L(0); PG8_MMA(1, 0, At, B0); PG8_BAR; PG8_SCHED;
            PG8_STAGE(PG8_SB(0, 1), b2 + hstepB, voffB);
            PG8_WAIT_V(6); PG8_BAR; PG8_MMA(1, 1, At, B1); PG8_BAR;
            PG8_LDB(B0, 1, 0); PG8_SCHED; PG8_LDA(At, 1, 0); PG8_STAGE(PG8_SA(0, 1), a2 + hstepA, voffA);
            PG8_WAIT_L(8); PG8_BAR; PG8_WAIT_L(0); PG8_MMA(0, 0, At, B0); PG8_BAR; PG8_SCHED;
            PG8_LDB(B1, 1, 1); PG8_STAGE(PG8_SB(1, 0), b3, voffB);
            PG8_BAR; PG8_WAIT_L(0); PG8_MMA(0, 1, At, B1); PG8_BAR;
            PG8_LDA(At, 1, 1); PG8_STAGE(PG8_SA(1, 0), a3, voffA);
            PG8_BAR; PG8_WAIT_L(0); PG8_MMA(1, 0, At, B0); PG8_BAR; PG8_SCHED;
            PG8_STAGE(PG8_SB(1, 1), b3 + hstepB, voffB);
            PG8_WAIT_V(6); PG8_BAR; PG8_MMA(1, 1, At, B1); PG8_BAR;
            }
        }
        if constexpr (ALIGN_EPI) { if (wr == 0) PG8_BAR; }
        E(acc, est, cur, wr, wc, fr, fq); S.done(cur);
        if (!has_next) break;
#pragma unroll
        for (int a = 0; a < 2; ++a)
#pragma unroll
            for (int b = 0; b < 2; ++b)
#pragma unroll
                for (int m = 0; m < 4; ++m)
#pragma unroll
                    for (int n = 0; n < 2; ++n) acc[a][b][m][n] = (f32x4){0.f, 0.f, 0.f, 0.f};
        cur = nxt; cA = nA; cB = nB; ++ui;
        if constexpr (ALIGN_EPI) { if (wr == 1) PG8_BAR; }
    }
    PG8_WAIT_V(0);
    if constexpr (!ALIGN_EPI) { if (wr == 0) PG8_BAR; }
    PG8_BAR;
#undef PG8_SA
#undef PG8_SB
#undef PG8_STAGE
#undef PG8_LDA
#undef PG8_LDB
#undef PG8_MMA
#undef PG8_WAIT_V
#undef PG8_WAIT_L
#undef PG8_BAR
#undef PG8_SCHED
}
#else
template <class Epi, class Sched, bool ALIGN_EPI = false, bool SP2 = false, bool HALFN = false>
void gemm_phase(unsigned char* lds, const Gemm g, const Sched& S, const Epi& E) {
    const int tid = threadIdx.x, wid = tid >> 6, lane = tid & 63, wr = wid >> 2, wc = wid & 3, fr = lane & 15, fq = lane >> 4;
    static thread_local float* Ct = nullptr; static thread_local float* Af = nullptr; static thread_local float* Bf = nullptr;
    Unit u; typename Epi::State est;
    for (int i = 0; S.next(i, u); ++i) {
        S.a_ready(u);
        __syncthreads();
        if (tid == 0) {
            if (!Ct) { Ct = new float[256 * 256]; Af = new float[256 * 4096]; Bf = new float[256 * 4096]; }
            const int K = g.K;
            for (int r = 0; r < 256; ++r) for (int k = 0; k < K; ++k) { Af[r * K + k] = bf2f(g.A[(size_t)(u.pm * 256 + r) * g.lda + u.ka + k]); Bf[r * K + k] = HALFN ? (r < 128 ? bf2f(g.Bt[(size_t)(u.pn * 128 + r) * g.ldb + u.kb + k]) : 0.f) : bf2f(g.Bt[(size_t)(u.pn * 256 + r) * g.ldb + u.kb + k]); }
            for (int r = 0; r < 256; ++r) for (int c = 0; c < 256; ++c) { float s = 0.f; const float* a = Af + r * K; const float* b = Bf + c * K; for (int k = 0; k < K; ++k) s += a[k] * b[k]; Ct[r * 256 + c] = s; }
        }
        __syncthreads();
        f32x4 acc[2][2][4][2];
        for (int ai = 0; ai < 2; ++ai) for (int bj = 0; bj < 2; ++bj) for (int m = 0; m < 4; ++m) for (int n = 0; n < 2; ++n) for (int e = 0; e < 4; ++e) {
            const int r = 128 * ai + 64 * wr + 16 * m + fr; const int c = Epi::PERM ? (128 * bj + 32 * wc + 8 * fq + 4 * n + e) : (128 * bj + 32 * wc + 16 * n + 4 * fq + e);
            acc[ai][bj][m][n][e] = Ct[r * 256 + c]; }
        E(acc, est, u, wr, wc, fr, fq); S.done(u);
    }
    __syncthreads();
}
#endif
}
namespace pg8 {
struct EpiMod {
    static constexpr bool PERM = false; typedef NoState State;
    float* C; const float* bias;
    __device__ __forceinline__ void operator()(const f32x4 (&acc)[2][2][4][2], State& st, const Unit& u, int wr, int wc, int fr_in, int fq_in) const {
        int fr = fr_in, fq = fq_in; OPAQUE_V(fr); OPAQUE_V(fq);
        const int row0 = wr * 64 + fr, col0 = u.aux * BM + wc * 32 + 4 * fq;
#pragma unroll
        for (int ai = 0; ai < 2; ++ai)
#pragma unroll
            for (int m = 0; m < 4; ++m) { float* rowp = C + (size_t)(row0 + ai * HALF + m * 16) * NMOD + col0;
#pragma unroll
                for (int bj = 0; bj < 2; ++bj)
#pragma unroll
                    for (int n = 0; n < 2; ++n) *(f32x4*)(rowp + bj * HALF + n * 16) = acc[ai][bj][m][n] + *(const f32x4*)(bias + col0 + bj * HALF + n * 16); }
    }
};
struct EpiProj {
    static constexpr bool PERM = true; typedef NoState State;
    bf16* proj; bf16* gate; float* outk_p; float* outv_p; float* outk_s; float* outv_s; bf16* vt;
    __device__ __forceinline__ void operator()(const f32x4 (&acc)[2][2][4][2], State& st, const Unit& u, int wr, int wc, int fr_in, int fq_in) const {
        int fr = fr_in, fq = fq_in; OPAQUE_V(fr); OPAQUE_V(fq);
        const int t = u.aux; const bool isg = t >= 11;
        const int row0 = u.pm * BM + wr * 64 + fr, colt = wc * 32 + 8 * fq;
        bf16* base = isg ? gate + (size_t)(t - 11) * 256 : proj + (size_t)t * 256; const int ldc = isg ? NGATE : NPROJ;
#pragma unroll
        for (int ai = 0; ai < 2; ++ai)
#pragma unroll
            for (int m = 0; m < 4; ++m) { const int row = row0 + ai * HALF + m * 16; bf16* rowp = base + (size_t)row * ldc + colt;
#pragma unroll
                for (int bj = 0; bj < 2; ++bj) { f32x4 v0 = acc[ai][bj][m][0], v1 = acc[ai][bj][m][1];
                    if (isg) {
#pragma unroll
                        for (int e = 0; e < 4; ++e) { v0[e] = sigmoidf_(v0[e]); v1[e] = sigmoidf_(v1[e]); } }
                    else if (t >= 9) { if (t == 10 && row < MP) { const int cv = colt + bj * HALF, bb = row / SEQ, tt = row % SEQ; bf16* vp = vt + ((size_t)(bb * SBH + (cv >> 6)) * 64 + (cv & 63)) * SEQ + tt;
#pragma unroll
                            for (int e = 0; e < 4; ++e) { vp[(size_t)e * SEQ] = (bf16)f2bf(v0[e]); vp[(size_t)(4 + e) * SEQ] = (bf16)f2bf(v1[e]); } }
                        float* o = (row < MP) ? ((t == 9 ? outk_p : outv_p) + (size_t)row * 256) : ((t == 9 ? outk_s : outv_s) + (size_t)(row - MP) * 256);
                        *(f32x4*)(o + colt + bj * HALF) = v0; *(f32x4*)(o + colt + bj * HALF + 4) = v1; }
                    v4u w; w.x = pk2(v0[0], v0[1]); w.y = pk2(v0[2], v0[3]); w.z = pk2(v1[0], v1[1]); w.w = pk2(v1[2], v1[3]);
                    *(v4u*)(rowp + bj * HALF) = w; } }
    }
};
struct EpiGlu {
    static constexpr bool PERM = true; typedef NoState State;
    const bf16* ys; bf16* y;
    __device__ __forceinline__ void operator()(const f32x4 (&acc)[2][2][4][2], State& st, const Unit& u, int wr, int wc, int fr_in, int fq_in) const {
        int fr = fr_in, fq = fq_in; OPAQUE_V(fr); OPAQUE_V(fq);
        const int row0 = u.pm * BM + wr * 64 + fr, colt = wc * 32 + 8 * fq;
#pragma unroll
        for (int ai = 0; ai < 2; ++ai)
#pragma unroll
            for (int m = 0; m < 4; ++m) { const int row = row0 + ai * HALF + m * 16;
#pragma unroll
                for (int bj = 0; bj < 2; ++bj) { const f32x4 v0 = acc[ai][bj][m][0], v1 = acc[ai][bj][m][1];
                    const v4u s = *(const v4u*)(ys + (size_t)row * 256 + colt + bj * HALF);
                    v4u w; w.x = pk2(bflo(s.x) * sigmoidf_(v0[0]), bfhi(s.x) * sigmoidf_(v0[1])); w.y = pk2(bflo(s.y) * sigmoidf_(v0[2]), bfhi(s.y) * sigmoidf_(v0[3]));
                    w.z = pk2(bflo(s.z) * sigmoidf_(v1[0]), bfhi(s.z) * sigmoidf_(v1[1])); w.w = pk2(bflo(s.w) * sigmoidf_(v1[2]), bfhi(s.w) * sigmoidf_(v1[3]));
                    *(v4u*)(y + (size_t)row * D + colt + bj * HALF) = w; } CFENCE(); }
    }
};
struct EpiMerge {
    static constexpr bool PERM = false; struct State { f32x4 macc[2][4][2]; };
    const bf16* gate; bf16* mgb;
    __device__ __forceinline__ void operator()(const f32x4 (&acc)[2][2][4][2], State& st, const Unit& u, int wr, int wc, int fr_in, int fq_in) const {
        int fr = fr_in, fq = fq_in; OPAQUE_V(fr); OPAQUE_V(fq);
        const int n_ = u.aux >> 8, pc = u.aux & 255;
        const int row0 = u.pm * BM + wr * 64 + fr, col0 = pc * HALF + wc * 32 + 4 * fq;
        v2u gw[2][4][2];
#pragma unroll
        for (int ai = 0; ai < 2; ++ai)
#pragma unroll
            for (int m = 0; m < 4; ++m)
#pragma unroll
                for (int n = 0; n < 2; ++n) gw[ai][m][n] = *(const v2u*)(gate + (size_t)(row0 + ai * HALF + m * 16) * NGATE + n_ * D + col0 + n * 16);
        CFENCE();
#pragma unroll
        for (int ai = 0; ai < 2; ++ai)
#pragma unroll
            for (int m = 0; m < 4; ++m) { const int row = row0 + ai * HALF + m * 16;
#pragma unroll
                for (int n = 0; n < 2; ++n) { const int col = col0 + n * 16; const v2u g2 = gw[ai][m][n];
                    f32x4 v = acc[ai][0][m][n]; v[0] *= bflo(g2.x); v[1] *= bfhi(g2.x); v[2] *= bflo(g2.y); v[3] *= bfhi(g2.y);
                    if (n_ > 0) v += st.macc[ai][m][n];
                    st.macc[ai][m][n] = v;
                    if (n_ == 3) { v2u o; o.x = pk2(v[0], v[1]); o.y = pk2(v[2], v[3]); *(v2u*)(mgb + (size_t)row * D + col) = o; } } }
    }
};
struct EpiRes {
    static constexpr bool PERM = false; typedef NoState State;
    const float* xP; const float* xS; const float* gmod; float* out;
    __device__ __forceinline__ void operator()(const f32x4 (&acc)[2][2][4][2], State& st, const Unit& u, int wr, int wc, int fr_in, int fq_in) const {
        int fr = fr_in, fq = fq_in; OPAQUE_V(fr); OPAQUE_V(fq);
        const int row0 = u.pm * BM + wr * 64 + fr, col0 = u.aux * BM + wc * 32 + 4 * fq;
        const float* gr = gmod + (size_t)seq_of(u.pm * BM) * NMOD;
        f32x4 gv[2][2];
#pragma unroll
        for (int bj = 0; bj < 2; ++bj)
#pragma unroll
            for (int n = 0; n < 2; ++n) gv[bj][n] = *(const f32x4*)(gr + col0 + bj * HALF + n * 16) + 1.0f;
#pragma unroll
        for (int ai = 0; ai < 2; ++ai)
#pragma unroll
            for (int mp = 0; mp < 2; ++mp) { f32x4 xv[2][2][2];
#pragma unroll
                for (int mm = 0; mm < 2; ++mm) { const int row = row0 + ai * HALF + (2 * mp + mm) * 16; const float* xr = row < MP ? xP + (size_t)row * D : xS + (size_t)(row - MP) * D;
#pragma unroll
                    for (int bj = 0; bj < 2; ++bj)
#pragma unroll
                        for (int n = 0; n < 2; ++n) xv[mm][bj][n] = *(const f32x4*)(xr + col0 + bj * HALF + n * 16); }
                CFENCE();
#pragma unroll
                for (int mm = 0; mm < 2; ++mm) { const int row = row0 + ai * HALF + (2 * mp + mm) * 16;
#pragma unroll
                    for (int bj = 0; bj < 2; ++bj)
#pragma unroll
                        for (int n = 0; n < 2; ++n) *(f32x4*)(out + (size_t)row * D + col0 + bj * HALF + n * 16) = xv[mm][bj][n] * ALPHA + gv[bj][n] * acc[ai][bj][2 * mp + mm][n]; }
                CFENCE(); }
    }
};
struct EpiPart {
    static constexpr bool PERM = false; typedef NoState State;
    float* part;
    __device__ __forceinline__ void operator()(const f32x4 (&acc)[2][2][4][2], State& st, const Unit& u, int wr, int wc, int fr_in, int fq_in) const {
        int fr = fr_in, fq = fq_in; OPAQUE_V(fr); OPAQUE_V(fq);
        const int ks = u.aux >> 8, pn = u.aux & 255; const int row0 = u.pm * BM - MP + wr * 64 + fr, col0 = pn * BM + wc * 32 + 4 * fq;
        float* base = part + (size_t)ks * MS * D;
#pragma unroll
        for (int ai = 0; ai < 2; ++ai)
#pragma unroll
            for (int m = 0; m < 4; ++m) { float* rowp = base + (size_t)(row0 + ai * HALF + m * 16) * D + col0;
#pragma unroll
                for (int bj = 0; bj < 2; ++bj)
#pragma unroll
                    for (int n = 0; n < 2; ++n) *(f32x4*)(rowp + bj * HALF + n * 16) = acc[ai][bj][m][n]; }
    }
};
struct EpiUp {
    static constexpr bool PERM = true; typedef NoState State;
    bf16* act;
    __device__ __forceinline__ void operator()(const f32x4 (&acc)[2][2][4][2], State& st, const Unit& u, int wr, int wc, int fr_in, int fq_in) const {
        int fr = fr_in, fq = fq_in; OPAQUE_V(fr); OPAQUE_V(fq);
        const int row0 = u.pm * BM + wr * 64 + fr, col0 = u.aux * HALF + wc * 32 + 8 * fq;
#pragma unroll
        for (int ai = 0; ai < 2; ++ai)
#pragma unroll
            for (int m = 0; m < 4; ++m) { const int row = row0 + ai * HALF + m * 16;
                const f32x4 a0 = acc[ai][0][m][0], a1 = acc[ai][0][m][1], b0 = acc[ai][1][m][0], b1 = acc[ai][1][m][1];
                v4u w; w.x = pk2(siluf_(a0[0]) * b0[0], siluf_(a0[1]) * b0[1]); w.y = pk2(siluf_(a0[2]) * b0[2], siluf_(a0[3]) * b0[3]);
                w.z = pk2(siluf_(a1[0]) * b1[0], siluf_(a1[1]) * b1[1]); w.w = pk2(siluf_(a1[2]) * b1[2], siluf_(a1[3]) * b1[3]);
                *(v4u*)(act + (size_t)row * DFF + col0) = w; }
    }
};
}
struct Args { const float* in[38]; float* out; unsigned char* ws; int ph_lo, ph_hi, li, pad; };
enum { I_XP = 0, I_XS, I_CK, I_CV, I_SRE, I_SIM, I_SCB, I_SD, I_SCD, I_PT, I_CP, I_CS, I_WADA, I_BADA, I_WIN, I_ARE, I_AIM, I_LDT, I_BRE, I_BIM, I_CRE, I_CIM, I_SSD, I_WGLU,
       I_CBW, I_DCW, I_DAL, I_DDT, I_DNW, I_WBR, I_WGATE, I_WO, I_L1G, I_L1B, I_WUP, I_WDN, I_L2G, I_L2B };
constexpr int NWAVES = 8, RING_BYTES = 131072, MISC_OFF = RING_BYTES, LDS_BYTES = 147456;
#ifndef CPU_EMU
#define XB_TMO      128
#define XB_XCNT(j)  (256  + 64 * (j))
#define XB_XSUB(j)  (1280 + 64 * (j))
#define XB_XGEN(j)  (2304 + 64 * (j))
#define XB_TOP      3328
#define XB_TOPGEN   3392
#define XCD_BAR_WORDS 3456
#define XB_SPIN_CAP (1u << 18)
__device__ __forceinline__ unsigned xb_ld(unsigned* p)              { return __hip_atomic_load(p, __ATOMIC_RELAXED, __HIP_MEMORY_SCOPE_AGENT); }
__device__ __forceinline__ unsigned xb_add(unsigned* p, unsigned v) { return __hip_atomic_fetch_add(p, v, __ATOMIC_RELAXED, __HIP_MEMORY_SCOPE_AGENT); }
__device__ __forceinline__ unsigned xb_xcc_id() { return (unsigned)__builtin_amdgcn_s_getreg((3 << 11) | 20) & 0xFu; }
#define XB_SPIN(cond, bar) do { unsigned _sp = 0; while (cond) { __builtin_amdgcn_s_sleep(1); \
    if ((++_sp & 255u) == 0u) { if (xb_ld(&(bar)[XB_TMO])) break; if (_sp > XB_SPIN_CAP) { atomicAdd(&(bar)[XB_TMO], 1u); break; } } } } while (0)
struct XcdBarrier { unsigned* bar; unsigned x; volatile LAS_HW unsigned* st; };
__device__ __forceinline__ XcdBarrier xcd_barrier_post(unsigned* bar, volatile LAS_HW unsigned* st) {
    XcdBarrier b; b.bar = bar; b.x = xb_xcc_id(); b.st = st;
    if (threadIdx.x == 0) (void)xb_add(&bar[XB_XCNT(b.x)], 1u);
    return b;
}
__device__ __forceinline__ void xcd_barrier_complete(unsigned* bar, unsigned x, unsigned& nloc, unsigned& nx) {
    const unsigned G = gridDim.x * gridDim.y * gridDim.z;
    unsigned sum, cnt, mine, sp = 0u;
    for (;;) {
        sum = 0u; cnt = 0u; mine = 0u;
#pragma unroll
        for (unsigned j = 0; j < 16; ++j) { const unsigned c = xb_ld(&bar[XB_XCNT(j)]); sum += c; cnt += (c > 0u) ? 1u : 0u; mine = (j == x) ? c : mine; }
        if (sum == G) break;
        __builtin_amdgcn_s_sleep(1);
        if ((++sp & 255u) == 0u) { if (xb_ld(&bar[XB_TMO])) break; if (sp > XB_SPIN_CAP) { atomicAdd(&bar[XB_TMO], 1u); break; } }
    }
    nloc = mine > 0u ? mine : 1u; nx = cnt > 0u ? cnt : 1u;
}
__device__ __forceinline__ void xcd_barrier(const XcdBarrier& b) {
    asm volatile("s_waitcnt vmcnt(0)" ::: "memory");
    __syncthreads();
    if (threadIdx.x == 0) {
        unsigned* bar = b.bar;
        __builtin_amdgcn_s_waitcnt(0);
        unsigned nloc = b.st[0], nx = b.st[1];
        if (nloc == 0u) { xcd_barrier_complete(bar, b.x, nloc, nx); b.st[0] = nloc; b.st[1] = nx; }
        const unsigned old = xb_add(&bar[XB_XSUB(b.x)], 1u);
        const unsigned gen = old / nloc;
        if (old + 1u == (gen + 1u) * nloc) {
            __builtin_amdgcn_fence(__ATOMIC_RELEASE, "agent");
            asm volatile("s_waitcnt vmcnt(0)" ::: "memory");
            const unsigned og = xb_add(&bar[XB_TOP], 1u);
            const unsigned tg = og / nx;
            if (og + 1u == (tg + 1u) * nx) xb_add(&bar[XB_TOPGEN], 1u);
            else XB_SPIN(xb_ld(&bar[XB_TOPGEN]) == tg, bar);
            __builtin_amdgcn_fence(__ATOMIC_ACQUIRE, "agent");
            xb_add(&bar[XB_XGEN(b.x)], 1u);
            asm volatile("s_waitcnt vmcnt(0)" ::: "memory");
        } else {
            XB_SPIN(xb_ld(&bar[XB_XGEN(b.x)]) == gen, bar);
            __builtin_amdgcn_fence(__ATOMIC_ACQUIRE, "agent");
            asm volatile("s_waitcnt vmcnt(0)" ::: "memory");
        }
    }
    __syncthreads();
}
#else
#define XCD_BAR_WORDS 3456
struct XcdBarrier { int dummy; };
inline void xcd_barrier(const XcdBarrier&) { emu::grid_sync(); }
#endif

#define TIDSV(vb_, vg_) int tid_ = threadIdx.x; OPAQUE_V(tid_); const int tid = tid_, lane = tid & 63, wave = __builtin_amdgcn_readfirstlane(tid >> 6), G = (vg_), bid = (vb_), gw = bid * NWAVES + wave, NGW = G * NWAVES; (void)lane; (void)wave; (void)gw; (void)NGW; (void)G; (void)bid
#define TIDS int tid_ = threadIdx.x; OPAQUE_V(tid_); const int tid = tid_, lane = tid & 63, wave = __builtin_amdgcn_readfirstlane(tid >> 6), G = gridDim.x, bid = blockIdx.x, gw = bid * NWAVES + wave, NGW = G * NWAVES; (void)lane; (void)wave; (void)gw; (void)NGW; (void)G; (void)bid
__device__ __forceinline__ bf16* wsb(const Args& A, size_t off) { return (bf16*)(A.ws + off); }
__device__ __forceinline__ float* wsf(const Args& A, size_t off) { return (float*)(A.ws + off); }
__device__ __forceinline__ float softplusf_(float x) { return fmaxf(x, 0.f) + __logf(1.0f + __expf(-fabsf(x))); }
__device__ __forceinline__ void tr_item(const float* W, int N, int K, int k0, int c0, bf16* WT, int drow0, LAS float* scr, int lane) {
    float wv[32];
#pragma unroll
    for (int i = 0; i < 32; ++i) wv[i] = W[(size_t)(k0 + 2 * i + (lane >> 5)) * N + c0 + (lane & 31)];
    CFENCE();
#pragma unroll
    for (int i = 0; i < 32; ++i) scr[(2 * i + (lane >> 5)) * 33 + (lane & 31)] = wv[i];
    WAVE_SYNC();
    const int c = lane & 7;
#pragma unroll
    for (int j = 0; j < 4; ++j) { const int n = (lane >> 3) + 8 * j; const LAS float* s = scr + (8 * c) * 33 + n;
        v4u o; o.x = pk2(s[0 * 33], s[1 * 33]); o.y = pk2(s[2 * 33], s[3 * 33]); o.z = pk2(s[4 * 33], s[5 * 33]); o.w = pk2(s[6 * 33], s[7 * 33]);
        *(v4u*)(WT + (size_t)(drow0 + n) * K + k0 + 8 * c) = o; }
    WAVE_SYNC();
}
__device__ __forceinline__ void ph_prologue(const Args& A, LAS unsigned char* lds) {
    TIDS;
    LAS float* scr = (LAS float*)(lds + wave * 16384);
    constexpr int I_ADA = 16 * 192, I_IN1 = 16 * 64, I_IN2 = 16 * 24, I_GT = 16 * 128, I_GLU = 4 * 8, I_BR = 4 * 4 * 32, I_WO_ = 16 * 32, I_UP = 16 * 176, I_DN = 44 * 32;
    constexpr int PER_L = I_ADA + I_IN1 + I_IN2 + I_GT + I_GLU + I_BR + I_WO_ + I_UP + I_DN;
    for (int it = gw; it < DEPTH * PER_L; it += NGW) {
        const int l = it / PER_L; int r = it % PER_L; unsigned char* wl = A.ws + WS_W + (size_t)l * WL_SIZE;
        if (r < I_ADA) { const int kb = r / 192, nb = r % 192; tr_item(A.in[I_WADA] + (size_t)l * D * NMOD, NMOD, D, kb * 64, nb * 32, (bf16*)(wl + WL_ADA), nb * 32, scr, lane); continue; } r -= I_ADA;
        if (r < I_IN1) { const int kb = r / 64, nb = r % 64; tr_item(A.in[I_WIN] + (size_t)l * D * NIN, NIN, D, kb * 64, nb * 32, (bf16*)(wl + WL_W1), nb * 32, scr, lane); continue; } r -= I_IN1;
        if (r < I_IN2) { const int kb = r / 24, nb = r % 24; tr_item(A.in[I_WIN] + (size_t)l * D * NIN, NIN, D, kb * 64, 2056 + nb * 32, (bf16*)(wl + WL_W1), 2048 + nb * 32, scr, lane); continue; } r -= I_IN2;
        if (r < I_GT) { const int kb = r / 128, nb = r % 128; tr_item(A.in[I_WGATE] + (size_t)l * D * NGATE, NGATE, D, kb * 64, nb * 32, (bf16*)(wl + WL_W1), NPROJ + nb * 32, scr, lane); continue; } r -= I_GT;
        if (r < I_GLU) { const int kb = r / 8, nb = r % 8; tr_item(A.in[I_WGLU] + (size_t)l * 256 * 256, 256, 256, kb * 64, nb * 32, (bf16*)(wl + WL_GLU), nb * 32, scr, lane); continue; } r -= I_GLU;
        if (r < I_BR) { const int n = r / 128, r2 = r % 128, kb = r2 / 32, nb = r2 % 32; tr_item(A.in[I_WBR] + (size_t)(l * 4 + n) * 256 * D, D, 256, kb * 64, nb * 32, (bf16*)(wl + WL_BR), n * D + nb * 32, scr, lane); continue; } r -= I_BR;
        if (r < I_WO_) { const int kb = r / 32, nb = r % 32; tr_item(A.in[I_WO] + (size_t)l * D * D, D, D, kb * 64, nb * 32, (bf16*)(wl + WL_WO), nb * 32, scr, lane); continue; } r -= I_WO_;
        if (r < I_UP) { const int kb = r / 176, nb = r % 176; const int c0 = nb * 32, j = c0 < DFF ? c0 : c0 - DFF; const int drow = (j / 128) * 256 + (c0 < DFF ? 0 : 128) + (j % 128);
            tr_item(A.in[I_WUP] + (size_t)l * D * NUP, NUP, D, kb * 64, c0, (bf16*)(wl + WL_UP), drow, scr, lane); continue; } r -= I_UP;
        { const int kb = r / 32, nb = r % 32; tr_item(A.in[I_WDN] + (size_t)l * DFF * D, D, DFF, kb * 64, nb * 32, (bf16*)(wl + WL_DN), nb * 32, scr, lane); }
    }
    const int gt = bid * (NWAVES * 64) + tid, NGT = G * NWAVES * 64;
    for (int i = gt; i < DEPTH * 8 * D; i += NGT) { const int l = i / (8 * D), j = (i / D) % 8, k = i % D; ((float*)(A.ws + WS_W + (size_t)l * WL_SIZE + WL_LOG))[j * D + k] = A.in[I_WIN][((size_t)l * D + k) * NIN + 2048 + j]; }
    for (int i = gt; i < 256 * D; i += NGT) { const int r = i / D, k = i % D; float v = 0.f;
        if (r < NB) v = siluf_(A.in[I_CP][r * D + k]); else if (r < NSEQ) v = siluf_(A.in[I_CS][(r - NB) * D + k]);
        wsb(A, WS_CSILU)[i] = (bf16)f2bf(v); }
}
struct ModOrder {
    int G, c;
    __host__ __device__ bool next(int i, pg8::Unit& u) const { const int L = i * G + c; if (L >= 24 * DEPTH) return false; const int l = L / 24, pn = L % 24;
        u.pm = 0; u.pn = l * (int)(WL_SIZE / (512 * 1024)) + pn; u.ka = 0; u.kb = 0; u.aux = pn | (l << 8); return true; }
    __device__ __forceinline__ void a_ready(const pg8::Unit&) const {}
    __device__ __forceinline__ void done(const pg8::Unit&) const {}
};
struct EpiMod2 { static constexpr bool PERM = false; typedef pg8::NoState State; float* C; const float* bias;
    __device__ __forceinline__ void operator()(const f32x4 (&acc)[2][2][4][2], State& st, const pg8::Unit& u, int wr, int wc, int fr, int fq) const {
        const int l = u.aux >> 8; pg8::Unit u2 = u; u2.aux = u.aux & 255; pg8::EpiMod e{C + (size_t)l * 256 * NMOD, bias + (size_t)l * NMOD}; e(acc, st, u2, wr, wc, fr, fq); } };
template <int MODE> __device__ __forceinline__ void ph_rows(const Args& A, int l) {
    TIDS;
    const float* MOD = wsf(A, WS_MOD);
    const int ln = (MODE == 2) ? l + 1 : l;
    const bool second = !(MODE == 2 && l == DEPTH - 1);
    f32x4 gG[4], gB[4], wl[8][4];
    if (MODE != 0) { const float* gp = A.in[MODE == 1 ? I_L1G : I_L2G] + (size_t)l * D; const float* bp = A.in[MODE == 1 ? I_L1B : I_L2B] + (size_t)l * D;
#pragma unroll
        for (int j = 0; j < 4; ++j) { gG[j] = ((const f32x4*)gp)[lane + 64 * j]; gB[j] = ((const f32x4*)bp)[lane + 64 * j]; } }
    if (MODE != 1 && second) { const float* wp = (const float*)(A.ws + WS_W + (size_t)ln * WL_SIZE + WL_LOG);
#pragma unroll
        for (int jj = 0; jj < 8; ++jj)
#pragma unroll
            for (int j = 0; j < 4; ++j) wl[jj][j] = ((const f32x4*)(wp + jj * D))[lane + 64 * j]; }
    f32x4 mSh[4], mSc[4]; int cur_seq = -1;
    for (int m = gw; m < M; m += NGW) {
        const float* src; float* dstx = nullptr;
        if (MODE == 0) src = m < MP ? A.in[I_XP] + (size_t)m * D : A.in[I_XS] + (size_t)(m - MP) * D;
        else if (MODE == 1) { src = wsf(A, WS_X1) + (size_t)m * D; dstx = wsf(A, WS_X1) + (size_t)m * D; }
        else { src = wsf(A, WS_X2) + (size_t)m * D; dstx = (l == DEPTH - 1) ? A.out + O_Y + (size_t)m * D : wsf(A, WS_X2) + (size_t)m * D; }
        f32x4 v[4];
#pragma unroll
        for (int j = 0; j < 4; ++j) v[j] = ((const f32x4*)src)[lane + 64 * j];
        const int sq = seq_of(m);
        if (second && sq != cur_seq) { cur_seq = sq; const float* mr = MOD + ((size_t)ln * 256 + sq) * NMOD + (MODE == 1 ? 3 * D : 0);
#pragma unroll
            for (int j = 0; j < 4; ++j) { mSh[j] = ((const f32x4*)mr)[lane + 64 * j]; mSc[j] = ((const f32x4*)(mr + D))[lane + 64 * j] + 1.0f; } }
        if (MODE != 0 && m >= MP) {
            constexpr int NKS = MODE == 1 ? 4 : DFF / 256;
            const float* xin = MODE == 1 ? (l == 0 ? A.in[I_XS] + (size_t)(m - MP) * D : wsf(A, WS_X2) + (size_t)m * D) : wsf(A, WS_X1) + (size_t)m * D;
            const float* gr = MOD + ((size_t)l * 256 + sq) * NMOD + (MODE == 1 ? 2 * D : 5 * D);
#pragma unroll
            for (int j = 0; j < 4; ++j) { f32x4 sacc = {0.f, 0.f, 0.f, 0.f};
#pragma unroll
                for (int ks = 0; ks < NKS; ++ks) sacc += ((const f32x4*)(wsf(A, WS_PART) + ((size_t)ks * MS + (m - MP)) * D))[lane + 64 * j];
                v[j] = ((const f32x4*)xin)[lane + 64 * j] * ALPHA + (((const f32x4*)gr)[lane + 64 * j] + 1.0f) * sacc; } }
        if (MODE != 0) {
            float s = 0.f;
#pragma unroll
            for (int j = 0; j < 4; ++j) s += (v[j][0] + v[j][1]) + (v[j][2] + v[j][3]);
            const float mean = wave_sum(s) * (1.f / D); float s2 = 0.f;
#pragma unroll
            for (int j = 0; j < 4; ++j) { v[j] = v[j] - mean; s2 += (v[j][0] * v[j][0] + v[j][1] * v[j][1]) + (v[j][2] * v[j][2] + v[j][3] * v[j][3]); }
            const float rstd = 1.f / sqrtf(wave_sum(s2) * (1.f / D) + LN_EPS);
#pragma unroll
            for (int j = 0; j < 4; ++j) { v[j] = v[j] * rstd * gG[j] + gB[j]; ((f32x4*)dstx)[lane + 64 * j] = v[j]; }
            if (!second) continue;
        }
        float s = 0.f;
#pragma unroll
        for (int j = 0; j < 4; ++j) s += (v[j][0] + v[j][1]) + (v[j][2] + v[j][3]);
        const float mean = wave_sum(s) * (1.f / D); float s2 = 0.f;
#pragma unroll
        for (int j = 0; j < 4; ++j) { v[j] = v[j] - mean; s2 += (v[j][0] * v[j][0] + v[j][1] * v[j][1]) + (v[j][2] * v[j][2] + v[j][3] * v[j][3]); }
        const float rstd = 1.f / sqrtf(wave_sum(s2) * (1.f / D) + LN_EPS);
        v2u* hrow = (v2u*)(wsb(A, WS_H) + (size_t)m * D);
#pragma unroll
        for (int j = 0; j < 4; ++j) { v[j] = v[j] * rstd * mSc[j] + mSh[j];
            v2u o; o.x = pk2(v[j][0], v[j][1]); o.y = pk2(v[j][2], v[j][3]); hrow[lane + 64 * j] = o; }
        if (MODE != 1) {
            float lg[8];
#pragma unroll
            for (int jj = 0; jj < 8; ++jj) { float t = 0.f;
#pragma unroll
                for (int j = 0; j < 4; ++j) t += (v[j][0] * wl[jj][j][0] + v[j][1] * wl[jj][j][1]) + (v[j][2] * wl[jj][j][2] + v[j][3] * wl[jj][j][3]);
                lg[jj] = wave_sum(t); }
            if (lane == 0) { float* o = wsf(A, WS_LOG8) + (size_t)m * 8; *(f32x4*)o = (f32x4){lg[0], lg[1], lg[2], lg[3]}; *(f32x4*)(o + 4) = (f32x4){lg[4], lg[5], lg[6], lg[7]}; }
        }
    }
}
struct SsmC { float abr, abi, bbr[16], bbi[16]; };
__device__ __forceinline__ void ssm_consts(const Args& A, int l, int g, int p, SsmC& c) {
    const int gi = l * 16 + g;
    const float dt = expf(A.in[I_LDT][gi]), ar = A.in[I_ARE][gi * 64 + p], ai = A.in[I_AIM][gi * 64 + p];
    const float mag = expf(dt * ar); c.abr = mag * cosf(dt * ai); c.abi = mag * sinf(dt * ai);
    const float den = ar * ar + ai * ai, fre = ((c.abr - 1.0f) * ar + c.abi * ai) / den, fim = (c.abi * ar - (c.abr - 1.0f) * ai) / den;
    const f32x4* br = (const f32x4*)(A.in[I_BRE] + (size_t)(gi * 64 + p) * 16); const f32x4* bi = (const f32x4*)(A.in[I_BIM] + (size_t)(gi * 64 + p) * 16);
#pragma unroll
    for (int q = 0; q < 4; ++q) { const f32x4 r = br[q], i = bi[q];
#pragma unroll
        for (int e = 0; e < 4; ++e) { c.bbr[4 * q + e] = fre * r[e] - fim * i[e]; c.bbi[4 * q + e] = fre * i[e] + fim * r[e]; } }
}
__device__ __forceinline__ void ssm_step(const SsmC& c, const bf16* urow, float& hr, float& hi) {
    const v4u u0 = *(const v4u*)urow, u1 = *(const v4u*)(urow + 8);
    float u[16] = {bflo(u0.x), bfhi(u0.x), bflo(u0.y), bfhi(u0.y), bflo(u0.z), bfhi(u0.z), bflo(u0.w), bfhi(u0.w), bflo(u1.x), bfhi(u1.x), bflo(u1.y), bfhi(u1.y), bflo(u1.z), bfhi(u1.z), bflo(u1.w), bfhi(u1.w)};
    float br = 0.f, bi = 0.f;
#pragma unroll
    for (int h = 0; h < 16; ++h) { br += c.bbr[h] * u[h]; bi += c.bbi[h] * u[h]; }
    const float nr = c.abr * hr - c.abi * hi + br, ni = c.abr * hi + c.abi * hr + bi; hr = nr; hi = ni;
}
constexpr int SSM_NCT = (NB * SSM_NCH + 15) / 16;
__device__ __forceinline__ void ph_ssm1(const Args& A, int l) {
    TIDS;
    const bf16* proj = wsb(A, WS_PROJ); const int gg = lane >> 4, i16 = lane & 15;
    for (int un = gw; un < 16 * 8 * SSM_NCT; un += NGW) {
        const int ctile = un % SSM_NCT, rt = (un / SSM_NCT) % 8, g = un / (SSM_NCT * 8);
        const int cidx = ctile * 16 + i16; const bool valid = cidx < NB * SSM_NCH; const int b = valid ? cidx / SSM_NCH : 0, c = valid ? cidx % SSM_NCH : 0;
        const bf16* up = proj + (size_t)(b * SEQ + c * SSM_CH + (gg >> 1)) * NPROJ + PC_U + g * 16 + 8 * (gg & 1);
        const bf16x8* wf = (const bf16x8*)(A.ws + WS_SSMW + (size_t)l * SSMW_L) + (size_t)((g * 8 + rt) * (SSM_CH / 2)) * 64 + lane;
        f32x4 acc = {0.f, 0.f, 0.f, 0.f};
#pragma unroll 8
        for (int ks = 0; ks < SSM_CH / 2; ++ks) { bf16x8 bv = *(const bf16x8*)(up + (size_t)(2 * ks) * NPROJ); if (!valid) bv = (bf16x8){0, 0, 0, 0, 0, 0, 0, 0};
            acc = __builtin_amdgcn_mfma_f32_16x16x32_bf16(wf[(size_t)ks * 64], bv, acc, 0, 0, 0); }
        if (valid) { float* sp = wsf(A, WS_SEND) + ((size_t)(b * 16 + g) * 128 + 16 * rt + 4 * gg) * SSM_NCH + c;
#pragma unroll
            for (int r = 0; r < 4; ++r) sp[(size_t)r * SSM_NCH] = acc[r]; }
    }
}
__device__ __forceinline__ void ph_ssm_weights(const Args& A) {
    TIDS;
    const int gt = bid * (NWAVES * 64) + tid, NGT = G * NWAVES * 64;
    for (int it = gt; it < DEPTH * 16 * 8 * (SSM_CH / 2) * 64; it += NGT) {
        const int ln = it & 63, ks = (it >> 6) % (SSM_CH / 2), rt = (it / (64 * (SSM_CH / 2))) % 8, g = (it / (64 * (SSM_CH / 2) * 8)) % 16, l = it / (64 * (SSM_CH / 2) * 8 * 16);
        const int gg = ln >> 4, rs = 16 * rt + (ln & 15), p = rs & 63, t = 2 * ks + (gg >> 1), h0 = 8 * (gg & 1), gi = l * 16 + g;
        const float dt = expf(A.in[I_LDT][gi]), ar = A.in[I_ARE][gi * 64 + p], ai = A.in[I_AIM][gi * 64 + p];
        const float mag = expf(dt * ar), abr = mag * cosf(dt * ai), abi = mag * sinf(dt * ai);
        const float den = ar * ar + ai * ai, fre = ((abr - 1.0f) * ar + abi * ai) / den, fim = (abi * ar - (abr - 1.0f) * ai) / den;
        const float n = (float)(SSM_CH - 1 - t), pm = expf(n * dt * ar), pr = pm * cosf(n * dt * ai), pi = pm * sinf(n * dt * ai);
        const float cr = pr * fre - pi * fim, ci = pr * fim + pi * fre;
        const float* br = A.in[I_BRE] + (size_t)(gi * 64 + p) * 16 + h0; const float* bi = A.in[I_BIM] + (size_t)(gi * 64 + p) * 16 + h0;
        float v[8];
#pragma unroll
        for (int j = 0; j < 8; ++j) v[j] = rs < 64 ? cr * br[j] - ci * bi[j] : cr * bi[j] + ci * br[j];
        v4u o; o.x = pk2(v[0], v[1]); o.y = pk2(v[2], v[3]); o.z = pk2(v[4], v[5]); o.w = pk2(v[6], v[7]);
        ((v4u*)(A.ws + WS_SSMW + (size_t)l * SSMW_L))[(size_t)((g * 8 + rt) * (SSM_CH / 2) + ks) * 64 + ln] = o;
    }
}
__device__ __forceinline__ float gelu_tanh(float x) { const float e = __expf(2.0f * 0.7978845608028654f * (x + 0.044715f * x * x * x)); return 0.5f * x * (2.0f - 2.0f / (1.0f + e)); }
__device__ __forceinline__ void ph_ssm2(const Args& A, LAS unsigned char* lds, int l, int vb, int vg) {
    TIDSV(vb, vg);
    LAS float* uf = (LAS float*)(lds + wave * 16384);
    LAS bf16* ht = (LAS bf16*)(uf + 256);
    const bf16* proj = wsb(A, WS_PROJ);
    const int gg = lane >> 4, i16 = lane & 15;
    constexpr int NPU = NB * 16 * SSM_NCH, NSU = DB * 16;
    for (int un = gw; un < NPU + NSU; un += NGW) {
        int g, m0, ntok; float hr, hi; float* fre = nullptr; float* fim = nullptr;
        if (un < NPU) { const int c = un % SSM_NCH; g = (un / SSM_NCH) % 16; const int b = un / (SSM_NCH * 16); m0 = b * SEQ + c * SSM_CH; ntok = SSM_CH;
            {
              const int gi0 = l * 16 + g; const float dt0 = expf(A.in[I_LDT][gi0]), ar0 = A.in[I_ARE][gi0 * 64 + lane], ai0 = A.in[I_AIM][gi0 * 64 + lane];
              const float mg0 = expf(dt0 * ar0); float pr = mg0 * cosf(dt0 * ai0), pi = mg0 * sinf(dt0 * ai0);
              for (int sq = 1; sq < SSM_CH; sq <<= 1) { const float nr = pr * pr - pi * pi, ni = 2.f * pr * pi; pr = nr; pi = ni; }
              hr = 0.f; hi = 0.f; const float* spr = wsf(A, WS_SEND) + ((size_t)(b * 16 + g) * 128 + lane) * SSM_NCH; const float* spi = spr + (size_t)64 * SSM_NCH;
              for (int c4 = 0; c4 < c; c4 += 4) { const f32x4 sr = *(const f32x4*)(spr + c4), si = *(const f32x4*)(spi + c4);
#pragma unroll
                  for (int e = 0; e < 4; ++e) if (c4 + e < c) { const float nr = pr * hr - pi * hi + sr[e], ni = pr * hi + pi * hr + si[e]; hr = nr; hi = ni; } } }
            if (c == SSM_NCH - 1) { fre = A.out + O_REP + ((size_t)(l * NB + b) * 16 + g) * 64; fim = A.out + O_IMP + ((size_t)(l * NB + b) * 16 + g) * 64; } }
        else { const int su = un - NPU; g = su & 15; const int s = su >> 4; m0 = MP + s * DEC_SEQ; ntok = DEC_SEQ;
            hr = A.in[I_SRE][((size_t)(l * DB + s) * 16 + g) * 64 + lane]; hi = A.in[I_SIM][((size_t)(l * DB + s) * 16 + g) * 64 + lane];
            fre = A.out + O_RES + ((size_t)(l * DB + s) * 16 + g) * 64; fim = A.out + O_IMS + ((size_t)(l * DB + s) * 16 + g) * 64; }
        SsmC k; ssm_consts(A, l, g, lane, k);
        const int gi = l * 16 + g;
        bf16x8 Cb[4];
#pragma unroll
        for (int ks = 0; ks < 4; ++ks) { const float* cp = A.in[ks < 2 ? I_CRE : I_CIM] + ((size_t)gi * 16 + i16) * 64 + 32 * (ks & 1) + 8 * gg; const float sg = ks < 2 ? 1.0f : -1.0f;
            const f32x4 c0 = *(const f32x4*)cp * sg, c1 = *(const f32x4*)(cp + 4) * sg; Cb[ks] = acc2b(c0, c1); }
        const float dd = A.in[I_SSD][l * 256 + g * 16 + i16];
        for (int t0 = 0; t0 < ntok; t0 += 16) {
            const int nt = (ntok - t0) < 16 ? (ntok - t0) : 16;
            { const int tt = lane >> 2, c4 = (lane & 3) * 4;
              if (tt < nt) { const v2u w = *(const v2u*)(proj + (size_t)(m0 + t0 + tt) * NPROJ + PC_U + g * 16 + c4); *(LAS f32x4*)(uf + tt * 16 + c4) = (f32x4){bflo(w.x), bfhi(w.x), bflo(w.y), bfhi(w.y)}; } }
            WAVE_SYNC();
            for (int t = 0; t < nt; ++t) {
                float br = 0.f, bi = 0.f;
#pragma unroll
                for (int q = 0; q < 4; ++q) { const f32x4 u = *(const LAS f32x4*)(uf + t * 16 + 4 * q);
#pragma unroll
                    for (int e = 0; e < 4; ++e) { br += k.bbr[4 * q + e] * u[e]; bi += k.bbi[4 * q + e] * u[e]; } }
                const float nr = k.abr * hr - k.abi * hi + br, ni = k.abr * hi + k.abi * hr + bi; hr = nr; hi = ni;
                ht[t * 136 + lane] = (bf16)f2bf(hr); ht[t * 136 + 64 + lane] = (bf16)f2bf(hi);
            }
            WAVE_SYNC();
            f32x4 acc = {0.f, 0.f, 0.f, 0.f};
#pragma unroll
            for (int ks = 0; ks < 4; ++ks) acc = __builtin_amdgcn_mfma_f32_16x16x32_bf16(*(const LAS bf16x8*)(ht + i16 * 136 + 32 * ks + 8 * gg), Cb[ks], acc, 0, 0, 0);
#pragma unroll
            for (int r = 0; r < 4; ++r) { const int tt = 4 * gg + r;
                if (tt < nt) { const float y = acc[r] + dd * uf[tt * 16 + i16]; wsb(A, WS_YS)[(size_t)(m0 + t0 + tt) * 256 + g * 16 + i16] = (bf16)f2bf(gelu_tanh(y)); } }
            WAVE_SYNC();
        }
        if (fre) { fre[lane] = hr; fim[lane] = hi; }
    }
}
__device__ __forceinline__ void ph_conv(const Args& A, int l, int vb, int vg) {
    TIDSV(vb, vg);
    const int gt = bid * (NWAVES * 64) + tid, NGT = G * NWAVES * 64;
    const bf16* proj = wsb(A, WS_PROJ); const float* w = A.in[I_CBW] + (size_t)l * 3 * 256;
    for (int i = gt; i < M * 32; i += NGT) {
        const int m = i >> 5, c = (i & 31) * 8;
        int t, L; const float* hist = nullptr; float* so;
        if (m < MP) { t = m % SEQ; L = SEQ; so = A.out + O_CBP + (size_t)(l * NB + m / SEQ) * 512; }
        else { const int s = (m - MP) / DEC_SEQ; t = (m - MP) % DEC_SEQ; L = DEC_SEQ; hist = A.in[I_SCB] + (size_t)(l * DB + s) * 512; so = A.out + O_CBS + (size_t)(l * DB + s) * 512; }
        float cx[3][8];
#pragma unroll
        for (int j = 0; j < 3; ++j) { const int tt = t - 2 + j;
            if (tt >= 0) { const bf16* r = proj + (size_t)(m - 2 + j) * NPROJ; const v4u cg = *(const v4u*)(r + PC_CG + c), xc = *(const v4u*)(r + PC_XC + c);
                cx[j][0] = bflo(cg.x) * bflo(xc.x); cx[j][1] = bfhi(cg.x) * bfhi(xc.x); cx[j][2] = bflo(cg.y) * bflo(xc.y); cx[j][3] = bfhi(cg.y) * bfhi(xc.y);
                cx[j][4] = bflo(cg.z) * bflo(xc.z); cx[j][5] = bfhi(cg.z) * bfhi(xc.z); cx[j][6] = bflo(cg.w) * bflo(xc.w); cx[j][7] = bfhi(cg.w) * bfhi(xc.w); }
            else if (hist) { const f32x4 h0 = *(const f32x4*)(hist + (2 + tt) * 256 + c), h1 = *(const f32x4*)(hist + (2 + tt) * 256 + c + 4);
#pragma unroll
                for (int e = 0; e < 4; ++e) { cx[j][e] = h0[e]; cx[j][4 + e] = h1[e]; } }
            else {
#pragma unroll
                for (int e = 0; e < 8; ++e) cx[j][e] = 0.f; } }
        const v4u bg = *(const v4u*)(proj + (size_t)m * NPROJ + PC_BG + c);
        const float bgf[8] = {bflo(bg.x), bfhi(bg.x), bflo(bg.y), bfhi(bg.y), bflo(bg.z), bfhi(bg.z), bflo(bg.w), bfhi(bg.w)};
        float o[8];
#pragma unroll
        for (int e = 0; e < 8; ++e) o[e] = bgf[e] * (w[c + e] * cx[0][e] + w[256 + c + e] * cx[1][e] + w[512 + c + e] * cx[2][e]);
        v4u ov; ov.x = pk2(o[0], o[1]); ov.y = pk2(o[2], o[3]); ov.z = pk2(o[4], o[5]); ov.w = pk2(o[6], o[7]);
        *(v4u*)(wsb(A, WS_Y) + (size_t)m * D + 256 + c) = ov;
        if (t >= L - 2) { float* sp = so + (t - (L - 2)) * 256 + c; *(f32x4*)sp = (f32x4){cx[2][0], cx[2][1], cx[2][2], cx[2][3]}; *(f32x4*)(sp + 4) = (f32x4){cx[2][4], cx[2][5], cx[2][6], cx[2][7]}; }
    }
}
__device__ __forceinline__ void ph_gdn_c1(const Args& A, LAS unsigned char* lds, int l) {
    TIDS;
    constexpr int XS = 72, GS = 68, RS = 132;
    LAS bf16* Qs = (LAS bf16*)lds; LAS bf16* Ks = Qs + 64 * XS; LAS bf16* Vs = Ks + 64 * XS;
    LAS float* GKK = (LAS float*)(lds + 27648); LAS float* GQK = GKK + 64 * GS; LAS float* rhs = GQK + 64 * GS;
    LAS float* Linv = rhs + 64 * RS; LAS float* sc = Linv + 1024;
    LAS float* DQ = sc, *DK = sc + 64, *RQ = sc + 128, *RK = sc + 192, *BET = sc + 256, *GC = sc + 320, *EGC = sc + 384, *EK = sc + 448;
    LAS float* Wst = GQK;
    const bf16* proj = wsb(A, WS_PROJ); const float* cw = A.in[I_DCW] + (size_t)l * 4 * GQKV; const float* lg8 = wsf(A, WS_LOG8);
    const int g = lane >> 4, i16 = lane & 15;
    for (int un = bid; un < NB * GH * GNCH; un += G) {
        const int c = un % GNCH, h = (un / GNCH) % GH, b = un / (GNCH * GH); const int m0 = b * SEQ + c * GCH;
        unsigned char* gd = A.ws + WS_GD + (size_t)un * GD_UNIT;
        if (wave < 6) { const int sec = wave >> 1, th = wave & 1, src = sec * 256 + h * 64 + lane, t0 = c * GCH + th * 32;
            const float w0 = cw[src], w1 = cw[GQKV + src], w2 = cw[2 * GQKV + src], w3 = cw[3 * GQKV + src];
            float x[35];
#pragma unroll
            for (int k = 0; k < 35; ++k) { const int tt = t0 - 3 + k; x[k] = tt >= 0 ? bf2f(proj[(size_t)(b * SEQ + tt) * NPROJ + PC_QKV + src]) : 0.f; }
            LAS bf16* X = sec == 0 ? Qs : (sec == 1 ? Ks : Vs);
#pragma unroll
            for (int k = 0; k < 32; ++k) X[(th * 32 + k) * XS + lane] = (bf16)f2bf(siluf_(w0 * x[k] + w1 * x[k + 1] + w2 * x[k + 2] + w3 * x[k + 3]));
            if (c == GNCH - 1 && th == 1) {
#pragma unroll
                for (int k = 0; k < 3; ++k) A.out[O_CDP + ((size_t)(l * NB + b) * 3 + k) * GQKV + src] = x[32 + k]; } }
        __syncthreads();
#pragma unroll
        for (int q2 = 0; q2 < 2; ++q2) { const int tt = 2 * wave + q2, rt = tt >> 2, ct = tt & 3;
            f32x4 akk = {0.f, 0.f, 0.f, 0.f}, aqk = {0.f, 0.f, 0.f, 0.f};
#pragma unroll
            for (int s = 0; s < 2; ++s) { const bf16x8 kc = *(const LAS bf16x8*)(Ks + (16 * ct + i16) * XS + 32 * s + 8 * g), kr = *(const LAS bf16x8*)(Ks + (16 * rt + i16) * XS + 32 * s + 8 * g),
                                                         qr = *(const LAS bf16x8*)(Qs + (16 * rt + i16) * XS + 32 * s + 8 * g);
                akk = __builtin_amdgcn_mfma_f32_16x16x32_bf16(kr, kc, akk, 0, 0, 0); aqk = __builtin_amdgcn_mfma_f32_16x16x32_bf16(qr, kc, aqk, 0, 0, 0); }
#pragma unroll
            for (int r = 0; r < 4; ++r) { GKK[(16 * rt + 4 * g + r) * GS + 16 * ct + i16] = akk[r]; GQK[(16 * rt + 4 * g + r) * GS + 16 * ct + i16] = aqk[r]; }
            if (rt == ct && g == (i16 >> 2)) { const int r = i16 & 3; DK[16 * rt + i16] = r == 0 ? akk[0] : r == 1 ? akk[1] : r == 2 ? akk[2] : akk[3]; } }
        if (wave < 4) { f32x4 aqq = {0.f, 0.f, 0.f, 0.f};
#pragma unroll
            for (int s = 0; s < 2; ++s) { const bf16x8 qr = *(const LAS bf16x8*)(Qs + (16 * wave + i16) * XS + 32 * s + 8 * g); aqq = __builtin_amdgcn_mfma_f32_16x16x32_bf16(qr, qr, aqq, 0, 0, 0); }
            if (g == (i16 >> 2)) { const int r = i16 & 3; DQ[16 * wave + i16] = r == 0 ? aqq[0] : r == 1 ? aqq[1] : r == 2 ? aqq[2] : aqq[3]; } }
        __syncthreads();
        if (wave == 0) { const float* lr = lg8 + (size_t)(m0 + lane) * 8;
            const float gv = -__expf(A.in[I_DAL][l * 4 + h]) * softplusf_(lr[4 + h] + A.in[I_DDT][l * 4 + h]);
            float gc = gv;
#pragma unroll
            for (int o = 1; o < 64; o <<= 1) { const float t = __shfl_up(gc, o); if (lane >= o) gc += t; }
            const float gl = __shfl(gc, 63);
            RK[lane] = 1.0f / sqrtf(DK[lane] + RMS_EPS); RQ[lane] = 0.125f / sqrtf(DQ[lane] + RMS_EPS); BET[lane] = sigmoidf_(lr[h]); GC[lane] = gc; EGC[lane] = __expf(gc); EK[lane] = __expf(gl - gc);
            if (lane == 0) wsf(A, WS_EGL)[un] = __expf(gl); }
        __syncthreads();
        for (int idx = tid; idx < 4096; idx += 512) { const int i = idx >> 6, j = idx & 63; GKK[i * GS + j] = i > j ? BET[i] * RK[i] * RK[j] * GKK[i * GS + j] * __expf(GC[i] - GC[j]) : 0.f; }
        for (int idx = tid; idx < 64 * 128; idx += 512) { const int i = idx >> 7, cc = idx & 127; rhs[i * RS + cc] = cc < 64 ? BET[i] * bf2f(Vs[i * XS + cc]) : BET[i] * EGC[i] * RK[i] * bf2f(Ks[i * XS + cc - 64]); }
        for (int idx = tid; idx < 4096; idx += 512) { const int f = idx >> 9, ln = (idx >> 3) & 63, j = idx & 7, row = 16 * (f >> 1) + (ln & 15), kx = 32 * (f & 1) + 16 * (j >> 2) + 4 * (ln >> 4) + (j & 3);
            ((bf16*)gd)[8192 + idx] = (bf16)f2bf(row >= kx ? RQ[row] * RK[kx] * GQK[row * GS + kx] * __expf(GC[row] - GC[kx]) : 0.f);
            ((bf16*)gd)[4096 + idx] = (bf16)f2bf(bf2f(Qs[row * XS + kx]) * RQ[row] * EGC[row]);
            ((bf16*)gd)[12288 + idx] = (bf16)f2bf(bf2f(Ks[kx * XS + row]) * RK[kx] * EK[kx]); }
        __syncthreads();
        if (wave == 0) { const int blk = lane >> 4, cI = lane & 15; float x[16];
            x[0] = cI == 0 ? 1.f : 0.f;
#pragma unroll
            for (int i = 1; i < 16; ++i) { float sacc = cI == i ? 1.f : 0.f;
#pragma unroll
                for (int j = 0; j < i; ++j) sacc -= GKK[(16 * blk + i) * GS + 16 * blk + j] * x[j];
                x[i] = sacc; }
#pragma unroll
            for (int i = 0; i < 16; ++i) Linv[blk * 256 + i * 16 + cI] = x[i]; }
        __syncthreads();
        { const f32x4 Z = {0.f, 0.f, 0.f, 0.f}; f32x4 X[4];
#define C1_LD4(p) ((f32x4)(*(const LAS f32x4*)(p)) * 1.0f)
#define C1_LF(I) acc2b(C1_LD4(Linv + (I) * 256 + i16 * 16 + 4 * g), Z)
#define C1_MF2(I, J) acc2b(-*(const LAS f32x4*)(GKK + (16 * (I) + i16) * GS + 16 * (J) + 4 * g), -*(const LAS f32x4*)(GKK + (16 * (I) + i16) * GS + 16 * ((J) + 1) + 4 * g))
#define C1_MF1(I, J) acc2b(-*(const LAS f32x4*)(GKK + (16 * (I) + i16) * GS + 16 * (J) + 4 * g), Z)
#define C1_R(I) (f32x4){rhs[(16 * (I) + 4 * g) * RS + 16 * wave + i16], rhs[(16 * (I) + 4 * g + 1) * RS + 16 * wave + i16], rhs[(16 * (I) + 4 * g + 2) * RS + 16 * wave + i16], rhs[(16 * (I) + 4 * g + 3) * RS + 16 * wave + i16]}
            f32x4 R = C1_R(0);
            X[0] = __builtin_amdgcn_mfma_f32_16x16x32_bf16(C1_LF(0), acc2b(R, Z), Z, 0, 0, 0);
            R = C1_R(1); R = __builtin_amdgcn_mfma_f32_16x16x32_bf16(C1_MF1(1, 0), acc2b(X[0], Z), R, 0, 0, 0);
            X[1] = __builtin_amdgcn_mfma_f32_16x16x32_bf16(C1_LF(1), acc2b(R, Z), Z, 0, 0, 0);
            const bf16x8 X01 = acc2b(X[0], X[1]);
            R = C1_R(2); R = __builtin_amdgcn_mfma_f32_16x16x32_bf16(C1_MF2(2, 0), X01, R, 0, 0, 0);
            X[2] = __builtin_amdgcn_mfma_f32_16x16x32_bf16(C1_LF(2), acc2b(R, Z), Z, 0, 0, 0);
            R = C1_R(3); R = __builtin_amdgcn_mfma_f32_16x16x32_bf16(C1_MF2(3, 0), X01, R, 0, 0, 0); R = __builtin_amdgcn_mfma_f32_16x16x32_bf16(C1_MF1(3, 2), acc2b(X[2], Z), R, 0, 0, 0);
            X[3] = __builtin_amdgcn_mfma_f32_16x16x32_bf16(C1_LF(3), acc2b(R, Z), Z, 0, 0, 0);
#undef C1_LF
#undef C1_LD4
#undef C1_MF2
#undef C1_MF1
#undef C1_R
            if (wave < 4) {
#pragma unroll
                for (int I = 0; I < 4; ++I) ((f32x4*)(gd + 32768))[(wave * 4 + I) * 64 + lane] = X[I]; }
            else {
#pragma unroll
                for (int I = 0; I < 4; ++I)
#pragma unroll
                    for (int r = 0; r < 4; ++r) Wst[(16 * I + 4 * g + r) * GS + 16 * (wave - 4) + i16] = -X[I][r]; } }
        __syncthreads();
        for (int idx = tid; idx < 4096; idx += 512) { const int f = idx >> 9, ln = (idx >> 3) & 63, j = idx & 7, row = 16 * (f >> 1) + (ln & 15), kx = 32 * (f & 1) + 16 * (j >> 2) + 4 * (ln >> 4) + (j & 3);
            ((bf16*)gd)[idx] = (bf16)f2bf(Wst[row * GS + kx]); }
        __syncthreads();
    }
}
__device__ __forceinline__ void ph_gdn_scan(const Args& A, LAS unsigned char* lds, int l) {
    TIDS;
    for (int grp2 = bid; grp2 < NB * GH * 2; grp2 += G) {
        const int grp = grp2 >> 1, half = grp2 & 1, h = grp % GH, b = grp / GH;
        const unsigned char* gbase = A.ws + WS_GD + (size_t)(b * GH + h) * GNCH * GD_UNIT;
        LAS float* egt = (LAS float*)(lds + 2 * GD_UNIT);
        if (wave >= 4) {
            const int lw = wave - 4; v4u r0[12], r1[12], r2[12], r3[12];
            const v4u* src = (const v4u*)gbase + lw * 12 * 64 + lane;
            LAS v4u* dst0 = (LAS v4u*)lds + lw * 12 * 64 + lane;
#define SC_LOAD(R, c) do { const int c_ = (c) < GNCH ? (c) : GNCH - 1; _Pragma("unroll") for (int k = 0; k < 12; ++k) R[k] = src[(size_t)c_ * (GD_UNIT / 16) + k * 64]; } while (0)
#define SC_STORE(R, c) do { LAS v4u* d_ = dst0 + ((c) & 1) * (GD_UNIT / 16); _Pragma("unroll") for (int k = 0; k < 12; ++k) d_[k * 64] = R[k]; } while (0)
            SC_LOAD(r0, 0); SC_STORE(r0, 0); SC_LOAD(r1, 1); SC_LOAD(r2, 2); SC_LOAD(r3, 3); SC_LOAD(r0, 4);
            if (lw == 0) { for (int k = lane; k < GNCH; k += 64) egt[k] = wsf(A, WS_EGL)[(size_t)(b * GH + h) * GNCH + k]; }
            RAW_BAR();
            for (int c = 0; c < GNCH; c += 4) {
                SC_STORE(r1, c + 1); SC_LOAD(r1, c + 5); RAW_BAR();
                SC_STORE(r2, c + 2); SC_LOAD(r2, c + 6); RAW_BAR();
                SC_STORE(r3, c + 3); SC_LOAD(r3, c + 7); RAW_BAR();
                SC_STORE(r0, c + 4); SC_LOAD(r0, c + 8); RAW_BAR();
            }
#undef SC_LOAD
#undef SC_STORE
        } else {
            const int vs = half * 2 + (wave & 1), g = lane >> 4, cc = lane & 15; const bool act = wave < 2;
            f32x4 S[4];
#pragma unroll
            for (int T = 0; T < 4; ++T) S[T] = (f32x4){0.f, 0.f, 0.f, 0.f};
            RAW_BAR();
            for (int c = 0; c < GNCH; ++c) {
                const float egl = egt[c];
                if (act) {
                const LAS unsigned char* slot = lds + (c & 1) * GD_UNIT;
                const LAS bf16x8* fr = (const LAS bf16x8*)slot + lane;
                const LAS f32x4* uvp = (const LAS f32x4*)(slot + 32768) + (vs * 4) * 64 + lane;
                bf16x8 F[4][8]; f32x4 u[4], o[4];
#pragma unroll
                for (int x = 0; x < 4; ++x)
#pragma unroll
                    for (int f = 0; f < 8; ++f) F[x][f] = fr[(x * 8 + f) * 64];
#pragma unroll
                for (int T = 0; T < 4; ++T) u[T] = uvp[T * 64];
                CFENCE();
                bf16x8 Sb[2] = {acc2b(S[0], S[1]), acc2b(S[2], S[3])};
#pragma unroll
                for (int T = 0; T < 4; ++T) { o[T] = (f32x4){0.f, 0.f, 0.f, 0.f};
#pragma unroll
                    for (int s = 0; s < 2; ++s) { u[T] = __builtin_amdgcn_mfma_f32_16x16x32_bf16(F[0][2 * T + s], Sb[s], u[T], 0, 0, 0); o[T] = __builtin_amdgcn_mfma_f32_16x16x32_bf16(F[1][2 * T + s], Sb[s], o[T], 0, 0, 0); } }
                bf16x8 ub[2] = {acc2b(u[0], u[1]), acc2b(u[2], u[3])};
#pragma unroll
                for (int T = 0; T < 4; ++T) { S[T] = S[T] * egl;
#pragma unroll
                    for (int s = 0; s < 2; ++s) { S[T] = __builtin_amdgcn_mfma_f32_16x16x32_bf16(F[3][2 * T + s], ub[s], S[T], 0, 0, 0); o[T] = __builtin_amdgcn_mfma_f32_16x16x32_bf16(F[2][2 * T + s], ub[s], o[T], 0, 0, 0); } }
                float* od = wsf(A, WS_ODRAW) + (size_t)(b * SEQ + c * GCH + 4 * g) * 256 + h * 64 + vs * 16 + cc;
#pragma unroll
                for (int T = 0; T < 4; ++T)
#pragma unroll
                    for (int r = 0; r < 4; ++r) od[(size_t)(16 * T + r) * 256] = o[T][r];
                }
                RAW_BAR();
            }
            if (act) {
            float* so = A.out + O_DP + (((size_t)(l * NB + b) * GH + h) * 64 + 4 * g) * 64 + vs * 16 + cc;
#pragma unroll
            for (int T = 0; T < 4; ++T)
#pragma unroll
                for (int r = 0; r < 4; ++r) so[(16 * T + r) * 64] = S[T][r];
            }
        }
        __syncthreads();
    }
}
__device__ __forceinline__ void ph_gdn_sample(const Args& A, LAS unsigned char* lds, int l, int vb, int vg) {
    TIDSV(vb, vg);
    if (wave < 2 || wave >= 7) return;
    LAS float* S = (LAS float*)(lds + 40960 + (wave - 2) * 16384);
    LAS float* kq = (LAS float*)(lds + MISC_OFF + 1024 + wave * 512);
    const bf16* proj = wsb(A, WS_PROJ); const float* cw = A.in[I_DCW] + (size_t)l * 4 * GQKV; const float* lg8 = wsf(A, WS_LOG8);
    for (int un = (wave - 2) * G + bid; un < DB * GH; un += 5 * G) {
        const int h = un % GH, s = un / GH;
        const float* s0 = A.in[I_SD] + ((size_t)(l * DB + s) * GH + h) * 4096;
        const float* hist = A.in[I_SCD] + (size_t)(l * DB + s) * 3 * GQKV;
        float xr[3][7];
#pragma unroll
        for (int sec = 0; sec < 3; ++sec) { const int src = sec * 256 + h * 64 + lane;
#pragma unroll
            for (int j = 0; j < 3; ++j) xr[sec][j] = hist[j * GQKV + src];
#pragma unroll
            for (int t = 0; t < 4; ++t) xr[sec][3 + t] = bf2f(proj[(size_t)(MP + s * DEC_SEQ + t) * NPROJ + PC_QKV + src]); }
        float lgb[4], lga[4];
#pragma unroll
        for (int t = 0; t < 4; ++t) { const float* lr = lg8 + ((size_t)MP + s * DEC_SEQ + t) * 8; lgb[t] = lr[h]; lga[t] = lr[4 + h]; }
#pragma unroll 16
        for (int kk = 0; kk < 64; ++kk) S[kk * 64 + lane] = s0[kk * 64 + lane];
        const float al = __expf(A.in[I_DAL][l * 4 + h]), dtb = A.in[I_DDT][l * 4 + h];
#pragma unroll
        for (int t = 0; t < DEC_SEQ; ++t) {
            const size_t m = (size_t)MP + s * DEC_SEQ + t;
            float val[3];
#pragma unroll
            for (int sec = 0; sec < 3; ++sec) { const int src = sec * 256 + h * 64 + lane;
                val[sec] = siluf_(cw[src] * xr[sec][t] + cw[GQKV + src] * xr[sec][t + 1] + cw[2 * GQKV + src] * xr[sec][t + 2] + cw[3 * GQKV + src] * xr[sec][t + 3]);
                if (t >= 1) A.out[O_CDS + ((size_t)(l * DB + s) * 3 + (t - 1)) * GQKV + src] = xr[sec][t + 3]; }
            const float sq = wave_sum(val[0] * val[0]), sk = wave_sum(val[1] * val[1]);
            const float qv = val[0] * (1.0f / sqrtf(sq + RMS_EPS)) * 0.125f, kv = val[1] * (1.0f / sqrtf(sk + RMS_EPS)), vv = val[2];
            const float beta = sigmoidf_(lgb[t]); const float xs = lga[t] + dtb; const float a = __expf(-al * (fmaxf(xs, 0.f) + __logf(1.0f + __expf(-fabsf(xs)))));
            kq[lane] = kv; kq[64 + lane] = qv;
            WAVE_SYNC();
            float kS = 0.f;
#pragma unroll 16
            for (int kk = 0; kk < 64; ++kk) kS += kq[kk] * S[kk * 64 + lane];
            float o = 0.f;
#pragma unroll 16
            for (int kk = 0; kk < 64; ++kk) { const float bk = beta * kq[kk]; const float sn = a * (S[kk * 64 + lane] - bk * kS) + bk * vv; S[kk * 64 + lane] = sn; o += kq[64 + kk] * sn; }
            wsf(A, WS_ODRAW)[m * 256 + h * 64 + lane] = o;
            WAVE_SYNC();
        }
        float* so = A.out + O_DS + ((size_t)(l * DB + s) * GH + h) * 4096;
#pragma unroll 16
        for (int kk = 0; kk < 64; ++kk) so[kk * 64 + lane] = S[kk * 64 + lane];
    }
}
__device__ __forceinline__ void ph_gdn_out(const Args& A, int l) {
    TIDS;
    const int sub = lane >> 4, c4 = (lane & 15) * 4;
    const f32x4 nw = *(const f32x4*)(A.in[I_DNW] + l * 64 + c4);
    for (int idx = gw * 4 + sub; idx < M * GH; idx += NGW * 4) { const size_t m = idx >> 2; const int h = idx & 3;
        const f32x4 o = *(const f32x4*)(wsf(A, WS_ODRAW) + m * 256 + h * 64 + c4);
        float ss = (o[0] * o[0] + o[1] * o[1]) + (o[2] * o[2] + o[3] * o[3]);
        ss += __shfl_xor(ss, 1); ss += __shfl_xor(ss, 2); ss += __shfl_xor(ss, 4); ss += __shfl_xor(ss, 8);
        const float rs = 1.0f / sqrtf(ss * (1.0f / 64.0f) + RMS_EPS);
        const v2u zw = *(const v2u*)(wsb(A, WS_PROJ) + m * NPROJ + PC_Z + h * 64 + c4);
        v2u ov; ov.x = pk2(o[0] * rs * nw[0] * siluf_(bflo(zw.x)), o[1] * rs * nw[1] * siluf_(bfhi(zw.x))); ov.y = pk2(o[2] * rs * nw[2] * siluf_(bflo(zw.y)), o[3] * rs * nw[3] * siluf_(bfhi(zw.y)));
        *(v2u*)(wsb(A, WS_Y) + m * D + 512 + h * 64 + c4) = ov; }
}
__device__ __forceinline__ void sb_terms(float z, float& ls, float& ln) { const float L = log1pf(__expf(-fabsf(z))); ls = fminf(z, 0.f) - L; ln = -fmaxf(z, 0.f) - L; }
constexpr float SB_CUT = -105.0f;
__device__ __forceinline__ void ph_sb_prompt(const Args& A, int l, int vb, int vg) {
    TIDSV(vb, vg); (void)l;
    const bf16* proj = wsb(A, WS_PROJ); const bf16* vtg = wsb(A, WS_VT);
    constexpr int NQB = SEQ / 32;
    const int g = lane >> 4, i16 = lane & 15;
    for (int un0 = gw; un0 < NB * SBH * NQB; un0 += NGW) {
        const int un = NB * SBH * NQB - 1 - un0;
        const int qb = un / (NB * SBH), h = un % SBH, b = (un / SBH) % NB;
        const int q0 = qb * 32;
        bf16x8 Qb[2][2];
#pragma unroll
        for (int ct = 0; ct < 2; ++ct)
#pragma unroll
            for (int s = 0; s < 2; ++s) Qb[ct][s] = *(const bf16x8*)(proj + ((size_t)b * SEQ + q0 + 16 * ct + i16) * NPROJ + PC_Q + h * 64 + 32 * s + 8 * g);
        f32x4 O[4][2];
#pragma unroll
        for (int rt = 0; rt < 4; ++rt) { O[rt][0] = (f32x4){0.f, 0.f, 0.f, 0.f}; O[rt][1] = (f32x4){0.f, 0.f, 0.f, 0.f}; }
        float R[2] = {0.f, 0.f};
        const bf16* vth = vtg + ((size_t)(b * SBH + h) * 64) * SEQ;
        for (int kb = q0 >> 6; kb >= 0; --kb) {
            const int k0 = kb * 64;
            bf16x8 Ka[4][2], Va[4][2];
#pragma unroll
            for (int T = 0; T < 4; ++T)
#pragma unroll
                for (int s = 0; s < 2; ++s) { Ka[T][s] = *(const bf16x8*)(proj + ((size_t)b * SEQ + k0 + 16 * (i16 >> 2) + 4 * T + (i16 & 3)) * NPROJ + PC_K + h * 64 + 32 * s + 8 * g);
                                              Va[T][s] = *(const bf16x8*)(vth + (size_t)(16 * T + i16) * SEQ + k0 + 16 * g + 8 * s); }
            const bool diag = (k0 + 63 >= q0);
#pragma unroll
            for (int ct = 0; ct < 2; ++ct) {
                f32x4 z[4];
#pragma unroll
                for (int T = 0; T < 4; ++T) { z[T] = (f32x4){0.f, 0.f, 0.f, 0.f};
#pragma unroll
                    for (int s = 0; s < 2; ++s) z[T] = __builtin_amdgcn_mfma_f32_16x16x32_bf16(Ka[T][s], Qb[ct][s], z[T], 0, 0, 0); }
                const int qi = q0 + 16 * ct + i16;
                float run = 0.f; f32x4 lsv[4], sfx[4];
#pragma unroll
                for (int T = 3; T >= 0; --T)
#pragma unroll
                    for (int r = 3; r >= 0; --r) { const float zz = z[T][r] * 0.125f; const float L = __logf(1.0f + __expf(-fabsf(zz))); const float ls = fminf(zz, 0.f) - L;
                        const bool valid = !diag || (k0 + 16 * g + 4 * T + r) < qi;
                        lsv[T][r] = valid ? ls : -1e30f; sfx[T][r] = run; run += valid ? (ls - zz) : 0.f; }
                const float p1 = __shfl_down(run, 16), p2 = __shfl_down(run, 32), p3 = __shfl_down(run, 48);
                const float gs = (g < 3 ? p1 : 0.f) + (g < 2 ? p2 : 0.f) + (g < 1 ? p3 : 0.f);
                float tot = run + __shfl_xor(run, 16); tot += __shfl_xor(tot, 32);
                const float base = R[ct] + gs;
#pragma unroll
                for (int T = 0; T < 4; ++T)
#pragma unroll
                    for (int r = 0; r < 4; ++r) z[T][r] = __expf(lsv[T][r] + base + sfx[T][r]);
                R[ct] += tot;
                const bf16x8 Wb0 = acc2b(z[0], z[1]), Wb1 = acc2b(z[2], z[3]);
#pragma unroll
                for (int rt = 0; rt < 4; ++rt) { O[rt][ct] = __builtin_amdgcn_mfma_f32_16x16x32_bf16(Va[rt][0], Wb0, O[rt][ct], 0, 0, 0); O[rt][ct] = __builtin_amdgcn_mfma_f32_16x16x32_bf16(Va[rt][1], Wb1, O[rt][ct], 0, 0, 0); }
            }
            if (!diag && __all(R[0] < SB_CUT && R[1] < SB_CUT)) break;
        }
#pragma unroll
        for (int ct = 0; ct < 2; ++ct)
#pragma unroll
            for (int rt = 0; rt < 4; ++rt) { v2u o; o.x = pk2(O[rt][ct][0], O[rt][ct][1]); o.y = pk2(O[rt][ct][2], O[rt][ct][3]);
                *(v2u*)(wsb(A, WS_Y) + ((size_t)b * SEQ + q0 + 16 * ct + i16) * D + 768 + h * 64 + 16 * rt + 4 * g) = o; }
    }
}
__device__ __forceinline__ void ph_sb_sample(const Args& A, LAS unsigned char* lds, int l, int vb, int vg) {
    TIDSV(vb, vg);
    if (wave >= 2) return;
    LAS float* vt = (LAS float*)(lds + wave * 20480);
    LAS float* qs = vt + 64 * 68;
    LAS float* wq = qs + 256;
    const bf16* proj = wsb(A, WS_PROJ); const int* pt = (const int*)A.in[I_PT];
    for (int un = wave * G + bid; un < DB * SBH; un += 2 * G) {
        const int h = un % SBH, s = un / SBH;
#pragma unroll
        for (int qi = 0; qi < 4; ++qi) qs[qi * 64 + lane] = bf2f(proj[((size_t)MP + s * DEC_SEQ + qi) * NPROJ + PC_Q + h * 64 + lane]) * 0.125f;
        WAVE_SYNC();
        float R[4] = {0.f, 0.f, 0.f, 0.f}; f32x4 acc = {0.f, 0.f, 0.f, 0.f};
        const int qi_b = lane & 3, ds = lane >> 2;
        for (int tile = 0; tile * 64 < PAST + DEC_SEQ; ++tile) {
            const int p = PAST + DEC_SEQ - 1 - (tile * 64 + lane);
            f32x4 kr[16], vr[16];
            if (p >= PAST) { const bf16* rp = proj + ((size_t)MP + s * DEC_SEQ + (p - PAST)) * NPROJ + h * 64;
#pragma unroll
                for (int x = 0; x < 8; ++x) { const v4u kw = ((const v4u*)(rp + PC_K))[x], vw = ((const v4u*)(rp + PC_V))[x];
                    kr[2 * x] = (f32x4){bflo(kw.x), bfhi(kw.x), bflo(kw.y), bfhi(kw.y)}; kr[2 * x + 1] = (f32x4){bflo(kw.z), bfhi(kw.z), bflo(kw.w), bfhi(kw.w)};
                    vr[2 * x] = (f32x4){bflo(vw.x), bfhi(vw.x), bflo(vw.y), bfhi(vw.y)}; vr[2 * x + 1] = (f32x4){bflo(vw.z), bfhi(vw.z), bflo(vw.w), bfhi(vw.w)}; } }
            else if (p >= 0) { const int page = pt[s * NPAGES + p / PAGE]; const size_t off = ((((size_t)l * NPOOL + page) * PAGE + p % PAGE) * SBH + h) * 64;
#pragma unroll
                for (int x = 0; x < 16; ++x) { kr[x] = ((const f32x4*)(A.in[I_CK] + off))[x]; vr[x] = ((const f32x4*)(A.in[I_CV] + off))[x]; } }
            else {
#pragma unroll
                for (int x = 0; x < 16; ++x) { kr[x] = (f32x4){0.f, 0.f, 0.f, 0.f}; vr[x] = (f32x4){0.f, 0.f, 0.f, 0.f}; } }
#pragma unroll
            for (int x = 0; x < 16; ++x) *(LAS f32x4*)(vt + lane * 68 + 4 * x) = vr[x];
#pragma unroll
            for (int qi = 0; qi < 4; ++qi) { float z = 0.f;
#pragma unroll
                for (int x = 0; x < 16; ++x) { const f32x4 qv = *(const LAS f32x4*)(qs + qi * 64 + 4 * x); z += (kr[x][0] * qv[0] + kr[x][1] * qv[1]) + (kr[x][2] * qv[2] + kr[x][3] * qv[3]); }
                float ls, ln; sb_terms(z, ls, ln);
                const bool valid = p >= 0 && p < PAST + qi; const float lnv = valid ? ln : 0.f;
                float incl = lnv;
#pragma unroll
                for (int o = 1; o < 64; o <<= 1) { const float t = __shfl_up(incl, o); if (lane >= o) incl += t; }
                wq[qi * 64 + lane] = valid ? __expf(ls + R[qi] + (incl - lnv)) : 0.f;
                R[qi] += __shfl(incl, 63); }
            WAVE_SYNC();
#pragma unroll 8
            for (int key = 0; key < 64; ++key) acc += *(const LAS f32x4*)(vt + key * 68 + 4 * ds) * wq[qi_b * 64 + key];
            WAVE_SYNC();
            if (R[0] < SB_CUT && R[1] < SB_CUT && R[2] < SB_CUT && R[3] < SB_CUT) break;
        }
        v2u o; o.x = pk2(acc[0], acc[1]); o.y = pk2(acc[2], acc[3]);
        *(v2u*)(wsb(A, WS_Y) + ((size_t)MP + s * DEC_SEQ + qi_b) * D + 768 + h * 64 + ds * 4) = o;
    }
}
constexpr int PH_PER_LAYER = 12, NPHASE = 2 + PH_PER_LAYER * DEPTH;
#ifndef DUP_MASK
#define DUP_MASK 0
#endif
#if DUP_MASK
__device__ __forceinline__ int rep_n(int k) { int n = ((DUP_MASK >> k) & 1) ? 2 : 1; asm volatile("" : "+s"(n)); return n; }
#define REP(k) _Pragma("nounroll") for (int rep_ = 0, repn_ = rep_n(k); rep_ < repn_; ++rep_)
#else
#define REP(k)
#endif
#ifndef PROBE_LAST
#define PROBE_LAST 0
#endif
#ifndef TIME_SUB
#define TIME_SUB 0
#endif
#ifndef TIME_MASK
#define TIME_MASK 0
#endif
#ifndef MK_N_LAUNCHES
#define MK_N_LAUNCHES 1
#endif
__global__ void __launch_bounds__(NWAVES * 64, 2) fwd_kernel(Args A) {
#ifndef CPU_EMU
    extern __shared__ __attribute__((aligned(16))) unsigned char lds_raw[];
    LAS unsigned char* lds = (LAS unsigned char*)lds_raw;
    volatile LAS unsigned* MISC = (volatile LAS unsigned*)(lds + MISC_OFF);
    for (int u = threadIdx.x; u < (LDS_BYTES - MISC_OFF) / 4; u += NWAVES * 64) ((LAS unsigned*)(lds + MISC_OFF))[u] = 0u;
    __syncthreads();
    XcdBarrier bar; bar.bar = (unsigned*)(A.ws + WS_CTL) + CW_BAR + A.li * XCD_BAR_WORDS; bar.x = 0; bar.st = nullptr;
    if (A.ph_hi - A.ph_lo > 1) bar = xcd_barrier_post((unsigned*)(A.ws + WS_CTL) + CW_BAR + A.li * XCD_BAR_WORDS, MISC + 8);
#else
    unsigned char* lds = emu::B->lds; XcdBarrier bar{0};
#endif
    const int lo = A.ph_lo, hi = A.ph_hi, G = gridDim.x, bid = blockIdx.x;
#define IN(k) (lo <= (k) && (k) < hi)
#if TIME_MASK || TIME_SUB
    unsigned long long tp_ = __builtin_amdgcn_s_memrealtime(), tacc_ = 0;
#define SEAM(k) do { if (IN((k) + 1)) xcd_barrier(bar); { const unsigned long long tn_ = __builtin_amdgcn_s_memrealtime(); if ((TIME_MASK >> (k)) & 1) tacc_ += tn_ - tp_; tp_ = tn_; } } while (0)
#else
#define SEAM(k) do { if (IN((k) + 1)) xcd_barrier(bar); } while (0)
#endif
    if (IN(0)) { REP(9) ph_prologue(A, lds); ph_ssm_weights(A); SEAM(0); }
    if (IN(1)) {
        pg8::Gemm g{wsb(A, WS_CSILU), (const bf16*)(A.ws + WS_W + WL_ADA), D, D, D}; ModOrder S{G, bid}; EpiMod2 E{wsf(A, WS_MOD), A.in[I_BADA]};
        pg8::gemm_phase<EpiMod2, ModOrder, true, true>(lds, g, S, E); SEAM(1);
    }
    for (int l = 0; l < DEPTH; ++l) {
        const int pb = 2 + PH_PER_LAYER * l;
        unsigned char* wl = A.ws + WS_W + (size_t)l * WL_SIZE;
        if (IN(pb + 0)) { if (l == 0) ph_rows<0>(A, 0); SEAM(pb + 0); }
        if (IN(pb + 1)) {
            pg8::Gemm g{wsb(A, WS_H), (const bf16*)(wl + WL_W1), D, D, D}; pg8::GridOrder S; S.init(M / 256, N1 / 256, G, bid);
            pg8::EpiProj E{wsb(A, WS_PROJ), wsb(A, WS_GATE), A.out + O_KP + (size_t)l * MP * 256, A.out + O_VP + (size_t)l * MP * 256, A.out + O_KS + (size_t)l * MS * 256, A.out + O_VS + (size_t)l * MS * 256, wsb(A, WS_VT)};
            REP(5) pg8::gemm_phase<pg8::EpiProj, pg8::GridOrder, true, true>(lds, g, S, E); SEAM(pb + 1);
        }
#if TIME_SUB
#define SUBT(k, call) do { const unsigned long long ts_ = __builtin_amdgcn_s_memrealtime(); call; if ((TIME_SUB >> (k)) & 1) tacc_ += __builtin_amdgcn_s_memrealtime() - ts_; } while (0)
#else
#define SUBT(k, call) do { call; } while (0)
#endif
        if (IN(pb + 2)) { SUBT(0, REP(3) ph_gdn_c1(A, lds, l)); SUBT(4, REP(4) ph_ssm1(A, l)); SUBT(6, SEAM(pb + 2)); }
        if (IN(pb + 3)) {
            constexpr int NSC = NB * GH * 2; const bool split = G > NSC + 8; const int vb = split ? bid - NSC : bid, vg = split ? G - NSC : G;
            if (!split || bid < NSC) { SUBT(7, REP(0) ph_gdn_scan(A, lds, l)); }
            if (!split || bid >= NSC) { __syncthreads();
                SUBT(1, REP(2) ph_sb_prompt(A, l, vb, vg)); SUBT(8, REP(4) ph_ssm2(A, lds, l, (vb + vg / 4) % vg, vg)); __syncthreads();
                SUBT(2, REP(10) ph_gdn_sample(A, lds, l, (vb + vg / 2) % vg, vg)); SUBT(3, REP(1) ph_sb_sample(A, lds, l, (vb + (3 * vg) / 4) % vg, vg)); }
            SUBT(9, SEAM(pb + 3)); }
        if (IN(pb + 4)) {
            REP(10) ph_gdn_out(A, l); REP(10) ph_conv(A, l, bid, G);
            pg8::Gemm g{wsb(A, WS_YS), (const bf16*)(wl + WL_GLU), 256, 256, 256}; pg8::GridOrder S; S.init(M / 256, 1, G, (bid + 64) % G);
            pg8::EpiGlu E{wsb(A, WS_YS), wsb(A, WS_Y)};
            REP(8) pg8::gemm_phase<pg8::EpiGlu, pg8::GridOrder, true, true>(lds, g, S, E); SEAM(pb + 4);
        }
        if (IN(pb + 6)) {
            pg8::Gemm g{wsb(A, WS_Y), (const bf16*)(wl + WL_BR), D, 256, 256}; pg8::MergeOrder S; S.init(M / 256, 8, G, bid);
            pg8::EpiMerge E; E.gate = wsb(A, WS_GATE); E.mgb = wsb(A, WS_MERGEB);
            REP(6) pg8::gemm_phase<pg8::EpiMerge, pg8::MergeOrder, true, true, true>(lds, g, S, E); SEAM(pb + 6);
        }
        if (IN(pb + 7)) {
            { pg8::Gemm g{wsb(A, WS_MERGEB), (const bf16*)(wl + WL_WO), D, D, D}; pg8::GridOrder S; S.init(MP / 256, 4, G, bid);
              pg8::EpiRes E{l == 0 ? A.in[I_XP] : wsf(A, WS_X2), l == 0 ? A.in[I_XS] : wsf(A, WS_X2) + (size_t)MP * D, wsf(A, WS_MOD) + (size_t)l * 256 * NMOD + 2 * D, wsf(A, WS_X1)};
              REP(8) pg8::gemm_phase<pg8::EpiRes, pg8::GridOrder, true, true>(lds, g, S, E); }
            { pg8::Gemm g{wsb(A, WS_MERGEB), (const bf16*)(wl + WL_WO), D, D, 256}; pg8::SplitOrder S{G, (bid + 128) % G, MP / 256, MS / 256, 4, 4};
              pg8::EpiPart E{wsf(A, WS_PART)};
              REP(8) pg8::gemm_phase<pg8::EpiPart, pg8::SplitOrder, true, true>(lds, g, S, E); }
            SEAM(pb + 7);
        }
        if (IN(pb + 8)) { ph_rows<1>(A, l); SEAM(pb + 8); }
        if (IN(pb + 9)) {
            pg8::Gemm g{wsb(A, WS_H), (const bf16*)(wl + WL_UP), D, D, D}; pg8::GridOrder S; S.init(M / 256, NUP / 256, G, bid);
            pg8::EpiUp E{wsb(A, WS_ACT)};
            REP(7) pg8::gemm_phase<pg8::EpiUp, pg8::GridOrder, true, true>(lds, g, S, E); SEAM(pb + 9);
        }
        if (IN(pb + 10)) {
            { pg8::Gemm g{wsb(A, WS_ACT), (const bf16*)(wl + WL_DN), DFF, DFF, DFF}; pg8::GridOrder S; S.init(MP / 256, 4, G, bid);
              pg8::EpiRes E{wsf(A, WS_X1), wsf(A, WS_X1) + (size_t)MP * D, wsf(A, WS_MOD) + (size_t)l * 256 * NMOD + 5 * D, wsf(A, WS_X2)};
              REP(7) pg8::gemm_phase<pg8::EpiRes, pg8::GridOrder, true, true>(lds, g, S, E); }
            { pg8::Gemm g{wsb(A, WS_ACT), (const bf16*)(wl + WL_DN), DFF, DFF, 256}; pg8::SplitOrder S{G, (bid + 128) % G, MP / 256, MS / 256, 4, DFF / 256};
              pg8::EpiPart E{wsf(A, WS_PART)};
              REP(7) pg8::gemm_phase<pg8::EpiPart, pg8::SplitOrder, true, true>(lds, g, S, E); }
            SEAM(pb + 10);
        }
        if (IN(pb + 11)) { ph_rows<2>(A, l); SEAM(pb + 11); }
    }
#if TIME_MASK || TIME_SUB
    if (blockIdx.x == (PROBE_LAST == 1 ? gridDim.x - 1 : PROBE_LAST) && threadIdx.x == 0) { const unsigned long long t0_ = __builtin_amdgcn_s_memrealtime(); while (__builtin_amdgcn_s_memrealtime() - t0_ < 4 * tacc_) __builtin_amdgcn_s_sleep(8); }
#endif
#undef IN
#undef SEAM
}
#ifndef CPU_EMU
extern "C" void kernel_launch(void* const* d_in, const int* in_sizes, int n_in, void* d_out, int out_size, void* d_ws, size_t ws_size, hipStream_t stream) {
    static int grid = 0;
    if (grid == 0) {
        if (n_in != 38 || (size_t)out_size != O_END || ws_size < WS_END) { fprintf(stderr, "kernel_launch: unexpected shapes (n_in %d out %d ws %zu; want 38, %zu, >= %zu)\n", n_in, out_size, ws_size, (size_t)O_END, (size_t)WS_END); grid = -1; return; }
        int dev = 0, cus = 0, per_cu = 0;
        if (hipGetDevice(&dev) != hipSuccess || hipDeviceGetAttribute(&cus, hipDeviceAttributeMultiprocessorCount, dev) != hipSuccess) { grid = -1; return; }
        if (hipFuncSetAttribute((const void*)fwd_kernel, hipFuncAttributeMaxDynamicSharedMemorySize, LDS_BYTES) != hipSuccess) { fprintf(stderr, "kernel_launch: hipFuncSetAttribute failed\n"); grid = -1; return; }
        if (hipOccupancyMaxActiveBlocksPerMultiprocessor(&per_cu, (const void*)fwd_kernel, NWAVES * 64, LDS_BYTES) != hipSuccess || per_cu < 1) { fprintf(stderr, "kernel_launch: occupancy query says %d\n", per_cu); }
        (void)hipGetLastError();
        grid = cus;
    }
    if (grid < 0) return;
    if (hipMemsetAsync((char*)d_ws + WS_CTL, 0, CTL_ZERO_BYTES, stream) != hipSuccess) return;
    Args a{};
    for (int i = 0; i < 38; ++i) a.in[i] = (const float*)d_in[i];
    a.out = (float*)d_out; a.ws = (unsigned char*)d_ws;
    if (MK_N_LAUNCHES == 1) { a.ph_lo = 0; a.ph_hi = NPHASE; a.li = 0; hipLaunchKernelGGL(fwd_kernel, dim3(grid), dim3(NWAVES * 64), LDS_BYTES, stream, a); }
    else for (int p = 0; p < NPHASE; ++p) { if (p == 2 + PH_PER_LAYER) continue; a.ph_lo = p; a.ph_hi = p + 1; a.li = 0; hipLaunchKernelGGL(fwd_kernel, dim3(grid), dim3(NWAVES * 64), LDS_BYTES, stream, a); }
}
#endif
```
